# Optimizing an MI355X kernel written in HIP

```python
import jax, jax.numpy as jnp
from jax import lax
import numpy as np

D_MODEL = 1024
BATCH = 2
SEQ = 16384
DEPTH = 2

CHUNK = 64
MIX_WIDTH = D_MODEL
A_HEADS = 4
A_DK = 128
A_DV = 128
B_HEADS = 4
B_DK = 64
B_DV = 128
GLA_RANK = 16
GLA_TAU = 16.0
C_HEADS = 4
C_DK = 64
C_DV = 128
ROPE_BASE = 10000.0
D_WIDTH = 512
D_BLOCKS = 8
D_BLOCK_DIM = D_WIDTH // D_BLOCKS
D_CONV = 4
RGLRU_C = 8.0
MOE_GROUPS = 4
MOE_EXPERTS_PER_GROUP = 8
MOE_N_EXPERTS = MOE_GROUPS * MOE_EXPERTS_PER_GROUP
MOE_TOPK = 2
MOE_DFF = 512
N_EVEN = (DEPTH + 1) // 2
N_ODD = DEPTH // 2
EPS = 1e-6

EVEN_SPLITS = (A_HEADS * A_DK, A_HEADS * A_DK, A_HEADS * A_DV, A_HEADS * A_DV,
               B_HEADS * B_DK, B_HEADS * B_DK, B_HEADS * B_DV, GLA_RANK, B_HEADS * B_DV)
EVEN_IN = sum(EVEN_SPLITS)
ODD_SPLITS = (C_HEADS * C_DK, C_HEADS * C_DK, C_HEADS * C_DV, C_HEADS * C_DV, D_WIDTH, D_WIDTH)
ODD_IN = sum(ODD_SPLITS)

kernel_name = 'hybrid_hgrn2_gla_retnet_rglru_hmoe'


def rms_norm(x, w):
    xf = x.astype(jnp.float32)
    y = xf * lax.rsqrt(jnp.mean(xf * xf, axis=-1, keepdims=True) + EPS)
    return (y * w.astype(jnp.float32)).astype(x.dtype)


def split_cols(t, sizes):
    return jnp.split(t, [int(c) for c in np.cumsum(sizes)[:-1]], axis=-1)


def split_heads(t, n_heads):
    B, L, _ = t.shape
    return t.reshape(B, L, n_heads, -1).transpose(0, 2, 1, 3)


def merge_heads(t):
    B, H, L, d = t.shape
    return t.transpose(0, 2, 1, 3).reshape(B, L, H * d)


def head_norm(o, w, center):
    if center:
        o = o - jnp.mean(o, axis=-1, keepdims=True)
    o = o * lax.rsqrt(jnp.mean(o * o, axis=-1, keepdims=True) + EPS)
    H, dv = o.shape[1], o.shape[3]
    return o * w.astype(jnp.float32).reshape(1, H, 1, dv)


def rope(t, pos):
    half = t.shape[-1] // 2
    inv = ROPE_BASE ** (-jnp.arange(half, dtype=jnp.float32) / half)
    ang = pos[:, None] * inv[None, :]
    cos, sin = jnp.cos(ang), jnp.sin(ang)
    t1, t2 = t[..., :half], t[..., half:]
    return jnp.concatenate([t1 * cos - t2 * sin, t1 * sin + t2 * cos], axis=-1)


def chunked_gla(q, k, v, log_g):
    B, H, L, dk = q.shape
    dv = v.shape[-1]
    n = L // CHUNK

    def to_chunks(t):
        return jnp.moveaxis(t.astype(jnp.float32).reshape(B, H, n, CHUNK, t.shape[-1]), 2, 0)

    causal = jnp.tril(jnp.ones((CHUNK, CHUNK), dtype=bool))[:, :, None]

    def step(S, blk):
        qc, kc, vc, gc = blk
        b = jnp.cumsum(gc, axis=2)
        b_last = b[:, :, -1:, :]
        o_inter = jnp.einsum('bhtd,bhdv->bhtv', qc * jnp.exp(b), S)
        rel = jnp.where(causal, b[:, :, :, None, :] - b[:, :, None, :, :], -jnp.inf)
        scores = jnp.einsum('bhtd,bhsd,bhtsd->bhts', qc, kc, jnp.exp(rel))
        o_intra = jnp.einsum('bhts,bhsv->bhtv', scores, vc)
        S = jnp.exp(b_last)[:, :, 0, :, None] * S + jnp.einsum(
            'bhsd,bhsv->bhdv', kc * jnp.exp(b_last - b), vc)
        return S, o_inter + o_intra

    S0 = jnp.zeros((B, H, dk, dv), jnp.float32)
    _, o = lax.scan(step, S0, (to_chunks(q), to_chunks(k), to_chunks(v), to_chunks(log_g)))
    return jnp.moveaxis(o, 0, 2).reshape(B, H, L, dv)


def even_mixer(h, w_in, lb, gla_w_up, gla_b_up, hgrn_norm_w, gla_norm_w, w_out):
    proj = (h @ w_in).astype(jnp.float32)
    a_q, a_f, a_i, a_g, b_q, b_k, b_v, b_low, b_r = split_cols(proj, EVEN_SPLITS)
    f = lb + (1.0 - lb) * jax.nn.sigmoid(a_f)
    o_a = chunked_gla(split_heads(a_q, A_HEADS), split_heads(1.0 - f, A_HEADS),
                      split_heads(a_i, A_HEADS), split_heads(jnp.log(f), A_HEADS))
    y_a = merge_heads(head_norm(o_a, hgrn_norm_w, False)) * jax.nn.silu(a_g)
    z = b_low @ gla_w_up + gla_b_up
    log_alpha = jax.nn.log_sigmoid(z) / GLA_TAU
    o_b = chunked_gla(split_heads(b_q * B_DK ** -0.5, B_HEADS), split_heads(b_k, B_HEADS),
                      split_heads(b_v, B_HEADS), split_heads(log_alpha, B_HEADS))
    y_b = merge_heads(head_norm(o_b, gla_norm_w, False)) * jax.nn.silu(b_r)
    y = jnp.concatenate([y_a, y_b], axis=-1).astype(h.dtype)
    return y @ w_out


def odd_mixer(h, w_in, ret_norm_w, conv_w, conv_b, w_r, b_r, w_i, b_i, lam, w_out):
    B, L, _ = h.shape
    proj = (h @ w_in).astype(jnp.float32)
    c_q, c_k, c_v, c_g, d_x, d_gate = split_cols(proj, ODD_SPLITS)
    pos = jnp.arange(L, dtype=jnp.float32)
    q = rope(split_heads(c_q, C_HEADS), pos)
    k = rope(split_heads(c_k, C_HEADS), pos) * C_DK ** -0.5
    log_gamma = jnp.log1p(-jnp.exp2(-5.0 - jnp.arange(C_HEADS, dtype=jnp.float32)))
    log_g = jnp.broadcast_to(log_gamma[None, :, None, None], (B, C_HEADS, L, C_DK))
    o_c = chunked_gla(q, k, split_heads(c_v, C_HEADS), log_g)
    y_c = merge_heads(head_norm(o_c, ret_norm_w, True)) * jax.nn.silu(c_g)
    xp = jnp.pad(d_x, ((0, 0), (D_CONV - 1, 0), (0, 0)))
    xc = conv_b
    for j in range(D_CONV):
        xc = xc + xp[:, j:j + L, :] * conv_w[j]
    xb = xc.reshape(B, L, D_BLOCKS, D_BLOCK_DIM)
    r = jax.nn.sigmoid(jnp.einsum('blnd,nde->blne', xb, w_r).reshape(B, L, D_WIDTH) + b_r)
    i = jax.nn.sigmoid(jnp.einsum('blnd,nde->blne', xb, w_i).reshape(B, L, D_WIDTH) + b_i)
    log_a = -RGLRU_C * r * jax.nn.softplus(-lam)
    a = jnp.exp(log_a)
    u = jnp.sqrt(-jnp.expm1(2.0 * log_a)) * (i * xc)

    def combine(left, right):
        a1, b1 = left
        a2, b2 = right
        return a1 * a2, a2 * b1 + b2

    _, hs = lax.associative_scan(combine, (a, u), axis=1)
    y_d = hs * jax.nn.gelu(d_gate)
    y = jnp.concatenate([y_c, y_d], axis=-1).astype(h.dtype)
    return y @ w_out


def hier_moe(h, w_group, b_group, w_expert, b_expert, w1, w3, w2):
    B, L, D = h.shape
    xt = h.reshape(B * L, D)
    g_logits = (xt @ w_group).astype(jnp.float32) + b_group
    g_prob = jax.nn.softmax(g_logits, axis=-1)
    g_idx = jnp.argmax(g_logits, axis=-1)
    g_w = jnp.take_along_axis(g_prob, g_idx[:, None], axis=-1)
    e_logits = ((xt @ w_expert).astype(jnp.float32) + b_expert).reshape(-1, MOE_GROUPS, MOE_EXPERTS_PER_GROUP)
    e_sel = jnp.take_along_axis(e_logits, g_idx[:, None, None], axis=1)[:, 0]
    top_v, top_i = lax.top_k(e_sel, MOE_TOPK)
    top_w = jax.nn.softmax(top_v, axis=-1)
    e_gate = jnp.sum(jax.nn.one_hot(top_i, MOE_EXPERTS_PER_GROUP) * top_w[..., None], axis=1)
    gate = (jax.nn.one_hot(g_idx, MOE_GROUPS)[:, :, None] * e_gate[:, None, :]
            * g_w[:, :, None]).reshape(-1, MOE_N_EXPERTS)

    def expert_step(acc, p):
        w1e, w3e, w2e, ge = p
        hid = jax.nn.silu(xt @ w1e) * (xt @ w3e)
        return acc + ge[:, None].astype(xt.dtype) * (hid @ w2e), None

    out, _ = lax.scan(expert_step, jnp.zeros_like(xt), (w1, w3, w2, gate.T))
    return out.reshape(B, L, D)


def setup_inputs(seed: int = 0) -> dict:
    key = jax.random.key(seed)
    ks = jax.random.split(key, 32)
    f32 = jnp.float32

    def nrm(k, shape, scale):
        return jax.random.normal(k, shape, f32) * scale

    def gain(k, shape):
        return 1.0 + 0.02 * jax.random.normal(k, shape, f32)

    u = jax.random.uniform(ks[18], (N_ODD, D_WIDTH), f32, minval=0.9, maxval=0.999)
    s = u ** (1.0 / RGLRU_C)
    return {
        'x': nrm(ks[0], (BATCH, SEQ, D_MODEL), 1.0),
        'norm_mix': gain(ks[1], (DEPTH, D_MODEL)),
        'norm_ffn': gain(ks[2], (DEPTH, D_MODEL)),
        'norm_final': gain(ks[3], (D_MODEL,)),
        'even_w_in': nrm(ks[4], (N_EVEN, D_MODEL, EVEN_IN), D_MODEL ** -0.5),
        'hgrn_lb_logits': nrm(ks[5], (DEPTH + 1, A_HEADS * A_DK), 0.5),
        'hgrn_norm_w': gain(ks[6], (N_EVEN, A_HEADS * A_DV)),
        'gla_w_up': nrm(ks[7], (N_EVEN, GLA_RANK, B_HEADS * B_DK), GLA_RANK ** -0.5),
        'gla_b_up': nrm(ks[8], (N_EVEN, B_HEADS * B_DK), 0.02),
        'gla_norm_w': gain(ks[9], (N_EVEN, B_HEADS * B_DV)),
        'even_w_out': nrm(ks[10], (N_EVEN, MIX_WIDTH, D_MODEL), MIX_WIDTH ** -0.5),
        'odd_w_in': nrm(ks[11], (N_ODD, D_MODEL, ODD_IN), D_MODEL ** -0.5),
        'ret_norm_w': gain(ks[12], (N_ODD, C_HEADS * C_DV)),
        'conv_w': nrm(ks[13], (N_ODD, D_CONV, D_WIDTH), D_CONV ** -0.5),
        'conv_b': nrm(ks[14], (N_ODD, D_WIDTH), 0.02),
        'rglru_w_r': nrm(ks[15], (N_ODD, D_BLOCKS, D_BLOCK_DIM, D_BLOCK_DIM), D_BLOCK_DIM ** -0.5),
        'rglru_b_r': nrm(ks[16], (N_ODD, D_WIDTH), 0.02),
        'rglru_w_i': nrm(ks[17], (N_ODD, D_BLOCKS, D_BLOCK_DIM, D_BLOCK_DIM), D_BLOCK_DIM ** -0.5),
        'rglru_b_i': nrm(ks[19], (N_ODD, D_WIDTH), 0.02),
        'rglru_lambda': jnp.log(s) - jnp.log1p(-s),
        'odd_w_out': nrm(ks[20], (N_ODD, MIX_WIDTH, D_MODEL), MIX_WIDTH ** -0.5),
        'moe_w_group': nrm(ks[21], (DEPTH, D_MODEL, MOE_GROUPS), D_MODEL ** -0.5),
        'moe_b_group': nrm(ks[22], (DEPTH, MOE_GROUPS), 0.01),
        'moe_w_expert': nrm(ks[23], (DEPTH, D_MODEL, MOE_N_EXPERTS), D_MODEL ** -0.5),
        'moe_b_expert': nrm(ks[24], (DEPTH, MOE_N_EXPERTS), 0.01),
        'moe_w1': nrm(ks[25], (DEPTH, MOE_N_EXPERTS, D_MODEL, MOE_DFF), D_MODEL ** -0.5),
        'moe_w3': nrm(ks[26], (DEPTH, MOE_N_EXPERTS, D_MODEL, MOE_DFF), D_MODEL ** -0.5),
        'moe_w2': nrm(ks[27], (DEPTH, MOE_N_EXPERTS, MOE_DFF, D_MODEL), MOE_DFF ** -0.5),
    }


def reference(x, norm_mix, norm_ffn, norm_final, even_w_in, hgrn_lb_logits, hgrn_norm_w,
              gla_w_up, gla_b_up, gla_norm_w, even_w_out, odd_w_in, ret_norm_w, conv_w, conv_b,
              rglru_w_r, rglru_b_r, rglru_w_i, rglru_b_i, rglru_lambda, odd_w_out,
              moe_w_group, moe_b_group, moe_w_expert, moe_b_expert, moe_w1, moe_w3, moe_w2):
    lb_table = jnp.cumsum(jax.nn.softmax(hgrn_lb_logits.astype(jnp.float32), axis=0), axis=0)
    for l in range(DEPTH):
        j = l // 2
        hn = rms_norm(x, norm_mix[l])
        if l % 2 == 0:
            mix = even_mixer(hn, even_w_in[j], lb_table[l], gla_w_up[j], gla_b_up[j],
                             hgrn_norm_w[j], gla_norm_w[j], even_w_out[j])
        else:
            mix = odd_mixer(hn, odd_w_in[j], ret_norm_w[j], conv_w[j], conv_b[j],
                            rglru_w_r[j], rglru_b_r[j], rglru_w_i[j], rglru_b_i[j],
                            rglru_lambda[j], odd_w_out[j])
        x = x + mix
        x = x + hier_moe(rms_norm(x, norm_ffn[l]), moe_w_group[l], moe_b_group[l],
                         moe_w_expert[l], moe_b_expert[l], moe_w1[l], moe_w3[l], moe_w2[l])
    return rms_norm(x, norm_final)
```

```cpp
#include <hip/hip_runtime.h>
#include <cstdio>
#include <cstdint>

#define GAS __attribute__((address_space(1)))
#define LAS __attribute__((address_space(3)))
typedef unsigned short bf16;
typedef unsigned v4u __attribute__((ext_vector_type(4)));
typedef unsigned v2u __attribute__((ext_vector_type(2)));
typedef float f32x4 __attribute__((ext_vector_type(4)));
typedef short bf16x8 __attribute__((ext_vector_type(8)));

constexpr int NT = 32768, D = 1024, SEQ = 16384;
constexpr int EV_N = 3584, OD_N = 2560, EV_LD = 3600;
constexpr float EPS = 1e-6f;
constexpr int NEXP = 32, SLOT_ROWS = 2 * NT + NEXP * 256;

constexpr size_t MiB = 1u << 20;
constexpr size_t WS_CTL = 0, CTL_BYTES = 1 * MiB;
constexpr size_t WS_WIN0 = 2 * MiB, WS_WOUT0 = 9 * MiB, WS_WIN1 = 11 * MiB, WS_WOUT1 = 16 * MiB, WS_W13 = 18 * MiB, WS_W2 = 146 * MiB;
constexpr size_t WS_ACT = 210 * MiB, WS_PROJ = 274 * MiB, WS_H = WS_PROJ, WS_Y = WS_PROJ + 72 * MiB;
constexpr size_t WS_BLOW = 498 * MiB, WS_META = 500 * MiB, WS_LIST = 501 * MiB, WS_ST = 505 * MiB, WS_END = 522 * MiB;
constexpr int CW_TMO = 0, CW_BAR = 4096, CW_CNT = 16384;

constexpr int NWAVES = 8;
constexpr int LDS_BYTES = 163840;
constexpr int LDS_MISC = 147456;

__device__ __forceinline__ float bf2f(bf16 b) { return __builtin_bit_cast(float, (unsigned)b << 16); }
__device__ __forceinline__ unsigned f2bf(float f) { unsigned u = __builtin_bit_cast(unsigned, f); return (u + 0x7fffu + ((u >> 16) & 1u)) >> 16; }
__device__ __forceinline__ unsigned pk2(float lo, float hi) { return f2bf(lo) | (f2bf(hi) << 16); }
__device__ __forceinline__ float sigmoidf_(float x) { return 1.f / (1.f + __expf(-x)); }
__device__ __forceinline__ float siluf_(float x) { return x * sigmoidf_(x); }
__device__ __forceinline__ float gelu_tanh_(float x) { const float u = 0.7978845608f * (x + 0.044715f * x * x * x); return x * sigmoidf_(2.f * u); }
__device__ __forceinline__ float wave_sum(float v) {
#pragma unroll
    for (int o = 1; o < 64; o <<= 1) v += __shfl_xor(v, o);
    return v;
}
#define LDS_WAIT() asm volatile("s_waitcnt lgkmcnt(0)" ::: "memory")

struct Frame {
    LAS unsigned char* lds;
    int tid, lane, wave, vcu, G;
    const float* const* in;
    float* out; unsigned char* ws;
    unsigned* ctl;
};

__device__ __forceinline__ void tr_item(const float* W, int ldw, int k0, int c0, bf16* WT, int K, int r0, LAS float* scr, int lane) {
#pragma unroll 8
    for (int i = 0; i < 32; ++i) { const int kk = 2 * i + (lane >> 5); scr[kk * 33 + (lane & 31)] = W[(size_t)(k0 + kk) * ldw + c0 + (lane & 31)]; }
    LDS_WAIT(); asm volatile("" ::: "memory");
    const int c = lane & 7;
#pragma unroll
    for (int j = 0; j < 4; ++j) { const int n = (lane >> 3) + 8 * j; const LAS float* s = scr + (8 * c) * 33 + n;
        v4u o; o.x = pk2(s[0 * 33], s[1 * 33]); o.y = pk2(s[2 * 33], s[3 * 33]); o.z = pk2(s[4 * 33], s[5 * 33]); o.w = pk2(s[6 * 33], s[7 * 33]);
        *(v4u*)(WT + (size_t)(r0 + n) * K + k0 + 8 * c) = o; }
    LDS_WAIT(); asm volatile("" ::: "memory");
}

__device__ __forceinline__ void phase_prologue(Frame& F) {
    LAS float* WL = (LAS float*)F.lds;
    LAS float* scr = (LAS float*)(F.lds + 65536 + F.wave * 8704);
    const float* w_in0 = F.in[4];
    for (int s = F.tid; s < 16 * 1024; s += 512) { const int k = s >> 4, o = s & 15; WL[o * 1024 + k] = w_in0[(size_t)k * EV_LD + 3072 + o]; }
    const int gw = F.vcu * NWAVES + F.wave, NGW = F.G * NWAVES;
    bf16* WIN0 = (bf16*)(F.ws + WS_WIN0); bf16* WOUT0 = (bf16*)(F.ws + WS_WOUT0); bf16* WIN1 = (bf16*)(F.ws + WS_WIN1); bf16* WOUT1 = (bf16*)(F.ws + WS_WOUT1);
    bf16* W13 = (bf16*)(F.ws + WS_W13); bf16* W2 = (bf16*)(F.ws + WS_W2);
    constexpr int I_A = 16 * 96, I_B = 16 * 16, I_C = 16 * 32, I_D = 16 * 80, I_E = 16 * 32, I_F = 2 * 32 * 2 * 256, I_G = 2 * 32 * 256;
    constexpr int NITEMS = I_A + I_B + I_C + I_D + I_E + I_F + I_G;
    for (int it = gw; it < NITEMS; it += NGW) {
        int r = it;
        if (r < I_A) { const int kb = r / 96, nb = r % 96; tr_item(w_in0, EV_LD, 64 * kb, 32 * nb, WIN0, 1024, 32 * nb, scr, F.lane); continue; } r -= I_A;
        if (r < I_B) { const int kb = r / 16, nb = r % 16; tr_item(w_in0, EV_LD, 64 * kb, 3088 + 32 * nb, WIN0, 1024, 3072 + 32 * nb, scr, F.lane); continue; } r -= I_B;
        if (r < I_C) { const int kb = r / 32, nb = r % 32; tr_item(F.in[10], 1024, 64 * kb, 32 * nb, WOUT0, 1024, 32 * nb, scr, F.lane); continue; } r -= I_C;
        if (r < I_D) { const int kb = r / 80, nb = r % 80; tr_item(F.in[11], OD_N, 64 * kb, 32 * nb, WIN1, 1024, 32 * nb, scr, F.lane); continue; } r -= I_D;
        if (r < I_E) { const int kb = r / 32, nb = r % 32; tr_item(F.in[20], 1024, 64 * kb, 32 * nb, WOUT1, 1024, 32 * nb, scr, F.lane); continue; } r -= I_E;
        if (r < I_F) { const int le = r / 512, q = r % 512, which = q / 256, kb = (q % 256) / 16, nb = q % 16;
            const float* src = (which ? F.in[26] : F.in[25]) + (size_t)le * 1024 * 512; const int n0 = 32 * nb;
            tr_item(src, 512, 64 * kb, n0, W13 + (size_t)le * 1024 * 1024, 1024, 256 * (n0 >> 7) + (n0 & 127) + which * 128, scr, F.lane); continue; } r -= I_F;
        { const int le = r / 256, q = r % 256, kb = q / 32, nb = q % 32;
            tr_item(F.in[27] + (size_t)le * 512 * 1024, 1024, 64 * kb, 32 * nb, W2 + (size_t)le * 1024 * 512, 512, 32 * nb, scr, F.lane); }
    }
    __syncthreads();
    const float* x = F.in[0]; const float* g = F.in[1];
    bf16* XN = (bf16*)(F.ws + WS_ACT); float* BL = (float*)(F.ws + WS_BLOW);
    f32x4 gv[4];
#pragma unroll
    for (int j = 0; j < 4; ++j) gv[j] = *((const f32x4*)g + 64 * j + F.lane);
    for (int m = gw; m < NT; m += NGW) {
        const f32x4* xr = (const f32x4*)(x + (size_t)m * D) + F.lane;
        f32x4 v[4]; float s = 0.f;
#pragma unroll
        for (int j = 0; j < 4; ++j) { v[j] = xr[64 * j]; s += (v[j].x * v[j].x + v[j].y * v[j].y) + (v[j].z * v[j].z + v[j].w * v[j].w); }
        const float rstd = rsqrtf(wave_sum(s) * (1.f / D) + EPS);
        v2u* o8 = (v2u*)(XN + (size_t)m * D) + F.lane;
#pragma unroll
        for (int j = 0; j < 4; ++j) { v[j] = v[j] * rstd * gv[j]; v2u w; w.x = pk2(v[j].x, v[j].y); w.y = pk2(v[j].z, v[j].w); o8[64 * j] = w; }
        float mine = 0.f;
#pragma unroll 4
        for (int o = 0; o < 16; ++o) {
            const LAS f32x4* wl = (const LAS f32x4*)(WL + o * 1024) + F.lane; float p = 0.f;
#pragma unroll
            for (int j = 0; j < 4; ++j) { const f32x4 w = wl[64 * j]; p += (v[j].x * w.x + v[j].y * w.y) + (v[j].z * w.z + v[j].w * w.w); }
            p = wave_sum(p); mine = (F.lane == o) ? p : mine;
        }
        if (F.lane < 16) BL[(size_t)m * 16 + F.lane] = mine;
    }
}

__device__ __forceinline__ void phase_router(Frame& F, int layer) {
    LAS float* WL = (LAS float*)F.lds;
    LAS int* hist = (LAS int*)(F.lds + LDS_MISC + 1024); LAS int* base = hist + 32;
    LAS int* s_e0 = base + 32; LAS int* s_e1 = s_e0 + 128; LAS int* s_r0 = s_e1 + 128; LAS int* s_r1 = s_r0 + 128;
    LAS float* s_w0 = (LAS float*)(s_r1 + 128); LAS float* s_w1 = s_w0 + 128;
    const float* wg = F.in[21] + (size_t)layer * 1024 * 4; const float* we = F.in[23] + (size_t)layer * 1024 * 32;
    for (int s = F.tid; s < 4096; s += 512) WL[(s & 3) * 1024 + (s >> 2)] = wg[s];
    for (int s = F.tid; s < 32768; s += 512) WL[(4 + (s & 31)) * 1024 + (s >> 5)] = we[s];
    const float* g = F.in[2] + layer * 1024;
    const float bias = F.lane < 4 ? F.in[22][layer * 4 + F.lane] : (F.lane < 36 ? F.in[24][layer * 32 + F.lane - 4] : 0.f);
    unsigned* cnt = F.ctl + CW_CNT + 64 * layer;
    bf16* XN = (bf16*)(F.ws + WS_ACT);
    int* ME0 = (int*)(F.ws + WS_META); int* ME1 = ME0 + NT; int* MR0 = ME1 + NT; int* MR1 = MR0 + NT; float* MW0 = (float*)(MR1 + NT); float* MW1 = MW0 + NT;
    int* LIST = (int*)(F.ws + WS_LIST);
    f32x4 gv[4];
#pragma unroll
    for (int j = 0; j < 4; ++j) gv[j] = *((const f32x4*)g + 64 * j + F.lane);
    __syncthreads();
    for (int row0 = 128 * F.vcu; row0 < NT; row0 += 128 * F.G) {
        if (F.tid < 32) hist[F.tid] = 0;
        __syncthreads();
        for (int bt = 0; bt < 4; ++bt) {
            const int rl = F.wave * 16 + bt * 4, m0 = row0 + rl;
            f32x4 hn[4][4];
#pragma unroll
            for (int r = 0; r < 4; ++r) {
                const f32x4* xr = (const f32x4*)(F.out + (size_t)(m0 + r) * D) + F.lane; float s = 0.f;
#pragma unroll
                for (int j = 0; j < 4; ++j) { hn[r][j] = xr[64 * j]; s += (hn[r][j].x * hn[r][j].x + hn[r][j].y * hn[r][j].y) + (hn[r][j].z * hn[r][j].z + hn[r][j].w * hn[r][j].w); }
                const float rstd = rsqrtf(wave_sum(s) * (1.f / D) + EPS);
                v2u* o8 = (v2u*)(XN + (size_t)(m0 + r) * D) + F.lane;
#pragma unroll
                for (int j = 0; j < 4; ++j) { hn[r][j] = hn[r][j] * rstd * gv[j]; v2u w; w.x = pk2(hn[r][j].x, hn[r][j].y); w.y = pk2(hn[r][j].z, hn[r][j].w); o8[64 * j] = w; }
            }
            float res[4] = {0.f, 0.f, 0.f, 0.f};
#pragma unroll 2
            for (int o = 0; o < 36; ++o) {
                const LAS f32x4* wl = (const LAS f32x4*)(WL + o * 1024) + F.lane;
                float p[4] = {0.f, 0.f, 0.f, 0.f};
#pragma unroll
                for (int j = 0; j < 4; ++j) { const f32x4 w = wl[64 * j];
#pragma unroll
                    for (int r = 0; r < 4; ++r) p[r] += (hn[r][j].x * w.x + hn[r][j].y * w.y) + (hn[r][j].z * w.z + hn[r][j].w * w.w); }
#pragma unroll
                for (int r = 0; r < 4; ++r) { const float s = wave_sum(p[r]); res[r] = (F.lane == o) ? s : res[r]; }
            }
#pragma unroll
            for (int r = 0; r < 4; ++r) {
                const float lg = res[r] + bias;
                const float g0 = __shfl(lg, 0), g1 = __shfl(lg, 1), g2 = __shfl(lg, 2), g3 = __shfl(lg, 3);
                int gi = 0; float gm = g0;
                if (g1 > gm) { gm = g1; gi = 1; } if (g2 > gm) { gm = g2; gi = 2; } if (g3 > gm) { gm = g3; gi = 3; }
                const float gwt = 1.f / (expf(g0 - gm) + expf(g1 - gm) + expf(g2 - gm) + expf(g3 - gm));
                float v0 = -3.0e38f, v1 = -3.0e38f; int i0 = 0, i1 = 0;
#pragma unroll
                for (int i = 0; i < 8; ++i) { const float ev = __shfl(lg, 4 + gi * 8 + i);
                    if (ev > v0) { v1 = v0; i1 = i0; v0 = ev; i0 = i; } else if (ev > v1) { v1 = ev; i1 = i; } }
                const float ex = expf(v1 - v0), tw0 = 1.f / (1.f + ex), tw1 = ex / (1.f + ex);
                if (F.lane == r) {
                    const int e0 = gi * 8 + i0, e1 = gi * 8 + i1;
                    s_e0[rl + r] = e0; s_e1[rl + r] = e1; s_w0[rl + r] = gwt * tw0; s_w1[rl + r] = gwt * tw1;
                    s_r0[rl + r] = atomicAdd((int*)&hist[e0], 1); s_r1[rl + r] = atomicAdd((int*)&hist[e1], 1);
                }
            }
        }
        __syncthreads();
        if (F.tid < 32) base[F.tid] = (int)atomicAdd(cnt + F.tid, (unsigned)hist[F.tid]);
        __syncthreads();
        if (F.tid < 128) {
            const int m = row0 + F.tid, e0 = s_e0[F.tid], e1 = s_e1[F.tid], r0 = base[e0] + s_r0[F.tid], r1 = base[e1] + s_r1[F.tid];
            ME0[m] = e0; ME1[m] = e1; MR0[m] = r0; MR1[m] = r1; MW0[m] = s_w0[F.tid]; MW1[m] = s_w1[F.tid];
            LIST[(size_t)e0 * NT + r0] = m; LIST[(size_t)e1 * NT + r1] = m;
        }
        __syncthreads();
    }
}

__device__ __forceinline__ void phase_combine(Frame& F, int layer) {
    LAS int* poff = (LAS int*)(F.lds + LDS_MISC + 1024);
    const unsigned* cnt = F.ctl + CW_CNT + 64 * layer;
    if (F.tid == 0) { int acc = 0; for (int e = 0; e < 32; ++e) { poff[e] = acc; acc += ((int)cnt[e] + 255) & ~255; } poff[32] = acc; }
    __syncthreads();
    const int gw = F.vcu * NWAVES + F.wave, NGW = F.G * NWAVES;
    const float* g = layer == 0 ? F.in[1] + 1024 : F.in[3];
    const bf16* Y = (const bf16*)(F.ws + WS_Y); bf16* XN = (bf16*)(F.ws + WS_ACT);
    const int* ME0 = (const int*)(F.ws + WS_META); const int* ME1 = ME0 + NT; const int* MR0 = ME1 + NT; const int* MR1 = MR0 + NT; const float* MW0 = (const float*)(MR1 + NT); const float* MW1 = MW0 + NT;
    f32x4 gv[4];
#pragma unroll
    for (int j = 0; j < 4; ++j) gv[j] = *((const f32x4*)g + 64 * j + F.lane);
    for (int m = gw; m < NT; m += NGW) {
        const int s0 = poff[ME0[m]] + MR0[m], s1 = poff[ME1[m]] + MR1[m]; const float w0 = MW0[m], w1 = MW1[m];
        f32x4* xr = (f32x4*)(F.out + (size_t)m * D) + F.lane;
        const v2u* y0 = (const v2u*)(Y + (size_t)s0 * D) + F.lane; const v2u* y1 = (const v2u*)(Y + (size_t)s1 * D) + F.lane;
        f32x4 v[4]; float s = 0.f;
#pragma unroll
        for (int j = 0; j < 4; ++j) { v[j] = xr[64 * j]; const v2u a = y0[64 * j], b = y1[64 * j];
            v[j].x += w0 * bf2f((bf16)(a.x & 0xffff)) + w1 * bf2f((bf16)(b.x & 0xffff)); v[j].y += w0 * bf2f((bf16)(a.x >> 16)) + w1 * bf2f((bf16)(b.x >> 16));
            v[j].z += w0 * bf2f((bf16)(a.y & 0xffff)) + w1 * bf2f((bf16)(b.y & 0xffff)); v[j].w += w0 * bf2f((bf16)(a.y >> 16)) + w1 * bf2f((bf16)(b.y >> 16));
            s += (v[j].x * v[j].x + v[j].y * v[j].y) + (v[j].z * v[j].z + v[j].w * v[j].w); }
        const float rstd = rsqrtf(wave_sum(s) * (1.f / D) + EPS);
        if (layer == 0) {
            v2u* o8 = (v2u*)(XN + (size_t)m * D) + F.lane;
#pragma unroll
            for (int j = 0; j < 4; ++j) { xr[64 * j] = v[j]; const f32x4 n = v[j] * rstd * gv[j]; v2u w; w.x = pk2(n.x, n.y); w.y = pk2(n.z, n.w); o8[64 * j] = w; }
        } else {
#pragma unroll
            for (int j = 0; j < 4; ++j) xr[64 * j] = v[j] * rstd * gv[j];
        }
    }
}

struct Args { const float* in[28]; float* out; unsigned char* ws; int ph_lo, ph_hi; };
__global__ void __launch_bounds__(NWAVES * 64, 2) mega(Args args) {
    extern __shared__ __attribute__((aligned(16))) unsigned char lds[];
    Frame F;
    F.lds = (LAS unsigned char*)lds; F.tid = threadIdx.x; F.lane = F.tid & 63; F.wave = __builtin_amdgcn_readfirstlane(F.tid >> 6);
    F.G = gridDim.x; { const int bx = blockIdx.x; F.vcu = (F.G % 8 == 0) ? (bx % 8) * (F.G / 8) + bx / 8 : bx; }
    F.in = args.in; F.out = args.out; F.ws = args.ws; F.ctl = (unsigned*)(args.ws + WS_CTL);
    const int lo = args.ph_lo, hi = args.ph_hi;
#define IN(k) (lo <= (k) && (k) < hi)
    if (IN(0)) phase_prologue(F);
    if (IN(6)) phase_router(F, 0);
    if (IN(9)) phase_combine(F, 0);
    if (IN(15)) phase_router(F, 1);
    if (IN(18)) phase_combine(F, 1);
#undef IN
}

struct NG { const bf16* A; const bf16* Bt; int N, K; bf16* Ob; float* Of; const float* Res; const unsigned* cnt; const int* list; };
template <int MODE> __global__ void __launch_bounds__(256) k_gemm_naive(NG a) {
    __shared__ float As[16][68], Bs[16][68], Cs[16][68]; __shared__ int poff[33];
    const int t = threadIdx.x, tx = t & 15, ty = t >> 4, m0 = blockIdx.y * 64, n0 = blockIdx.x * 64, K = a.K;
    const bf16* Bt = a.Bt; int e = 0;
    if (MODE >= 2) {
        if (t == 0) { int acc = 0; for (int i = 0; i < 32; ++i) { poff[i] = acc; acc += ((int)a.cnt[i] + 255) & ~255; } poff[32] = acc; }
        __syncthreads();
        if (m0 >= poff[32]) return;
        while (m0 >= poff[e + 1]) ++e;
        Bt += (size_t)e * (MODE == 2 ? 1024 * 1024 : 1024 * 512);
    }
    const int lr = t >> 2, kq = (t & 3) * 4;
    int arow = m0 + lr;
    if (MODE == 2) { const int idx = arow - poff[e]; arow = idx < (int)a.cnt[e] ? a.list[(size_t)e * NT + idx] : 0; }
    const bf16* ap = a.A + (size_t)arow * K + kq;
    int br = n0 + lr, br2 = 0;
    if (MODE == 2) { br = 256 * (br >> 7) + (br & 127); br2 = br + 128; }
    const bf16* bp = Bt + (size_t)br * K + kq; const bf16* bp2 = Bt + (size_t)br2 * K + kq;
    float acc[4][4], acc2[4][4];
#pragma unroll
    for (int i = 0; i < 4; ++i)
#pragma unroll
        for (int j = 0; j < 4; ++j) { acc[i][j] = 0.f; acc2[i][j] = 0.f; }
    for (int k0 = 0; k0 < K; k0 += 16) {
        { const v2u w = *(const v2u*)(ap + k0); As[kq][lr] = bf2f((bf16)(w.x & 0xffff)); As[kq + 1][lr] = bf2f((bf16)(w.x >> 16)); As[kq + 2][lr] = bf2f((bf16)(w.y & 0xffff)); As[kq + 3][lr] = bf2f((bf16)(w.y >> 16)); }
        { const v2u w = *(const v2u*)(bp + k0); Bs[kq][lr] = bf2f((bf16)(w.x & 0xffff)); Bs[kq + 1][lr] = bf2f((bf16)(w.x >> 16)); Bs[kq + 2][lr] = bf2f((bf16)(w.y & 0xffff)); Bs[kq + 3][lr] = bf2f((bf16)(w.y >> 16)); }
        if (MODE == 2) { const v2u w = *(const v2u*)(bp2 + k0); Cs[kq][lr] = bf2f((bf16)(w.x & 0xffff)); Cs[kq + 1][lr] = bf2f((bf16)(w.x >> 16)); Cs[kq + 2][lr] = bf2f((bf16)(w.y & 0xffff)); Cs[kq + 3][lr] = bf2f((bf16)(w.y >> 16)); }
        __syncthreads();
#pragma unroll
        for (int k = 0; k < 16; ++k) {
            float av[4], bv[4], cv[4];
#pragma unroll
            for (int i = 0; i < 4; ++i) { av[i] = As[k][ty * 4 + i]; bv[i] = Bs[k][tx * 4 + i]; cv[i] = MODE == 2 ? Cs[k][tx * 4 + i] : 0.f; }
#pragma unroll
            for (int i = 0; i < 4; ++i)
#pragma unroll
                for (int j = 0; j < 4; ++j) { acc[i][j] += av[i] * bv[j]; if (MODE == 2) acc2[i][j] += av[i] * cv[j]; }
        }
        __syncthreads();
    }
#pragma unroll
    for (int i = 0; i < 4; ++i)
#pragma unroll
        for (int j = 0; j < 4; ++j) {
            const int m = m0 + ty * 4 + i, n = n0 + tx * 4 + j;
            if (MODE == 0) a.Ob[(size_t)m * a.N + n] = (bf16)f2bf(acc[i][j]);
            if (MODE == 1) a.Of[(size_t)m * a.N + n] = a.Res[(size_t)m * a.N + n] + acc[i][j];
            if (MODE == 2) a.Ob[(size_t)m * 512 + n] = (bf16)f2bf(siluf_(acc[i][j]) * acc2[i][j]);
            if (MODE == 3) a.Ob[(size_t)m * 1024 + n] = (bf16)f2bf(acc[i][j]);
        }
}

__global__ void __launch_bounds__(128) k_mix_even_naive(const bf16* PROJ, const float* blow, const float* lbl, const float* hnw, const float* wup, const float* bup, const float* gnw, bf16* Y) {
    const int bid = blockIdx.x, j = threadIdx.x, lane = j & 63, wv = j >> 6;
    __shared__ float sq[2][128], sk[2][128], sg[2][128], red[2][2];
    if (bid < 8) {
        const int b = bid >> 2, h = bid & 3, c = h * 128 + j;
        float lb; { const float l0 = lbl[c], l1 = lbl[512 + c], l2 = lbl[1024 + c]; const float mx = fmaxf(l0, fmaxf(l1, l2)); const float e0 = expf(l0 - mx), e1 = expf(l1 - mx), e2 = expf(l2 - mx); lb = e0 / (e0 + e1 + e2); }
        float s[128];
#pragma unroll
        for (int d = 0; d < 128; ++d) s[d] = 0.f;
        const float nw = hnw[c];
        for (int t = 0; t < SEQ; ++t) {
            const bf16* P = PROJ + (size_t)(b * SEQ + t) * EV_N; const int pb = t & 1;
            const float f = lb + (1.f - lb) * sigmoidf_(bf2f(P[512 + c]));
            sq[pb][j] = bf2f(P[c]); sk[pb][j] = 1.f - f; sg[pb][j] = f;
            const float v = bf2f(P[1024 + c]);
            __syncthreads();
            float o = 0.f;
#pragma unroll
            for (int d = 0; d < 128; ++d) { s[d] = sg[pb][d] * s[d] + sk[pb][d] * v; o += sq[pb][d] * s[d]; }
            const float ss = wave_sum(o * o); if (lane == 0) red[pb][wv] = ss;
            __syncthreads();
            const float rstd = rsqrtf((red[pb][0] + red[pb][1]) * (1.f / 128.f) + EPS);
            Y[(size_t)(b * SEQ + t) * 1024 + c] = (bf16)f2bf(o * rstd * nw * siluf_(bf2f(P[1536 + c])));
        }
    } else {
        const int b = (bid - 8) >> 2, h = bid & 3, c = h * 128 + j, dcol = h * 64 + (j & 63);
        float wu[16];
#pragma unroll
        for (int r = 0; r < 16; ++r) wu[r] = wup[r * 256 + dcol];
        const float bu = bup[dcol];
        float s[64];
#pragma unroll
        for (int d = 0; d < 64; ++d) s[d] = 0.f;
        const float nw = gnw[c];
        for (int t = 0; t < SEQ; ++t) {
            const size_t row = (size_t)b * SEQ + t;
            const bf16* P = PROJ + row * EV_N; const int pb = t & 1;
            if (j < 64) {
                float z = bu;
#pragma unroll
                for (int r = 0; r < 16; ++r) z += blow[row * 16 + r] * wu[r];
                const float ls = fminf(z, 0.f) - log1pf(expf(-fabsf(z)));
                sg[pb][j] = expf(ls * (1.f / 16.f)); sq[pb][j] = bf2f(P[2048 + dcol]) * 0.125f; sk[pb][j] = bf2f(P[2304 + dcol]);
            }
            const float v = bf2f(P[2560 + c]);
            __syncthreads();
            float o = 0.f;
#pragma unroll
            for (int d = 0; d < 64; ++d) { s[d] = sg[pb][d] * s[d] + sk[pb][d] * v; o += sq[pb][d] * s[d]; }
            const float ss = wave_sum(o * o); if (lane == 0) red[pb][wv] = ss;
            __syncthreads();
            const float rstd = rsqrtf((red[pb][0] + red[pb][1]) * (1.f / 128.f) + EPS);
            Y[row * 1024 + 512 + c] = (bf16)f2bf(o * rstd * nw * siluf_(bf2f(P[3072 + c])));
        }
    }
}

__global__ void __launch_bounds__(128) k_ret_naive(const bf16* PROJ, const float* rnw, bf16* Y) {
    const int bid = blockIdx.x, j = threadIdx.x, lane = j & 63, wv = j >> 6, b = bid >> 2, h = bid & 3, c = h * 128 + j;
    __shared__ float sq[2][64], sk[2][64], red[2][2], red2[2][2];
    const int d = j & 63, i = d & 31;
    const float ci = exp2f(-(float)i * (13.287712379549449f / 32.f)) * 0.15915494309189535f;
    const float gamma = 1.f - exp2f(-5.f - (float)h);
    float s[64];
#pragma unroll
    for (int dd = 0; dd < 64; ++dd) s[dd] = 0.f;
    const float nw = rnw[c];
    for (int t = 0; t < SEQ; ++t) {
        const size_t row = (size_t)b * SEQ + t; const bf16* P = PROJ + row * OD_N; const int pb = t & 1;
        if (j < 64) {
            float rev = (float)t * ci; rev -= floorf(rev);
            const float sn = __builtin_amdgcn_sinf(rev), cs = __builtin_amdgcn_cosf(rev);
            const float q1 = bf2f(P[h * 64 + i]), q2 = bf2f(P[h * 64 + 32 + i]), k1 = bf2f(P[256 + h * 64 + i]), k2 = bf2f(P[256 + h * 64 + 32 + i]);
            sq[pb][d] = d < 32 ? q1 * cs - q2 * sn : q1 * sn + q2 * cs;
            sk[pb][d] = (d < 32 ? k1 * cs - k2 * sn : k1 * sn + k2 * cs) * 0.125f;
        }
        const float v = bf2f(P[512 + c]);
        __syncthreads();
        float o = 0.f;
#pragma unroll
        for (int dd = 0; dd < 64; ++dd) { s[dd] = gamma * s[dd] + sk[pb][dd] * v; o += sq[pb][dd] * s[dd]; }
        const float sm = wave_sum(o); if (lane == 0) red[pb][wv] = sm;
        __syncthreads();
        const float oc = o - (red[pb][0] + red[pb][1]) * (1.f / 128.f);
        const float ss = wave_sum(oc * oc); if (lane == 0) red2[pb][wv] = ss;
        __syncthreads();
        const float rstd = rsqrtf((red2[pb][0] + red2[pb][1]) * (1.f / 128.f) + EPS);
        Y[row * 1024 + c] = (bf16)f2bf(oc * rstd * nw * siluf_(bf2f(P[1024 + c])));
    }
}

__global__ void __launch_bounds__(64) k_rglru_naive(const bf16* PROJ, const float* cw, const float* cb, const float* wr, const float* br, const float* wi, const float* bi, const float* lam, bf16* Y) {
    const int b = blockIdx.x >> 3, n = blockIdx.x & 7, e = threadIdx.x, c = n * 64 + e;
    float wrr[64], wii[64];
#pragma unroll
    for (int d = 0; d < 64; ++d) { wrr[d] = wr[(n * 64 + d) * 64 + e]; wii[d] = wi[(n * 64 + d) * 64 + e]; }
    const float c0 = cw[c], c1 = cw[512 + c], c2 = cw[1024 + c], c3 = cw[1536 + c], cbb = cb[c], brr = br[c], bii = bi[c];
    const float sp = log1pf(expf(-lam[c]));
    float x1 = 0.f, x2 = 0.f, x3 = 0.f, hh = 0.f;
    for (int t = 0; t < SEQ; ++t) {
        const size_t row = (size_t)b * SEQ + t; const bf16* P = PROJ + row * OD_N;
        const float dx = bf2f(P[1536 + c]);
        const float xc = cbb + c0 * x3 + c1 * x2 + c2 * x1 + c3 * dx;
        x3 = x2; x2 = x1; x1 = dx;
        float rp = brr, ip = bii;
#pragma unroll
        for (int d = 0; d < 64; ++d) { const float xd = __shfl(xc, d); rp += xd * wrr[d]; ip += xd * wii[d]; }
        const float r = sigmoidf_(rp), ig = sigmoidf_(ip), la = -8.f * r * sp, aa = expf(la);
        const float u = sqrtf(fmaxf(0.f, -expm1f(2.f * la))) * (ig * xc);
        hh = aa * hh + u;
        Y[row * 1024 + 512 + c] = (bf16)f2bf(hh * gelu_tanh_(bf2f(P[2048 + c])));
    }
}

extern "C" void kernel_launch(void* const* d_in, const int* in_sizes, int n_in, void* d_out, int out_size, void* d_ws, size_t ws_size, hipStream_t stream) {
    static int grid = 0;
    if (grid == 0) {
        if (n_in != 28 || out_size != NT * D || ws_size < WS_END) { fprintf(stderr, "kernel_launch: unexpected problem (n_in %d, out %d, ws %zu)\n", n_in, out_size, ws_size); grid = -1; return; }
        int dev = 0, cus = 0;
        if (hipGetDevice(&dev) != hipSuccess || hipDeviceGetAttribute(&cus, hipDeviceAttributeMultiprocessorCount, dev) != hipSuccess) { grid = -1; return; }
        if (hipFuncSetAttribute((const void*)mega, hipFuncAttributeMaxDynamicSharedMemorySize, LDS_BYTES) != hipSuccess) { fprintf(stderr, "kernel_launch: hipFuncSetAttribute failed\n"); grid = -1; return; }
        (void)hipGetLastError();
        grid = cus;
    }
    if (grid < 0) return;
    (void)hipMemsetAsync((char*)d_ws + WS_CTL, 0, CTL_BYTES, stream);
    Args a{};
    for (int i = 0; i < 28; ++i) a.in[i] = (const float*)d_in[i];
    a.out = (float*)d_out; a.ws = (unsigned char*)d_ws;
    unsigned char* ws = (unsigned char*)d_ws;
    const float* const* in = (const float* const*)a.in;
    auto run = [&](int lo, int hi) { a.ph_lo = lo; a.ph_hi = hi; hipLaunchKernelGGL(mega, dim3(grid), dim3(NWAVES * 64), LDS_BYTES, stream, a); };
    bf16* ACT = (bf16*)(ws + WS_ACT); bf16* PROJ = (bf16*)(ws + WS_PROJ); bf16* H = (bf16*)(ws + WS_H); bf16* Y = (bf16*)(ws + WS_Y);
    const unsigned* ctl = (const unsigned*)(ws + WS_CTL); const int* LIST = (const int*)(ws + WS_LIST);
    run(0, 1);
    for (int l = 0; l < 2; ++l) {
        const int NP = l == 0 ? EV_N : OD_N;
        { NG g{ACT, (const bf16*)(ws + (l == 0 ? WS_WIN0 : WS_WIN1)), NP, 1024, PROJ, nullptr, nullptr, nullptr, nullptr};
          hipLaunchKernelGGL(k_gemm_naive<0>, dim3(NP / 64, NT / 64), dim3(256), 0, stream, g); }
        if (l == 0) hipLaunchKernelGGL(k_mix_even_naive, dim3(16), dim3(128), 0, stream, PROJ, (const float*)(ws + WS_BLOW), in[5], in[6], in[7], in[8], in[9], ACT);
        else { hipLaunchKernelGGL(k_ret_naive, dim3(8), dim3(128), 0, stream, PROJ, in[12], ACT);
               hipLaunchKernelGGL(k_rglru_naive, dim3(16), dim3(64), 0, stream, PROJ, in[13], in[14], in[15], in[16], in[17], in[18], in[19], ACT); }
        { NG g{ACT, (const bf16*)(ws + (l == 0 ? WS_WOUT0 : WS_WOUT1)), 1024, 1024, nullptr, (float*)d_out, l == 0 ? in[0] : (const float*)d_out, nullptr, nullptr};
          hipLaunchKernelGGL(k_gemm_naive<1>, dim3(16, NT / 64), dim3(256), 0, stream, g); }
        run(6 + 9 * l, 7 + 9 * l);
        { NG g{ACT, (const bf16*)(ws + WS_W13) + (size_t)l * 32 * 1024 * 1024, 512, 1024, H, nullptr, nullptr, ctl + CW_CNT + 64 * l, LIST};
          hipLaunchKernelGGL(k_gemm_naive<2>, dim3(8, SLOT_ROWS / 64), dim3(256), 0, stream, g); }
        { NG g{H, (const bf16*)(ws + WS_W2) + (size_t)l * 32 * 1024 * 512, 1024, 512, Y, nullptr, nullptr, ctl + CW_CNT + 64 * l, LIST};
          hipLaunchKernelGGL(k_gemm_naive<3>, dim3(16, SLOT_ROWS / 64), dim3(256), 0, stream, g); }
        run(9 + 9 * l, 10 + 9 * l);
    }
}
```

```cpp
#include <hip/hip_runtime.h>
#include <cstdio>
#include <cstdint>

#define GAS __attribute__((address_space(1)))
#define LAS __attribute__((address_space(3)))
typedef unsigned short bf16;
typedef unsigned v4u __attribute__((ext_vector_type(4)));
typedef unsigned v2u __attribute__((ext_vector_type(2)));
typedef float f32x4 __attribute__((ext_vector_type(4)));
typedef float f32x2 __attribute__((ext_vector_type(2)));
typedef short bf16x8 __attribute__((ext_vector_type(8)));

constexpr int NT = 32768, D = 1024, SEQ = 16384;
constexpr int EV_N = 3584, OD_N = 2560, EV_LD = 3600;
constexpr float EPS = 1e-6f;
constexpr int NEXP = 32, SLOT_ROWS = 2 * NT + NEXP * 256;

constexpr size_t MiB = 1u << 20;
constexpr size_t WS_CTL = 0, CTL_BYTES = 1 * MiB;
constexpr size_t WS_WIN0 = 2 * MiB, WS_WOUT0 = 9 * MiB, WS_WIN1 = 11 * MiB, WS_WOUT1 = 16 * MiB, WS_W13 = 18 * MiB, WS_W2 = 146 * MiB;
constexpr size_t WS_ACT = 210 * MiB, WS_PROJ = 274 * MiB, WS_H = WS_PROJ, WS_Y = WS_PROJ + 72 * MiB;
constexpr size_t WS_BLOW = 498 * MiB, WS_META = 500 * MiB, WS_LIST = 501 * MiB, WS_ST = 505 * MiB, WS_END = 522 * MiB;
constexpr int CW_TMO = 0, CW_BAR = 4096, CW_CNT = 16384;

constexpr int NWAVES = 8;
constexpr int LDS_BYTES = 163840;
constexpr int LDS_MISC = 147456;

__device__ __forceinline__ float bf2f(bf16 b) { return __builtin_bit_cast(float, (unsigned)b << 16); }
__device__ __forceinline__ unsigned f2bf(float f) { unsigned u = __builtin_bit_cast(unsigned, f); return (u + 0x7fffu + ((u >> 16) & 1u)) >> 16; }
__device__ __forceinline__ unsigned pk2(float lo, float hi) { return f2bf(lo) | (f2bf(hi) << 16); }
__device__ __forceinline__ float sigmoidf_(float x) { return 1.f / (1.f + __expf(-x)); }
__device__ __forceinline__ float siluf_(float x) { return x * sigmoidf_(x); }
__device__ __forceinline__ float gelu_tanh_(float x) { const float u = 0.7978845608f * (x + 0.044715f * x * x * x); return x * sigmoidf_(2.f * u); }
__device__ __forceinline__ float wave_sum(float v) {
#pragma unroll
    for (int o = 1; o < 64; o <<= 1) v += __shfl_xor(v, o);
    return v;
}
#define LDS_WAIT() asm volatile("s_waitcnt lgkmcnt(0)" ::: "memory")

struct Frame {
    LAS unsigned char* lds;
    int tid, lane, wave, vcu, G;
    const float* const* in;
    float* out; unsigned char* ws;
    unsigned* ctl;
};


#define XB_TMO      128
#define XB_XCNT(j)  (256  + 64 * (j))
#define XB_XSUB(j)  (1280 + 64 * (j))
#define XB_XGEN(j)  (2304 + 64 * (j))
#define XB_TOP      3328
#define XB_TOPGEN   3392
#define XCD_BAR_WORDS 3456
#define XB_SPIN_CAP (1u << 18)
__device__ __forceinline__ unsigned xb_ld(unsigned* p)              { return __hip_atomic_load(p, __ATOMIC_RELAXED, __HIP_MEMORY_SCOPE_AGENT); }
__device__ __forceinline__ unsigned xb_add(unsigned* p, unsigned v) { return __hip_atomic_fetch_add(p, v, __ATOMIC_RELAXED, __HIP_MEMORY_SCOPE_AGENT); }
__device__ __forceinline__ unsigned xb_xcc_id() { return (unsigned)__builtin_amdgcn_s_getreg((3 << 11) | 20) & 0xFu; }
#define XB_SPIN(cond, bar) do { unsigned _sp = 0; while (cond) { __builtin_amdgcn_s_sleep(1); \
    if ((++_sp & 255u) == 0u) { if (xb_ld(&(bar)[XB_TMO])) break; if (_sp > XB_SPIN_CAP) { atomicAdd(&(bar)[XB_TMO], 1u); break; } } } } while (0)
struct XcdBarrier { unsigned* bar; unsigned x; volatile LAS unsigned* st; };
__device__ __forceinline__ XcdBarrier xcd_barrier_post(unsigned* bar, volatile LAS unsigned* st) {
    XcdBarrier b; b.bar = bar; b.x = xb_xcc_id(); b.st = st;
    if (threadIdx.x == 0) (void)xb_add(&bar[XB_XCNT(b.x)], 1u);
    return b;
}
__device__ __forceinline__ void xcd_barrier_complete(unsigned* bar, unsigned x, unsigned& nloc, unsigned& nx) {
    const unsigned G = gridDim.x * gridDim.y * gridDim.z;
    unsigned sum, cnt, mine, sp = 0u;
    for (;;) {
        sum = 0u; cnt = 0u; mine = 0u;
#pragma unroll
        for (unsigned j = 0; j < 16; ++j) { const unsigned c = xb_ld(&bar[XB_XCNT(j)]); sum += c; cnt += (c > 0u) ? 1u : 0u; mine = (j == x) ? c : mine; }
        if (sum == G) break;
        __builtin_amdgcn_s_sleep(1);
        if ((++sp & 255u) == 0u) { if (xb_ld(&bar[XB_TMO])) break; if (sp > XB_SPIN_CAP) { atomicAdd(&bar[XB_TMO], 1u); break; } }
    }
    nloc = mine > 0u ? mine : 1u; nx = cnt > 0u ? cnt : 1u;
}
__device__ __forceinline__ void xcd_barrier(const XcdBarrier& b) {
    asm volatile("s_waitcnt vmcnt(0)" ::: "memory");
    __syncthreads();
    if (threadIdx.x == 0) {
        unsigned* bar = b.bar;
        __builtin_amdgcn_s_waitcnt(0);
        unsigned nloc = b.st[0], nx = b.st[1];
        if (nloc == 0u) { xcd_barrier_complete(bar, b.x, nloc, nx); b.st[0] = nloc; b.st[1] = nx; }
        const unsigned old = xb_add(&bar[XB_XSUB(b.x)], 1u);
        const unsigned gen = old / nloc;
        if (old + 1u == (gen + 1u) * nloc) {
            __builtin_amdgcn_fence(__ATOMIC_RELEASE, "agent");
            asm volatile("s_waitcnt vmcnt(0)" ::: "memory");
            const unsigned og = xb_add(&bar[XB_TOP], 1u);
            const unsigned tg = og / nx;
            if (og + 1u == (tg + 1u) * nx) xb_add(&bar[XB_TOPGEN], 1u);
            else XB_SPIN(xb_ld(&bar[XB_TOPGEN]) == tg, bar);
            __builtin_amdgcn_fence(__ATOMIC_ACQUIRE, "agent");
            xb_add(&bar[XB_XGEN(b.x)], 1u);
            asm volatile("s_waitcnt vmcnt(0)" ::: "memory");
        } else {
            XB_SPIN(xb_ld(&bar[XB_XGEN(b.x)]) == gen, bar);
            __builtin_amdgcn_fence(__ATOMIC_ACQUIRE, "agent");
            asm volatile("s_waitcnt vmcnt(0)" ::: "memory");
        }
    }
    __syncthreads();
}

namespace pg8 {
typedef unsigned u32x4 __attribute__((ext_vector_type(4)));
constexpr int BM = 256, BK = 64, HALF = 128, HTB = HALF * BK * 2, STAGE_BYTES = 8 * HTB, NXCD = 8, WGM = 8;
__host__ __device__ __forceinline__ int lds_byte(int r, int c) { const int st = (r >> 4) * 2 + (c >> 5), rr = r & 15, cc = c & 31, ob = rr * 64 + cc * 2; return st * 1024 + (ob ^ (((ob >> 9) & 1) << 5)); }
__host__ __device__ __forceinline__ void stage_rc(int b, int& R, int& C) { const int st = b / 1024, sb = b % 1024, swz = sb ^ (((sb >> 9) & 1) << 5); R = (st >> 1) * 16 + swz / 64; C = (st & 1) * 32 + (swz % 64) / 2; }
__host__ __device__ __forceinline__ int perm32(int rho) { const int n = rho >> 4, i = rho & 15; return 8 * (i >> 2) + 4 * n + (i & 3); }
struct Unit { int pm, pn, e; };
__device__ __forceinline__ unsigned cvt_pk_bf16(float lo, float hi) { unsigned r; asm volatile("v_cvt_pk_bf16_f32 %0, %1, %2" : "=v"(r) : "v"(lo), "v"(hi)); return r; }

struct DenseOrder {
    int nM, nN, nwg, G, c, K; const char* A; const char* Bt;
    __device__ __forceinline__ void init(const void* A_, const void* Bt_, int M, int N, int K_, int G_, int c_) { A = (const char*)A_; Bt = (const char*)Bt_; nM = M / BM; nN = N / BM; nwg = nM * nN; G = G_; c = c_; K = K_; }
    __device__ __forceinline__ bool next(int i, Unit& u) const {
        const long L = (long)i * G + c; if (L >= nwg) return false;
        int wgid = (int)L; { const int q = nwg / NXCD, r = nwg % NXCD, xcd = wgid % NXCD, off = wgid / NXCD; wgid = (xcd < r ? xcd * (q + 1) : r * (q + 1) + (xcd - r) * q) + off; }
        const int nig = WGM * nN, gid = wgid / nig, fm = gid * WGM, gsz = (nM - fm) < WGM ? (nM - fm) : WGM;
        u.pm = fm + ((wgid % nig) % gsz); u.pn = (wgid % nig) / gsz; u.e = 0; return true;
    }
    __device__ __forceinline__ unsigned a_off(const Unit& u, int r) const { return (unsigned)((u.pm * BM + r) * K) * 2u; }
    __device__ __forceinline__ const char* b_ptr(const Unit& u) const { return Bt + (size_t)u.pn * BM * K * 2; }
};
struct MoeOrder {
    const LAS int* poff; const unsigned* cnt; const int* list; const char* A; const char* Bt; size_t estride; int K, G, c; bool gather;
    __device__ __forceinline__ bool next(int i, Unit& u) const {
        const int L = i * G + c, np = __builtin_amdgcn_readfirstlane(poff[32]) >> 8; if (L >= np * 4) return false;
        u.pm = L >> 2; u.pn = L & 3; const int row = u.pm << 8; int e = 0;
        while (row >= __builtin_amdgcn_readfirstlane(poff[e + 1])) ++e;
        u.e = e; return true;
    }
    __device__ __forceinline__ unsigned a_off(const Unit& u, int r) const {
        if (!gather) return (unsigned)((u.pm * BM + r) * K) * 2u;
        const int idx = u.pm * BM + r - poff[u.e]; const int tok = idx < (int)cnt[u.e] ? list[(size_t)u.e * NT + idx] : 0;
        return (unsigned)tok * (unsigned)(K * 2);
    }
    __device__ __forceinline__ const char* b_ptr(const Unit& u) const { return Bt + (size_t)u.e * estride + (size_t)u.pn * BM * K * 2; }
};

struct EpiBf {
    static constexpr bool PERM = true;
    bf16* O; int ldc;
    __device__ __forceinline__ void operator()(const f32x4 (&acc)[2][2][4][2], const Unit& u, int wr, int wc, int fr, int fq) const {
        const int row0 = u.pm * BM + wr * 64 + fr, col0 = u.pn * BM + wc * 32 + 8 * fq;
#pragma unroll
        for (int ai = 0; ai < 2; ++ai)
#pragma unroll
            for (int m = 0; m < 4; ++m) { bf16* rowp = O + (size_t)(row0 + ai * HALF + m * 16) * ldc + col0;
#pragma unroll
                for (int bj = 0; bj < 2; ++bj) { const f32x4 v0 = acc[ai][bj][m][0], v1 = acc[ai][bj][m][1];
                    u32x4 w; w.x = cvt_pk_bf16(v0[0], v0[1]); w.y = cvt_pk_bf16(v0[2], v0[3]); w.z = cvt_pk_bf16(v1[0], v1[1]); w.w = cvt_pk_bf16(v1[2], v1[3]);
                    *(u32x4*)(rowp + bj * HALF) = w; } }
    }
};
struct EpiRes {
    static constexpr bool PERM = false;
    const float* res; float* out;
    __device__ __forceinline__ void operator()(const f32x4 (&acc)[2][2][4][2], const Unit& u, int wr, int wc, int fr, int fq) const {
        const int row0 = u.pm * BM + wr * 64 + fr, col0 = u.pn * BM + wc * 32 + 4 * fq;
#pragma unroll
        for (int ai = 0; ai < 2; ++ai)
#pragma unroll
            for (int m = 0; m < 4; ++m) { const size_t off = (size_t)(row0 + ai * HALF + m * 16) * 1024 + col0;
#pragma unroll
                for (int bj = 0; bj < 2; ++bj)
#pragma unroll
                    for (int n = 0; n < 2; ++n) *(f32x4*)(out + off + bj * HALF + n * 16) = *(const f32x4*)(res + off + bj * HALF + n * 16) + acc[ai][bj][m][n];
                asm volatile("" ::: "memory"); }
    }
};
struct EpiUp {
    static constexpr bool PERM = true;
    bf16* H;
    __device__ __forceinline__ void operator()(const f32x4 (&acc)[2][2][4][2], const Unit& u, int wr, int wc, int fr, int fq) const {
        const int row0 = u.pm * BM + wr * 64 + fr, col0 = u.pn * HALF + wc * 32 + 8 * fq;
#pragma unroll
        for (int ai = 0; ai < 2; ++ai)
#pragma unroll
            for (int m = 0; m < 4; ++m) { bf16* rowp = H + (size_t)(row0 + ai * HALF + m * 16) * 512 + col0;
                float h[8];
#pragma unroll
                for (int n = 0; n < 2; ++n)
#pragma unroll
                    for (int i = 0; i < 4; ++i) { const float a = acc[ai][0][m][n][i], b = acc[ai][1][m][n][i]; h[n * 4 + i] = a * __builtin_amdgcn_rcpf(1.f + __expf(-a)) * b; }
                u32x4 w; w.x = cvt_pk_bf16(h[0], h[1]); w.y = cvt_pk_bf16(h[2], h[3]); w.z = cvt_pk_bf16(h[4], h[5]); w.w = cvt_pk_bf16(h[6], h[7]);
                *(u32x4*)rowp = w; }
    }
};

template <class Epi, class Sched, bool ALIGN_EPI>
__device__ __forceinline__ void gemm_phase(LAS unsigned char* lds, const int K, const Sched& S, const Epi& E) {
    int tid = threadIdx.x; asm volatile("" : "+v"(tid));
    const int wid = __builtin_amdgcn_readfirstlane(tid >> 6), lane = tid & 63, wr = wid >> 2, wc = wid & 3, fr = lane & 15, fq = lane >> 4;
    const int nt = K / BK;
    int RA[2]; unsigned CA[2], voffB[2];
#pragma unroll
    for (int i = 0; i < 2; ++i) { int R, C; stage_rc(tid * 16 + i * 8192, R, C); const int Rb = Epi::PERM ? ((R & ~31) + perm32(R & 31)) : R;
        RA[i] = R; CA[i] = (unsigned)C * 2u; voffB[i] = (unsigned)(Rb * K + C) * 2u; }
    const size_t kstep = (size_t)(BK * 2);
    const size_t hstep = (size_t)HALF * K * 2;
    const unsigned ldsw = (unsigned)wid * 1024u;
    const int aoff = lds_byte(wr * 64 + fr, fq * 8), boff = lds_byte(wc * 32 + fr, fq * 8);
    const char* const A0 = S.A;
#define PG8_SA(b, h) (((b) * 2 + (h)) * HTB)
#define PG8_SB(b, h) ((4 + (b) * 2 + (h)) * HTB)
#define PG8_STAGE(bufoff, gbase, voff) do { _Pragma("unroll") for (int _i = 0; _i < 2; ++_i) \
        __builtin_amdgcn_global_load_lds((const unsigned*)((const char*)(gbase) + (voff)[_i]), (LAS unsigned*)(lds + (bufoff) + ldsw + _i * 8192), 16, 0, 0); } while (0)
#define PG8_STAGEA(bufoff, kbyte, o0, o1) do { \
        __builtin_amdgcn_global_load_lds((const unsigned*)(A0 + (kbyte) + (o0)), (LAS unsigned*)(lds + (bufoff) + ldsw), 16, 0, 0); \
        __builtin_amdgcn_global_load_lds((const unsigned*)(A0 + (kbyte) + (o1)), (LAS unsigned*)(lds + (bufoff) + ldsw + 8192), 16, 0, 0); } while (0)
#define PG8_LDA(dst, b, h) do { _Pragma("unroll") for (int m = 0; m < 4; ++m) _Pragma("unroll") for (int k = 0; k < 2; ++k) dst[m][k] = *(const LAS bf16x8*)(lds + PG8_SA(b, h) + aoff + m * 2048 + k * 1024); } while (0)
#define PG8_LDB(dst, b, h) do { _Pragma("unroll") for (int n = 0; n < 2; ++n) _Pragma("unroll") for (int k = 0; k < 2; ++k) dst[n][k] = *(const LAS bf16x8*)(lds + PG8_SB(b, h) + boff + n * 2048 + k * 1024); } while (0)
#define PG8_MMA(ai, bj, At, Bt) do { __builtin_amdgcn_s_setprio(1); _Pragma("unroll") for (int m = 0; m < 4; ++m) _Pragma("unroll") for (int n = 0; n < 2; ++n) _Pragma("unroll") for (int k = 0; k < 2; ++k) \
        acc[ai][bj][m][n] = __builtin_amdgcn_mfma_f32_16x16x32_bf16(Bt[n][k], At[m][k], acc[ai][bj][m][n], 0, 0, 0); __builtin_amdgcn_s_setprio(0); } while (0)
#define PG8_WAIT_V(n) asm volatile("s_waitcnt vmcnt(" #n ")" ::: "memory")
#define PG8_WAIT_L(n) asm volatile("s_waitcnt lgkmcnt(" #n ")" ::: "memory")
#define PG8_BAR __builtin_amdgcn_s_barrier()
#define PG8_SCHED __builtin_amdgcn_sched_barrier(0)
    Unit cur, nxt; int ui = 0;
    if (!S.next(0, cur)) return;
    f32x4 acc[2][2][4][2];
#pragma unroll
    for (int a = 0; a < 2; ++a)
#pragma unroll
        for (int b = 0; b < 2; ++b)
#pragma unroll
            for (int m = 0; m < 4; ++m)
#pragma unroll
                for (int n = 0; n < 2; ++n) acc[a][b][m][n] = (f32x4){0.f, 0.f, 0.f, 0.f};
    bf16x8 At[4][2], B0[2][2], B1[2][2];
    unsigned oc00, oc01, oc10, oc11, on00, on01, on10, on11;
    oc00 = S.a_off(cur, RA[0]) + CA[0]; oc01 = S.a_off(cur, RA[1]) + CA[1]; oc10 = S.a_off(cur, HALF + RA[0]) + CA[0]; oc11 = S.a_off(cur, HALF + RA[1]) + CA[1];
    const char* cB = S.b_ptr(cur);
    PG8_STAGE(PG8_SB(0, 0), cB, voffB); PG8_STAGE(PG8_SB(0, 1), cB + hstep, voffB); PG8_STAGEA(PG8_SA(0, 0), 0, oc00, oc01); PG8_STAGEA(PG8_SA(0, 1), 0, oc10, oc11);
    if (wr == 1) PG8_BAR;
    PG8_WAIT_V(2); PG8_BAR;
    PG8_STAGE(PG8_SB(1, 0), cB + kstep, voffB); PG8_STAGEA(PG8_SA(1, 0), kstep, oc00, oc01); PG8_STAGE(PG8_SB(1, 1), cB + hstep + kstep, voffB);
    PG8_WAIT_V(6); PG8_BAR;
    for (;;) {
        const bool has_next = S.next(ui + 1, nxt);
        const char* nB = cB;
        on00 = oc00; on01 = oc01; on10 = oc10; on11 = oc11;
        if (has_next) { nB = S.b_ptr(nxt); on00 = S.a_off(nxt, RA[0]) + CA[0]; on01 = S.a_off(nxt, RA[1]) + CA[1]; on10 = S.a_off(nxt, HALF + RA[0]) + CA[0]; on11 = S.a_off(nxt, HALF + RA[1]) + CA[1]; }
        for (int t = 0; t < nt; t += 2) {
            const bool last = (t == nt - 2);
            const size_t k1 = (size_t)(t + 1) * kstep, k2 = last ? 0 : (size_t)(t + 2) * kstep, k3 = k2 + kstep;
            const char* b2 = last ? nB : cB + (size_t)(t + 2) * kstep; const char* b3 = b2 + kstep;
            const unsigned p00 = last ? on00 : oc00, p01 = last ? on01 : oc01, p10 = last ? on10 : oc10, p11 = last ? on11 : oc11;
            PG8_LDB(B0, 0, 0); PG8_LDB(B1, 0, 1); PG8_SCHED; PG8_LDA(At, 0, 0); PG8_STAGEA(PG8_SA(1, 1), k1, oc10, oc11);
            PG8_WAIT_V(8); PG8_WAIT_L(0); PG8_BAR; PG8_MMA(0, 0, At, B0); PG8_MMA(0, 1, At, B1); PG8_BAR; PG8_SCHED;
            PG8_LDA(At, 0, 1); PG8_STAGE(PG8_SB(0, 0), b2, voffB); PG8_STAGE(PG8_SB(0, 1), b2 + hstep, voffB); PG8_STAGEA(PG8_SA(0, 0), k2, p00, p01);
            PG8_WAIT_V(8); PG8_WAIT_L(0); PG8_BAR; PG8_MMA(1, 0, At, B0); PG8_MMA(1, 1, At, B1); PG8_BAR; PG8_SCHED;
            PG8_LDB(B0, 1, 0); PG8_LDB(B1, 1, 1); PG8_SCHED; PG8_LDA(At, 1, 0); PG8_STAGEA(PG8_SA(0, 1), k2, p10, p11);
            PG8_WAIT_V(8); PG8_WAIT_L(0); PG8_BAR; PG8_MMA(0, 0, At, B0); PG8_MMA(0, 1, At, B1); PG8_BAR; PG8_SCHED;
            PG8_LDA(At, 1, 1); PG8_STAGE(PG8_SB(1, 0), b3, voffB); PG8_STAGE(PG8_SB(1, 1), b3 + hstep, voffB); PG8_STAGEA(PG8_SA(1, 0), k3, p00, p01);
            PG8_WAIT_V(8); PG8_WAIT_L(0); PG8_BAR; PG8_MMA(1, 0, At, B0); PG8_MMA(1, 1, At, B1); PG8_BAR; PG8_SCHED;
        }
        if constexpr (ALIGN_EPI) { if (wr == 0) PG8_BAR; }
        E(acc, cur, wr, wc, fr, fq);
        if (!has_next) break;
#pragma unroll
        for (int a = 0; a < 2; ++a)
#pragma unroll
            for (int b = 0; b < 2; ++b)
#pragma unroll
                for (int m = 0; m < 4; ++m)
#pragma unroll
                    for (int n = 0; n < 2; ++n) acc[a][b][m][n] = (f32x4){0.f, 0.f, 0.f, 0.f};
        cur = nxt; cB = nB; oc00 = on00; oc01 = on01; oc10 = on10; oc11 = on11; ++ui;
        if constexpr (ALIGN_EPI) { if (wr == 1) PG8_BAR; }
    }
    PG8_WAIT_V(0);
    if constexpr (!ALIGN_EPI) { if (wr == 0) PG8_BAR; }
    PG8_BAR;
#undef PG8_SA
#undef PG8_SB
#undef PG8_STAGE
#undef PG8_STAGEA
#undef PG8_LDA
#undef PG8_LDB
#undef PG8_MMA
#undef PG8_WAIT_V
#undef PG8_WAIT_L
#undef PG8_BAR
#undef PG8_SCHED
}
}

#define PHASE_IDS(F) do { int _t = threadIdx.x; asm volatile("" : "+v"(_t)); (F).tid = _t; (F).lane = _t & 63; (F).wave = __builtin_amdgcn_readfirstlane(_t >> 6); } while (0)
__device__ __forceinline__ void tr_item(const float* W, int ldw, int k0, int c0, bf16* WT, int K, int r0, LAS float* scr, int lane) {
#pragma unroll 8
    for (int i = 0; i < 32; ++i) { const int kk = 2 * i + (lane >> 5); scr[kk * 33 + (lane & 31)] = W[(size_t)(k0 + kk) * ldw + c0 + (lane & 31)]; }
    LDS_WAIT(); asm volatile("" ::: "memory");
    const int c = lane & 7;
#pragma unroll
    for (int j = 0; j < 4; ++j) { const int n = (lane >> 3) + 8 * j; const LAS float* s = scr + (8 * c) * 33 + n;
        v4u o; o.x = pk2(s[0 * 33], s[1 * 33]); o.y = pk2(s[2 * 33], s[3 * 33]); o.z = pk2(s[4 * 33], s[5 * 33]); o.w = pk2(s[6 * 33], s[7 * 33]);
        *(v4u*)(WT + (size_t)(r0 + n) * K + k0 + 8 * c) = o; }
    LDS_WAIT(); asm volatile("" ::: "memory");
}

__device__ __forceinline__ void phase_prologue(Frame& F) {
    PHASE_IDS(F);
    LAS float* WL = (LAS float*)F.lds;
    LAS float* scr = (LAS float*)(F.lds + 65536 + F.wave * 8704);
    const float* w_in0 = F.in[4];
    for (int s = F.tid; s < 16 * 1024; s += 512) { const int k = s >> 4, o = s & 15; WL[o * 1024 + k] = w_in0[(size_t)k * EV_LD + 3072 + o]; }
    const int gw = F.vcu * NWAVES + F.wave, NGW = F.G * NWAVES;
    bf16* WIN0 = (bf16*)(F.ws + WS_WIN0); bf16* WOUT0 = (bf16*)(F.ws + WS_WOUT0); bf16* WIN1 = (bf16*)(F.ws + WS_WIN1); bf16* WOUT1 = (bf16*)(F.ws + WS_WOUT1);
    bf16* W13 = (bf16*)(F.ws + WS_W13); bf16* W2 = (bf16*)(F.ws + WS_W2);
    constexpr int I_A = 16 * 96, I_B = 16 * 16, I_C = 16 * 32, I_D = 16 * 80, I_E = 16 * 32, I_F = 2 * 32 * 2 * 256, I_G = 2 * 32 * 256;
    constexpr int NITEMS = I_A + I_B + I_C + I_D + I_E + I_F + I_G;
    for (int it = gw; it < NITEMS; it += NGW) {
        int r = it;
        if (r < I_A) { const int kb = r / 96, nb = r % 96; tr_item(w_in0, EV_LD, 64 * kb, 32 * nb, WIN0, 1024, 32 * nb, scr, F.lane); continue; } r -= I_A;
        if (r < I_B) { const int kb = r / 16, nb = r % 16; tr_item(w_in0, EV_LD, 64 * kb, 3088 + 32 * nb, WIN0, 1024, 3072 + 32 * nb, scr, F.lane); continue; } r -= I_B;
        if (r < I_C) { const int kb = r / 32, nb = r % 32; tr_item(F.in[10], 1024, 64 * kb, 32 * nb, WOUT0, 1024, 32 * nb, scr, F.lane); continue; } r -= I_C;
        if (r < I_D) { const int kb = r / 80, nb = r % 80; tr_item(F.in[11], OD_N, 64 * kb, 32 * nb, WIN1, 1024, 32 * nb, scr, F.lane); continue; } r -= I_D;
        if (r < I_E) { const int kb = r / 32, nb = r % 32; tr_item(F.in[20], 1024, 64 * kb, 32 * nb, WOUT1, 1024, 32 * nb, scr, F.lane); continue; } r -= I_E;
        if (r < I_F) { const int le = r / 512, q = r % 512, which = q / 256, kb = (q % 256) / 16, nb = q % 16;
            const float* src = (which ? F.in[26] : F.in[25]) + (size_t)le * 1024 * 512; const int n0 = 32 * nb;
            tr_item(src, 512, 64 * kb, n0, W13 + (size_t)le * 1024 * 1024, 1024, 256 * (n0 >> 7) + (n0 & 127) + which * 128, scr, F.lane); continue; } r -= I_F;
        { const int le = r / 256, q = r % 256, kb = q / 32, nb = q % 32;
            tr_item(F.in[27] + (size_t)le * 512 * 1024, 1024, 64 * kb, 32 * nb, W2 + (size_t)le * 1024 * 512, 512, 32 * nb, scr, F.lane); }
    }
    __syncthreads();
    const float* x = F.in[0]; const float* g = F.in[1];
    bf16* XN = (bf16*)(F.ws + WS_ACT); float* BL = (float*)(F.ws + WS_BLOW);
    f32x4 gv[4];
#pragma unroll
    for (int j = 0; j < 4; ++j) gv[j] = *((const f32x4*)g + 64 * j + F.lane);
    for (int m = gw; m < NT; m += NGW) {
        const f32x4* xr = (const f32x4*)(x + (size_t)m * D) + F.lane;
        f32x4 v[4]; float s = 0.f;
#pragma unroll
        for (int j = 0; j < 4; ++j) { v[j] = xr[64 * j]; s += (v[j].x * v[j].x + v[j].y * v[j].y) + (v[j].z * v[j].z + v[j].w * v[j].w); }
        const float rstd = rsqrtf(wave_sum(s) * (1.f / D) + EPS);
        v2u* o8 = (v2u*)(XN + (size_t)m * D) + F.lane;
#pragma unroll
        for (int j = 0; j < 4; ++j) { v[j] = v[j] * rstd * gv[j]; v2u w; w.x = pk2(v[j].x, v[j].y); w.y = pk2(v[j].z, v[j].w); o8[64 * j] = w; }
        float mine = 0.f;
#pragma unroll 4
        for (int o = 0; o < 16; ++o) {
            const LAS f32x4* wl = (const LAS f32x4*)(WL + o * 1024) + F.lane; float p = 0.f;
#pragma unroll
            for (int j = 0; j < 4; ++j) { const f32x4 w = wl[64 * j]; p += (v[j].x * w.x + v[j].y * w.y) + (v[j].z * w.z + v[j].w * w.w); }
            p = wave_sum(p); mine = (F.lane == o) ? p : mine;
        }
        if (F.lane < 16) BL[(size_t)m * 16 + F.lane] = mine;
    }
}

__device__ __forceinline__ void phase_router(Frame& F, int layer) {
    PHASE_IDS(F);
    LAS float* WL = (LAS float*)F.lds;
    LAS int* hist = (LAS int*)(F.lds + LDS_MISC + 1024); LAS int* base = hist + 32;
    LAS int* s_e0 = base + 32; LAS int* s_e1 = s_e0 + 128; LAS int* s_r0 = s_e1 + 128; LAS int* s_r1 = s_r0 + 128;
    LAS float* s_w0 = (LAS float*)(s_r1 + 128); LAS float* s_w1 = s_w0 + 128;
    const float* wg = F.in[21] + (size_t)layer * 1024 * 4; const float* we = F.in[23] + (size_t)layer * 1024 * 32;
    for (int s = F.tid; s < 4096; s += 512) WL[(s & 3) * 1024 + (s >> 2)] = wg[s];
    for (int s = F.tid; s < 32768; s += 512) WL[(4 + (s & 31)) * 1024 + (s >> 5)] = we[s];
    const float* g = F.in[2] + layer * 1024;
    const float bias = F.lane < 4 ? F.in[22][layer * 4 + F.lane] : (F.lane < 36 ? F.in[24][layer * 32 + F.lane - 4] : 0.f);
    unsigned* cnt = F.ctl + CW_CNT + 64 * layer;
    bf16* XN = (bf16*)(F.ws + WS_ACT);
    int* ME0 = (int*)(F.ws + WS_META); int* ME1 = ME0 + NT; int* MR0 = ME1 + NT; int* MR1 = MR0 + NT; float* MW0 = (float*)(MR1 + NT); float* MW1 = MW0 + NT;
    int* LIST = (int*)(F.ws + WS_LIST);
    f32x4 gv[4];
#pragma unroll
    for (int j = 0; j < 4; ++j) gv[j] = *((const f32x4*)g + 64 * j + F.lane);
    __syncthreads();
    for (int row0 = 128 * F.vcu; row0 < NT; row0 += 128 * F.G) {
        if (F.tid < 32) hist[F.tid] = 0;
        __syncthreads();
        for (int bt = 0; bt < 4; ++bt) {
            const int rl = F.wave * 16 + bt * 4, m0 = row0 + rl;
            f32x4 hn[4][4];
#pragma unroll
            for (int r = 0; r < 4; ++r) {
                const f32x4* xr = (const f32x4*)(F.out + (size_t)(m0 + r) * D) + F.lane; float s = 0.f;
#pragma unroll
                for (int j = 0; j < 4; ++j) { hn[r][j] = xr[64 * j]; s += (hn[r][j].x * hn[r][j].x + hn[r][j].y * hn[r][j].y) + (hn[r][j].z * hn[r][j].z + hn[r][j].w * hn[r][j].w); }
                const float rstd = rsqrtf(wave_sum(s) * (1.f / D) + EPS);
                v2u* o8 = (v2u*)(XN + (size_t)(m0 + r) * D) + F.lane;
#pragma unroll
                for (int j = 0; j < 4; ++j) { hn[r][j] = hn[r][j] * rstd * gv[j]; v2u w; w.x = pk2(hn[r][j].x, hn[r][j].y); w.y = pk2(hn[r][j].z, hn[r][j].w); o8[64 * j] = w; }
            }
            float res[4] = {0.f, 0.f, 0.f, 0.f};
#pragma unroll 2
            for (int o = 0; o < 36; ++o) {
                const LAS f32x4* wl = (const LAS f32x4*)(WL + o * 1024) + F.lane;
                float p[4] = {0.f, 0.f, 0.f, 0.f};
#pragma unroll
                for (int j = 0; j < 4; ++j) { const f32x4 w = wl[64 * j];
#pragma unroll
                    for (int r = 0; r < 4; ++r) p[r] += (hn[r][j].x * w.x + hn[r][j].y * w.y) + (hn[r][j].z * w.z + hn[r][j].w * w.w); }
#pragma unroll
                for (int r = 0; r < 4; ++r) { const float s = wave_sum(p[r]); res[r] = (F.lane == o) ? s : res[r]; }
            }
#pragma unroll
            for (int r = 0; r < 4; ++r) {
                const float lg = res[r] + bias;
                const float g0 = __shfl(lg, 0), g1 = __shfl(lg, 1), g2 = __shfl(lg, 2), g3 = __shfl(lg, 3);
                int gi = 0; float gm = g0;
                if (g1 > gm) { gm = g1; gi = 1; } if (g2 > gm) { gm = g2; gi = 2; } if (g3 > gm) { gm = g3; gi = 3; }
                const float gwt = 1.f / (expf(g0 - gm) + expf(g1 - gm) + expf(g2 - gm) + expf(g3 - gm));
                float v0 = -3.0e38f, v1 = -3.0e38f; int i0 = 0, i1 = 0;
#pragma unroll
                for (int i = 0; i < 8; ++i) { const float ev = __shfl(lg, 4 + gi * 8 + i);
                    if (ev > v0) { v1 = v0; i1 = i0; v0 = ev; i0 = i; } else if (ev > v1) { v1 = ev; i1 = i; } }
                const float ex = expf(v1 - v0), tw0 = 1.f / (1.f + ex), tw1 = ex / (1.f + ex);
                if (F.lane == r) {
                    const int e0 = gi * 8 + i0, e1 = gi * 8 + i1;
                    s_e0[rl + r] = e0; s_e1[rl + r] = e1; s_w0[rl + r] = gwt * tw0; s_w1[rl + r] = gwt * tw1;
                    s_r0[rl + r] = atomicAdd((int*)&hist[e0], 1); s_r1[rl + r] = atomicAdd((int*)&hist[e1], 1);
                }
            }
        }
        __syncthreads();
        if (F.tid < 32) base[F.tid] = (int)atomicAdd(cnt + F.tid, (unsigned)hist[F.tid]);
        __syncthreads();
        if (F.tid < 128) {
            const int m = row0 + F.tid, e0 = s_e0[F.tid], e1 = s_e1[F.tid], r0 = base[e0] + s_r0[F.tid], r1 = base[e1] + s_r1[F.tid];
            ME0[m] = e0; ME1[m] = e1; MR0[m] = r0; MR1[m] = r1; MW0[m] = s_w0[F.tid]; MW1[m] = s_w1[F.tid];
            LIST[(size_t)e0 * NT + r0] = m; LIST[(size_t)e1 * NT + r1] = m;
        }
        __syncthreads();
    }
}

__device__ __forceinline__ void phase_combine(Frame& F, int layer) {
    PHASE_IDS(F);
    LAS int* poff = (LAS int*)(F.lds + LDS_MISC + 1024);
    const unsigned* cnt = F.ctl + CW_CNT + 64 * layer;
    if (F.tid == 0) { int acc = 0; for (int e = 0; e < 32; ++e) { poff[e] = acc; acc += ((int)cnt[e] + 255) & ~255; } poff[32] = acc; }
    __syncthreads();
    const int gw = F.vcu * NWAVES + F.wave, NGW = F.G * NWAVES;
    const float* g = layer == 0 ? F.in[1] + 1024 : F.in[3];
    const bf16* Y = (const bf16*)(F.ws + WS_Y); bf16* XN = (bf16*)(F.ws + WS_ACT);
    const int* ME0 = (const int*)(F.ws + WS_META); const int* ME1 = ME0 + NT; const int* MR0 = ME1 + NT; const int* MR1 = MR0 + NT; const float* MW0 = (const float*)(MR1 + NT); const float* MW1 = MW0 + NT;
    f32x4 gv[4];
#pragma unroll
    for (int j = 0; j < 4; ++j) gv[j] = *((const f32x4*)g + 64 * j + F.lane);
    for (int m = gw; m < NT; m += NGW) {
        const int s0 = poff[ME0[m]] + MR0[m], s1 = poff[ME1[m]] + MR1[m]; const float w0 = MW0[m], w1 = MW1[m];
        f32x4* xr = (f32x4*)(F.out + (size_t)m * D) + F.lane;
        const v2u* y0 = (const v2u*)(Y + (size_t)s0 * D) + F.lane; const v2u* y1 = (const v2u*)(Y + (size_t)s1 * D) + F.lane;
        f32x4 v[4]; float s = 0.f;
#pragma unroll
        for (int j = 0; j < 4; ++j) { v[j] = xr[64 * j]; const v2u a = y0[64 * j], b = y1[64 * j];
            v[j].x += w0 * bf2f((bf16)(a.x & 0xffff)) + w1 * bf2f((bf16)(b.x & 0xffff)); v[j].y += w0 * bf2f((bf16)(a.x >> 16)) + w1 * bf2f((bf16)(b.x >> 16));
            v[j].z += w0 * bf2f((bf16)(a.y & 0xffff)) + w1 * bf2f((bf16)(b.y & 0xffff)); v[j].w += w0 * bf2f((bf16)(a.y >> 16)) + w1 * bf2f((bf16)(b.y >> 16));
            s += (v[j].x * v[j].x + v[j].y * v[j].y) + (v[j].z * v[j].z + v[j].w * v[j].w); }
        const float rstd = rsqrtf(wave_sum(s) * (1.f / D) + EPS);
        if (layer == 0) {
            v2u* o8 = (v2u*)(XN + (size_t)m * D) + F.lane;
#pragma unroll
            for (int j = 0; j < 4; ++j) { xr[64 * j] = v[j]; const f32x4 n = v[j] * rstd * gv[j]; v2u w; w.x = pk2(n.x, n.y); w.y = pk2(n.z, n.w); o8[64 * j] = w; }
        } else {
#pragma unroll
            for (int j = 0; j < 4; ++j) xr[64 * j] = v[j] * rstd * gv[j];
        }
    }
}


namespace mx {
typedef short s4 __attribute__((ext_vector_type(4)));
constexpr int PV = 272, PP = 144;
template <int DK> struct Lay { static constexpr int PK = DK * 2 + 16, QS = 0, KS = 64 * PK, VV = 2 * 64 * PK, ST = VV + 64 * PV, PM = ST + 128 * PK, VEC = PM + 64 * PP, PART = VEC + 3 * DK * 4, RED = PART + 8 * DK * 4, END = RED + 4096; };
static_assert(Lay<128>::END <= LDS_MISC, "mixer LDS map");
__device__ __forceinline__ bf16x8 row_frag(const LAS unsigned char* base, int pitch, int row0, int kk, int lane) {
    return *(const LAS bf16x8*)(base + (row0 + (lane & 15)) * pitch + (32 * kk + 8 * (lane >> 4)) * 2);
}
__device__ __forceinline__ bf16x8 tr_frag(const LAS unsigned char* base, int pitch, int k0, int c0, int lane) {
    const int g = lane >> 4, q = (lane & 15) >> 2, p = lane & 3;
    const LAS unsigned char* a = base + (k0 + 8 * g + q) * pitch + (c0 + 4 * p) * 2;
    const s4 lo = __builtin_amdgcn_ds_read_tr16_b64_v4i16((LAS s4*)a);
    const s4 hi = __builtin_amdgcn_ds_read_tr16_b64_v4i16((LAS s4*)(a + 4 * pitch));
    return __builtin_shufflevector(lo, hi, 0, 1, 2, 3, 4, 5, 6, 7);
}
#define MFMA16(a, b, c) __builtin_amdgcn_mfma_f32_16x16x32_bf16(a, b, c, 0, 0, 0)

struct UnitP { const bf16* PROJ; bf16* YM; const float* nw; const float* BL; const float* p0; const float* p1; const float* p2; int b, h, seg; };

template <int KIND> struct KC {
    static constexpr int DK = KIND == 0 ? 128 : 64, LDP = KIND == 2 ? OD_N : EV_N;
    __device__ static __forceinline__ int qcol(int h) { return KIND == 0 ? h * 128 : (KIND == 1 ? 2048 + h * 64 : h * 64); }
    __device__ static __forceinline__ int kcol(int h) { return KIND == 0 ? 512 + h * 128 : (KIND == 1 ? 2304 + h * 64 : 256 + h * 64); }
    __device__ static __forceinline__ int vcol(int h) { return KIND == 0 ? 1024 + h * 128 : (KIND == 1 ? 2560 + h * 128 : 512 + h * 128); }
    __device__ static __forceinline__ int gcol(int h) { return KIND == 0 ? 1536 + h * 128 : (KIND == 1 ? 3072 + h * 128 : 1024 + h * 128); }
    __device__ static __forceinline__ int ocol(int h) { return KIND == 1 ? 512 + h * 128 : h * 128; }
};

template <int KIND, bool FULL>
__device__ __forceinline__ void mix_unit(LAS unsigned char* lds, float* Sg, float* Bg, const UnitP& U) {
    using K = KC<KIND>; constexpr int DK = K::DK, LDP = K::LDP, NJT = DK == 128 ? 8 : 4; using L = Lay<DK>; constexpr int PK = L::PK;
    int tid = threadIdx.x; asm volatile("" : "+v"(tid));
    const int lane = tid & 63, wave = __builtin_amdgcn_readfirstlane(tid >> 6), g = lane >> 4, c = lane & 15;
    const int h = U.h, dt = DK == 128 ? wave : (wave & 3), jt0 = DK == 128 ? 0 : 4 * (wave >> 2);
    LAS float* EM = (LAS float*)(lds + L::VEC); LAS float* EL = EM + DK; LAS float* BT = EL + DK; LAS float* PART = (LAS float*)(lds + L::PART);
    float lb0 = 0.f, lb1 = 0.f, wu[16], bu = 0.f, ci = 0.f, lgg = 0.f;
    if (KIND == 0) {
        const float* lbl = U.p0; const int col = h * 128 + 2 * lane;
#pragma unroll
        for (int x = 0; x < 2; ++x) { const float l0 = lbl[col + x], l1 = lbl[512 + col + x], l2 = lbl[1024 + col + x]; const float mx_ = fmaxf(l0, fmaxf(l1, l2));
            const float e0 = __expf(l0 - mx_), e1 = __expf(l1 - mx_), e2 = __expf(l2 - mx_); const float v = e0 / (e0 + e1 + e2); if (x == 0) lb0 = v; else lb1 = v; }
    }
    if (KIND == 1) {
#pragma unroll
        for (int r = 0; r < 16; ++r) wu[r] = U.p0[r * 256 + h * 64 + lane];
        bu = U.p1[h * 64 + lane];
    }
    if (KIND == 2) { ci = exp2f(-(float)(lane & 31) * (13.287712379549449f / 32.f)) * 0.15915494309189535f; lgg = log1pf(-exp2f(-5.f - (float)h)); }
    f32x4 S[NJT];
#pragma unroll
    for (int jt = 0; jt < NJT; ++jt) {
        if (FULL) {
#pragma unroll
            for (int i = 0; i < 4; ++i) S[jt][i] = Sg[(16 * dt + 4 * g + i) * 128 + 16 * (jt0 + jt) + c];
        } else S[jt] = (f32x4){0.f, 0.f, 0.f, 0.f};
    }
    f32x4 nw4[4];
    if (FULL) {
#pragma unroll
        for (int x = 0; x < 4; ++x) nw4[x] = *(const f32x4*)(U.nw + h * 128 + 16 * (4 * (wave >> 2) + x) + 4 * g);
    }
    if (tid < DK) BT[tid] = 0.f;
    for (int ch = 0; ch < 16; ++ch) {
        const int pos0 = U.seg * 1024 + ch * 64; const size_t row0 = (size_t)U.b * SEQ + pos0;
        { const bf16* Vp = U.PROJ + (row0 + (tid >> 3)) * LDP + K::vcol(h) + (tid & 7) * 16;
          const v4u v0 = *(const v4u*)Vp, v1 = *(const v4u*)(Vp + 8);
          *(LAS v4u*)(lds + L::VV + (tid >> 3) * PV + (tid & 7) * 32) = v0; *(LAS v4u*)(lds + L::VV + (tid >> 3) * PV + (tid & 7) * 32 + 16) = v1; }
        if (KIND == 0) {
            const bf16* P = U.PROJ + (row0 + 8 * wave) * LDP + 2 * lane;
            unsigned af[8], qq[8];
#pragma unroll
            for (int tt = 0; tt < 8; ++tt) { af[tt] = *(const unsigned*)(P + (size_t)tt * LDP + K::kcol(h)); qq[tt] = *(const unsigned*)(P + (size_t)tt * LDP + K::qcol(h)); }
            float cs0[8], cs1[8], k0[8], k1[8]; float c0 = 0.f, c1 = 0.f;
#pragma unroll
            for (int tt = 0; tt < 8; ++tt) {
                const float f0 = lb0 + (1.f - lb0) * sigmoidf_(bf2f((bf16)(af[tt] & 0xffff))), f1 = lb1 + (1.f - lb1) * sigmoidf_(bf2f((bf16)(af[tt] >> 16)));
                c0 += __logf(f0); c1 += __logf(f1); cs0[tt] = c0; cs1[tt] = c1; k0[tt] = 1.f - f0; k1[tt] = 1.f - f1;
            }
            *(LAS f32x2*)(PART + wave * 128 + 2 * lane) = (f32x2){c0, c1};
            __syncthreads();
            float off0 = 0.f, off1 = 0.f, mid0 = 0.f, mid1 = 0.f, tot0 = 0.f, tot1 = 0.f;
#pragma unroll
            for (int w2 = 0; w2 < 8; ++w2) { const f32x2 p = *(const LAS f32x2*)(PART + w2 * 128 + 2 * lane);
                if (w2 < wave) { off0 += p.x; off1 += p.y; } if (w2 < 4) { mid0 += p.x; mid1 += p.y; } tot0 += p.x; tot1 += p.y; }
#pragma unroll
            for (int tt = 0; tt < 8; ++tt) {
                const float b0 = off0 + cs0[tt], b1 = off1 + cs1[tt];
                const float q0 = bf2f((bf16)(qq[tt] & 0xffff)) * __expf(fminf(b0 - mid0, 60.f)), q1 = bf2f((bf16)(qq[tt] >> 16)) * __expf(fminf(b1 - mid1, 60.f));
                const float kk0 = k0[tt] * __expf(fminf(mid0 - b0, 60.f)), kk1 = k1[tt] * __expf(fminf(mid1 - b1, 60.f));
                *(LAS unsigned*)(lds + L::QS + (8 * wave + tt) * PK + 4 * lane) = pg8::cvt_pk_bf16(q0, q1);
                *(LAS unsigned*)(lds + L::KS + (8 * wave + tt) * PK + 4 * lane) = pg8::cvt_pk_bf16(kk0, kk1);
            }
            if (wave == 0) { *(LAS f32x2*)(EM + 2 * lane) = (f32x2){__expf(mid0), __expf(mid1)}; *(LAS f32x2*)(EL + 2 * lane) = (f32x2){__expf(tot0 - mid0), __expf(tot1 - mid1)};
                const f32x2 o = *(const LAS f32x2*)(BT + 2 * lane); *(LAS f32x2*)(BT + 2 * lane) = (f32x2){o.x + tot0, o.y + tot1}; }
        } else if (KIND == 1) {
            const bf16* P = U.PROJ + (row0 + 8 * wave) * LDP + lane;
            float cs[8], qv[8], kv[8]; float cc = 0.f;
#pragma unroll
            for (int tt = 0; tt < 8; ++tt) {
                const float* bl = U.BL + (row0 + 8 * wave + tt) * 16; float z = bu;
#pragma unroll
                for (int r = 0; r < 16; ++r) z += bl[r] * wu[r];
                const float ls = fminf(z, 0.f) - __logf(1.f + __expf(-fabsf(z)));
                cc += ls * (1.f / 16.f); cs[tt] = cc;
                qv[tt] = bf2f(P[(size_t)tt * LDP + K::qcol(h)]) * 0.125f; kv[tt] = bf2f(P[(size_t)tt * LDP + K::kcol(h)]);
            }
            PART[wave * 64 + lane] = cc;
            __syncthreads();
            float off = 0.f, mid = 0.f, tot = 0.f;
#pragma unroll
            for (int w2 = 0; w2 < 8; ++w2) { const float p = PART[w2 * 64 + lane]; if (w2 < wave) off += p; if (w2 < 4) mid += p; tot += p; }
#pragma unroll
            for (int tt = 0; tt < 8; ++tt) {
                const float b = off + cs[tt];
                *(LAS bf16*)(lds + L::QS + (8 * wave + tt) * PK + 2 * lane) = (bf16)f2bf(qv[tt] * __expf(fminf(b - mid, 60.f)));
                *(LAS bf16*)(lds + L::KS + (8 * wave + tt) * PK + 2 * lane) = (bf16)f2bf(kv[tt] * __expf(fminf(mid - b, 60.f)));
            }
            if (wave == 0) { EM[lane] = __expf(mid); EL[lane] = __expf(tot - mid); BT[lane] += tot; }
        } else {
            const bf16* P = U.PROJ + (row0 + 8 * wave) * LDP + lane;
#pragma unroll
            for (int tt = 0; tt < 8; ++tt) {
                const int tl = 8 * wave + tt; float rev = (float)(pos0 + tl) * ci; rev -= floorf(rev);
                const float sn = __builtin_amdgcn_sinf(rev), cs = __builtin_amdgcn_cosf(rev);
                const float qv = bf2f(P[(size_t)tt * LDP + K::qcol(h)]), kv = bf2f(P[(size_t)tt * LDP + K::kcol(h)]);
                const float qp = __shfl_xor(qv, 32), kp = __shfl_xor(kv, 32);
                const float qr = lane < 32 ? qv * cs - qp * sn : qp * sn + qv * cs;
                const float kr = (lane < 32 ? kv * cs - kp * sn : kp * sn + kv * cs) * 0.125f;
                const float e = (float)(tl - 31) * lgg;
                *(LAS bf16*)(lds + L::QS + tl * PK + 2 * lane) = (bf16)f2bf(qr * __expf(e));
                *(LAS bf16*)(lds + L::KS + tl * PK + 2 * lane) = (bf16)f2bf(kr * __expf(-e));
            }
            if (wave == 0) { const float e32 = __expf(32.f * lgg); EM[lane] = e32; EL[lane] = e32; BT[lane] += 64.f * lgg; }
            __syncthreads();
        }
        __syncthreads();
        { const f32x4 em4 = *(const LAS f32x4*)(EM + 16 * dt + 4 * g);
#pragma unroll
          for (int jt = 0; jt < NJT; ++jt) { S[jt] = S[jt] * em4;
              if (FULL) { v2u w; w.x = pg8::cvt_pk_bf16(S[jt][0], S[jt][1]); w.y = pg8::cvt_pk_bf16(S[jt][2], S[jt][3]);
                  *(LAS v2u*)(lds + L::ST + (16 * (jt0 + jt) + c) * PK + (16 * dt + 4 * g) * 2) = w; } } }
        if (FULL) {
            const int st = wave & 3, tt0 = 2 * (wave >> 2);
            f32x4 p0 = (f32x4){0.f, 0.f, 0.f, 0.f}, p1 = p0;
#pragma unroll
            for (int kk = 0; kk < DK / 32; ++kk) { const bf16x8 a = row_frag(lds + L::KS, PK, 16 * st, kk, lane);
                p0 = MFMA16(a, row_frag(lds + L::QS, PK, 16 * tt0, kk, lane), p0); p1 = MFMA16(a, row_frag(lds + L::QS, PK, 16 * (tt0 + 1), kk, lane), p1); }
#pragma unroll
            for (int x = 0; x < 2; ++x) { const f32x4 p = x ? p1 : p0; const int t = 16 * (tt0 + x) + c, s = 16 * st + 4 * g;
                v2u w; w.x = pg8::cvt_pk_bf16(s <= t ? p[0] : 0.f, s + 1 <= t ? p[1] : 0.f); w.y = pg8::cvt_pk_bf16(s + 2 <= t ? p[2] : 0.f, s + 3 <= t ? p[3] : 0.f);
                *(LAS v2u*)(lds + L::PM + t * PP + s * 2) = w; }
        }
        {
#pragma unroll
          for (int kk = 0; kk < 2; ++kk) { const bf16x8 a = tr_frag(lds + L::KS, PK, 32 * kk, 16 * dt, lane);
#pragma unroll
              for (int jt = 0; jt < NJT; ++jt) S[jt] = MFMA16(a, tr_frag(lds + L::VV, PV, 32 * kk, 16 * (jt0 + jt), lane), S[jt]); }
          const f32x4 el4 = *(const LAS f32x4*)(EL + 16 * dt + 4 * g);
#pragma unroll
          for (int jt = 0; jt < NJT; ++jt) S[jt] = S[jt] * el4;
        }
        __syncthreads();
        if (FULL) {
            const int tt = wave & 3, jh = wave >> 2, t = 16 * tt + c;
            f32x4 o[4];
#pragma unroll
            for (int x = 0; x < 4; ++x) o[x] = (f32x4){0.f, 0.f, 0.f, 0.f};
#pragma unroll
            for (int kk = 0; kk < 2; ++kk) { const bf16x8 bb = row_frag(lds + L::PM, PP, 16 * tt, kk, lane);
#pragma unroll
                for (int x = 0; x < 4; ++x) o[x] = MFMA16(tr_frag(lds + L::VV, PV, 32 * kk, 16 * (4 * jh + x), lane), bb, o[x]); }
#pragma unroll
            for (int kk = 0; kk < DK / 32; ++kk) { const bf16x8 bb = row_frag(lds + L::QS, PK, 16 * tt, kk, lane);
#pragma unroll
                for (int x = 0; x < 4; ++x) o[x] = MFMA16(row_frag(lds + L::ST, PK, 16 * (4 * jh + x), kk, lane), bb, o[x]); }
            float sm = 0.f, sq = 0.f;
#pragma unroll
            for (int x = 0; x < 4; ++x)
#pragma unroll
                for (int i = 0; i < 4; ++i) { sm += o[x][i]; sq += o[x][i] * o[x][i]; }
            sm += __shfl_xor(sm, 16); sq += __shfl_xor(sq, 16); sm += __shfl_xor(sm, 32); sq += __shfl_xor(sq, 32);
            LAS f32x2* RED = (LAS f32x2*)(lds + L::RED) + (ch & 1) * 128;
            if (g == 0) RED[jh * 64 + t] = (f32x2){sm, sq};
            __syncthreads();
            const f32x2 r0 = RED[t], r1 = RED[64 + t];
            const float mean = KIND == 2 ? (r0.x + r1.x) * (1.f / 128.f) : 0.f;
            const float rstd = rsqrtf(fmaxf((r0.y + r1.y) * (1.f / 128.f) - mean * mean, 0.f) + EPS);
            const bf16* gp = U.PROJ + (row0 + t) * LDP + K::gcol(h) + 16 * (4 * jh) + 4 * g;
            bf16* yp = U.YM + (row0 + t) * 1024 + K::ocol(h) + 16 * (4 * jh) + 4 * g;
#pragma unroll
            for (int x = 0; x < 4; ++x) { const v2u gq = *(const v2u*)(gp + 16 * x);
                const float g0 = bf2f((bf16)(gq.x & 0xffff)), g1 = bf2f((bf16)(gq.x >> 16)), g2 = bf2f((bf16)(gq.y & 0xffff)), g3 = bf2f((bf16)(gq.y >> 16));
                v2u w; w.x = pg8::cvt_pk_bf16((o[x][0] - mean) * rstd * nw4[x][0] * siluf_(g0), (o[x][1] - mean) * rstd * nw4[x][1] * siluf_(g1));
                w.y = pg8::cvt_pk_bf16((o[x][2] - mean) * rstd * nw4[x][2] * siluf_(g2), (o[x][3] - mean) * rstd * nw4[x][3] * siluf_(g3));
                *(v2u*)(yp + 16 * x) = w; }
        }
    }
    if (!FULL) {
#pragma unroll
        for (int jt = 0; jt < NJT; ++jt)
#pragma unroll
            for (int i = 0; i < 4; ++i) Sg[(16 * dt + 4 * g + i) * 128 + 16 * (jt0 + jt) + c] = S[jt][i];
        __syncthreads();
        if (tid < DK) Bg[tid] = BT[tid];
    }
    __syncthreads();
}
}


namespace rg {
constexpr int PX = 272, PW = 144, XCB = 0, XCF = 64 * PX, WT = XCF + 64 * 132 * 4, END = WT + 4 * 64 * PW;
static_assert(END <= LDS_MISC, "rglru LDS map");
template <bool FULL>
__device__ __forceinline__ void unit(LAS unsigned char* lds, const bf16* PROJ, bf16* YM, const float* const* in, int b, int seg, int cg, float* RA, float* RH) {
    int tid = threadIdx.x; asm volatile("" : "+v"(tid));
    const int lane = tid & 63, wave = __builtin_amdgcn_readfirstlane(tid >> 6), g = lane >> 4, c = lane & 15;
    const int n0 = 2 * cg, chbase = cg * 128;
    const float* w_r = in[15]; const float* w_i = in[17];
    for (int i = tid; i < 4 * 4096; i += 512) { const int m = i >> 12, gate = m >> 1, nb = m & 1, d = (i >> 6) & 63, e = i & 63;
        const float v = (gate ? w_i : w_r)[((n0 + nb) * 64 + d) * 64 + e];
        *(LAS bf16*)(lds + WT + m * 64 * PW + e * PW + d * 2) = (bf16)f2bf(v); }
    float cw0[4], cw1[4]; const int cc = chbase + 2 * lane;
#pragma unroll
    for (int j = 0; j < 4; ++j) { cw0[j] = in[13][j * 512 + cc]; cw1[j] = in[13][j * 512 + cc + 1]; }
    const float cb0 = in[14][cc], cb1 = in[14][cc + 1];
    const int nb = wave >> 2, e0 = 16 * (wave & 3), chl = nb * 64 + e0 + c, chn = chbase + chl;
    const float brr = in[16][chn], bii = in[18][chn], sp = __logf(1.f + __expf(-in[19][chn]));
    float hcar = FULL ? RH[chn] : 0.f, atot = 1.f;
    __syncthreads();
    for (int ch = 0; ch < 16; ++ch) {
        const int pos0 = seg * 1024 + ch * 64; const size_t row0 = (size_t)b * SEQ + pos0;
        {
            float x0[11], x1[11];
#pragma unroll
            for (int r = 0; r < 11; ++r) { const int pos = pos0 + 8 * wave - 3 + r; unsigned w = 0u;
                if (pos >= 0) w = *(const unsigned*)(PROJ + ((size_t)b * SEQ + pos) * OD_N + 1536 + cc);
                x0[r] = bf2f((bf16)(w & 0xffff)); x1[r] = bf2f((bf16)(w >> 16)); }
#pragma unroll
            for (int tt = 0; tt < 8; ++tt) {
                const float a0 = cb0 + cw0[0] * x0[tt] + cw0[1] * x0[tt + 1] + cw0[2] * x0[tt + 2] + cw0[3] * x0[tt + 3];
                const float a1 = cb1 + cw1[0] * x1[tt] + cw1[1] * x1[tt + 1] + cw1[2] * x1[tt + 2] + cw1[3] * x1[tt + 3];
                *(LAS unsigned*)(lds + XCB + (8 * wave + tt) * PX + 4 * lane) = pg8::cvt_pk_bf16(a0, a1);
                *(LAS f32x2*)(lds + XCF + ((8 * wave + tt) * 132 + 2 * lane) * 4) = (f32x2){a0, a1};
            }
        }
        __syncthreads();
        f32x4 R[4], I[4];
#pragma unroll
        for (int tt = 0; tt < 4; ++tt) { R[tt] = (f32x4){0.f, 0.f, 0.f, 0.f}; I[tt] = R[tt]; }
#pragma unroll
        for (int kk = 0; kk < 2; ++kk) {
            const bf16x8 fr = mx::row_frag(lds + WT + nb * 64 * PW, PW, e0, kk, lane), fi = mx::row_frag(lds + WT + (2 + nb) * 64 * PW, PW, e0, kk, lane);
#pragma unroll
            for (int tt = 0; tt < 4; ++tt) { const bf16x8 a = mx::row_frag(lds + XCB + nb * 128, PX, 16 * tt, kk, lane); R[tt] = MFMA16(a, fr, R[tt]); I[tt] = MFMA16(a, fi, I[tt]); }
        }
#pragma unroll
        for (int tt = 0; tt < 4; ++tt) {
            float av[4], uv[4];
#pragma unroll
            for (int i = 0; i < 4; ++i) { const int t = 16 * tt + 4 * g + i;
                const float r = sigmoidf_(R[tt][i] + brr), ig = sigmoidf_(I[tt][i] + bii), la = -8.f * r * sp, a = __expf(la), x2 = 2.f * la;
                const float om = x2 > -0.05f ? -x2 * (1.f + x2 * (0.5f + x2 * (1.f / 6.f))) : 1.f - a * a;
                av[i] = a; uv[i] = sqrtf(fmaxf(om, 0.f)) * ig * *(const LAS float*)(lds + XCF + (t * 132 + chl) * 4); }
            float As = av[0] * av[1] * av[2] * av[3], Hs = ((uv[0] * av[1] + uv[1]) * av[2] + uv[2]) * av[3] + uv[3];
            float Ai = As, Hi = Hs;
            { const float Ap = __shfl(Ai, (lane - 16) & 63), Hp = __shfl(Hi, (lane - 16) & 63); if (g >= 1) { Hi = Hp * Ai + Hi; Ai = Ap * Ai; } }
            { const float Ap = __shfl(Ai, (lane - 32) & 63), Hp = __shfl(Hi, (lane - 32) & 63); if (g >= 2) { Hi = Hp * Ai + Hi; Ai = Ap * Ai; } }
            const float Ae = __shfl(Ai, (lane - 16) & 63), He = __shfl(Hi, (lane - 16) & 63), At = __shfl(Ai, 48 + c), Ht = __shfl(Hi, 48 + c);
            float h = g == 0 ? hcar : Ae * hcar + He;
            if (FULL) {
#pragma unroll
                for (int i = 0; i < 4; ++i) { const size_t row = row0 + 16 * tt + 4 * g + i; h = av[i] * h + uv[i];
                    YM[row * 1024 + 512 + chn] = (bf16)f2bf(h * gelu_tanh_(bf2f(PROJ[row * OD_N + 2048 + chn]))); }
            }
            hcar = At * hcar + Ht; atot *= At;
        }
        __syncthreads();
    }
    if (!FULL && g == 0) { RA[chn] = atot; RH[chn] = hcar; }
}
}

template <int SUB> __device__ __forceinline__ void phase_mix(Frame& F, int layer) {
    float* SG = (float*)(F.ws + WS_ST); float* BG = (float*)(F.ws + WS_ST + 16 * MiB);
    const bf16* PROJ = (const bf16*)(F.ws + WS_PROJ); bf16* YM = (bf16*)(F.ws + WS_ACT);
    float* RA = (float*)(F.ws + WS_ST + 16 * MiB + 256 * 1024); float* RH = RA + 2 * 16 * 512;
    if (SUB == 1) {
        int tid = threadIdx.x; asm volatile("" : "+v"(tid));
        const int nel = (layer == 0 ? 16 : 8) * 16384;
        for (int idx = F.vcu * 512 + tid; idx < nel; idx += F.G * 512) {
            const int cidx = idx >> 14, e = idx & 16383, DK = (layer == 0 && cidx < 8) ? 128 : 64;
            if (e >= DK * 128) continue;
            const int d = e >> 7; float carry = 0.f;
            for (int seg = 0; seg < 16; ++seg) { float* p = SG + (size_t)(cidx * 16 + seg) * 16384 + e; const float tmp = *p; *p = carry; carry = __expf(BG[(cidx * 16 + seg) * 128 + d]) * carry + tmp; }
        }
        if (layer == 1) for (int idx = F.vcu * 512 + tid; idx < 1024; idx += F.G * 512) { const int bb = idx >> 9, cch = idx & 511; float carry = 0.f;
            for (int seg = 0; seg < 16; ++seg) { const int o = (bb * 16 + seg) * 512 + cch; const float ta = RA[o], th = RH[o]; RH[o] = carry; carry = ta * carry + th; } }
        return;
    }
    for (int u = F.vcu; u < 256; u += F.G) {
        const int cidx = u >> 4, seg = u & 15, chain = cidx & 7;
        mx::UnitP U; U.PROJ = PROJ; U.YM = YM; U.BL = (const float*)(F.ws + WS_BLOW); U.b = chain >> 2; U.h = chain & 3; U.seg = seg; U.p2 = nullptr;
        float* Sg = SG + (size_t)(cidx * 16 + seg) * 16384; float* Bg = BG + (cidx * 16 + seg) * 128;
        if (layer == 0) {
            if (cidx < 8) { U.nw = F.in[6]; U.p0 = F.in[5]; U.p1 = nullptr; mx::mix_unit<0, SUB == 2>(F.lds, Sg, Bg, U); }
            else { U.nw = F.in[9]; U.p0 = F.in[7]; U.p1 = F.in[8]; mx::mix_unit<1, SUB == 2>(F.lds, Sg, Bg, U); }
        } else {
            if (cidx < 8) { U.nw = F.in[12]; U.p0 = nullptr; U.p1 = nullptr; mx::mix_unit<2, SUB == 2>(F.lds, Sg, Bg, U); }
            else { const int x = u - 128, bb = x >> 6, sg = (x >> 2) & 15, cg = x & 3; rg::unit<SUB == 2>(F.lds, PROJ, YM, F.in, bb, sg, cg, RA + (bb * 16 + sg) * 512, RH + (bb * 16 + sg) * 512); }
        }
    }
}

__device__ __forceinline__ void moe_poff(Frame& F, int layer) {
    PHASE_IDS(F);
    LAS int* poff = (LAS int*)(F.lds + LDS_MISC + 1024);
    const unsigned* cnt = F.ctl + CW_CNT + 64 * layer;
    __syncthreads();
    if (F.tid == 0) { int acc = 0; for (int e = 0; e < 32; ++e) { poff[e] = acc; acc += ((int)cnt[e] + 255) & ~255; } poff[32] = acc; }
    __syncthreads();
}
struct Args { const float* in[28]; float* out; unsigned char* ws; int ph_lo, ph_hi, li, pad; };
__global__ void __launch_bounds__(NWAVES * 64, 2) mega(Args args) {
    extern __shared__ __attribute__((aligned(16))) unsigned char lds[];
    Frame F;
    F.lds = (LAS unsigned char*)lds; F.tid = threadIdx.x; F.lane = F.tid & 63; F.wave = __builtin_amdgcn_readfirstlane(F.tid >> 6);
    F.G = gridDim.x; { const int bx = blockIdx.x; F.vcu = (F.G % 8 == 0) ? (bx % 8) * (F.G / 8) + bx / 8 : bx; }
    F.in = args.in; F.out = args.out; F.ws = args.ws; F.ctl = (unsigned*)(args.ws + WS_CTL);
    const int lo = args.ph_lo, hi = args.ph_hi;
    for (int u = F.tid; u < (LDS_BYTES - LDS_MISC) / 4; u += NWAVES * 64) ((LAS unsigned*)(F.lds + LDS_MISC))[u] = 0u;
    __syncthreads();
    XcdBarrier bar; bar.bar = F.ctl + CW_BAR + args.li * XCD_BAR_WORDS; bar.x = 0; bar.st = nullptr;
    if (hi - lo > 1) bar = xcd_barrier_post(F.ctl + CW_BAR + args.li * XCD_BAR_WORDS, (volatile LAS unsigned*)(F.lds + LDS_MISC + 32));
#ifndef ONLY_MASK
#define ONLY_MASK 0x7ffff
#endif
#define IN(k) (((ONLY_MASK >> (k)) & 1) && lo <= (k) && (k) < hi)
#define SEAM(k) do { if (IN(k) && IN((k) + 1)) xcd_barrier(bar); } while (0)
    bf16* ACT = (bf16*)(F.ws + WS_ACT); bf16* PROJ = (bf16*)(F.ws + WS_PROJ); bf16* H = (bf16*)(F.ws + WS_H); bf16* Y = (bf16*)(F.ws + WS_Y);
    const LAS int* poff = (const LAS int*)(F.lds + LDS_MISC + 1024);
    if (IN(0)) phase_prologue(F);
    SEAM(0);
#pragma unroll
    for (int l = 0; l < 2; ++l) {
        const int pb = 9 * l;
        if (IN(pb + 1)) {
            const int N = l == 0 ? EV_N : OD_N;
            pg8::DenseOrder S; S.init(ACT, F.ws + (l == 0 ? WS_WIN0 : WS_WIN1), NT, N, 1024, F.G, (int)blockIdx.x);
            pg8::EpiBf E{PROJ, N};
            pg8::gemm_phase<pg8::EpiBf, pg8::DenseOrder, true>(F.lds, 1024, S, E);
        }
        SEAM(pb + 1);
#ifndef FAST_MIX
#define FAST_MIX 7
#endif
        if ((FAST_MIX >> l) & 1) {
            if (IN(pb + 2)) phase_mix<0>(F, l);
            SEAM(pb + 2);
            if (IN(pb + 3)) phase_mix<1>(F, l);
            SEAM(pb + 3);
            if (IN(pb + 4)) phase_mix<2>(F, l);
            SEAM(pb + 4);
        }
        if (IN(pb + 5)) {
            pg8::DenseOrder S; S.init(ACT, F.ws + (l == 0 ? WS_WOUT0 : WS_WOUT1), NT, 1024, 1024, F.G, (int)blockIdx.x);
            pg8::EpiRes E{l == 0 ? F.in[0] : (const float*)F.out, F.out};
            pg8::gemm_phase<pg8::EpiRes, pg8::DenseOrder, true>(F.lds, 1024, S, E);
        }
        SEAM(pb + 5);
        if (IN(pb + 6)) phase_router(F, l);
        SEAM(pb + 6);
        if (IN(pb + 7)) {
            moe_poff(F, l);
            pg8::MoeOrder S{poff, F.ctl + CW_CNT + 64 * l, (const int*)(F.ws + WS_LIST), (const char*)ACT, (const char*)(F.ws + WS_W13) + (size_t)l * 32 * 1024 * 1024 * 2, (size_t)1024 * 1024 * 2, 1024, F.G, F.vcu, true};
            pg8::EpiUp E{H};
            pg8::gemm_phase<pg8::EpiUp, pg8::MoeOrder, true>(F.lds, 1024, S, E);
        }
        SEAM(pb + 7);
        if (IN(pb + 8)) {
            moe_poff(F, l);
            pg8::MoeOrder S{poff, F.ctl + CW_CNT + 64 * l, (const int*)(F.ws + WS_LIST), (const char*)H, (const char*)(F.ws + WS_W2) + (size_t)l * 32 * 1024 * 512 * 2, (size_t)1024 * 512 * 2, 512, F.G, F.vcu, false};
            pg8::EpiBf E{Y, 1024};
            pg8::gemm_phase<pg8::EpiBf, pg8::MoeOrder, true>(F.lds, 512, S, E);
        }
        SEAM(pb + 8);
        if (IN(pb + 9)) phase_combine(F, l);
        SEAM(pb + 9);
    }
#undef IN
#undef SEAM
}

struct NG { const bf16* A; const bf16* Bt; int N, K; bf16* Ob; float* Of; const float* Res; const unsigned* cnt; const int* list; };
template <int MODE> __global__ void __launch_bounds__(256) k_gemm_naive(NG a) {
    __shared__ float As[16][68], Bs[16][68], Cs[16][68]; __shared__ int poff[33];
    const int t = threadIdx.x, tx = t & 15, ty = t >> 4, m0 = blockIdx.y * 64, n0 = blockIdx.x * 64, K = a.K;
    const bf16* Bt = a.Bt; int e = 0;
    if (MODE >= 2) {
        if (t == 0) { int acc = 0; for (int i = 0; i < 32; ++i) { poff[i] = acc; acc += ((int)a.cnt[i] + 255) & ~255; } poff[32] = acc; }
        __syncthreads();
        if (m0 >= poff[32]) return;
        while (m0 >= poff[e + 1]) ++e;
        Bt += (size_t)e * (MODE == 2 ? 1024 * 1024 : 1024 * 512);
    }
    const int lr = t >> 2, kq = (t & 3) * 4;
    int arow = m0 + lr;
    if (MODE == 2) { const int idx = arow - poff[e]; arow = idx < (int)a.cnt[e] ? a.list[(size_t)e * NT + idx] : 0; }
    const bf16* ap = a.A + (size_t)arow * K + kq;
    int br = n0 + lr, br2 = 0;
    if (MODE == 2) { br = 256 * (br >> 7) + (br & 127); br2 = br + 128; }
    const bf16* bp = Bt + (size_t)br * K + kq; const bf16* bp2 = Bt + (size_t)br2 * K + kq;
    float acc[4][4], acc2[4][4];
#pragma unroll
    for (int i = 0; i < 4; ++i)
#pragma unroll
        for (int j = 0; j < 4; ++j) { acc[i][j] = 0.f; acc2[i][j] = 0.f; }
    for (int k0 = 0; k0 < K; k0 += 16) {
        { const v2u w = *(const v2u*)(ap + k0); As[kq][lr] = bf2f((bf16)(w.x & 0xffff)); As[kq + 1][lr] = bf2f((bf16)(w.x >> 16)); As[kq + 2][lr] = bf2f((bf16)(w.y & 0xffff)); As[kq + 3][lr] = bf2f((bf16)(w.y >> 16)); }
        { const v2u w = *(const v2u*)(bp + k0); Bs[kq][lr] = bf2f((bf16)(w.x & 0xffff)); Bs[kq + 1][lr] = bf2f((bf16)(w.x >> 16)); Bs[kq + 2][lr] = bf2f((bf16)(w.y & 0xffff)); Bs[kq + 3][lr] = bf2f((bf16)(w.y >> 16)); }
        if (MODE == 2) { const v2u w = *(const v2u*)(bp2 + k0); Cs[kq][lr] = bf2f((bf16)(w.x & 0xffff)); Cs[kq + 1][lr] = bf2f((bf16)(w.x >> 16)); Cs[kq + 2][lr] = bf2f((bf16)(w.y & 0xffff)); Cs[kq + 3][lr] = bf2f((bf16)(w.y >> 16)); }
        __syncthreads();
#pragma unroll
        for (int k = 0; k < 16; ++k) {
            float av[4], bv[4], cv[4];
#pragma unroll
            for (int i = 0; i < 4; ++i) { av[i] = As[k][ty * 4 + i]; bv[i] = Bs[k][tx * 4 + i]; cv[i] = MODE == 2 ? Cs[k][tx * 4 + i] : 0.f; }
#pragma unroll
            for (int i = 0; i < 4; ++i)
#pragma unroll
                for (int j = 0; j < 4; ++j) { acc[i][j] += av[i] * bv[j]; if (MODE == 2) acc2[i][j] += av[i] * cv[j]; }
        }
        __syncthreads();
    }
#pragma unroll
    for (int i = 0; i < 4; ++i)
#pragma unroll
        for (int j = 0; j < 4; ++j) {
            const int m = m0 + ty * 4 + i, n = n0 + tx * 4 + j;
            if (MODE == 0) a.Ob[(size_t)m * a.N + n] = (bf16)f2bf(acc[i][j]);
            if (MODE == 1) a.Of[(size_t)m * a.N + n] = a.Res[(size_t)m * a.N + n] + acc[i][j];
            if (MODE == 2) a.Ob[(size_t)m * 512 + n] = (bf16)f2bf(siluf_(acc[i][j]) * acc2[i][j]);
            if (MODE == 3) a.Ob[(size_t)m * 1024 + n] = (bf16)f2bf(acc[i][j]);
        }
}

__global__ void __launch_bounds__(128) k_mix_even_naive(const bf16* PROJ, const float* blow, const float* lbl, const float* hnw, const float* wup, const float* bup, const float* gnw, bf16* Y) {
    const int bid = blockIdx.x, j = threadIdx.x, lane = j & 63, wv = j >> 6;
    __shared__ float sq[2][128], sk[2][128], sg[2][128], red[2][2];
    if (bid < 8) {
        const int b = bid >> 2, h = bid & 3, c = h * 128 + j;
        float lb; { const float l0 = lbl[c], l1 = lbl[512 + c], l2 = lbl[1024 + c]; const float mx = fmaxf(l0, fmaxf(l1, l2)); const float e0 = expf(l0 - mx), e1 = expf(l1 - mx), e2 = expf(l2 - mx); lb = e0 / (e0 + e1 + e2); }
        float s[128];
#pragma unroll
        for (int d = 0; d < 128; ++d) s[d] = 0.f;
        const float nw = hnw[c];
        for (int t = 0; t < SEQ; ++t) {
            const bf16* P = PROJ + (size_t)(b * SEQ + t) * EV_N; const int pb = t & 1;
            const float f = lb + (1.f - lb) * sigmoidf_(bf2f(P[512 + c]));
            sq[pb][j] = bf2f(P[c]); sk[pb][j] = 1.f - f; sg[pb][j] = f;
            const float v = bf2f(P[1024 + c]);
            __syncthreads();
            float o = 0.f;
#pragma unroll
            for (int d = 0; d < 128; ++d) { s[d] = sg[pb][d] * s[d] + sk[pb][d] * v; o += sq[pb][d] * s[d]; }
            const float ss = wave_sum(o * o); if (lane == 0) red[pb][wv] = ss;
            __syncthreads();
            const float rstd = rsqrtf((red[pb][0] + red[pb][1]) * (1.f / 128.f) + EPS);
            Y[(size_t)(b * SEQ + t) * 1024 + c] = (bf16)f2bf(o * rstd * nw * siluf_(bf2f(P[1536 + c])));
        }
    } else {
        const int b = (bid - 8) >> 2, h = bid & 3, c = h * 128 + j, dcol = h * 64 + (j & 63);
        float wu[16];
#pragma unroll
        for (int r = 0; r < 16; ++r) wu[r] = wup[r * 256 + dcol];
        const float bu = bup[dcol];
        float s[64];
#pragma unroll
        for (int d = 0; d < 64; ++d) s[d] = 0.f;
        const float nw = gnw[c];
        for (int t = 0; t < SEQ; ++t) {
            const size_t row = (size_t)b * SEQ + t;
            const bf16* P = PROJ + row * EV_N; const int pb = t & 1;
            if (j < 64) {
                float z = bu;
#pragma unroll
                for (int r = 0; r < 16; ++r) z += blow[row * 16 + r] * wu[r];
                const float ls = fminf(z, 0.f) - log1pf(expf(-fabsf(z)));
                sg[pb][j] = expf(ls * (1.f / 16.f)); sq[pb][j] = bf2f(P[2048 + dcol]) * 0.125f; sk[pb][j] = bf2f(P[2304 + dcol]);
            }
            const float v = bf2f(P[2560 + c]);
            __syncthreads();
            float o = 0.f;
#pragma unroll
            for (int d = 0; d < 64; ++d) { s[d] = sg[pb][d] * s[d] + sk[pb][d] * v; o += sq[pb][d] * s[d]; }
            const float ss = wave_sum(o * o); if (lane == 0) red[pb][wv] = ss;
            __syncthreads();
            const float rstd = rsqrtf((red[pb][0] + red[pb][1]) * (1.f / 128.f) + EPS);
            Y[row * 1024 + 512 + c] = (bf16)f2bf(o * rstd * nw * siluf_(bf2f(P[3072 + c])));
        }
    }
}

__global__ void __launch_bounds__(128) k_ret_naive(const bf16* PROJ, const float* rnw, bf16* Y) {
    const int bid = blockIdx.x, j = threadIdx.x, lane = j & 63, wv = j >> 6, b = bid >> 2, h = bid & 3, c = h * 128 + j;
    __shared__ float sq[2][64], sk[2][64], red[2][2], red2[2][2];
    const int d = j & 63, i = d & 31;
    const float ci = exp2f(-(float)i * (13.287712379549449f / 32.f)) * 0.15915494309189535f;
    const float gamma = 1.f - exp2f(-5.f - (float)h);
    float s[64];
#pragma unroll
    for (int dd = 0; dd < 64; ++dd) s[dd] = 0.f;
    const float nw = rnw[c];
    for (int t = 0; t < SEQ; ++t) {
        const size_t row = (size_t)b * SEQ + t; const bf16* P = PROJ + row * OD_N; const int pb = t & 1;
        if (j < 64) {
            float rev = (float)t * ci; rev -= floorf(rev);
            const float sn = __builtin_amdgcn_sinf(rev), cs = __builtin_amdgcn_cosf(rev);
            const float q1 = bf2f(P[h * 64 + i]), q2 = bf2f(P[h * 64 + 32 + i]), k1 = bf2f(P[256 + h * 64 + i]), k2 = bf2f(P[256 + h * 64 + 32 + i]);
            sq[pb][d] = d < 32 ? q1 * cs - q2 * sn : q1 * sn + q2 * cs;
            sk[pb][d] = (d < 32 ? k1 * cs - k2 * sn : k1 * sn + k2 * cs) * 0.125f;
        }
        const float v = bf2f(P[512 + c]);
        __syncthreads();
        float o = 0.f;
#pragma unroll
        for (int dd = 0; dd < 64; ++dd) { s[dd] = gamma * s[dd] + sk[pb][dd] * v; o += sq[pb][dd] * s[dd]; }
        const float sm = wave_sum(o); if (lane == 0) red[pb][wv] = sm;
        __syncthreads();
        const float oc = o - (red[pb][0] + red[pb][1]) * (1.f / 128.f);
        const float ss = wave_sum(oc * oc); if (lane == 0) red2[pb][wv] = ss;
        __syncthreads();
        const float rstd = rsqrtf((red2[pb][0] + red2[pb][1]) * (1.f / 128.f) + EPS);
        Y[row * 1024 + c] = (bf16)f2bf(oc * rstd * nw * siluf_(bf2f(P[1024 + c])));
    }
}

__global__ void __launch_bounds__(64) k_rglru_naive(const bf16* PROJ, const float* cw, const float* cb, const float* wr, const float* br, const float* wi, const float* bi, const float* lam, bf16* Y) {
    const int b = blockIdx.x >> 3, n = blockIdx.x & 7, e = threadIdx.x, c = n * 64 + e;
    float wrr[64], wii[64];
#pragma unroll
    for (int d = 0; d < 64; ++d) { wrr[d] = wr[(n * 64 + d) * 64 + e]; wii[d] = wi[(n * 64 + d) * 64 + e]; }
    const float c0 = cw[c], c1 = cw[512 + c], c2 = cw[1024 + c], c3 = cw[1536 + c], cbb = cb[c], brr = br[c], bii = bi[c];
    const float sp = log1pf(expf(-lam[c]));
    float x1 = 0.f, x2 = 0.f, x3 = 0.f, hh = 0.f;
    for (int t = 0; t < SEQ; ++t) {
        const size_t row = (size_t)b * SEQ + t; const bf16* P = PROJ + row * OD_N;
        const float dx = bf2f(P[1536 + c]);
        const float xc = cbb + c0 * x3 + c1 * x2 + c2 * x1 + c3 * dx;
        x3 = x2; x2 = x1; x1 = dx;
        float rp = brr, ip = bii;
#pragma unroll
        for (int d = 0; d < 64; ++d) { const float xd = __shfl(xc, d); rp += xd * wrr[d]; ip += xd * wii[d]; }
        const float r = sigmoidf_(rp), ig = sigmoidf_(ip), la = -8.f * r * sp, aa = expf(la);
        const float u = sqrtf(fmaxf(0.f, -expm1f(2.f * la))) * (ig * xc);
        hh = aa * hh + u;
        Y[row * 1024 + 512 + c] = (bf16)f2bf(hh * gelu_tanh_(bf2f(P[2048 + c])));
    }
}

extern "C" void kernel_launch(void* const* d_in, const int* in_sizes, int n_in, void* d_out, int out_size, void* d_ws, size_t ws_size, hipStream_t stream) {
    static int grid = 0;
    if (grid == 0) {
        if (n_in != 28 || out_size != NT * D || ws_size < WS_END) { fprintf(stderr, "kernel_launch: unexpected problem (n_in %d, out %d, ws %zu)\n", n_in, out_size, ws_size); grid = -1; return; }
        int dev = 0, cus = 0;
        if (hipGetDevice(&dev) != hipSuccess || hipDeviceGetAttribute(&cus, hipDeviceAttributeMultiprocessorCount, dev) != hipSuccess) { grid = -1; return; }
        if (hipFuncSetAttribute((const void*)mega, hipFuncAttributeMaxDynamicSharedMemorySize, LDS_BYTES) != hipSuccess) { fprintf(stderr, "kernel_launch: hipFuncSetAttribute failed\n"); grid = -1; return; }
        (void)hipGetLastError();
        grid = cus;
    }
    if (grid < 0) return;
    (void)hipMemsetAsync((char*)d_ws + WS_CTL, 0, CTL_BYTES, stream);
    Args a{};
    for (int i = 0; i < 28; ++i) a.in[i] = (const float*)d_in[i];
    a.out = (float*)d_out; a.ws = (unsigned char*)d_ws;
    unsigned char* ws = (unsigned char*)d_ws;
    const float* const* in = (const float* const*)a.in;
    int nli = 0;
    auto run = [&](int lo, int hi) { a.ph_lo = lo; a.ph_hi = hi; a.li = (hi - lo > 1) ? nli++ : 0; hipLaunchKernelGGL(mega, dim3(grid), dim3(NWAVES * 64), LDS_BYTES, stream, a); };
    bf16* ACT = (bf16*)(ws + WS_ACT); bf16* PROJ = (bf16*)(ws + WS_PROJ);
#ifndef FAST_MIX
#define FAST_MIX 7
#endif
    auto naive_even = [&]() { hipLaunchKernelGGL(k_mix_even_naive, dim3(16), dim3(128), 0, stream, PROJ, (const float*)(ws + WS_BLOW), in[5], in[6], in[7], in[8], in[9], ACT); };
    auto naive_ret = [&]() { hipLaunchKernelGGL(k_ret_naive, dim3(8), dim3(128), 0, stream, PROJ, in[12], ACT); };
    auto naive_lru = [&]() { hipLaunchKernelGGL(k_rglru_naive, dim3(16), dim3(64), 0, stream, PROJ, in[13], in[14], in[15], in[16], in[17], in[18], in[19], ACT); };
    if (FAST_MIX == 7) { run(0, 19); }
    else if (FAST_MIX == 1) { run(0, 11); naive_ret(); naive_lru(); run(14, 19); }
    else if (FAST_MIX == 3) { run(0, 14); naive_lru(); run(14, 19); }
    else { run(0, 2); naive_even(); run(5, 11); naive_ret(); naive_lru(); run(14, 19); }
}
```

```cpp
#include <hip/hip_runtime.h>
#include <cstdio>
#include <cstdint>

#define GAS __attribute__((address_space(1)))
#define LAS __attribute__((address_space(3)))
typedef unsigned short bf16;
typedef unsigned v4u __attribute__((ext_vector_type(4)));
typedef unsigned v2u __attribute__((ext_vector_type(2)));
typedef float f32x4 __attribute__((ext_vector_type(4)));
typedef float f32x2 __attribute__((ext_vector_type(2)));
typedef short bf16x8 __attribute__((ext_vector_type(8)));

constexpr int NT = 32768, D = 1024, SEQ = 16384;
constexpr int EV_N = 3584, OD_N = 2560, EV_LD = 3600;
constexpr float EPS = 1e-6f;
constexpr int NEXP = 32, SLOT_ROWS = 2 * NT + NEXP * 256;

constexpr size_t MiB = 1u << 20;
constexpr size_t WS_CTL = 0, CTL_BYTES = 1 * MiB;
constexpr size_t WS_WIN0 = 2 * MiB, WS_WOUT0 = 9 * MiB, WS_WIN1 = 11 * MiB, WS_WOUT1 = 16 * MiB, WS_W13 = 18 * MiB, WS_W2 = 146 * MiB;
constexpr size_t WS_ACT = 210 * MiB, WS_PROJ = 274 * MiB, WS_H = WS_PROJ, WS_Y = WS_PROJ + 72 * MiB;
constexpr size_t WS_BLOW = 498 * MiB, WS_META = 500 * MiB, WS_LIST = 501 * MiB, WS_ST = 505 * MiB, WS_SSQ = 522 * MiB, WS_END = 524 * MiB;
constexpr int CW_TMO = 0, CW_BAR = 4096, CW_CNT = 16384;

constexpr int NWAVES = 8;
constexpr int LDS_BYTES = 163840;
constexpr int LDS_MISC = 149504;

__device__ __forceinline__ float bf2f(bf16 b) { return __builtin_bit_cast(float, (unsigned)b << 16); }
__device__ __forceinline__ unsigned pk2(float lo, float hi) { unsigned r; asm("v_cvt_pk_bf16_f32 %0, %1, %2" : "=v"(r) : "v"(lo), "v"(hi)); return r; }
__device__ __forceinline__ unsigned f2bf(float f) { return pk2(f, f) & 0xffffu; }
__device__ __forceinline__ float sigmoidf_(float x) { return __builtin_amdgcn_rcpf(1.f + __expf(-x)); }
__device__ __forceinline__ float siluf_(float x) { return x * sigmoidf_(x); }
__device__ __forceinline__ float gelu_tanh_(float x) { const float u = 0.7978845608f * (x + 0.044715f * x * x * x); return x * sigmoidf_(2.f * u); }
__device__ __forceinline__ float wave_sum(float v) {
#pragma unroll
    for (int o = 1; o < 64; o <<= 1) v += __shfl_xor(v, o);
    return v;
}
#define LDS_WAIT() asm volatile("s_waitcnt lgkmcnt(0)" ::: "memory")

struct Frame {
    LAS unsigned char* lds;
    int tid, lane, wave, vcu, G;
    const float* const* in;
    float* out; unsigned char* ws;
    unsigned* ctl;
};


#define XB_TMO      128
#define XB_XCNT(j)  (256  + 64 * (j))
#define XB_XSUB(j)  (1280 + 64 * (j))
#define XB_XGEN(j)  (2304 + 64 * (j))
#define XB_TOP      3328
#define XB_TOPGEN   3392
#define XCD_BAR_WORDS 3456
#define XB_SPIN_CAP (1u << 18)
__device__ __forceinline__ unsigned xb_ld(unsigned* p)              { return __hip_atomic_load(p, __ATOMIC_RELAXED, __HIP_MEMORY_SCOPE_AGENT); }
__device__ __forceinline__ unsigned xb_add(unsigned* p, unsigned v) { return __hip_atomic_fetch_add(p, v, __ATOMIC_RELAXED, __HIP_MEMORY_SCOPE_AGENT); }
__device__ __forceinline__ unsigned xb_xcc_id() { return (unsigned)__builtin_amdgcn_s_getreg((3 << 11) | 20) & 0xFu; }
#define XB_SPIN(cond, bar) do { unsigned _sp = 0; while (cond) { __builtin_amdgcn_s_sleep(1); \
    if ((++_sp & 255u) == 0u) { if (xb_ld(&(bar)[XB_TMO])) break; if (_sp > XB_SPIN_CAP) { atomicAdd(&(bar)[XB_TMO], 1u); break; } } } } while (0)
struct XcdBarrier { unsigned* bar; unsigned x; volatile LAS unsigned* st; };
__device__ __forceinline__ XcdBarrier xcd_barrier_post(unsigned* bar, volatile LAS unsigned* st) {
    XcdBarrier b; b.bar = bar; b.x = xb_xcc_id(); b.st = st;
    if (threadIdx.x == 0) (void)xb_add(&bar[XB_XCNT(b.x)], 1u);
    return b;
}
__device__ __forceinline__ void xcd_barrier_complete(unsigned* bar, unsigned x, unsigned& nloc, unsigned& nx) {
    const unsigned G = gridDim.x * gridDim.y * gridDim.z;
    unsigned sum, cnt, mine, sp = 0u;
    for (;;) {
        sum = 0u; cnt = 0u; mine = 0u;
#pragma unroll
        for (unsigned j = 0; j < 16; ++j) { const unsigned c = xb_ld(&bar[XB_XCNT(j)]); sum += c; cnt += (c > 0u) ? 1u : 0u; mine = (j == x) ? c : mine; }
        if (sum == G) break;
        __builtin_amdgcn_s_sleep(1);
        if ((++sp & 255u) == 0u) { if (xb_ld(&bar[XB_TMO])) break; if (sp > XB_SPIN_CAP) { atomicAdd(&bar[XB_TMO], 1u); break; } }
    }
    nloc = mine > 0u ? mine : 1u; nx = cnt > 0u ? cnt : 1u;
}
__device__ __forceinline__ void xcd_barrier(const XcdBarrier& b) {
    asm volatile("s_waitcnt vmcnt(0)" ::: "memory");
    __syncthreads();
    if (threadIdx.x == 0) {
        unsigned* bar = b.bar;
        __builtin_amdgcn_s_waitcnt(0);
        unsigned nloc = b.st[0], nx = b.st[1];
        if (nloc == 0u) { xcd_barrier_complete(bar, b.x, nloc, nx); b.st[0] = nloc; b.st[1] = nx; }
        const unsigned old = xb_add(&bar[XB_XSUB(b.x)], 1u);
        const unsigned gen = old / nloc;
        if (old + 1u == (gen + 1u) * nloc) {
            __builtin_amdgcn_fence(__ATOMIC_RELEASE, "agent");
            asm volatile("s_waitcnt vmcnt(0)" ::: "memory");
            const unsigned og = xb_add(&bar[XB_TOP], 1u);
            const unsigned tg = og / nx;
            if (og + 1u == (tg + 1u) * nx) xb_add(&bar[XB_TOPGEN], 1u);
            else XB_SPIN(xb_ld(&bar[XB_TOPGEN]) == tg, bar);
            __builtin_amdgcn_fence(__ATOMIC_ACQUIRE, "agent");
            xb_add(&bar[XB_XGEN(b.x)], 1u);
            asm volatile("s_waitcnt vmcnt(0)" ::: "memory");
        } else {
            XB_SPIN(xb_ld(&bar[XB_XGEN(b.x)]) == gen, bar);
            __builtin_amdgcn_fence(__ATOMIC_ACQUIRE, "agent");
            asm volatile("s_waitcnt vmcnt(0)" ::: "memory");
        }
    }
    __syncthreads();
}

namespace pg8 {
typedef unsigned u32x4 __attribute__((ext_vector_type(4)));
constexpr int BM = 256, BK = 64, HALF = 128, HTB = HALF * BK * 2, STAGE_BYTES = 8 * HTB, NXCD = 8, WGM = 8;
__host__ __device__ __forceinline__ int lds_byte(int r, int c) { const int st = (r >> 4) * 2 + (c >> 5), rr = r & 15, cc = c & 31, ob = rr * 64 + cc * 2; return st * 1024 + (ob ^ (((ob >> 9) & 1) << 5)); }
__host__ __device__ __forceinline__ void stage_rc(int b, int& R, int& C) { const int st = b / 1024, sb = b % 1024, swz = sb ^ (((sb >> 9) & 1) << 5); R = (st >> 1) * 16 + swz / 64; C = (st & 1) * 32 + (swz % 64) / 2; }
__host__ __device__ __forceinline__ int perm32(int rho) { const int n = rho >> 4, i = rho & 15; return 8 * (i >> 2) + 4 * n + (i & 3); }
struct Unit { int pm, pn, e; };
__device__ __forceinline__ unsigned cvt_pk_bf16(float lo, float hi) { return pk2(lo, hi); }

struct DenseOrder {
    int nM, nN, nwg, G, c, K; const char* A; const char* Bt;
    __device__ __forceinline__ void init(const void* A_, const void* Bt_, int M, int N, int K_, int G_, int c_) { A = (const char*)A_; Bt = (const char*)Bt_; nM = M / BM; nN = N / BM; nwg = nM * nN; G = G_; c = c_; K = K_; }
    __device__ __forceinline__ bool next(int i, Unit& u) const {
        const long L = (long)i * G + c; if (L >= nwg) return false;
        int wgid = (int)L; { const int q = nwg / NXCD, r = nwg % NXCD, xcd = wgid % NXCD, off = wgid / NXCD; wgid = (xcd < r ? xcd * (q + 1) : r * (q + 1) + (xcd - r) * q) + off; }
        const int nig = WGM * nN, gid = wgid / nig, fm = gid * WGM, gsz = (nM - fm) < WGM ? (nM - fm) : WGM;
        u.pm = fm + ((wgid % nig) % gsz); u.pn = (wgid % nig) / gsz; u.e = 0; return true;
    }
    __device__ __forceinline__ unsigned a_off(const Unit& u, int r) const { return (unsigned)((u.pm * BM + r) * K) * 2u; }
    __device__ __forceinline__ const char* b_ptr(const Unit& u) const { return Bt + (size_t)u.pn * BM * K * 2; }
};
struct MoeOrder {
    const LAS int* poff; const unsigned* cnt; const int* list; const char* A; const char* Bt; size_t estride; int K, G, c; bool gather;
    __device__ __forceinline__ bool next(int i, Unit& u) const {
        const int L = i * G + c, np = __builtin_amdgcn_readfirstlane(poff[32]) >> 8; if (L >= np * 4) return false;
        u.pm = L >> 2; u.pn = L & 3; const int row = u.pm << 8; int e = 0;
        while (row >= __builtin_amdgcn_readfirstlane(poff[e + 1])) ++e;
        u.e = e; return true;
    }
    __device__ __forceinline__ unsigned a_off(const Unit& u, int r) const {
        if (!gather) return (unsigned)((u.pm * BM + r) * K) * 2u;
        const int idx = min(u.pm * BM + r - poff[u.e], poff[33 + u.e] - 1);
        return (unsigned)list[(size_t)u.e * NT + idx] * (unsigned)(K * 2);
    }
    __device__ __forceinline__ const char* b_ptr(const Unit& u) const { return Bt + (size_t)u.e * estride + (size_t)u.pn * BM * K * 2; }
};

struct EpiBf {
    static constexpr bool PERM = true;
    bf16* O; int ldc;
    __device__ __forceinline__ void operator()(const f32x4 (&acc)[2][2][4][2], const Unit& u, int wr, int wc, int fr, int fq) const {
        const int row0 = u.pm * BM + wr * 64 + fr, col0 = u.pn * BM + wc * 32 + 8 * fq;
#pragma unroll
        for (int ai = 0; ai < 2; ++ai)
#pragma unroll
            for (int m = 0; m < 4; ++m) { bf16* rowp = O + (size_t)(row0 + ai * HALF + m * 16) * ldc + col0;
#pragma unroll
                for (int bj = 0; bj < 2; ++bj) { const f32x4 v0 = acc[ai][bj][m][0], v1 = acc[ai][bj][m][1];
                    u32x4 w; w.x = cvt_pk_bf16(v0[0], v0[1]); w.y = cvt_pk_bf16(v0[2], v0[3]); w.z = cvt_pk_bf16(v1[0], v1[1]); w.w = cvt_pk_bf16(v1[2], v1[3]);
                    *(u32x4*)(rowp + bj * HALF) = w; } }
    }
};
template <bool RES_BF16>
struct EpiRes {
    static constexpr bool PERM = true;
    const void* res; bf16* xout; float* ssq;
    __device__ __forceinline__ void operator()(const f32x4 (&acc)[2][2][4][2], const Unit& u, int wr, int wc, int fr, int fq) const {
        const int row0 = u.pm * BM + wr * 64 + fr, col0 = u.pn * BM + wc * 32 + 8 * fq;
#pragma unroll
        for (int ai = 0; ai < 2; ++ai)
#pragma unroll
            for (int m = 0; m < 4; ++m) { const int row = row0 + ai * HALF + m * 16; const size_t off = (size_t)row * 1024 + col0; float ss = 0.f;
#pragma unroll
                for (int bj = 0; bj < 2; ++bj) {
                    f32x4 r0, r1;
                    if (RES_BF16) { const u32x4 rw = *(const u32x4*)((const bf16*)res + off + bj * HALF);
                        r0 = (f32x4){__builtin_bit_cast(float, rw.x << 16), __builtin_bit_cast(float, rw.x & 0xffff0000u), __builtin_bit_cast(float, rw.y << 16), __builtin_bit_cast(float, rw.y & 0xffff0000u)};
                        r1 = (f32x4){__builtin_bit_cast(float, rw.z << 16), __builtin_bit_cast(float, rw.z & 0xffff0000u), __builtin_bit_cast(float, rw.w << 16), __builtin_bit_cast(float, rw.w & 0xffff0000u)}; }
                    else { r0 = *(const f32x4*)((const float*)res + off + bj * HALF); r1 = *(const f32x4*)((const float*)res + off + bj * HALF + 4); }
                    const f32x4 v0 = r0 + acc[ai][bj][m][0], v1 = r1 + acc[ai][bj][m][1];
                    ss += ((v0[0] * v0[0] + v0[1] * v0[1]) + (v0[2] * v0[2] + v0[3] * v0[3])) + ((v1[0] * v1[0] + v1[1] * v1[1]) + (v1[2] * v1[2] + v1[3] * v1[3]));
                    u32x4 w; w.x = cvt_pk_bf16(v0[0], v0[1]); w.y = cvt_pk_bf16(v0[2], v0[3]); w.z = cvt_pk_bf16(v1[0], v1[1]); w.w = cvt_pk_bf16(v1[2], v1[3]);
                    *(u32x4*)(xout + off + bj * HALF) = w; }
                ss += __shfl_xor(ss, 16); ss += __shfl_xor(ss, 32);
                if (fq == 0) ssq[(size_t)row * 16 + u.pn * 4 + wc] = ss;
                asm volatile("" ::: "memory"); }
    }
};
struct EpiUp {
    static constexpr bool PERM = true;
    bf16* H;
    __device__ __forceinline__ void operator()(const f32x4 (&acc)[2][2][4][2], const Unit& u, int wr, int wc, int fr, int fq) const {
        const int row0 = u.pm * BM + wr * 64 + fr, col0 = u.pn * HALF + wc * 32 + 8 * fq;
#pragma unroll
        for (int ai = 0; ai < 2; ++ai)
#pragma unroll
            for (int m = 0; m < 4; ++m) { bf16* rowp = H + (size_t)(row0 + ai * HALF + m * 16) * 512 + col0;
                float h[8];
#pragma unroll
                for (int n = 0; n < 2; ++n)
#pragma unroll
                    for (int i = 0; i < 4; ++i) { const float a = acc[ai][0][m][n][i], b = acc[ai][1][m][n][i]; h[n * 4 + i] = a * __builtin_amdgcn_rcpf(1.f + __expf(-a)) * b; }
                u32x4 w; w.x = cvt_pk_bf16(h[0], h[1]); w.y = cvt_pk_bf16(h[2], h[3]); w.z = cvt_pk_bf16(h[4], h[5]); w.w = cvt_pk_bf16(h[6], h[7]);
                *(u32x4*)rowp = w; }
    }
};

template <class Epi, class Sched, bool ALIGN_EPI>
__device__ __forceinline__ void gemm_phase(LAS unsigned char* lds, const int K, const Sched& S, const Epi& E) {
    int tid = threadIdx.x; asm volatile("" : "+v"(tid));
    const int wid = __builtin_amdgcn_readfirstlane(tid >> 6), lane = tid & 63, wr = wid >> 2, wc = wid & 3, fr = lane & 15, fq = lane >> 4;
    const int nt = K / BK;
    int RA[2]; unsigned CA[2], voffB[2];
#pragma unroll
    for (int i = 0; i < 2; ++i) { int R, C; stage_rc(tid * 16 + i * 8192, R, C); const int Rb = Epi::PERM ? ((R & ~31) + perm32(R & 31)) : R;
        RA[i] = R; CA[i] = (unsigned)C * 2u; voffB[i] = (unsigned)(Rb * K + C) * 2u; }
    const size_t kstep = (size_t)(BK * 2);
    const size_t hstep = (size_t)HALF * K * 2;
    const unsigned ldsw = (unsigned)wid * 1024u;
    const int aoff = lds_byte(wr * 64 + fr, fq * 8), boff = lds_byte(wc * 32 + fr, fq * 8);
    const char* const A0 = S.A;
#define PG8_SA(b, h) (((b) * 2 + (h)) * HTB)
#define PG8_SB(b, h) ((4 + (b) * 2 + (h)) * HTB)
#define PG8_STAGE(bufoff, gbase, voff) do { _Pragma("unroll") for (int _i = 0; _i < 2; ++_i) \
        __builtin_amdgcn_global_load_lds((const unsigned*)((const char*)(gbase) + (voff)[_i]), (LAS unsigned*)(lds + (bufoff) + ldsw + _i * 8192), 16, 0, 0); } while (0)
#define PG8_STAGEA(bufoff, kbyte, o0, o1) do { \
        __builtin_amdgcn_global_load_lds((const unsigned*)(A0 + (kbyte) + (o0)), (LAS unsigned*)(lds + (bufoff) + ldsw), 16, 0, 0); \
        __builtin_amdgcn_global_load_lds((const unsigned*)(A0 + (kbyte) + (o1)), (LAS unsigned*)(lds + (bufoff) + ldsw + 8192), 16, 0, 0); } while (0)
#define PG8_LDA(dst, b, h) do { _Pragma("unroll") for (int m = 0; m < 4; ++m) _Pragma("unroll") for (int k = 0; k < 2; ++k) dst[m][k] = *(const LAS bf16x8*)(lds + PG8_SA(b, h) + aoff + m * 2048 + k * 1024); } while (0)
#define PG8_LDB(dst, b, h) do { _Pragma("unroll") for (int n = 0; n < 2; ++n) _Pragma("unroll") for (int k = 0; k < 2; ++k) dst[n][k] = *(const LAS bf16x8*)(lds + PG8_SB(b, h) + boff + n * 2048 + k * 1024); } while (0)
#define PG8_MMA(ai, bj, At, Bt) do { __builtin_amdgcn_s_setprio(1); _Pragma("unroll") for (int m = 0; m < 4; ++m) _Pragma("unroll") for (int n = 0; n < 2; ++n) _Pragma("unroll") for (int k = 0; k < 2; ++k) \
        acc[ai][bj][m][n] = __builtin_amdgcn_mfma_f32_16x16x32_bf16(Bt[n][k], At[m][k], acc[ai][bj][m][n], 0, 0, 0); __builtin_amdgcn_s_setprio(0); } while (0)
#define PG8_WAIT_V(n) asm volatile("s_waitcnt vmcnt(" #n ")" ::: "memory")
#define PG8_WAIT_L(n) asm volatile("s_waitcnt lgkmcnt(" #n ")" ::: "memory")
#define PG8_BAR __builtin_amdgcn_s_barrier()
#define PG8_SCHED __builtin_amdgcn_sched_barrier(0)
    Unit cur, nxt; int ui = 0;
    if (!S.next(0, cur)) return;
    f32x4 acc[2][2][4][2];
#pragma unroll
    for (int a = 0; a < 2; ++a)
#pragma unroll
        for (int b = 0; b < 2; ++b)
#pragma unroll
            for (int m = 0; m < 4; ++m)
#pragma unroll
                for (int n = 0; n < 2; ++n) acc[a][b][m][n] = (f32x4){0.f, 0.f, 0.f, 0.f};
    bf16x8 At[4][2], B0[2][2], B1[2][2];
    unsigned oc00, oc01, oc10, oc11, on00, on01, on10, on11;
    oc00 = S.a_off(cur, RA[0]) + CA[0]; oc01 = S.a_off(cur, RA[1]) + CA[1]; oc10 = S.a_off(cur, HALF + RA[0]) + CA[0]; oc11 = S.a_off(cur, HALF + RA[1]) + CA[1];
    const char* cB = S.b_ptr(cur);
    PG8_STAGE(PG8_SB(0, 0), cB, voffB); PG8_STAGE(PG8_SB(0, 1), cB + hstep, voffB); PG8_STAGEA(PG8_SA(0, 0), 0, oc00, oc01); PG8_STAGEA(PG8_SA(0, 1), 0, oc10, oc11);
    if (wr == 1) PG8_BAR;
    PG8_WAIT_V(2); PG8_BAR;
    PG8_STAGE(PG8_SB(1, 0), cB + kstep, voffB); PG8_STAGEA(PG8_SA(1, 0), kstep, oc00, oc01); PG8_STAGE(PG8_SB(1, 1), cB + hstep + kstep, voffB);
    PG8_WAIT_V(6); PG8_BAR;
    for (;;) {
        const bool has_next = S.next(ui + 1, nxt);
        const char* nB = cB;
        on00 = oc00; on01 = oc01; on10 = oc10; on11 = oc11;
        if (has_next) { nB = S.b_ptr(nxt); on00 = S.a_off(nxt, RA[0]) + CA[0]; on01 = S.a_off(nxt, RA[1]) + CA[1]; on10 = S.a_off(nxt, HALF + RA[0]) + CA[0]; on11 = S.a_off(nxt, HALF + RA[1]) + CA[1]; }
        for (int t = 0; t < nt; t += 2) {
            const bool last = (t == nt - 2);
            const size_t k1 = (size_t)(t + 1) * kstep, k2 = last ? 0 : (size_t)(t + 2) * kstep, k3 = k2 + kstep;
            const char* b2 = last ? nB : cB + (size_t)(t + 2) * kstep; const char* b3 = b2 + kstep;
            const unsigned p00 = last ? on00 : oc00, p01 = last ? on01 : oc01, p10 = last ? on10 : oc10, p11 = last ? on11 : oc11;
            PG8_LDB(B0, 0, 0); PG8_LDB(B1, 0, 1); PG8_SCHED; PG8_LDA(At, 0, 0); PG8_STAGEA(PG8_SA(1, 1), k1, oc10, oc11);
            PG8_WAIT_V(8); PG8_WAIT_L(0); PG8_BAR; PG8_MMA(0, 0, At, B0); PG8_MMA(0, 1, At, B1); PG8_BAR; PG8_SCHED;
            PG8_LDA(At, 0, 1); PG8_STAGE(PG8_SB(0, 0), b2, voffB); PG8_STAGE(PG8_SB(0, 1), b2 + hstep, voffB); PG8_STAGEA(PG8_SA(0, 0), k2, p00, p01);
            PG8_WAIT_V(8); PG8_WAIT_L(0); PG8_BAR; PG8_MMA(1, 0, At, B0); PG8_MMA(1, 1, At, B1); PG8_BAR; PG8_SCHED;
            PG8_LDB(B0, 1, 0); PG8_LDB(B1, 1, 1); PG8_SCHED; PG8_LDA(At, 1, 0); PG8_STAGEA(PG8_SA(0, 1), k2, p10, p11);
            PG8_WAIT_V(8); PG8_WAIT_L(0); PG8_BAR; PG8_MMA(0, 0, At, B0); PG8_MMA(0, 1, At, B1); PG8_BAR; PG8_SCHED;
            PG8_LDA(At, 1, 1); PG8_STAGE(PG8_SB(1, 0), b3, voffB); PG8_STAGE(PG8_SB(1, 1), b3 + hstep, voffB); PG8_STAGEA(PG8_SA(1, 0), k3, p00, p01);
            PG8_WAIT_V(8); PG8_WAIT_L(0); PG8_BAR; PG8_MMA(1, 0, At, B0); PG8_MMA(1, 1, At, B1); PG8_BAR; PG8_SCHED;
        }
        if constexpr (ALIGN_EPI) { if (wr == 0) PG8_BAR; }
        E(acc, cur, wr, wc, fr, fq);
        if (!has_next) break;
#pragma unroll
        for (int a = 0; a < 2; ++a)
#pragma unroll
            for (int b = 0; b < 2; ++b)
#pragma unroll
                for (int m = 0; m < 4; ++m)
#pragma unroll
                    for (int n = 0; n < 2; ++n) acc[a][b][m][n] = (f32x4){0.f, 0.f, 0.f, 0.f};
        cur = nxt; cB = nB; oc00 = on00; oc01 = on01; oc10 = on10; oc11 = on11; ++ui;
        if constexpr (ALIGN_EPI) { if (wr == 1) PG8_BAR; }
    }
    PG8_WAIT_V(0);
    if constexpr (!ALIGN_EPI) { if (wr == 0) PG8_BAR; }
    PG8_BAR;
#undef PG8_SA
#undef PG8_SB
#undef PG8_STAGE
#undef PG8_STAGEA
#undef PG8_LDA
#undef PG8_LDB
#undef PG8_MMA
#undef PG8_WAIT_V
#undef PG8_WAIT_L
#undef PG8_BAR
#undef PG8_SCHED
}
}

#define PHASE_IDS(F) do { int _t = threadIdx.x; asm volatile("" : "+v"(_t)); (F).tid = _t; (F).lane = _t & 63; (F).wave = __builtin_amdgcn_readfirstlane(_t >> 6); } while (0)
__device__ __forceinline__ void tr_item(const float* W, int ldw, int k0, int c0, bf16* WT, int K, int r0, LAS float* scr, int lane) {
    float tv[32];
#pragma unroll
    for (int i = 0; i < 32; ++i) tv[i] = W[(size_t)(k0 + 2 * i + (lane >> 5)) * ldw + c0 + (lane & 31)];
#pragma unroll
    for (int i = 0; i < 32; ++i) scr[(2 * i + (lane >> 5)) * 33 + (lane & 31)] = tv[i];
    LDS_WAIT(); asm volatile("" ::: "memory");
    const int c = lane & 7;
#pragma unroll
    for (int j = 0; j < 4; ++j) { const int n = (lane >> 3) + 8 * j; const LAS float* s = scr + (8 * c) * 33 + n;
        v4u o; o.x = pk2(s[0 * 33], s[1 * 33]); o.y = pk2(s[2 * 33], s[3 * 33]); o.z = pk2(s[4 * 33], s[5 * 33]); o.w = pk2(s[6 * 33], s[7 * 33]);
        *(v4u*)(WT + (size_t)(r0 + n) * K + k0 + 8 * c) = o; }
    LDS_WAIT(); asm volatile("" ::: "memory");
}

__device__ __forceinline__ void phase_prologue(Frame& F) {
    PHASE_IDS(F);
    LAS float* WL = (LAS float*)F.lds;
    LAS float* scr = (LAS float*)(F.lds + 65536 + F.wave * 8704);
    const float* w_in0 = F.in[4];
    for (int s = F.tid; s < 16 * 1024; s += 512) { const int k = s >> 4, o = s & 15; WL[o * 1024 + k] = w_in0[(size_t)k * EV_LD + 3072 + o]; }
    const int gw = F.vcu * NWAVES + F.wave, NGW = F.G * NWAVES;
    bf16* WIN0 = (bf16*)(F.ws + WS_WIN0); bf16* WOUT0 = (bf16*)(F.ws + WS_WOUT0); bf16* WIN1 = (bf16*)(F.ws + WS_WIN1); bf16* WOUT1 = (bf16*)(F.ws + WS_WOUT1);
    bf16* W13 = (bf16*)(F.ws + WS_W13); bf16* W2 = (bf16*)(F.ws + WS_W2);
    constexpr int I_A = 16 * 96, I_B = 16 * 16, I_C = 16 * 32, I_D = 16 * 80, I_E = 16 * 32, I_F = 2 * 32 * 2 * 256, I_G = 2 * 32 * 256;
    constexpr int NITEMS = I_A + I_B + I_C + I_D + I_E + I_F + I_G;
    for (int it = gw; it < NITEMS; it += NGW) {
        int r = it;
        if (r < I_A) { const int kb = r / 96, nb = r % 96; tr_item(w_in0, EV_LD, 64 * kb, 32 * nb, WIN0, 1024, 32 * nb, scr, F.lane); continue; } r -= I_A;
        if (r < I_B) { const int kb = r / 16, nb = r % 16; tr_item(w_in0, EV_LD, 64 * kb, 3088 + 32 * nb, WIN0, 1024, 3072 + 32 * nb, scr, F.lane); continue; } r -= I_B;
        if (r < I_C) { const int kb = r / 32, nb = r % 32; tr_item(F.in[10], 1024, 64 * kb, 32 * nb, WOUT0, 1024, 32 * nb, scr, F.lane); continue; } r -= I_C;
        if (r < I_D) { const int kb = r / 80, nb = r % 80; tr_item(F.in[11], OD_N, 64 * kb, 32 * nb, WIN1, 1024, 32 * nb, scr, F.lane); continue; } r -= I_D;
        if (r < I_E) { const int kb = r / 32, nb = r % 32; tr_item(F.in[20], 1024, 64 * kb, 32 * nb, WOUT1, 1024, 32 * nb, scr, F.lane); continue; } r -= I_E;
        if (r < I_F) { const int le = r / 512, q = r % 512, which = q / 256, kb = (q % 256) / 16, nb = q % 16;
            const float* src = (which ? F.in[26] : F.in[25]) + (size_t)le * 1024 * 512; const int n0 = 32 * nb;
            tr_item(src, 512, 64 * kb, n0, W13 + (size_t)le * 1024 * 1024, 1024, 256 * (n0 >> 7) + (n0 & 127) + which * 128, scr, F.lane); continue; } r -= I_F;
        { const int le = r / 256, q = r % 256, kb = q / 32, nb = q % 32;
            tr_item(F.in[27] + (size_t)le * 512 * 1024, 1024, 64 * kb, 32 * nb, W2 + (size_t)le * 1024 * 512, 512, 32 * nb, scr, F.lane); }
    }
    __syncthreads();
    const float* x = F.in[0]; const float* g = F.in[1];
    bf16* XN = (bf16*)(F.ws + WS_ACT); float* BL = (float*)(F.ws + WS_BLOW);
    f32x4 gv[4];
#pragma unroll
    for (int j = 0; j < 4; ++j) gv[j] = *((const f32x4*)g + 64 * j + F.lane);
    for (int m = gw; m < NT; m += NGW) {
        asm volatile("" ::: "memory");
        const f32x4* xr = (const f32x4*)(x + (size_t)m * D) + F.lane;
        f32x4 v[4]; float s = 0.f;
#pragma unroll
        for (int j = 0; j < 4; ++j) { v[j] = xr[64 * j]; s += (v[j].x * v[j].x + v[j].y * v[j].y) + (v[j].z * v[j].z + v[j].w * v[j].w); }
        const float rstd = rsqrtf(wave_sum(s) * (1.f / D) + EPS);
        v2u* o8 = (v2u*)(XN + (size_t)m * D) + F.lane;
#pragma unroll
        for (int j = 0; j < 4; ++j) { v[j] = v[j] * rstd * gv[j]; v2u w; w.x = pk2(v[j].x, v[j].y); w.y = pk2(v[j].z, v[j].w); o8[64 * j] = w; }
        float p[16];
#pragma unroll
        for (int o = 0; o < 16; ++o) {
            const LAS f32x4* wl = (const LAS f32x4*)(WL + o * 1024) + F.lane; float a = 0.f;
#pragma unroll
            for (int j = 0; j < 4; ++j) { const f32x4 w = wl[64 * j]; a += (v[j].x * w.x + v[j].y * w.y) + (v[j].z * w.z + v[j].w * w.w); }
            p[o] = a;
        }
#pragma unroll
        for (int o = 0; o < 8; ++o) { const bool hi = (F.lane & 32) != 0; const float snd = hi ? p[o] : p[o + 8], kp = hi ? p[o + 8] : p[o]; p[o] = kp + __shfl_xor(snd, 32); }
#pragma unroll
        for (int o = 0; o < 4; ++o) { const bool hi = (F.lane & 16) != 0; const float snd = hi ? p[o] : p[o + 4], kp = hi ? p[o + 4] : p[o]; p[o] = kp + __shfl_xor(snd, 16); }
#pragma unroll
        for (int o = 0; o < 2; ++o) { const bool hi = (F.lane & 8) != 0; const float snd = hi ? p[o] : p[o + 2], kp = hi ? p[o + 2] : p[o]; p[o] = kp + __shfl_xor(snd, 8); }
        { const bool hi = (F.lane & 4) != 0; const float snd = hi ? p[0] : p[1], kp = hi ? p[1] : p[0]; p[0] = kp + __shfl_xor(snd, 4); }
        p[0] += __shfl_xor(p[0], 2); p[0] += __shfl_xor(p[0], 1);
        if ((F.lane & 3) == 0) BL[(size_t)m * 16 + ((F.lane >> 5) & 1) * 8 + ((F.lane >> 4) & 1) * 4 + ((F.lane >> 3) & 1) * 2 + ((F.lane >> 2) & 1)] = p[0];
    }
}

__device__ __forceinline__ float row16_max(float v) { v = fmaxf(v, __shfl_xor(v, 1)); v = fmaxf(v, __shfl_xor(v, 2)); v = fmaxf(v, __shfl_xor(v, 4)); return fmaxf(v, __shfl_xor(v, 8)); }
__device__ __forceinline__ float row16_sum(float v) { v += __shfl_xor(v, 1); v += __shfl_xor(v, 2); v += __shfl_xor(v, 4); return v + __shfl_xor(v, 8); }
__device__ __forceinline__ int row16_min(int v) { v = min(v, __shfl_xor(v, 1)); v = min(v, __shfl_xor(v, 2)); v = min(v, __shfl_xor(v, 4)); return min(v, __shfl_xor(v, 8)); }
__device__ __forceinline__ void phase_router(Frame& F, int layer, const bf16* XR) {
    PHASE_IDS(F);
    constexpr int PW = 2064;
    LAS unsigned char* WH = F.lds; LAS unsigned char* WLO = F.lds + 36 * PW;
    LAS float* GL = (LAS float*)(F.lds + LDS_MISC + 1024);
    LAS int* hist = (LAS int*)(F.lds + LDS_MISC + 1024 + 4096); LAS int* base = hist + 32;
    LAS int* s_e0 = base + 32; LAS int* s_e1 = s_e0 + 128; LAS int* s_r0 = s_e1 + 128; LAS int* s_r1 = s_r0 + 128;
    LAS float* s_w0 = (LAS float*)(s_r1 + 128); LAS float* s_w1 = s_w0 + 128;
    const float* wg = F.in[21] + (size_t)layer * 1024 * 4; const float* we = F.in[23] + (size_t)layer * 1024 * 32;
    const float* g = F.in[2] + layer * 1024;
    for (int s = F.tid; s < 1024; s += 512) GL[s] = g[s];
    for (int s = F.tid; s < 4096; s += 512) { const int k = s >> 2, o = s & 3; const float w = wg[s] * g[k]; const unsigned hb = f2bf(w);
        *(LAS bf16*)(WH + o * PW + k * 2) = (bf16)hb; *(LAS bf16*)(WLO + o * PW + k * 2) = (bf16)f2bf(w - bf2f((bf16)hb)); }
    for (int s = F.tid; s < 32768; s += 512) { const int k = s >> 5, o = 4 + (s & 31); const float w = we[s] * g[k]; const unsigned hb = f2bf(w);
        *(LAS bf16*)(WH + o * PW + k * 2) = (bf16)hb; *(LAS bf16*)(WLO + o * PW + k * 2) = (bf16)f2bf(w - bf2f((bf16)hb)); }
    const int c = F.lane & 15, q = F.lane >> 4;
    float bias[3];
#pragma unroll
    for (int jt = 0; jt < 3; ++jt) { const int col = 16 * jt + c; bias[jt] = col < 4 ? F.in[22][layer * 4 + col] : (col < 36 ? F.in[24][layer * 32 + col - 4] : 0.f); }
    unsigned* cnt = F.ctl + CW_CNT + 64 * layer;
    bf16* XN = (bf16*)(F.ws + WS_ACT); const float* SSQ = (const float*)(F.ws + WS_SSQ);
    int* ME0 = (int*)(F.ws + WS_META); int* ME1 = ME0 + NT; int* MR0 = ME1 + NT; int* MR1 = MR0 + NT; float* MW0 = (float*)(MR1 + NT); float* MW1 = MW0 + NT;
    int* LIST = (int*)(F.ws + WS_LIST);
    int wrow[3];
#pragma unroll
    for (int jt = 0; jt < 3; ++jt) wrow[jt] = min(16 * jt + c, 35) * PW + 16 * q;
    __syncthreads();
    for (int row0 = 128 * F.vcu; row0 < NT; row0 += 128 * F.G) {
        if (F.tid < 32) hist[F.tid] = 0;
        __syncthreads();
        const int rl = F.wave * 16, row = row0 + rl + c;
        float rstd; { const f32x4 sp = *(const f32x4*)(SSQ + (size_t)row * 16 + 4 * q); float s = (sp[0] + sp[1]) + (sp[2] + sp[3]); s += __shfl_xor(s, 16); s += __shfl_xor(s, 32); rstd = rsqrtf(s * (1.f / D) + EPS); }
        const bf16* xr = XR + (size_t)row * D + 8 * q; bf16* xo = XN + (size_t)row * D + 8 * q;
        f32x4 acc[3];
#pragma unroll
        for (int jt = 0; jt < 3; ++jt) acc[jt] = (f32x4){0.f, 0.f, 0.f, 0.f};
        for (int k4 = 0; k4 < 32; k4 += 8) {
            v4u xw[8];
#pragma unroll
            for (int u = 0; u < 8; ++u) xw[u] = *(const v4u*)(xr + 32 * (k4 + u));
#pragma unroll
            for (int u = 0; u < 8; ++u) {
                const int kk = k4 + u;
                const f32x4 ga = *(const LAS f32x4*)(GL + 32 * kk + 8 * q), gb = *(const LAS f32x4*)(GL + 32 * kk + 8 * q + 4);
                const v4u w = xw[u];
#define BLO(x) __builtin_bit_cast(float, (x) << 16)
#define BHI(x) __builtin_bit_cast(float, (x) & 0xffff0000u)
                v4u xn; xn.x = pk2(BLO(w.x) * rstd * ga[0], BHI(w.x) * rstd * ga[1]); xn.y = pk2(BLO(w.y) * rstd * ga[2], BHI(w.y) * rstd * ga[3]);
                xn.z = pk2(BLO(w.z) * rstd * gb[0], BHI(w.z) * rstd * gb[1]); xn.w = pk2(BLO(w.w) * rstd * gb[2], BHI(w.w) * rstd * gb[3]);
#undef BLO
#undef BHI
                *(v4u*)(xo + 32 * kk) = xn;
                const bf16x8 ah = __builtin_bit_cast(bf16x8, w);
#pragma unroll
                for (int jt = 0; jt < 3; ++jt) { const bf16x8 bh = *(const LAS bf16x8*)(WH + wrow[jt] + 64 * kk), bl = *(const LAS bf16x8*)(WLO + wrow[jt] + 64 * kk);
                    acc[jt] = __builtin_amdgcn_mfma_f32_16x16x32_bf16(ah, bh, acc[jt], 0, 0, 0); acc[jt] = __builtin_amdgcn_mfma_f32_16x16x32_bf16(ah, bl, acc[jt], 0, 0, 0); }
            }
        }
#pragma unroll
        for (int i = 0; i < 4; ++i) {
            const float rs = __shfl(rstd, 4 * q + i);
            const float l0 = acc[0][i] * rs + bias[0], l1 = acc[1][i] * rs + bias[1], l2 = acc[2][i] * rs + bias[2];
            const float gvl = c < 4 ? l0 : -3.0e38f;
            const float gmax = row16_max(gvl); const int gi = row16_min(gvl == gmax ? c : 99);
            const float gwt = 1.f / row16_sum(c < 4 ? __expf(gvl - gmax) : 0.f);
            const int jt = c < 4 ? (gi == 1 ? 1 : 2) : (c < 12 ? (gi == 0 ? 0 : 1) : (gi == 1 ? 0 : 1));
            const bool valid = c < 4 ? (gi == 1 || gi == 3) : (c < 12 ? (gi == 0 || gi == 2) : (gi == 1 || gi == 3));
            const int eidx = 16 * jt + c - 4 - 8 * gi;
            float cv = jt == 0 ? l0 : (jt == 1 ? l1 : l2); cv = (valid && eidx >= 0 && eidx < 8) ? cv : -3.0e38f;
            const float v0 = row16_max(cv); const int i0 = row16_min(cv == v0 ? eidx : 99);
            const float cv2 = eidx == i0 ? -3.0e38f : cv;
            const float v1 = row16_max(cv2); const int i1 = row16_min(cv2 == v1 ? eidx : 99);
            const float ex = __expf(v1 - v0), tw0 = 1.f / (1.f + ex), tw1 = ex / (1.f + ex);
            if (c == 0) { const int r = rl + 4 * q + i, e0 = gi * 8 + i0, e1 = gi * 8 + i1;
                s_e0[r] = e0; s_e1[r] = e1; s_w0[r] = gwt * tw0; s_w1[r] = gwt * tw1;
                s_r0[r] = atomicAdd((int*)&hist[e0], 1); s_r1[r] = atomicAdd((int*)&hist[e1], 1); }
        }
        __syncthreads();
        if (F.tid < 32) base[F.tid] = (int)atomicAdd(cnt + F.tid, (unsigned)hist[F.tid]);
        __syncthreads();
        if (F.tid < 128) {
            const int m = row0 + F.tid, e0 = s_e0[F.tid], e1 = s_e1[F.tid], r0 = base[e0] + s_r0[F.tid], r1 = base[e1] + s_r1[F.tid];
            ME0[m] = e0; ME1[m] = e1; MR0[m] = r0; MR1[m] = r1; MW0[m] = s_w0[F.tid]; MW1[m] = s_w1[F.tid];
            LIST[(size_t)e0 * NT + r0] = m; LIST[(size_t)e1 * NT + r1] = m;
        }
        __syncthreads();
    }
}

__device__ __forceinline__ void phase_combine(Frame& F, int layer, const bf16* XRin, bf16* XRout) {
    PHASE_IDS(F);
    LAS int* poff = (LAS int*)(F.lds + LDS_MISC + 1024);
    const unsigned* cnt = F.ctl + CW_CNT + 64 * layer;
    if (F.tid == 0) { int acc = 0; for (int e = 0; e < 32; ++e) { poff[e] = acc; acc += ((int)cnt[e] + 255) & ~255; } poff[32] = acc; }
    __syncthreads();
    const int gw = F.vcu * NWAVES + F.wave, NGW = F.G * NWAVES;
    const float* g = layer == 0 ? F.in[1] + 1024 : F.in[3];
    const bf16* Y = (const bf16*)(F.ws + WS_Y); bf16* XN = (bf16*)(F.ws + WS_ACT);
    const int* ME0 = (const int*)(F.ws + WS_META); const int* ME1 = ME0 + NT; const int* MR0 = ME1 + NT; const int* MR1 = MR0 + NT; const float* MW0 = (const float*)(MR1 + NT); const float* MW1 = MW0 + NT;
    f32x4 gv[4];
#pragma unroll
    for (int j = 0; j < 4; ++j) gv[j] = *((const f32x4*)g + 64 * j + F.lane);
    for (int m0 = gw; m0 < NT; m0 += 2 * NGW) {
        int mr[2]; mr[0] = m0; mr[1] = (m0 + NGW < NT) ? m0 + NGW : m0;
        f32x4 v[2][4]; v2u ya[2][4], yb[2][4]; float w0[2], w1[2];
#pragma unroll
        for (int r = 0; r < 2; ++r) {
            const int m = mr[r]; const int s0 = poff[ME0[m]] + MR0[m], s1 = poff[ME1[m]] + MR1[m]; w0[r] = MW0[m]; w1[r] = MW1[m];
            const v2u* xr = (const v2u*)(XRin + (size_t)m * D) + F.lane;
            const v2u* y0 = (const v2u*)(Y + (size_t)s0 * D) + F.lane; const v2u* y1 = (const v2u*)(Y + (size_t)s1 * D) + F.lane;
#pragma unroll
            for (int j = 0; j < 4; ++j) { const v2u xw = xr[64 * j]; v[r][j] = (f32x4){bf2f((bf16)(xw.x & 0xffff)), bf2f((bf16)(xw.x >> 16)), bf2f((bf16)(xw.y & 0xffff)), bf2f((bf16)(xw.y >> 16))}; ya[r][j] = y0[64 * j]; yb[r][j] = y1[64 * j]; }
        }
#pragma unroll
        for (int r = 0; r < 2; ++r) {
            const int m = mr[r]; float s = 0.f;
            f32x4* xr = (f32x4*)(F.out + (size_t)m * D) + F.lane; v2u* xo2 = (v2u*)(XRout + (size_t)m * D) + F.lane;
#pragma unroll
            for (int j = 0; j < 4; ++j) { const v2u a = ya[r][j], b = yb[r][j];
                v[r][j].x += w0[r] * bf2f((bf16)(a.x & 0xffff)) + w1[r] * bf2f((bf16)(b.x & 0xffff)); v[r][j].y += w0[r] * bf2f((bf16)(a.x >> 16)) + w1[r] * bf2f((bf16)(b.x >> 16));
                v[r][j].z += w0[r] * bf2f((bf16)(a.y & 0xffff)) + w1[r] * bf2f((bf16)(b.y & 0xffff)); v[r][j].w += w0[r] * bf2f((bf16)(a.y >> 16)) + w1[r] * bf2f((bf16)(b.y >> 16));
                s += (v[r][j].x * v[r][j].x + v[r][j].y * v[r][j].y) + (v[r][j].z * v[r][j].z + v[r][j].w * v[r][j].w); }
            const float rstd = rsqrtf(wave_sum(s) * (1.f / D) + EPS);
            if (r == 1 && mr[1] == mr[0]) continue;
            if (layer == 0) {
                v2u* o8 = (v2u*)(XN + (size_t)m * D) + F.lane;
#pragma unroll
                for (int j = 0; j < 4; ++j) { v2u xw; xw.x = pk2(v[r][j].x, v[r][j].y); xw.y = pk2(v[r][j].z, v[r][j].w); xo2[64 * j] = xw; const f32x4 n = v[r][j] * rstd * gv[j]; v2u w; w.x = pk2(n.x, n.y); w.y = pk2(n.z, n.w); o8[64 * j] = w; }
            } else {
#pragma unroll
                for (int j = 0; j < 4; ++j) xr[64 * j] = v[r][j] * rstd * gv[j];
            }
        }
    }
}


namespace mx {
typedef short s4 __attribute__((ext_vector_type(4)));
constexpr int PV = 272, PP = 144;
template <int DK> struct Lay { static constexpr int PK = DK * 2 + 16, QS = 0, KS = 64 * PK, VV = 2 * 64 * PK, ST = VV + 64 * PV, PM = ST + 128 * PK, VEC = PM + 64 * PP, PART = VEC + 3 * DK * 4, RED = PART + 8 * DK * 4, BLS = RED + 4096, END = BLS + 4096; };
static_assert(Lay<128>::END <= LDS_MISC, "mixer LDS map");
__device__ __forceinline__ bf16x8 row_frag(const LAS unsigned char* base, int pitch, int row0, int kk, int lane) {
    return *(const LAS bf16x8*)(base + (row0 + (lane & 15)) * pitch + (32 * kk + 8 * (lane >> 4)) * 2);
}
__device__ __forceinline__ bf16x8 tr_frag(const LAS unsigned char* base, int pitch, int k0, int c0, int lane) {
    const int g = lane >> 4, q = (lane & 15) >> 2, p = lane & 3;
    const LAS unsigned char* a = base + (k0 + 8 * g + q) * pitch + (c0 + 4 * p) * 2;
    const s4 lo = __builtin_amdgcn_ds_read_tr16_b64_v4i16((LAS s4*)a);
    const s4 hi = __builtin_amdgcn_ds_read_tr16_b64_v4i16((LAS s4*)(a + 4 * pitch));
    return __builtin_shufflevector(lo, hi, 0, 1, 2, 3, 4, 5, 6, 7);
}
#define MFMA16(a, b, c) __builtin_amdgcn_mfma_f32_16x16x32_bf16(a, b, c, 0, 0, 0)

struct UnitP { const bf16* PROJ; bf16* YM; const float* nw; const float* BL; const float* p0; const float* p1; const float* p2; int b, h, seg; };

template <int KIND> struct KC {
    static constexpr int DK = KIND == 0 ? 128 : 64, LDP = KIND == 2 ? OD_N : EV_N;
    __device__ static __forceinline__ int qcol(int h) { return KIND == 0 ? h * 128 : (KIND == 1 ? 2048 + h * 64 : h * 64); }
    __device__ static __forceinline__ int kcol(int h) { return KIND == 0 ? 512 + h * 128 : (KIND == 1 ? 2304 + h * 64 : 256 + h * 64); }
    __device__ static __forceinline__ int vcol(int h) { return KIND == 0 ? 1024 + h * 128 : (KIND == 1 ? 2560 + h * 128 : 512 + h * 128); }
    __device__ static __forceinline__ int gcol(int h) { return KIND == 0 ? 1536 + h * 128 : (KIND == 1 ? 3072 + h * 128 : 1024 + h * 128); }
    __device__ static __forceinline__ int ocol(int h) { return KIND == 1 ? 512 + h * 128 : h * 128; }
};

template <int KIND, bool FULL>
__device__ __forceinline__ void mix_unit(LAS unsigned char* lds, float* Sg, float* Bg, const UnitP& U) {
    using K = KC<KIND>; constexpr int DK = K::DK, LDP = K::LDP, NJT = DK == 128 ? 8 : 4; using L = Lay<DK>; constexpr int PK = L::PK;
    int tid = threadIdx.x; asm volatile("" : "+v"(tid));
    const int lane = tid & 63, wave = __builtin_amdgcn_readfirstlane(tid >> 6), g = lane >> 4, c = lane & 15;
    const int h = U.h, dt = DK == 128 ? wave : (wave & 3), jt0 = DK == 128 ? 0 : 4 * (wave >> 2);
    LAS float* EM = (LAS float*)(lds + L::VEC); LAS float* EL = EM + DK; LAS float* BT = EL + DK; LAS float* PART = (LAS float*)(lds + L::PART);
    float lb0 = 0.f, lb1 = 0.f, wu[16], bu = 0.f, ci = 0.f, lgg = 0.f;
    if (KIND == 0) {
        const float* lbl = U.p0; const int col = h * 128 + 2 * lane;
#pragma unroll
        for (int x = 0; x < 2; ++x) { const float l0 = lbl[col + x], l1 = lbl[512 + col + x], l2 = lbl[1024 + col + x]; const float mx_ = fmaxf(l0, fmaxf(l1, l2));
            const float e0 = __expf(l0 - mx_), e1 = __expf(l1 - mx_), e2 = __expf(l2 - mx_); const float v = e0 / (e0 + e1 + e2); if (x == 0) lb0 = v; else lb1 = v; }
    }
    if (KIND == 1) {
#pragma unroll
        for (int r = 0; r < 16; ++r) wu[r] = U.p0[r * 256 + h * 64 + lane];
        bu = U.p1[h * 64 + lane];
    }
    if (KIND == 2) { ci = exp2f(-(float)(lane & 31) * (13.287712379549449f / 32.f)) * 0.15915494309189535f; lgg = log1pf(-exp2f(-5.f - (float)h)); }
    f32x4 S[NJT];
#pragma unroll
    for (int jt = 0; jt < NJT; ++jt) {
        if (FULL) {
#pragma unroll
            for (int i = 0; i < 4; ++i) S[jt][i] = Sg[(16 * dt + 4 * g + i) * 128 + 16 * (jt0 + jt) + c];
        } else S[jt] = (f32x4){0.f, 0.f, 0.f, 0.f};
    }
    f32x4 nw4[4];
    if (FULL) {
#pragma unroll
        for (int x = 0; x < 4; ++x) nw4[x] = *(const f32x4*)(U.nw + h * 128 + 16 * (4 * (wave >> 2) + x) + 4 * g);
    }
    if (tid < DK) BT[tid] = KIND == 0 ? 1.f : 0.f;
    v4u rv0, rv1; unsigned ra[8], rb[8]; f32x4 rbl = (f32x4){0.f, 0.f, 0.f, 0.f};
    auto load_raw = [&](int ch) {
        const size_t row0 = (size_t)U.b * SEQ + U.seg * 1024 + ch * 64;
        const bf16* Vp = U.PROJ + (row0 + (tid >> 3)) * LDP + K::vcol(h) + (tid & 7) * 16;
        rv0 = *(const v4u*)Vp; rv1 = *(const v4u*)(Vp + 8);
        if (KIND == 1 && tid < 256) rbl = *(const f32x4*)(U.BL + (row0 + (tid >> 2)) * 16 + (tid & 3) * 4);
        if (KIND == 0) {
            const bf16* P = U.PROJ + (row0 + 8 * wave) * LDP + 2 * lane;
#pragma unroll
            for (int tt = 0; tt < 8; ++tt) { ra[tt] = *(const unsigned*)(P + (size_t)tt * LDP + K::kcol(h)); if (FULL) rb[tt] = *(const unsigned*)(P + (size_t)tt * LDP + K::qcol(h)); }
        } else {
            const bf16* P = U.PROJ + (row0 + 8 * wave) * LDP + lane;
#pragma unroll
            for (int tt = 0; tt < 8; ++tt) { ra[tt] = P[(size_t)tt * LDP + K::kcol(h)]; if (FULL) rb[tt] = P[(size_t)tt * LDP + K::qcol(h)]; }
        }
    };
    load_raw(0);
    for (int ch = 0; ch < 16; ++ch) {
        const int pos0 = U.seg * 1024 + ch * 64; const size_t row0 = (size_t)U.b * SEQ + pos0;
        *(LAS v4u*)(lds + L::VV + (tid >> 3) * PV + (tid & 7) * 32) = rv0; *(LAS v4u*)(lds + L::VV + (tid >> 3) * PV + (tid & 7) * 32 + 16) = rv1;
        if (KIND == 0) {
            float cp0[8], cp1[8], k0[8], k1[8]; float c0 = 1.f, c1 = 1.f;
#pragma unroll
            for (int tt = 0; tt < 8; ++tt) {
                const float f0 = lb0 + (1.f - lb0) * sigmoidf_(bf2f((bf16)(ra[tt] & 0xffff))), f1 = lb1 + (1.f - lb1) * sigmoidf_(bf2f((bf16)(ra[tt] >> 16)));
                c0 *= f0; c1 *= f1; cp0[tt] = c0; cp1[tt] = c1; k0[tt] = 1.f - f0; k1[tt] = 1.f - f1;
            }
            *(LAS f32x2*)(PART + wave * 128 + 2 * lane) = (f32x2){c0, c1};
            __syncthreads();
            float pre0 = 1.f, pre1 = 1.f, mid0 = 1.f, mid1 = 1.f, hi0 = 1.f, hi1 = 1.f;
#pragma unroll
            for (int w2 = 0; w2 < 8; ++w2) { const f32x2 p = *(const LAS f32x2*)(PART + w2 * 128 + 2 * lane);
                if (w2 < 4) { mid0 *= p.x; mid1 *= p.y; } else { hi0 *= p.x; hi1 *= p.y; }
                if (wave < 4 ? (w2 > wave && w2 < 4) : (w2 >= 4 && w2 < wave)) { pre0 *= p.x; pre1 *= p.y; } }
#pragma unroll
            for (int tt = 0; tt < 8; ++tt) {
                float qs0, qs1, ks0, ks1;
                if (wave >= 4) { qs0 = pre0 * cp0[tt]; qs1 = pre1 * cp1[tt]; ks0 = __builtin_amdgcn_rcpf(fmaxf(qs0, 1e-26f)); ks1 = __builtin_amdgcn_rcpf(fmaxf(qs1, 1e-26f)); }
                else { ks0 = pre0 * c0 * __builtin_amdgcn_rcpf(fmaxf(cp0[tt], 1e-26f)); ks1 = pre1 * c1 * __builtin_amdgcn_rcpf(fmaxf(cp1[tt], 1e-26f));
                       qs0 = __builtin_amdgcn_rcpf(fmaxf(ks0, 1e-26f)); qs1 = __builtin_amdgcn_rcpf(fmaxf(ks1, 1e-26f)); }
                *(LAS unsigned*)(lds + L::KS + (8 * wave + tt) * PK + 4 * lane) = pg8::cvt_pk_bf16(k0[tt] * ks0, k1[tt] * ks1);
                if (FULL) *(LAS unsigned*)(lds + L::QS + (8 * wave + tt) * PK + 4 * lane) = pg8::cvt_pk_bf16(bf2f((bf16)(rb[tt] & 0xffff)) * qs0, bf2f((bf16)(rb[tt] >> 16)) * qs1);
            }
            if (wave == 0) { *(LAS f32x2*)(EM + 2 * lane) = (f32x2){mid0, mid1}; *(LAS f32x2*)(EL + 2 * lane) = (f32x2){hi0, hi1};
                const f32x2 o = *(const LAS f32x2*)(BT + 2 * lane); *(LAS f32x2*)(BT + 2 * lane) = (f32x2){o.x * mid0 * hi0, o.y * mid1 * hi1}; }
        } else if (KIND == 1) {
            LAS float* BLS = (LAS float*)(lds + L::BLS);
            if (tid < 256) *(LAS f32x4*)(BLS + (tid >> 2) * 16 + (tid & 3) * 4) = rbl;
            __syncthreads();
            float cs[8]; float cc = 0.f;
#pragma unroll
            for (int tt = 0; tt < 8; ++tt) {
                const LAS f32x4* bl = (const LAS f32x4*)(BLS + (8 * wave + tt) * 16); float z = bu;
#pragma unroll
                for (int r = 0; r < 4; ++r) { const f32x4 bq = bl[r]; z += (bq[0] * wu[4 * r] + bq[1] * wu[4 * r + 1]) + (bq[2] * wu[4 * r + 2] + bq[3] * wu[4 * r + 3]); }
                const float ls = fminf(z, 0.f) - __logf(1.f + __expf(-fabsf(z)));
                cc += ls * (1.f / 16.f); cs[tt] = cc;
            }
            PART[wave * 64 + lane] = cc;
            __syncthreads();
            float off = 0.f, mid = 0.f, tot = 0.f;
#pragma unroll
            for (int w2 = 0; w2 < 8; ++w2) { const float p = PART[w2 * 64 + lane]; if (w2 < wave) off += p; if (w2 < 4) mid += p; tot += p; }
#pragma unroll
            for (int tt = 0; tt < 8; ++tt) {
                const float b = off + cs[tt];
                *(LAS bf16*)(lds + L::KS + (8 * wave + tt) * PK + 2 * lane) = (bf16)f2bf(bf2f((bf16)ra[tt]) * __expf(fminf(mid - b, 60.f)));
                if (FULL) *(LAS bf16*)(lds + L::QS + (8 * wave + tt) * PK + 2 * lane) = (bf16)f2bf(bf2f((bf16)rb[tt]) * 0.125f * __expf(fminf(b - mid, 60.f)));
            }
            if (wave == 0) { EM[lane] = __expf(mid); EL[lane] = __expf(tot - mid); BT[lane] += tot; }
        } else {
#pragma unroll
            for (int tt = 0; tt < 8; ++tt) {
                const int tl = 8 * wave + tt; float rev = (float)(pos0 + tl) * ci; rev -= floorf(rev);
                const float sn = __builtin_amdgcn_sinf(rev), cs = __builtin_amdgcn_cosf(rev);
                const float e = (float)(tl - 31) * lgg;
                const float kv = bf2f((bf16)ra[tt]), kp = __shfl_xor(kv, 32);
                const float kr = (lane < 32 ? kv * cs - kp * sn : kp * sn + kv * cs) * 0.125f;
                *(LAS bf16*)(lds + L::KS + tl * PK + 2 * lane) = (bf16)f2bf(kr * __expf(-e));
                if (FULL) { const float qv = bf2f((bf16)rb[tt]), qp = __shfl_xor(qv, 32); const float qr = lane < 32 ? qv * cs - qp * sn : qp * sn + qv * cs;
                    *(LAS bf16*)(lds + L::QS + tl * PK + 2 * lane) = (bf16)f2bf(qr * __expf(e)); }
            }
            if (wave == 0) { const float e32 = __expf(32.f * lgg); EM[lane] = e32; EL[lane] = e32; BT[lane] += 64.f * lgg; }
        }
        if (ch + 1 < 16) load_raw(ch + 1);
        v2u gq[4];
        if (FULL) { const bf16* gp = U.PROJ + (row0 + 16 * (wave & 3) + c) * LDP + K::gcol(h) + 16 * (4 * (wave >> 2)) + 4 * g;
#pragma unroll
            for (int x = 0; x < 4; ++x) gq[x] = *(const v2u*)(gp + 16 * x); }
        __syncthreads();
        { const f32x4 em4 = *(const LAS f32x4*)(EM + 16 * dt + 4 * g);
#pragma unroll
          for (int jt = 0; jt < NJT; ++jt) { S[jt] = S[jt] * em4;
              if (FULL) { v2u w; w.x = pg8::cvt_pk_bf16(S[jt][0], S[jt][1]); w.y = pg8::cvt_pk_bf16(S[jt][2], S[jt][3]);
                  *(LAS v2u*)(lds + L::ST + (16 * (jt0 + jt) + c) * PK + (16 * dt + 4 * g) * 2) = w; } } }
        if (FULL) {
            const int st = wave & 3, tt0 = 2 * (wave >> 2);
            f32x4 p0 = (f32x4){0.f, 0.f, 0.f, 0.f}, p1 = p0;
#pragma unroll
            for (int kk = 0; kk < DK / 32; ++kk) { const bf16x8 a = row_frag(lds + L::KS, PK, 16 * st, kk, lane);
                p0 = MFMA16(a, row_frag(lds + L::QS, PK, 16 * tt0, kk, lane), p0); p1 = MFMA16(a, row_frag(lds + L::QS, PK, 16 * (tt0 + 1), kk, lane), p1); }
#pragma unroll
            for (int x = 0; x < 2; ++x) { const f32x4 p = x ? p1 : p0; const int t = 16 * (tt0 + x) + c, s = 16 * st + 4 * g;
                v2u w; w.x = pg8::cvt_pk_bf16(s <= t ? p[0] : 0.f, s + 1 <= t ? p[1] : 0.f); w.y = pg8::cvt_pk_bf16(s + 2 <= t ? p[2] : 0.f, s + 3 <= t ? p[3] : 0.f);
                *(LAS v2u*)(lds + L::PM + t * PP + s * 2) = w; }
        }
        {
#pragma unroll
          for (int kk = 0; kk < 2; ++kk) { const bf16x8 a = tr_frag(lds + L::KS, PK, 32 * kk, 16 * dt, lane);
#pragma unroll
              for (int jt = 0; jt < NJT; ++jt) S[jt] = MFMA16(a, tr_frag(lds + L::VV, PV, 32 * kk, 16 * (jt0 + jt), lane), S[jt]); }
          const f32x4 el4 = *(const LAS f32x4*)(EL + 16 * dt + 4 * g);
#pragma unroll
          for (int jt = 0; jt < NJT; ++jt) S[jt] = S[jt] * el4;
        }
        __syncthreads();
        if (FULL) {
            const int tt = wave & 3, jh = wave >> 2, t = 16 * tt + c;
            f32x4 o[4];
#pragma unroll
            for (int x = 0; x < 4; ++x) o[x] = (f32x4){0.f, 0.f, 0.f, 0.f};
#pragma unroll
            for (int kk = 0; kk < 2; ++kk) { const bf16x8 bb = row_frag(lds + L::PM, PP, 16 * tt, kk, lane);
#pragma unroll
                for (int x = 0; x < 4; ++x) o[x] = MFMA16(tr_frag(lds + L::VV, PV, 32 * kk, 16 * (4 * jh + x), lane), bb, o[x]); }
#pragma unroll
            for (int kk = 0; kk < DK / 32; ++kk) { const bf16x8 bb = row_frag(lds + L::QS, PK, 16 * tt, kk, lane);
#pragma unroll
                for (int x = 0; x < 4; ++x) o[x] = MFMA16(row_frag(lds + L::ST, PK, 16 * (4 * jh + x), kk, lane), bb, o[x]); }
            float sm = 0.f, sq = 0.f;
#pragma unroll
            for (int x = 0; x < 4; ++x)
#pragma unroll
                for (int i = 0; i < 4; ++i) { sm += o[x][i]; sq += o[x][i] * o[x][i]; }
            sm += __shfl_xor(sm, 16); sq += __shfl_xor(sq, 16); sm += __shfl_xor(sm, 32); sq += __shfl_xor(sq, 32);
            LAS f32x2* RED = (LAS f32x2*)(lds + L::RED) + (ch & 1) * 128;
            if (g == 0) RED[jh * 64 + t] = (f32x2){sm, sq};
            __syncthreads();
            const f32x2 r0 = RED[t], r1 = RED[64 + t];
            const float mean = KIND == 2 ? (r0.x + r1.x) * (1.f / 128.f) : 0.f;
            const float rstd = rsqrtf(fmaxf((r0.y + r1.y) * (1.f / 128.f) - mean * mean, 0.f) + EPS);
            bf16* yp = U.YM + (row0 + t) * 1024 + K::ocol(h) + 16 * (4 * jh) + 4 * g;
#pragma unroll
            for (int x = 0; x < 4; ++x) {
                const float g0 = bf2f((bf16)(gq[x].x & 0xffff)), g1 = bf2f((bf16)(gq[x].x >> 16)), g2 = bf2f((bf16)(gq[x].y & 0xffff)), g3 = bf2f((bf16)(gq[x].y >> 16));
                v2u w; w.x = pg8::cvt_pk_bf16((o[x][0] - mean) * rstd * nw4[x][0] * siluf_(g0), (o[x][1] - mean) * rstd * nw4[x][1] * siluf_(g1));
                w.y = pg8::cvt_pk_bf16((o[x][2] - mean) * rstd * nw4[x][2] * siluf_(g2), (o[x][3] - mean) * rstd * nw4[x][3] * siluf_(g3));
                *(v2u*)(yp + 16 * x) = w; }
        }
    }
    if (!FULL) {
#pragma unroll
        for (int jt = 0; jt < NJT; ++jt)
#pragma unroll
            for (int i = 0; i < 4; ++i) Sg[(16 * dt + 4 * g + i) * 128 + 16 * (jt0 + jt) + c] = S[jt][i];
        __syncthreads();
        if (tid < DK) Bg[tid] = KIND == 0 ? BT[tid] : __expf(BT[tid]);
    }
    __syncthreads();
}
}


namespace rg {
constexpr int PX = 272, PW = 144, XCB = 0, XCF = 64 * PX, WT = XCF + 64 * 132 * 4, END = WT + 4 * 64 * PW;
static_assert(END <= LDS_MISC, "rglru LDS map");
template <bool FULL>
__device__ __forceinline__ void unit(LAS unsigned char* lds, const bf16* PROJ, bf16* YM, const float* const* in, int b, int seg, int cg, float* RA, float* RH) {
    int tid = threadIdx.x; asm volatile("" : "+v"(tid));
    const int lane = tid & 63, wave = __builtin_amdgcn_readfirstlane(tid >> 6), g = lane >> 4, c = lane & 15;
    const int n0 = 2 * cg, chbase = cg * 128;
    const float* w_r = in[15]; const float* w_i = in[17];
    for (int i = tid; i < 4 * 4096; i += 512) { const int m = i >> 12, gate = m >> 1, nb = m & 1, d = (i >> 6) & 63, e = i & 63;
        const float v = (gate ? w_i : w_r)[((n0 + nb) * 64 + d) * 64 + e];
        *(LAS bf16*)(lds + WT + m * 64 * PW + e * PW + d * 2) = (bf16)f2bf(v); }
    float cw0[4], cw1[4]; const int cc = chbase + 2 * lane;
#pragma unroll
    for (int j = 0; j < 4; ++j) { cw0[j] = in[13][j * 512 + cc]; cw1[j] = in[13][j * 512 + cc + 1]; }
    const float cb0 = in[14][cc], cb1 = in[14][cc + 1];
    const int nb = wave >> 2, e0 = 16 * (wave & 3), chl = nb * 64 + e0 + c, chn = chbase + chl;
    const float brr = in[16][chn], bii = in[18][chn], sp = __logf(1.f + __expf(-in[19][chn]));
    float hcar = FULL ? RH[chn] : 0.f, atot = 1.f;
    unsigned xw[11];
    auto load_x = [&](int ch) {
#pragma unroll
        for (int r = 0; r < 11; ++r) { const int pos = seg * 1024 + ch * 64 + 8 * wave - 3 + r; xw[r] = 0u;
            if (pos >= 0) xw[r] = *(const unsigned*)(PROJ + ((size_t)b * SEQ + pos) * OD_N + 1536 + cc); }
    };
    load_x(0);
    __syncthreads();
    for (int ch = 0; ch < 16; ++ch) {
        const int pos0 = seg * 1024 + ch * 64; const size_t row0 = (size_t)b * SEQ + pos0;
        {
            float x0[11], x1[11];
#pragma unroll
            for (int r = 0; r < 11; ++r) { x0[r] = bf2f((bf16)(xw[r] & 0xffff)); x1[r] = bf2f((bf16)(xw[r] >> 16)); }
#pragma unroll
            for (int tt = 0; tt < 8; ++tt) {
                const float a0 = cb0 + cw0[0] * x0[tt] + cw0[1] * x0[tt + 1] + cw0[2] * x0[tt + 2] + cw0[3] * x0[tt + 3];
                const float a1 = cb1 + cw1[0] * x1[tt] + cw1[1] * x1[tt + 1] + cw1[2] * x1[tt + 2] + cw1[3] * x1[tt + 3];
                *(LAS unsigned*)(lds + XCB + (8 * wave + tt) * PX + 4 * lane) = pg8::cvt_pk_bf16(a0, a1);
                *(LAS f32x2*)(lds + XCF + ((8 * wave + tt) * 132 + 2 * lane) * 4) = (f32x2){a0, a1};
            }
        }
        if (ch + 1 < 16) load_x(ch + 1);
        bf16 gt[16];
        if (FULL) {
#pragma unroll
            for (int tt = 0; tt < 4; ++tt)
#pragma unroll
                for (int i = 0; i < 4; ++i) gt[4 * tt + i] = PROJ[(row0 + 16 * tt + 4 * g + i) * OD_N + 2048 + chn];
        }
        __syncthreads();
        f32x4 R[4], I[4];
#pragma unroll
        for (int tt = 0; tt < 4; ++tt) { R[tt] = (f32x4){0.f, 0.f, 0.f, 0.f}; I[tt] = R[tt]; }
#pragma unroll
        for (int kk = 0; kk < 2; ++kk) {
            const bf16x8 fr = mx::row_frag(lds + WT + nb * 64 * PW, PW, e0, kk, lane), fi = mx::row_frag(lds + WT + (2 + nb) * 64 * PW, PW, e0, kk, lane);
#pragma unroll
            for (int tt = 0; tt < 4; ++tt) { const bf16x8 a = mx::row_frag(lds + XCB + nb * 128, PX, 16 * tt, kk, lane); R[tt] = MFMA16(a, fr, R[tt]); I[tt] = MFMA16(a, fi, I[tt]); }
        }
#pragma unroll
        for (int tt = 0; tt < 4; ++tt) {
            float av[4], uv[4];
#pragma unroll
            for (int i = 0; i < 4; ++i) { const int t = 16 * tt + 4 * g + i;
                const float r = sigmoidf_(R[tt][i] + brr), ig = sigmoidf_(I[tt][i] + bii), la = -8.f * r * sp, a = __expf(la), x2 = 2.f * la;
                const float om = x2 > -0.05f ? -x2 * (1.f + x2 * (0.5f + x2 * (1.f / 6.f))) : 1.f - a * a;
                av[i] = a; uv[i] = sqrtf(fmaxf(om, 0.f)) * ig * *(const LAS float*)(lds + XCF + (t * 132 + chl) * 4); }
            float As = av[0] * av[1] * av[2] * av[3], Hs = ((uv[0] * av[1] + uv[1]) * av[2] + uv[2]) * av[3] + uv[3];
            float Ai = As, Hi = Hs;
            { const float Ap = __shfl(Ai, (lane - 16) & 63), Hp = __shfl(Hi, (lane - 16) & 63); if (g >= 1) { Hi = Hp * Ai + Hi; Ai = Ap * Ai; } }
            { const float Ap = __shfl(Ai, (lane - 32) & 63), Hp = __shfl(Hi, (lane - 32) & 63); if (g >= 2) { Hi = Hp * Ai + Hi; Ai = Ap * Ai; } }
            const float Ae = __shfl(Ai, (lane - 16) & 63), He = __shfl(Hi, (lane - 16) & 63), At = __shfl(Ai, 48 + c), Ht = __shfl(Hi, 48 + c);
            float h = g == 0 ? hcar : Ae * hcar + He;
            if (FULL) {
#pragma unroll
                for (int i = 0; i < 4; ++i) { const size_t row = row0 + 16 * tt + 4 * g + i; h = av[i] * h + uv[i];
                    YM[row * 1024 + 512 + chn] = (bf16)f2bf(h * gelu_tanh_(bf2f(gt[4 * tt + i]))); }
            }
            hcar = At * hcar + Ht; atot *= At;
        }
        __syncthreads();
    }
    if (!FULL && g == 0) { RA[chn] = atot; RH[chn] = hcar; }
}
}

template <int SUB> __device__ __forceinline__ void phase_mix(Frame& F, int layer) {
    float* SG = (float*)(F.ws + WS_ST); float* BG = (float*)(F.ws + WS_ST + 16 * MiB);
    const bf16* PROJ = (const bf16*)(F.ws + WS_PROJ); bf16* YM = (bf16*)(F.ws + WS_ACT);
    float* RA = (float*)(F.ws + WS_ST + 16 * MiB + 256 * 1024); float* RH = RA + 2 * 16 * 512;
    if (SUB == 1) {
        int tid = threadIdx.x; asm volatile("" : "+v"(tid));
        const int nel = (layer == 0 ? 16 : 8) * 16384;
        for (int idx = F.vcu * 512 + tid; idx < nel; idx += F.G * 512) {
            const int cidx = idx >> 14, e = idx & 16383, DK = (layer == 0 && cidx < 8) ? 128 : 64;
            if (e >= DK * 128) continue;
            const int d = e >> 7; float carry = 0.f;
            for (int seg = 0; seg < 16; ++seg) { float* p = SG + (size_t)(cidx * 16 + seg) * 16384 + e; const float tmp = *p; *p = carry; carry = BG[(cidx * 16 + seg) * 128 + d] * carry + tmp; }
        }
        if (layer == 1) for (int idx = F.vcu * 512 + tid; idx < 1024; idx += F.G * 512) { const int bb = idx >> 9, cch = idx & 511; float carry = 0.f;
            for (int seg = 0; seg < 16; ++seg) { const int o = (bb * 16 + seg) * 512 + cch; const float ta = RA[o], th = RH[o]; RH[o] = carry; carry = ta * carry + th; } }
        return;
    }
    for (int u = F.vcu; u < 256; u += F.G) {
        const int cidx = u >> 4, seg = u & 15, chain = cidx & 7;
        mx::UnitP U; U.PROJ = PROJ; U.YM = YM; U.BL = (const float*)(F.ws + WS_BLOW); U.b = chain >> 2; U.h = chain & 3; U.seg = seg; U.p2 = nullptr;
        float* Sg = SG + (size_t)(cidx * 16 + seg) * 16384; float* Bg = BG + (cidx * 16 + seg) * 128;
        if (layer == 0) {
            if (cidx < 8) { U.nw = F.in[6]; U.p0 = F.in[5]; U.p1 = nullptr; mx::mix_unit<0, SUB == 2>(F.lds, Sg, Bg, U); }
            else { U.nw = F.in[9]; U.p0 = F.in[7]; U.p1 = F.in[8]; mx::mix_unit<1, SUB == 2>(F.lds, Sg, Bg, U); }
        } else {
            if (cidx < 8) { U.nw = F.in[12]; U.p0 = nullptr; U.p1 = nullptr; mx::mix_unit<2, SUB == 2>(F.lds, Sg, Bg, U); }
            else { const int x = u - 128, bb = x >> 6, sg = (x >> 2) & 15, cg = x & 3; rg::unit<SUB == 2>(F.lds, PROJ, YM, F.in, bb, sg, cg, RA + (bb * 16 + sg) * 512, RH + (bb * 16 + sg) * 512); }
        }
    }
}

__device__ __forceinline__ void moe_poff(Frame& F, int layer) {
    PHASE_IDS(F);
    LAS int* poff = (LAS int*)(F.lds + LDS_MISC + 1024);
    const unsigned* cnt = F.ctl + CW_CNT + 64 * layer;
    __syncthreads();
    if (F.tid == 0) { int acc = 0; for (int e = 0; e < 32; ++e) { const int n = (int)cnt[e]; poff[e] = acc; poff[33 + e] = n; acc += (n + 255) & ~255; } poff[32] = acc; }
    __syncthreads();
}
struct Args { const float* in[28]; float* out; unsigned char* ws; int ph_lo, ph_hi, li, pad; };
__global__ void __launch_bounds__(NWAVES * 64, 2) mega(Args args) {
    extern __shared__ __attribute__((aligned(16))) unsigned char lds[];
    Frame F;
    F.lds = (LAS unsigned char*)lds; F.tid = threadIdx.x; F.lane = F.tid & 63; F.wave = __builtin_amdgcn_readfirstlane(F.tid >> 6);
    F.G = gridDim.x; { const int bx = blockIdx.x; F.vcu = (F.G % 8 == 0) ? (bx % 8) * (F.G / 8) + bx / 8 : bx; }
    F.in = args.in; F.out = args.out; F.ws = args.ws; F.ctl = (unsigned*)(args.ws + WS_CTL);
    const int lo = args.ph_lo, hi = args.ph_hi;
    for (int u = F.tid; u < (LDS_BYTES - LDS_MISC) / 4; u += NWAVES * 64) ((LAS unsigned*)(F.lds + LDS_MISC))[u] = 0u;
    __syncthreads();
    XcdBarrier bar; bar.bar = F.ctl + CW_BAR + args.li * XCD_BAR_WORDS; bar.x = 0; bar.st = nullptr;
    if (hi - lo > 1) bar = xcd_barrier_post(F.ctl + CW_BAR + args.li * XCD_BAR_WORDS, (volatile LAS unsigned*)(F.lds + LDS_MISC + 32));
#ifndef ONLY_MASK
#define ONLY_MASK 0x7ffff
#endif
#define IN(k) (((ONLY_MASK >> (k)) & 1) && lo <= (k) && (k) < hi)
#define SEAM(k) do { if (IN(k) && IN((k) + 1)) xcd_barrier(bar); } while (0)
    bf16* ACT = (bf16*)(F.ws + WS_ACT); bf16* PROJ = (bf16*)(F.ws + WS_PROJ); bf16* H = (bf16*)(F.ws + WS_H); bf16* Y = (bf16*)(F.ws + WS_Y);
    const LAS int* poff = (const LAS int*)(F.lds + LDS_MISC + 1024);
    bf16* XR1 = (bf16*)F.out; bf16* XR2 = XR1 + (size_t)NT * D; bf16* XR3 = (bf16*)(F.ws + WS_W13);
    if (IN(0)) phase_prologue(F);
    SEAM(0);
#pragma unroll
    for (int l = 0; l < 2; ++l) {
        const int pb = 9 * l;
        if (IN(pb + 1)) {
            const int N = l == 0 ? EV_N : OD_N;
            pg8::DenseOrder S; S.init(ACT, F.ws + (l == 0 ? WS_WIN0 : WS_WIN1), NT, N, 1024, F.G, (int)blockIdx.x);
            pg8::EpiBf E{PROJ, N};
            pg8::gemm_phase<pg8::EpiBf, pg8::DenseOrder, true>(F.lds, 1024, S, E);
        }
        SEAM(pb + 1);
#ifndef FAST_MIX
#define FAST_MIX 7
#endif
        if ((FAST_MIX >> l) & 1) {
            if (IN(pb + 2)) phase_mix<0>(F, l);
            SEAM(pb + 2);
            if (IN(pb + 3)) phase_mix<1>(F, l);
            SEAM(pb + 3);
            if (IN(pb + 4)) phase_mix<2>(F, l);
            SEAM(pb + 4);
        }
        if (IN(pb + 5)) {
            pg8::DenseOrder S; S.init(ACT, F.ws + (l == 0 ? WS_WOUT0 : WS_WOUT1), NT, 1024, 1024, F.G, (int)blockIdx.x);
            if (l == 0) { pg8::EpiRes<false> E{F.in[0], XR1, (float*)(F.ws + WS_SSQ)}; pg8::gemm_phase<pg8::EpiRes<false>, pg8::DenseOrder, true>(F.lds, 1024, S, E); }
            else { pg8::EpiRes<true> E{XR2, XR3, (float*)(F.ws + WS_SSQ)}; pg8::gemm_phase<pg8::EpiRes<true>, pg8::DenseOrder, true>(F.lds, 1024, S, E); }
        }
        SEAM(pb + 5);
        if (IN(pb + 6)) phase_router(F, l, l == 0 ? XR1 : XR3);
        SEAM(pb + 6);
        if (IN(pb + 7)) {
            moe_poff(F, l);
            pg8::MoeOrder S{poff, F.ctl + CW_CNT + 64 * l, (const int*)(F.ws + WS_LIST), (const char*)ACT, (const char*)(F.ws + WS_W13) + (size_t)l * 32 * 1024 * 1024 * 2, (size_t)1024 * 1024 * 2, 1024, F.G, F.vcu, true};
            pg8::EpiUp E{H};
            pg8::gemm_phase<pg8::EpiUp, pg8::MoeOrder, true>(F.lds, 1024, S, E);
        }
        SEAM(pb + 7);
        if (IN(pb + 8)) {
            moe_poff(F, l);
            pg8::MoeOrder S{poff, F.ctl + CW_CNT + 64 * l, (const int*)(F.ws + WS_LIST), (const char*)H, (const char*)(F.ws + WS_W2) + (size_t)l * 32 * 1024 * 512 * 2, (size_t)1024 * 512 * 2, 512, F.G, F.vcu, false};
            pg8::EpiBf E{Y, 1024};
            pg8::gemm_phase<pg8::EpiBf, pg8::MoeOrder, true>(F.lds, 512, S, E);
        }
        SEAM(pb + 8);
        if (IN(pb + 9)) phase_combine(F, l, l == 0 ? XR1 : XR3, XR2);
        SEAM(pb + 9);
    }
#undef IN
#undef SEAM
}

struct NG { const bf16* A; const bf16* Bt; int N, K; bf16* Ob; float* Of; const float* Res; const unsigned* cnt; const int* list; };
template <int MODE> __global__ void __launch_bounds__(256) k_gemm_naive(NG a) {
    __shared__ float As[16][68], Bs[16][68], Cs[16][68]; __shared__ int poff[33];
    const int t = threadIdx.x, tx = t & 15, ty = t >> 4, m0 = blockIdx.y * 64, n0 = blockIdx.x * 64, K = a.K;
    const bf16* Bt = a.Bt; int e = 0;
    if (MODE >= 2) {
        if (t == 0) { int acc = 0; for (int i = 0; i < 32; ++i) { poff[i] = acc; acc += ((int)a.cnt[i] + 255) & ~255; } poff[32] = acc; }
        __syncthreads();
        if (m0 >= poff[32]) return;
        while (m0 >= poff[e + 1]) ++e;
        Bt += (size_t)e * (MODE == 2 ? 1024 * 1024 : 1024 * 512);
    }
    const int lr = t >> 2, kq = (t & 3) * 4;
    int arow = m0 + lr;
    if (MODE == 2) { const int idx = arow - poff[e]; arow = idx < (int)a.cnt[e] ? a.list[(size_t)e * NT + idx] : 0; }
    const bf16* ap = a.A + (size_t)arow * K + kq;
    int br = n0 + lr, br2 = 0;
    if (MODE == 2) { br = 256 * (br >> 7) + (br & 127); br2 = br + 128; }
    const bf16* bp = Bt + (size_t)br * K + kq; const bf16* bp2 = Bt + (size_t)br2 * K + kq;
    float acc[4][4], acc2[4][4];
#pragma unroll
    for (int i = 0; i < 4; ++i)
#pragma unroll
        for (int j = 0; j < 4; ++j) { acc[i][j] = 0.f; acc2[i][j] = 0.f; }
    for (int k0 = 0; k0 < K; k0 += 16) {
        { const v2u w = *(const v2u*)(ap + k0); As[kq][lr] = bf2f((bf16)(w.x & 0xffff)); As[kq + 1][lr] = bf2f((bf16)(w.x >> 16)); As[kq + 2][lr] = bf2f((bf16)(w.y & 0xffff)); As[kq + 3][lr] = bf2f((bf16)(w.y >> 16)); }
        { const v2u w = *(const v2u*)(bp + k0); Bs[kq][lr] = bf2f((bf16)(w.x & 0xffff)); Bs[kq + 1][lr] = bf2f((bf16)(w.x >> 16)); Bs[kq + 2][lr] = bf2f((bf16)(w.y & 0xffff)); Bs[kq + 3][lr] = bf2f((bf16)(w.y >> 16)); }
        if (MODE == 2) { const v2u w = *(const v2u*)(bp2 + k0); Cs[kq][lr] = bf2f((bf16)(w.x & 0xffff)); Cs[kq + 1][lr] = bf2f((bf16)(w.x >> 16)); Cs[kq + 2][lr] = bf2f((bf16)(w.y & 0xffff)); Cs[kq + 3][lr] = bf2f((bf16)(w.y >> 16)); }
        __syncthreads();
#pragma unroll
        for (int k = 0; k < 16; ++k) {
            float av[4], bv[4], cv[4];
#pragma unroll
            for (int i = 0; i < 4; ++i) { av[i] = As[k][ty * 4 + i]; bv[i] = Bs[k][tx * 4 + i]; cv[i] = MODE == 2 ? Cs[k][tx * 4 + i] : 0.f; }
#pragma unroll
            for (int i = 0; i < 4; ++i)
#pragma unroll
                for (int j = 0; j < 4; ++j) { acc[i][j] += av[i] * bv[j]; if (MODE == 2) acc2[i][j] += av[i] * cv[j]; }
        }
        __syncthreads();
    }
#pragma unroll
    for (int i = 0; i < 4; ++i)
#pragma unroll
        for (int j = 0; j < 4; ++j) {
            const int m = m0 + ty * 4 + i, n = n0 + tx * 4 + j;
            if (MODE == 0) a.Ob[(size_t)m * a.N + n] = (bf16)f2bf(acc[i][j]);
            if (MODE == 1) a.Of[(size_t)m * a.N + n] = a.Res[(size_t)m * a.N + n] + acc[i][j];
            if (MODE == 2) a.Ob[(size_t)m * 512 + n] = (bf16)f2bf(siluf_(acc[i][j]) * acc2[i][j]);
            if (MODE == 3) a.Ob[(size_t)m * 1024 + n] = (bf16)f2bf(acc[i][j]);
        }
}

__global__ void __launch_bounds__(128) k_mix_even_naive(const bf16* PROJ, const float* blow, const float* lbl, const float* hnw, const float* wup, const float* bup, const float* gnw, bf16* Y) {
    const int bid = blockIdx.x, j = threadIdx.x, lane = j & 63, wv = j >> 6;
    __shared__ float sq[2][128], sk[2][128], sg[2][128], red[2][2];
    if (bid < 8) {
        const int b = bid >> 2, h = bid & 3, c = h * 128 + j;
        float lb; { const float l0 = lbl[c], l1 = lbl[512 + c], l2 = lbl[1024 + c]; const float mx = fmaxf(l0, fmaxf(l1, l2)); const float e0 = expf(l0 - mx), e1 = expf(l1 - mx), e2 = expf(l2 - mx); lb = e0 / (e0 + e1 + e2); }
        float s[128];
#pragma unroll
        for (int d = 0; d < 128; ++d) s[d] = 0.f;
        const float nw = hnw[c];
        for (int t = 0; t < SEQ; ++t) {
            const bf16* P = PROJ + (size_t)(b * SEQ + t) * EV_N; const int pb = t & 1;
            const float f = lb + (1.f - lb) * sigmoidf_(bf2f(P[512 + c]));
            sq[pb][j] = bf2f(P[c]); sk[pb][j] = 1.f - f; sg[pb][j] = f;
            const float v = bf2f(P[1024 + c]);
            __syncthreads();
            float o = 0.f;
#pragma unroll
            for (int d = 0; d < 128; ++d) { s[d] = sg[pb][d] * s[d] + sk[pb][d] * v; o += sq[pb][d] * s[d]; }
            const float ss = wave_sum(o * o); if (lane == 0) red[pb][wv] = ss;
            __syncthreads();
            const float rstd = rsqrtf((red[pb][0] + red[pb][1]) * (1.f / 128.f) + EPS);
            Y[(size_t)(b * SEQ + t) * 1024 + c] = (bf16)f2bf(o * rstd * nw * siluf_(bf2f(P[1536 + c])));
        }
    } else {
        const int b = (bid - 8) >> 2, h = bid & 3, c = h * 128 + j, dcol = h * 64 + (j & 63);
        float wu[16];
#pragma unroll
        for (int r = 0; r < 16; ++r) wu[r] = wup[r * 256 + dcol];
        const float bu = bup[dcol];
        float s[64];
#pragma unroll
        for (int d = 0; d < 64; ++d) s[d] = 0.f;
        const float nw = gnw[c];
        for (int t = 0; t < SEQ; ++t) {
            const size_t row = (size_t)b * SEQ + t;
            const bf16* P = PROJ + row * EV_N; const int pb = t & 1;
            if (j < 64) {
                float z = bu;
#pragma unroll
                for (int r = 0; r < 16; ++r) z += blow[row * 16 + r] * wu[r];
                const float ls = fminf(z, 0.f) - log1pf(expf(-fabsf(z)));
                sg[pb][j] = expf(ls * (1.f / 16.f)); sq[pb][j] = bf2f(P[2048 + dcol]) * 0.125f; sk[pb][j] = bf2f(P[2304 + dcol]);
            }
            const float v = bf2f(P[2560 + c]);
            __syncthreads();
            float o = 0.f;
#pragma unroll
            for (int d = 0; d < 64; ++d) { s[d] = sg[pb][d] * s[d] + sk[pb][d] * v; o += sq[pb][d] * s[d]; }
            const float ss = wave_sum(o * o); if (lane == 0) red[pb][wv] = ss;
            __syncthreads();
            const float rstd = rsqrtf((red[pb][0] + red[pb][1]) * (1.f / 128.f) + EPS);
            Y[row * 1024 + 512 + c] = (bf16)f2bf(o * rstd * nw * siluf_(bf2f(P[3072 + c])));
        }
    }
}

__global__ void __launch_bounds__(128) k_ret_naive(const bf16* PROJ, const float* rnw, bf16* Y) {
    const int bid = blockIdx.x, j = threadIdx.x, lane = j & 63, wv = j >> 6, b = bid >> 2, h = bid & 3, c = h * 128 + j;
    __shared__ float sq[2][64], sk[2][64], red[2][2], red2[2][2];
    const int d = j & 63, i = d & 31;
    const float ci = exp2f(-(float)i * (13.287712379549449f / 32.f)) * 0.15915494309189535f;
    const float gamma = 1.f - exp2f(-5.f - (float)h);
    float s[64];
#pragma unroll
    for (int dd = 0; dd < 64; ++dd) s[dd] = 0.f;
    const float nw = rnw[c];
    for (int t = 0; t < SEQ; ++t) {
        const size_t row = (size_t)b * SEQ + t; const bf16* P = PROJ + row * OD_N; const int pb = t & 1;
        if (j < 64) {
            float rev = (float)t * ci; rev -= floorf(rev);
            const float sn = __builtin_amdgcn_sinf(rev), cs = __builtin_amdgcn_cosf(rev);
            const float q1 = bf2f(P[h * 64 + i]), q2 = bf2f(P[h * 64 + 32 + i]), k1 = bf2f(P[256 + h * 64 + i]), k2 = bf2f(P[256 + h * 64 + 32 + i]);
            sq[pb][d] = d < 32 ? q1 * cs - q2 * sn : q1 * sn + q2 * cs;
            sk[pb][d] = (d < 32 ? k1 * cs - k2 * sn : k1 * sn + k2 * cs) * 0.125f;
        }
        const float v = bf2f(P[512 + c]);
        __syncthreads();
        float o = 0.f;
#pragma unroll
        for (int dd = 0; dd < 64; ++dd) { s[dd] = gamma * s[dd] + sk[pb][dd] * v; o += sq[pb][dd] * s[dd]; }
        const float sm = wave_sum(o); if (lane == 0) red[pb][wv] = sm;
        __syncthreads();
        const float oc = o - (red[pb][0] + red[pb][1]) * (1.f / 128.f);
        const float ss = wave_sum(oc * oc); if (lane == 0) red2[pb][wv] = ss;
        __syncthreads();
        const float rstd = rsqrtf((red2[pb][0] + red2[pb][1]) * (1.f / 128.f) + EPS);
        Y[row * 1024 + c] = (bf16)f2bf(oc * rstd * nw * siluf_(bf2f(P[1024 + c])));
    }
}

__global__ void __launch_bounds__(64) k_rglru_naive(const bf16* PROJ, const float* cw, const float* cb, const float* wr, const float* br, const float* wi, const float* bi, const float* lam, bf16* Y) {
    const int b = blockIdx.x >> 3, n = blockIdx.x & 7, e = threadIdx.x, c = n * 64 + e;
    float wrr[64], wii[64];
#pragma unroll
    for (int d = 0; d < 64; ++d) { wrr[d] = wr[(n * 64 + d) * 64 + e]; wii[d] = wi[(n * 64 + d) * 64 + e]; }
    const float c0 = cw[c], c1 = cw[512 + c], c2 = cw[1024 + c], c3 = cw[1536 + c], cbb = cb[c], brr = br[c], bii = bi[c];
    const float sp = log1pf(expf(-lam[c]));
    float x1 = 0.f, x2 = 0.f, x3 = 0.f, hh = 0.f;
    for (int t = 0; t < SEQ; ++t) {
        const size_t row = (size_t)b * SEQ + t; const bf16* P = PROJ + row * OD_N;
        const float dx = bf2f(P[1536 + c]);
        const float xc = cbb + c0 * x3 + c1 * x2 + c2 * x1 + c3 * dx;
        x3 = x2; x2 = x1; x1 = dx;
        float rp = brr, ip = bii;
#pragma unroll
        for (int d = 0; d < 64; ++d) { const float xd = __shfl(xc, d); rp += xd * wrr[d]; ip += xd * wii[d]; }
        const float r = sigmoidf_(rp), ig = sigmoidf_(ip), la = -8.f * r * sp, aa = expf(la);
        const float u = sqrtf(fmaxf(0.f, -expm1f(2.f * la))) * (ig * xc);
        hh = aa * hh + u;
        Y[row * 1024 + 512 + c] = (bf16)f2bf(hh * gelu_tanh_(bf2f(P[2048 + c])));
    }
}

extern "C" void kernel_launch(void* const* d_in, const int* in_sizes, int n_in, void* d_out, int out_size, void* d_ws, size_t ws_size, hipStream_t stream) {
    static int grid = 0;
    if (grid == 0) {
        if (n_in != 28 || out_size != NT * D || ws_size < WS_END) { fprintf(stderr, "kernel_launch: unexpected problem (n_in %d, out %d, ws %zu)\n", n_in, out_size, ws_size); grid = -1; return; }
        int dev = 0, cus = 0;
        if (hipGetDevice(&dev) != hipSuccess || hipDeviceGetAttribute(&cus, hipDeviceAttributeMultiprocessorCount, dev) != hipSuccess) { grid = -1; return; }
        if (hipFuncSetAttribute((const void*)mega, hipFuncAttributeMaxDynamicSharedMemorySize, LDS_BYTES) != hipSuccess) { fprintf(stderr, "kernel_launch: hipFuncSetAttribute failed\n"); grid = -1; return; }
        (void)hipGetLastError();
        grid = cus;
    }
    if (grid < 0) return;
    (void)hipMemsetAsync((char*)d_ws + WS_CTL, 0, CTL_BYTES, stream);
    Args a{};
    for (int i = 0; i < 28; ++i) a.in[i] = (const float*)d_in[i];
    a.out = (float*)d_out; a.ws = (unsigned char*)d_ws;
    unsigned char* ws = (unsigned char*)d_ws;
    const float* const* in = (const float* const*)a.in;
    int nli = 0;
    auto run = [&](int lo, int hi) { a.ph_lo = lo; a.ph_hi = hi; a.li = (hi - lo > 1) ? nli++ : 0; hipLaunchKernelGGL(mega, dim3(grid), dim3(NWAVES * 64), LDS_BYTES, stream, a); };
    bf16* ACT = (bf16*)(ws + WS_ACT); bf16* PROJ = (bf16*)(ws + WS_PROJ);
#ifndef FAST_MIX
#define FAST_MIX 7
#endif
    auto naive_even = [&]() { hipLaunchKernelGGL(k_mix_even_naive, dim3(16), dim3(128), 0, stream, PROJ, (const float*)(ws + WS_BLOW), in[5], in[6], in[7], in[8], in[9], ACT); };
    auto naive_ret = [&]() { hipLaunchKernelGGL(k_ret_naive, dim3(8), dim3(128), 0, stream, PROJ, in[12], ACT); };
    auto naive_lru = [&]() { hipLaunchKernelGGL(k_rglru_naive, dim3(16), dim3(64), 0, stream, PROJ, in[13], in[14], in[15], in[16], in[17], in[18], in[19], ACT); };
    if (FAST_MIX == 7) { run(0, 19); }
    else if (FAST_MIX == 1) { run(0, 11); naive_ret(); naive_lru(); run(14, 19); }
    else if (FAST_MIX == 3) { run(0, 14); naive_lru(); run(14, 19); }
    else { run(0, 2); naive_even(); run(5, 11); naive_ret(); naive_lru(); run(14, 19); }
}
```

```cpp
#include <hip/hip_runtime.h>
#include <cstdio>
#include <cstdint>

#define GAS __attribute__((address_space(1)))
#define LAS __attribute__((address_space(3)))
typedef unsigned short bf16;
typedef unsigned v4u __attribute__((ext_vector_type(4)));
typedef unsigned v2u __attribute__((ext_vector_type(2)));
typedef float f32x4 __attribute__((ext_vector_type(4)));
typedef float f32x2 __attribute__((ext_vector_type(2)));
typedef short bf16x8 __attribute__((ext_vector_type(8)));

constexpr int NT = 32768, D = 1024, SEQ = 16384;
constexpr int EV_N = 3584, OD_N = 2560, EV_LD = 3600;
constexpr float EPS = 1e-6f;
constexpr int NEXP = 32, SLOT_ROWS = 2 * NT + NEXP * 256;

constexpr size_t MiB = 1u << 20;
constexpr size_t WS_CTL = 0, CTL_BYTES = 1 * MiB;
constexpr size_t WS_WIN0 = 2 * MiB, WS_WOUT0 = 9 * MiB, WS_WIN1 = 11 * MiB, WS_WOUT1 = 16 * MiB, WS_W13 = 18 * MiB, WS_W2 = 146 * MiB;
constexpr size_t WS_ACT = 210 * MiB, WS_PROJ = 274 * MiB, WS_H = WS_PROJ, WS_Y = WS_PROJ + 72 * MiB;
constexpr size_t WS_BLOW = 498 * MiB, WS_META = 500 * MiB, WS_LIST = 501 * MiB, WS_ST = 505 * MiB, WS_SSQ = 522 * MiB, WS_END = 524 * MiB;
constexpr int CW_TMO = 0, CW_BAR = 4096, CW_CNT = 16384;

constexpr int NWAVES = 8;
constexpr int LDS_BYTES = 163840;
constexpr int LDS_MISC = 149504;

__device__ __forceinline__ float bf2f(bf16 b) { return __builtin_bit_cast(float, (unsigned)b << 16); }
__device__ __forceinline__ unsigned pk2(float lo, float hi) { unsigned r; asm("v_cvt_pk_bf16_f32 %0, %1, %2" : "=v"(r) : "v"(lo), "v"(hi)); return r; }
__device__ __forceinline__ unsigned f2bf(float f) { return pk2(f, f) & 0xffffu; }
__device__ __forceinline__ float sigmoidf_(float x) { return __builtin_amdgcn_rcpf(1.f + __expf(-x)); }
__device__ __forceinline__ float siluf_(float x) { return x * sigmoidf_(x); }
__device__ __forceinline__ float gelu_tanh_(float x) { const float u = 0.7978845608f * (x + 0.044715f * x * x * x); return x * sigmoidf_(2.f * u); }
__device__ __forceinline__ float wave_sum(float v) {
#pragma unroll
    for (int o = 1; o < 64; o <<= 1) v += __shfl_xor(v, o);
    return v;
}
#define LDS_WAIT() asm volatile("s_waitcnt lgkmcnt(0)" ::: "memory")

struct Frame {
    LAS unsigned char* lds;
    int tid, lane, wave, vcu, G;
    const float* const* in;
    float* out; unsigned char* ws;
    unsigned* ctl;
};


#define XB_TMO      128
#define XB_XCNT(j)  (256  + 64 * (j))
#define XB_XSUB(j)  (1280 + 64 * (j))
#define XB_XGEN(j)  (2304 + 64 * (j))
#define XB_TOP      3328
#define XB_TOPGEN   3392
#define XCD_BAR_WORDS 3456
#define XB_SPIN_CAP (1u << 18)
__device__ __forceinline__ unsigned xb_ld(unsigned* p)              { return __hip_atomic_load(p, __ATOMIC_RELAXED, __HIP_MEMORY_SCOPE_AGENT); }
__device__ __forceinline__ unsigned xb_add(unsigned* p, unsigned v) { return __hip_atomic_fetch_add(p, v, __ATOMIC_RELAXED, __HIP_MEMORY_SCOPE_AGENT); }
__device__ __forceinline__ unsigned xb_xcc_id() { return (unsigned)__builtin_amdgcn_s_getreg((3 << 11) | 20) & 0xFu; }
#define XB_SPIN(cond, bar) do { unsigned _sp = 0; while (cond) { __builtin_amdgcn_s_sleep(1); \
    if ((++_sp & 255u) == 0u) { if (xb_ld(&(bar)[XB_TMO])) break; if (_sp > XB_SPIN_CAP) { atomicAdd(&(bar)[XB_TMO], 1u); break; } } } } while (0)
struct XcdBarrier { unsigned* bar; unsigned x; volatile LAS unsigned* st; };
__device__ __forceinline__ XcdBarrier xcd_barrier_post(unsigned* bar, volatile LAS unsigned* st) {
    XcdBarrier b; b.bar = bar; b.x = xb_xcc_id(); b.st = st;
    if (threadIdx.x == 0) (void)xb_add(&bar[XB_XCNT(b.x)], 1u);
    return b;
}
__device__ __forceinline__ void xcd_barrier_complete(unsigned* bar, unsigned x, unsigned& nloc, unsigned& nx) {
    const unsigned G = gridDim.x * gridDim.y * gridDim.z;
    unsigned sum, cnt, mine, sp = 0u;
    for (;;) {
        sum = 0u; cnt = 0u; mine = 0u;
#pragma unroll
        for (unsigned j = 0; j < 16; ++j) { const unsigned c = xb_ld(&bar[XB_XCNT(j)]); sum += c; cnt += (c > 0u) ? 1u : 0u; mine = (j == x) ? c : mine; }
        if (sum == G) break;
        __builtin_amdgcn_s_sleep(1);
        if ((++sp & 255u) == 0u) { if (xb_ld(&bar[XB_TMO])) break; if (sp > XB_SPIN_CAP) { atomicAdd(&bar[XB_TMO], 1u); break; } }
    }
    nloc = mine > 0u ? mine : 1u; nx = cnt > 0u ? cnt : 1u;
}
__device__ __forceinline__ void xcd_barrier(const XcdBarrier& b) {
    asm volatile("s_waitcnt vmcnt(0)" ::: "memory");
    __syncthreads();
    if (threadIdx.x == 0) {
        unsigned* bar = b.bar;
        __builtin_amdgcn_s_waitcnt(0);
        unsigned nloc = b.st[0], nx = b.st[1];
        if (nloc == 0u) { xcd_barrier_complete(bar, b.x, nloc, nx); b.st[0] = nloc; b.st[1] = nx; }
        const unsigned old = xb_add(&bar[XB_XSUB(b.x)], 1u);
        const unsigned gen = old / nloc;
        if (old + 1u == (gen + 1u) * nloc) {
            __builtin_amdgcn_fence(__ATOMIC_RELEASE, "agent");
            asm volatile("s_waitcnt vmcnt(0)" ::: "memory");
            const unsigned og = xb_add(&bar[XB_TOP], 1u);
            const unsigned tg = og / nx;
            if (og + 1u == (tg + 1u) * nx) xb_add(&bar[XB_TOPGEN], 1u);
            else XB_SPIN(xb_ld(&bar[XB_TOPGEN]) == tg, bar);
            __builtin_amdgcn_fence(__ATOMIC_ACQUIRE, "agent");
            xb_add(&bar[XB_XGEN(b.x)], 1u);
            asm volatile("s_waitcnt vmcnt(0)" ::: "memory");
        } else {
            XB_SPIN(xb_ld(&bar[XB_XGEN(b.x)]) == gen, bar);
            __builtin_amdgcn_fence(__ATOMIC_ACQUIRE, "agent");
            asm volatile("s_waitcnt vmcnt(0)" ::: "memory");
        }
    }
    __syncthreads();
}

namespace pg8 {
typedef unsigned u32x4 __attribute__((ext_vector_type(4)));
typedef int i32x4 __attribute__((ext_vector_type(4)));
typedef int i32x8 __attribute__((ext_vector_type(8)));
constexpr int BM = 256, BK = 64, HALF = 128, HTB = HALF * BK * 2, STAGE_BYTES = 8 * HTB, NXCD = 8, WGM = 8;
__host__ __device__ __forceinline__ int lds_byte(int r, int c) { const int st = (r >> 4) * 2 + (c >> 5), rr = r & 15, cc = c & 31, ob = rr * 64 + cc * 2; return st * 1024 + (ob ^ (((ob >> 9) & 1) << 5)); }
__host__ __device__ __forceinline__ void stage_rc(int b, int& R, int& C) { const int st = b / 1024, sb = b % 1024, swz = sb ^ (((sb >> 9) & 1) << 5); R = (st >> 1) * 16 + swz / 64; C = (st & 1) * 32 + (swz % 64) / 2; }
__host__ __device__ __forceinline__ int perm32(int rho) { const int n = rho >> 4, i = rho & 15; return 8 * (i >> 2) + 4 * n + (i & 3); }
struct Unit { int pm, pn, e; };
__device__ __forceinline__ unsigned cvt_pk_bf16(float lo, float hi) { return pk2(lo, hi); }

struct DenseOrder {
    int nM, nN, nwg, G, c, K; const char* A; const char* Bt;
    __device__ __forceinline__ void init(const void* A_, const void* Bt_, int M, int N, int K_, int G_, int c_) { A = (const char*)A_; Bt = (const char*)Bt_; nM = M / BM; nN = N / BM; nwg = nM * nN; G = G_; c = c_; K = K_; }
    __device__ __forceinline__ bool next(int i, Unit& u) const {
        const long L = (long)i * G + c; if (L >= nwg) return false;
        int wgid = (int)L; { const int q = nwg / NXCD, r = nwg % NXCD, xcd = wgid % NXCD, off = wgid / NXCD; wgid = (xcd < r ? xcd * (q + 1) : r * (q + 1) + (xcd - r) * q) + off; }
        const int nig = WGM * nN, gid = wgid / nig, fm = gid * WGM, gsz = (nM - fm) < WGM ? (nM - fm) : WGM;
        u.pm = fm + ((wgid % nig) % gsz); u.pn = (wgid % nig) / gsz; u.e = 0; return true;
    }
    __device__ __forceinline__ unsigned a_off(const Unit& u, int r) const { return (unsigned)((u.pm * BM + r) * K) * 2u; }
    __device__ __forceinline__ const char* b_ptr(const Unit& u) const { return Bt + (size_t)u.pn * BM * K * 2; }
};
struct MoeOrder {
    const LAS int* poff; const unsigned* cnt; const int* list; const char* A; const char* Bt; size_t estride; int K, G, c; bool gather;
    __device__ __forceinline__ bool next(int i, Unit& u) const {
        const int L = i * G + c, np = __builtin_amdgcn_readfirstlane(poff[32]) >> 8; if (L >= np * 4) return false;
        u.pm = L >> 2; u.pn = L & 3; const int row = u.pm << 8; int e = 0;
        while (row >= __builtin_amdgcn_readfirstlane(poff[e + 1])) ++e;
        u.e = e; return true;
    }
    __device__ __forceinline__ unsigned a_off(const Unit& u, int r) const {
        if (!gather) return (unsigned)((u.pm * BM + r) * K) * 2u;
        const int idx = min(u.pm * BM + r - poff[u.e], poff[33 + u.e] - 1);
        return (unsigned)list[(size_t)u.e * NT + idx] * (unsigned)(K * 2);
    }
    __device__ __forceinline__ const char* b_ptr(const Unit& u) const { return Bt + (size_t)u.e * estride + (size_t)u.pn * BM * K * 2; }
};

struct EpiBf {
    static constexpr bool PERM = true;
    bf16* O; int ldc; float scale;
    __device__ __forceinline__ void operator()(const f32x4 (&acc)[2][2][4][2], const Unit& u, int wr, int wc, int fr, int fq) const {
        const int row0 = u.pm * BM + wr * 64 + fr, col0 = u.pn * BM + wc * 32 + 8 * fq;
#pragma unroll
        for (int ai = 0; ai < 2; ++ai)
#pragma unroll
            for (int m = 0; m < 4; ++m) { bf16* rowp = O + (size_t)(row0 + ai * HALF + m * 16) * ldc + col0;
#pragma unroll
                for (int bj = 0; bj < 2; ++bj) { const f32x4 v0 = acc[ai][bj][m][0] * scale, v1 = acc[ai][bj][m][1] * scale;
                    u32x4 w; w.x = cvt_pk_bf16(v0[0], v0[1]); w.y = cvt_pk_bf16(v0[2], v0[3]); w.z = cvt_pk_bf16(v1[0], v1[1]); w.w = cvt_pk_bf16(v1[2], v1[3]);
                    *(u32x4*)(rowp + bj * HALF) = w; } }
    }
};
template <bool RES_BF16>
struct EpiRes {
    static constexpr bool PERM = true;
    const void* res; bf16* xout; float* ssq;
    __device__ __forceinline__ void operator()(const f32x4 (&acc)[2][2][4][2], const Unit& u, int wr, int wc, int fr, int fq) const {
        const int row0 = u.pm * BM + wr * 64 + fr, col0 = u.pn * BM + wc * 32 + 8 * fq;
#pragma unroll
        for (int ai = 0; ai < 2; ++ai)
#pragma unroll
            for (int m = 0; m < 4; ++m) { const int row = row0 + ai * HALF + m * 16; const size_t off = (size_t)row * 1024 + col0; float ss = 0.f;
#pragma unroll
                for (int bj = 0; bj < 2; ++bj) {
                    f32x4 r0, r1;
                    if (RES_BF16) { const u32x4 rw = *(const u32x4*)((const bf16*)res + off + bj * HALF);
                        r0 = (f32x4){__builtin_bit_cast(float, rw.x << 16), __builtin_bit_cast(float, rw.x & 0xffff0000u), __builtin_bit_cast(float, rw.y << 16), __builtin_bit_cast(float, rw.y & 0xffff0000u)};
                        r1 = (f32x4){__builtin_bit_cast(float, rw.z << 16), __builtin_bit_cast(float, rw.z & 0xffff0000u), __builtin_bit_cast(float, rw.w << 16), __builtin_bit_cast(float, rw.w & 0xffff0000u)}; }
                    else { r0 = *(const f32x4*)((const float*)res + off + bj * HALF); r1 = *(const f32x4*)((const float*)res + off + bj * HALF + 4); }
                    const f32x4 v0 = r0 + acc[ai][bj][m][0], v1 = r1 + acc[ai][bj][m][1];
                    ss += ((v0[0] * v0[0] + v0[1] * v0[1]) + (v0[2] * v0[2] + v0[3] * v0[3])) + ((v1[0] * v1[0] + v1[1] * v1[1]) + (v1[2] * v1[2] + v1[3] * v1[3]));
                    u32x4 w; w.x = cvt_pk_bf16(v0[0], v0[1]); w.y = cvt_pk_bf16(v0[2], v0[3]); w.z = cvt_pk_bf16(v1[0], v1[1]); w.w = cvt_pk_bf16(v1[2], v1[3]);
                    *(u32x4*)(xout + off + bj * HALF) = w; }
                ss += __shfl_xor(ss, 16); ss += __shfl_xor(ss, 32);
                if (fq == 0) ssq[(size_t)row * 16 + u.pn * 4 + wc] = ss;
                asm volatile("" ::: "memory"); }
    }
};
__device__ __forceinline__ unsigned pk4_fp8(float a, float b, float c, float d) { int p = __builtin_amdgcn_cvt_pk_fp8_f32(a, b, 0, false); return (unsigned)__builtin_amdgcn_cvt_pk_fp8_f32(c, d, p, true); }
struct EpiUp {
    static constexpr bool PERM = true;
    unsigned char* H;
    __device__ __forceinline__ void operator()(const f32x4 (&acc)[2][2][4][2], const Unit& u, int wr, int wc, int fr, int fq) const {
        const int row0 = u.pm * BM + wr * 64 + fr, col0 = u.pn * HALF + wc * 32 + 8 * fq;
#pragma unroll
        for (int ai = 0; ai < 2; ++ai)
#pragma unroll
            for (int m = 0; m < 4; ++m) { unsigned char* rowp = H + (size_t)(row0 + ai * HALF + m * 16) * 512 + col0;
                float h[8];
#pragma unroll
                for (int n = 0; n < 2; ++n)
#pragma unroll
                    for (int i = 0; i < 4; ++i) { const float a = acc[ai][0][m][n][i] * (1.f / 32.f), b = acc[ai][1][m][n][i] * (1.f / 32.f); h[n * 4 + i] = a * __builtin_amdgcn_rcpf(1.f + __expf(-a)) * b; }
                v2u w; w.x = pk4_fp8(h[0], h[1], h[2], h[3]); w.y = pk4_fp8(h[4], h[5], h[6], h[7]);
                *(v2u*)rowp = w; }
    }
};

template <class Epi, class Sched, bool ALIGN_EPI, bool FP8 = false>
__device__ __forceinline__ void gemm_phase(LAS unsigned char* lds, const int K_, const Sched& S, const Epi& E) {
    int K = K_; asm volatile("" : "+s"(K));
    int tid = threadIdx.x; asm volatile("" : "+v"(tid));
    const int wid = __builtin_amdgcn_readfirstlane(tid >> 6), lane = tid & 63, wr = wid >> 2, wc = wid & 3, fr = lane & 15, fq = lane >> 4;
    const int nt = K / BK;
    unsigned voffB[2];
#pragma unroll
    for (int i = 0; i < 2; ++i) { int R, C; stage_rc(tid * 16 + i * 8192, R, C); const int Rb = Epi::PERM ? ((R & ~31) + perm32(R & 31)) : R; voffB[i] = (unsigned)(Rb * K + C) * 2u; }
#define PG8_AOFF(u, o0, o1, o2, o3) do { int R0_, C0_, R1_, C1_; stage_rc(tid * 16, R0_, C0_); stage_rc(tid * 16 + 8192, R1_, C1_); \
        o0 = S.a_off(u, R0_) + (unsigned)C0_ * 2u; o1 = S.a_off(u, R1_) + (unsigned)C1_ * 2u; o2 = S.a_off(u, HALF + R0_) + (unsigned)C0_ * 2u; o3 = S.a_off(u, HALF + R1_) + (unsigned)C1_ * 2u; } while (0)
    const size_t kstep = (size_t)(BK * 2);
    const size_t hstep = (size_t)HALF * K * 2;
    const unsigned ldsw = (unsigned)wid * 1024u;
    const int aoff = lds_byte(wr * 64 + fr, fq * 8), boff = lds_byte(wc * 32 + fr, fq * 8);
    const char* const A0 = S.A;
#define PG8_SA(b, h) (((b) * 2 + (h)) * HTB)
#define PG8_SB(b, h) ((4 + (b) * 2 + (h)) * HTB)
#define PG8_STAGE(bufoff, gbase, voff) do { _Pragma("unroll") for (int _i = 0; _i < 2; ++_i) \
        __builtin_amdgcn_global_load_lds((const unsigned*)((const char*)(gbase) + (voff)[_i]), (LAS unsigned*)(lds + (bufoff) + ldsw + _i * 8192), 16, 0, 0); } while (0)
#define PG8_STAGEA(bufoff, kbyte, o0, o1) do { \
        __builtin_amdgcn_global_load_lds((const unsigned*)(A0 + (kbyte) + (o0)), (LAS unsigned*)(lds + (bufoff) + ldsw), 16, 0, 0); \
        __builtin_amdgcn_global_load_lds((const unsigned*)(A0 + (kbyte) + (o1)), (LAS unsigned*)(lds + (bufoff) + ldsw + 8192), 16, 0, 0); } while (0)
#define PG8_LD8(p) __builtin_shufflevector(*(const LAS i32x4*)(p), *(const LAS i32x4*)((p) + 1024), 0, 1, 2, 3, 4, 5, 6, 7)
#define PG8_LDA(dst, b, h) do { _Pragma("unroll") for (int m = 0; m < 4; ++m) dst[m] = PG8_LD8(lds + PG8_SA(b, h) + aoff + m * 2048); } while (0)
#define PG8_LDB(dst, b, h) do { _Pragma("unroll") for (int n = 0; n < 2; ++n) dst[n] = PG8_LD8(lds + PG8_SB(b, h) + boff + n * 2048); } while (0)
#define PG8_H(x, k) __builtin_bit_cast(bf16x8, __builtin_shufflevector(x, x, 4 * (k), 4 * (k) + 1, 4 * (k) + 2, 4 * (k) + 3))
#define PG8_MMA(ai, bj, At, Bt) do { __builtin_amdgcn_s_setprio(1); _Pragma("unroll") for (int m = 0; m < 4; ++m) _Pragma("unroll") for (int n = 0; n < 2; ++n) { \
        if constexpr (FP8) acc[ai][bj][m][n] = __builtin_amdgcn_mfma_scale_f32_16x16x128_f8f6f4(Bt[n], At[m], acc[ai][bj][m][n], 0, 0, 0, 0x7f7f7f7f, 0, 0x7f7f7f7f); \
        else { acc[ai][bj][m][n] = __builtin_amdgcn_mfma_f32_16x16x32_bf16(PG8_H(Bt[n], 0), PG8_H(At[m], 0), acc[ai][bj][m][n], 0, 0, 0); \
               acc[ai][bj][m][n] = __builtin_amdgcn_mfma_f32_16x16x32_bf16(PG8_H(Bt[n], 1), PG8_H(At[m], 1), acc[ai][bj][m][n], 0, 0, 0); } } \
        __builtin_amdgcn_s_setprio(0); } while (0)
#define PG8_WAIT_V(n) asm volatile("s_waitcnt vmcnt(" #n ")" ::: "memory")
#define PG8_WAIT_L(n) asm volatile("s_waitcnt lgkmcnt(" #n ")" ::: "memory")
#define PG8_BAR __builtin_amdgcn_s_barrier()
#define PG8_SCHED __builtin_amdgcn_sched_barrier(0)
    Unit cur, nxt; int ui = 0;
    if (!S.next(0, cur)) return;
    f32x4 acc[2][2][4][2];
#pragma unroll
    for (int a = 0; a < 2; ++a)
#pragma unroll
        for (int b = 0; b < 2; ++b)
#pragma unroll
            for (int m = 0; m < 4; ++m)
#pragma unroll
                for (int n = 0; n < 2; ++n) acc[a][b][m][n] = (f32x4){0.f, 0.f, 0.f, 0.f};
    i32x8 At[4], B0[2], B1[2];
    unsigned oc00, oc01, oc10, oc11, on00, on01, on10, on11;
    PG8_AOFF(cur, oc00, oc01, oc10, oc11);
    const char* cB = S.b_ptr(cur);
    PG8_STAGE(PG8_SB(0, 0), cB, voffB); PG8_STAGE(PG8_SB(0, 1), cB + hstep, voffB); PG8_STAGEA(PG8_SA(0, 0), 0, oc00, oc01); PG8_STAGEA(PG8_SA(0, 1), 0, oc10, oc11);
    if (wr == 1) PG8_BAR;
    PG8_WAIT_V(2); PG8_BAR;
    PG8_STAGE(PG8_SB(1, 0), cB + kstep, voffB); PG8_STAGEA(PG8_SA(1, 0), kstep, oc00, oc01); PG8_STAGE(PG8_SB(1, 1), cB + hstep + kstep, voffB);
    PG8_WAIT_V(6); PG8_BAR;
    for (;;) {
        const bool has_next = S.next(ui + 1, nxt);
        const char* nB = cB;
        on00 = oc00; on01 = oc01; on10 = oc10; on11 = oc11;
        if (has_next) { nB = S.b_ptr(nxt); PG8_AOFF(nxt, on00, on01, on10, on11); }
#pragma unroll 1
        for (int t = 0; t < nt; t += 2) {
            const bool last = (t == nt - 2);
            const size_t k1 = (size_t)(t + 1) * kstep, k2 = last ? 0 : (size_t)(t + 2) * kstep, k3 = k2 + kstep;
            const char* b2 = last ? nB : cB + (size_t)(t + 2) * kstep; const char* b3 = b2 + kstep;
            PG8_LDB(B0, 0, 0); PG8_LDB(B1, 0, 1); PG8_SCHED; PG8_LDA(At, 0, 0); PG8_STAGEA(PG8_SA(1, 1), k1, oc10, oc11);
            if (last) { oc00 = on00; oc01 = on01; oc10 = on10; oc11 = on11; }
            PG8_WAIT_V(8); PG8_WAIT_L(0); PG8_BAR; PG8_MMA(0, 0, At, B0); PG8_MMA(0, 1, At, B1); PG8_BAR; PG8_SCHED;
            PG8_LDA(At, 0, 1); PG8_STAGE(PG8_SB(0, 0), b2, voffB); PG8_STAGE(PG8_SB(0, 1), b2 + hstep, voffB); PG8_STAGEA(PG8_SA(0, 0), k2, oc00, oc01);
            PG8_WAIT_V(8); PG8_WAIT_L(0); PG8_BAR; PG8_MMA(1, 0, At, B0); PG8_MMA(1, 1, At, B1); PG8_BAR; PG8_SCHED;
            PG8_LDB(B0, 1, 0); PG8_LDB(B1, 1, 1); PG8_SCHED; PG8_LDA(At, 1, 0); PG8_STAGEA(PG8_SA(0, 1), k2, oc10, oc11);
            PG8_WAIT_V(8); PG8_WAIT_L(0); PG8_BAR; PG8_MMA(0, 0, At, B0); PG8_MMA(0, 1, At, B1); PG8_BAR; PG8_SCHED;
            PG8_LDA(At, 1, 1); PG8_STAGE(PG8_SB(1, 0), b3, voffB); PG8_STAGE(PG8_SB(1, 1), b3 + hstep, voffB); PG8_STAGEA(PG8_SA(1, 0), k3, oc00, oc01);
            PG8_WAIT_V(8); PG8_WAIT_L(0); PG8_BAR; PG8_MMA(1, 0, At, B0); PG8_MMA(1, 1, At, B1); PG8_BAR; PG8_SCHED;
        }
        if constexpr (ALIGN_EPI) { if (wr == 0) PG8_BAR; }
        E(acc, cur, wr, wc, fr, fq);
        if (!has_next) break;
#pragma unroll
        for (int a = 0; a < 2; ++a)
#pragma unroll
            for (int b = 0; b < 2; ++b)
#pragma unroll
                for (int m = 0; m < 4; ++m)
#pragma unroll
                    for (int n = 0; n < 2; ++n) acc[a][b][m][n] = (f32x4){0.f, 0.f, 0.f, 0.f};
        cur = nxt; cB = nB; ++ui;
        if constexpr (ALIGN_EPI) { if (wr == 1) PG8_BAR; }
    }
    PG8_WAIT_V(0);
    if constexpr (!ALIGN_EPI) { if (wr == 0) PG8_BAR; }
    PG8_BAR;
#undef PG8_SA
#undef PG8_SB
#undef PG8_STAGE
#undef PG8_STAGEA
#undef PG8_AOFF
#undef PG8_LDA
#undef PG8_LDB
#undef PG8_MMA
#undef PG8_LD8
#undef PG8_H
#undef PG8_WAIT_V
#undef PG8_WAIT_L
#undef PG8_BAR
#undef PG8_SCHED
}
}

#define PHASE_IDS(F) do { int _t = threadIdx.x; asm volatile("" : "+v"(_t)); (F).tid = _t; (F).lane = _t & 63; (F).wave = __builtin_amdgcn_readfirstlane(_t >> 6); } while (0)
struct TrItem { const float* W; bf16* WT; int ldw, K, mode, f8; };
__device__ __forceinline__ void tr_load(float (&tv)[32], const TrItem& t, int wave, int lane) {
#pragma unroll
    for (int i = 0; i < 32; ++i) tv[i] = t.W[(size_t)(8 * wave + (i >> 2)) * t.ldw + 64 * (i & 3) + lane];
}
__device__ __forceinline__ void tr_store(const float (&tv)[32], const TrItem& t, LAS float* scr, int wave, int lane) {
#pragma unroll
    for (int i = 0; i < 32; ++i) scr[(8 * wave + (i >> 2)) * 257 + 64 * (i & 3) + lane] = tv[i];
    __syncthreads();
    const int c = lane & 7;
#pragma unroll
    for (int j = 0; j < 4; ++j) { const int n = 32 * wave + 8 * j + (lane >> 3); const LAS float* s = scr + (8 * c) * 257 + n;
        v4u o; o.x = pk2(s[0 * 257], s[1 * 257]); o.y = pk2(s[2 * 257], s[3 * 257]); o.z = pk2(s[4 * 257], s[5 * 257]); o.w = pk2(s[6 * 257], s[7 * 257]);
        const int drow = t.mode ? 256 * (n >> 7) + (n & 127) : n;
        if (t.f8) { v2u o8; o8.x = pg8::pk4_fp8(s[0 * 257] * 32.f, s[1 * 257] * 32.f, s[2 * 257] * 32.f, s[3 * 257] * 32.f); o8.y = pg8::pk4_fp8(s[4 * 257] * 32.f, s[5 * 257] * 32.f, s[6 * 257] * 32.f, s[7 * 257] * 32.f);
            *(v2u*)((unsigned char*)t.WT + (size_t)drow * t.K + 8 * c) = o8; }
        else *(v4u*)(t.WT + (size_t)drow * t.K + 8 * c) = o; }
    __syncthreads();
}

__device__ __forceinline__ void phase_prologue(Frame& F) {
    PHASE_IDS(F);
    LAS float* WL = (LAS float*)F.lds;
    LAS float* scr = (LAS float*)(F.lds + 65536);
    const float* w_in0 = F.in[4];
    for (int s = F.tid; s < 16 * 1024; s += 512) { const int k = s >> 4, o = s & 15; WL[o * 1024 + k] = w_in0[(size_t)k * EV_LD + 3072 + o]; }
    const int gw = F.vcu * NWAVES + F.wave, NGW = F.G * NWAVES;
    bf16* WIN0 = (bf16*)(F.ws + WS_WIN0); bf16* WOUT0 = (bf16*)(F.ws + WS_WOUT0); bf16* WIN1 = (bf16*)(F.ws + WS_WIN1); bf16* WOUT1 = (bf16*)(F.ws + WS_WOUT1);
    bf16* W13 = (bf16*)(F.ws + WS_W13); bf16* W2 = (bf16*)(F.ws + WS_W2);
    constexpr int I_A = 16 * 12, I_B = 16 * 2, I_C = 16 * 4, I_D = 16 * 10, I_E = 16 * 4, I_F = 2 * 32 * 2 * 32, I_G = 2 * 32 * 32;
    constexpr int NITEMS = I_A + I_B + I_C + I_D + I_E + I_F + I_G;
    auto decode = [&](int it) {
        TrItem t; int r = it; t.mode = 0; t.f8 = 0;
        if (r < I_A) { const int kb = r / 12, nb = r % 12; t.ldw = EV_LD; t.K = 1024; t.W = w_in0 + (size_t)(64 * kb) * EV_LD + 256 * nb; t.WT = WIN0 + (size_t)(256 * nb) * 1024 + 64 * kb; return t; } r -= I_A;
        if (r < I_B) { const int kb = r / 2, nb = r % 2; t.ldw = EV_LD; t.K = 1024; t.W = w_in0 + (size_t)(64 * kb) * EV_LD + 3088 + 256 * nb; t.WT = WIN0 + (size_t)(3072 + 256 * nb) * 1024 + 64 * kb; return t; } r -= I_B;
        if (r < I_C) { const int kb = r / 4, nb = r % 4; t.ldw = 1024; t.K = 1024; t.W = F.in[10] + (size_t)(64 * kb) * 1024 + 256 * nb; t.WT = WOUT0 + (size_t)(256 * nb) * 1024 + 64 * kb; return t; } r -= I_C;
        if (r < I_D) { const int kb = r / 10, nb = r % 10; t.ldw = OD_N; t.K = 1024; t.W = F.in[11] + (size_t)(64 * kb) * OD_N + 256 * nb; t.WT = WIN1 + (size_t)(256 * nb) * 1024 + 64 * kb; return t; } r -= I_D;
        if (r < I_E) { const int kb = r / 4, nb = r % 4; t.ldw = 1024; t.K = 1024; t.W = F.in[20] + (size_t)(64 * kb) * 1024 + 256 * nb; t.WT = WOUT1 + (size_t)(256 * nb) * 1024 + 64 * kb; return t; } r -= I_E;
        if (r < I_F) { const int le = r / 64, q = r % 64, which = q / 32, kb = (q % 32) / 2, nb = q % 2;
            t.ldw = 512; t.K = 1024; t.mode = 1; t.f8 = 1; t.W = (which ? F.in[26] : F.in[25]) + (size_t)le * 1024 * 512 + (size_t)(64 * kb) * 512 + 256 * nb;
            t.WT = (bf16*)((unsigned char*)(W13 + (size_t)(le >> 5) * 32 * 1024 * 1024) + (size_t)(le & 31) * 1024 * 1024 + (size_t)(512 * nb + which * 128) * 1024 + 64 * kb); return t; } r -= I_F;
        { const int le = r / 32, q = r % 32, kb = q / 4, nb = q % 4;
            t.ldw = 1024; t.K = 512; t.f8 = 1; t.W = F.in[27] + (size_t)le * 512 * 1024 + (size_t)(64 * kb) * 1024 + 256 * nb;
            t.WT = (bf16*)((unsigned char*)(W2 + (size_t)(le >> 5) * 32 * 1024 * 512) + (size_t)(le & 31) * 1024 * 512 + (size_t)(256 * nb) * 512 + 64 * kb); return t; }
    };
    __syncthreads();
    {
        float ta[32], tb[32]; TrItem da, db; int it = F.vcu;
        if (it < NITEMS) { da = decode(it); tr_load(ta, da, F.wave, F.lane); }
        while (it < NITEMS) {
            const int i1 = it + F.G, i2 = it + 2 * F.G;
            if (i1 < NITEMS) { db = decode(i1); tr_load(tb, db, F.wave, F.lane); }
            tr_store(ta, da, scr, F.wave, F.lane);
            if (i1 >= NITEMS) break;
            if (i2 < NITEMS) { da = decode(i2); tr_load(ta, da, F.wave, F.lane); }
            tr_store(tb, db, scr, F.wave, F.lane);
            it = i2;
        }
    }
    __syncthreads();
    const float* x = F.in[0]; const float* g = F.in[1];
    bf16* XN = (bf16*)(F.ws + WS_ACT); float* BL = (float*)(F.ws + WS_BLOW);
    f32x4 gv[4];
#pragma unroll
    for (int j = 0; j < 4; ++j) gv[j] = *((const f32x4*)g + 64 * j + F.lane);
    for (int m = gw; m < NT; m += NGW) {
        asm volatile("" ::: "memory");
        const f32x4* xr = (const f32x4*)(x + (size_t)m * D) + F.lane;
        f32x4 v[4]; float s = 0.f;
#pragma unroll
        for (int j = 0; j < 4; ++j) { v[j] = xr[64 * j]; s += (v[j].x * v[j].x + v[j].y * v[j].y) + (v[j].z * v[j].z + v[j].w * v[j].w); }
        const float rstd = rsqrtf(wave_sum(s) * (1.f / D) + EPS);
        v2u* o8 = (v2u*)(XN + (size_t)m * D) + F.lane;
#pragma unroll
        for (int j = 0; j < 4; ++j) { v[j] = v[j] * rstd * gv[j]; v2u w; w.x = pk2(v[j].x, v[j].y); w.y = pk2(v[j].z, v[j].w); o8[64 * j] = w; }
        float p[16];
#pragma unroll
        for (int o = 0; o < 16; ++o) {
            const LAS f32x4* wl = (const LAS f32x4*)(WL + o * 1024) + F.lane; float a = 0.f;
#pragma unroll
            for (int j = 0; j < 4; ++j) { const f32x4 w = wl[64 * j]; a += (v[j].x * w.x + v[j].y * w.y) + (v[j].z * w.z + v[j].w * w.w); }
            p[o] = a;
        }
#pragma unroll
        for (int o = 0; o < 8; ++o) { const bool hi = (F.lane & 32) != 0; const float snd = hi ? p[o] : p[o + 8], kp = hi ? p[o + 8] : p[o]; p[o] = kp + __shfl_xor(snd, 32); }
#pragma unroll
        for (int o = 0; o < 4; ++o) { const bool hi = (F.lane & 16) != 0; const float snd = hi ? p[o] : p[o + 4], kp = hi ? p[o + 4] : p[o]; p[o] = kp + __shfl_xor(snd, 16); }
#pragma unroll
        for (int o = 0; o < 2; ++o) { const bool hi = (F.lane & 8) != 0; const float snd = hi ? p[o] : p[o + 2], kp = hi ? p[o + 2] : p[o]; p[o] = kp + __shfl_xor(snd, 8); }
        { const bool hi = (F.lane & 4) != 0; const float snd = hi ? p[0] : p[1], kp = hi ? p[1] : p[0]; p[0] = kp + __shfl_xor(snd, 4); }
        p[0] += __shfl_xor(p[0], 2); p[0] += __shfl_xor(p[0], 1);
        if ((F.lane & 3) == 0) BL[(size_t)m * 16 + ((F.lane >> 5) & 1) * 8 + ((F.lane >> 4) & 1) * 4 + ((F.lane >> 3) & 1) * 2 + ((F.lane >> 2) & 1)] = p[0];
    }
}

__device__ __forceinline__ float row16_max(float v) { v = fmaxf(v, __shfl_xor(v, 1)); v = fmaxf(v, __shfl_xor(v, 2)); v = fmaxf(v, __shfl_xor(v, 4)); return fmaxf(v, __shfl_xor(v, 8)); }
__device__ __forceinline__ float row16_sum(float v) { v += __shfl_xor(v, 1); v += __shfl_xor(v, 2); v += __shfl_xor(v, 4); return v + __shfl_xor(v, 8); }
__device__ __forceinline__ int row16_min(int v) { v = min(v, __shfl_xor(v, 1)); v = min(v, __shfl_xor(v, 2)); v = min(v, __shfl_xor(v, 4)); return min(v, __shfl_xor(v, 8)); }
__device__ __forceinline__ void phase_router(Frame& F, int layer, const bf16* XR) {
    PHASE_IDS(F);
    constexpr int PW = 2064;
    LAS unsigned char* WH = F.lds; LAS unsigned char* WLO = F.lds + 36 * PW;
    LAS float* GL = (LAS float*)(F.lds + LDS_MISC + 1024);
    LAS int* hist = (LAS int*)(F.lds + LDS_MISC + 1024 + 4096); LAS int* base = hist + 32;
    LAS int* s_e0 = base + 32; LAS int* s_e1 = s_e0 + 128; LAS int* s_r0 = s_e1 + 128; LAS int* s_r1 = s_r0 + 128;
    LAS float* s_w0 = (LAS float*)(s_r1 + 128); LAS float* s_w1 = s_w0 + 128;
    const float* wg = F.in[21] + (size_t)layer * 1024 * 4; const float* we = F.in[23] + (size_t)layer * 1024 * 32;
    const float* g = F.in[2] + layer * 1024;
    for (int s = F.tid; s < 1024; s += 512) GL[s] = g[s];
    for (int s = F.tid; s < 4096; s += 512) { const int k = s >> 2, o = s & 3; const float w = wg[s] * g[k]; const unsigned hb = f2bf(w);
        *(LAS bf16*)(WH + o * PW + k * 2) = (bf16)hb; *(LAS bf16*)(WLO + o * PW + k * 2) = (bf16)f2bf(w - bf2f((bf16)hb)); }
    for (int s = F.tid; s < 32768; s += 512) { const int k = s >> 5, o = 4 + (s & 31); const float w = we[s] * g[k]; const unsigned hb = f2bf(w);
        *(LAS bf16*)(WH + o * PW + k * 2) = (bf16)hb; *(LAS bf16*)(WLO + o * PW + k * 2) = (bf16)f2bf(w - bf2f((bf16)hb)); }
    const int c = F.lane & 15, q = F.lane >> 4;
    float bias[3];
#pragma unroll
    for (int jt = 0; jt < 3; ++jt) { const int col = 16 * jt + c; bias[jt] = col < 4 ? F.in[22][layer * 4 + col] : (col < 36 ? F.in[24][layer * 32 + col - 4] : 0.f); }
    unsigned* cnt = F.ctl + CW_CNT + 64 * layer;
    bf16* XN = (bf16*)(F.ws + WS_ACT); const float* SSQ = (const float*)(F.ws + WS_SSQ);
    int* ME0 = (int*)(F.ws + WS_META); int* ME1 = ME0 + NT; int* MR0 = ME1 + NT; int* MR1 = MR0 + NT; float* MW0 = (float*)(MR1 + NT); float* MW1 = MW0 + NT;
    int* LIST = (int*)(F.ws + WS_LIST);
    int wrow[3];
#pragma unroll
    for (int jt = 0; jt < 3; ++jt) wrow[jt] = min(16 * jt + c, 35) * PW + 16 * q;
    __syncthreads();
    for (int row0 = 128 * F.vcu; row0 < NT; row0 += 128 * F.G) {
        if (F.tid < 32) hist[F.tid] = 0;
        __syncthreads();
        const int rl = F.wave * 16, row = row0 + rl + c;
        float rstd; { const f32x4 sp = *(const f32x4*)(SSQ + (size_t)row * 16 + 4 * q); float s = (sp[0] + sp[1]) + (sp[2] + sp[3]); s += __shfl_xor(s, 16); s += __shfl_xor(s, 32); rstd = rsqrtf(s * (1.f / D) + EPS); }
        const bf16* xr = XR + (size_t)row * D + 8 * q; unsigned char* xo = (unsigned char*)XN + (size_t)row * D + 8 * q;
        f32x4 acc[3];
#pragma unroll
        for (int jt = 0; jt < 3; ++jt) acc[jt] = (f32x4){0.f, 0.f, 0.f, 0.f};
        for (int k4 = 0; k4 < 32; k4 += 8) {
            v4u xw[8];
#pragma unroll
            for (int u = 0; u < 8; ++u) xw[u] = *(const v4u*)(xr + 32 * (k4 + u));
#pragma unroll
            for (int u = 0; u < 8; ++u) {
                const int kk = k4 + u;
                const f32x4 ga = *(const LAS f32x4*)(GL + 32 * kk + 8 * q), gb = *(const LAS f32x4*)(GL + 32 * kk + 8 * q + 4);
                const v4u w = xw[u];
#define BLO(x) __builtin_bit_cast(float, (x) << 16)
#define BHI(x) __builtin_bit_cast(float, (x) & 0xffff0000u)
                v2u xn; xn.x = pg8::pk4_fp8(BLO(w.x) * rstd * ga[0], BHI(w.x) * rstd * ga[1], BLO(w.y) * rstd * ga[2], BHI(w.y) * rstd * ga[3]);
                xn.y = pg8::pk4_fp8(BLO(w.z) * rstd * gb[0], BHI(w.z) * rstd * gb[1], BLO(w.w) * rstd * gb[2], BHI(w.w) * rstd * gb[3]);
#undef BLO
#undef BHI
                *(v2u*)(xo + 32 * kk) = xn;
                const bf16x8 ah = __builtin_bit_cast(bf16x8, w);
#pragma unroll
                for (int jt = 0; jt < 3; ++jt) { const bf16x8 bh = *(const LAS bf16x8*)(WH + wrow[jt] + 64 * kk), bl = *(const LAS bf16x8*)(WLO + wrow[jt] + 64 * kk);
                    acc[jt] = __builtin_amdgcn_mfma_f32_16x16x32_bf16(ah, bh, acc[jt], 0, 0, 0); acc[jt] = __builtin_amdgcn_mfma_f32_16x16x32_bf16(ah, bl, acc[jt], 0, 0, 0); }
            }
        }
#pragma unroll
        for (int i = 0; i < 4; ++i) {
            const float rs = __shfl(rstd, 4 * q + i);
            const float l0 = acc[0][i] * rs + bias[0], l1 = acc[1][i] * rs + bias[1], l2 = acc[2][i] * rs + bias[2];
            const float gvl = c < 4 ? l0 : -3.0e38f;
            const float gmax = row16_max(gvl); const int gi = row16_min(gvl == gmax ? c : 99);
            const float gwt = 1.f / row16_sum(c < 4 ? __expf(gvl - gmax) : 0.f);
            const int jt = c < 4 ? (gi == 1 ? 1 : 2) : (c < 12 ? (gi == 0 ? 0 : 1) : (gi == 1 ? 0 : 1));
            const bool valid = c < 4 ? (gi == 1 || gi == 3) : (c < 12 ? (gi == 0 || gi == 2) : (gi == 1 || gi == 3));
            const int eidx = 16 * jt + c - 4 - 8 * gi;
            float cv = jt == 0 ? l0 : (jt == 1 ? l1 : l2); cv = (valid && eidx >= 0 && eidx < 8) ? cv : -3.0e38f;
            const float v0 = row16_max(cv); const int i0 = row16_min(cv == v0 ? eidx : 99);
            const float cv2 = eidx == i0 ? -3.0e38f : cv;
            const float v1 = row16_max(cv2); const int i1 = row16_min(cv2 == v1 ? eidx : 99);
            const float ex = __expf(v1 - v0), tw0 = 1.f / (1.f + ex), tw1 = ex / (1.f + ex);
            if (c == 0) { const int r = rl + 4 * q + i, e0 = gi * 8 + i0, e1 = gi * 8 + i1;
                s_e0[r] = e0; s_e1[r] = e1; s_w0[r] = gwt * tw0; s_w1[r] = gwt * tw1;
                s_r0[r] = atomicAdd((int*)&hist[e0], 1); s_r1[r] = atomicAdd((int*)&hist[e1], 1); }
        }
        __syncthreads();
        if (F.tid < 32) base[F.tid] = (int)atomicAdd(cnt + F.tid, (unsigned)hist[F.tid]);
        __syncthreads();
        if (F.tid < 128) {
            const int m = row0 + F.tid, e0 = s_e0[F.tid], e1 = s_e1[F.tid], r0 = base[e0] + s_r0[F.tid], r1 = base[e1] + s_r1[F.tid];
            ME0[m] = e0; ME1[m] = e1; MR0[m] = r0; MR1[m] = r1; MW0[m] = s_w0[F.tid]; MW1[m] = s_w1[F.tid];
            LIST[(size_t)e0 * NT + r0] = m; LIST[(size_t)e1 * NT + r1] = m;
        }
        __syncthreads();
    }
}

__device__ __forceinline__ void phase_combine(Frame& F, int layer, const bf16* XRin, bf16* XRout) {
    PHASE_IDS(F);
    LAS int* poff = (LAS int*)(F.lds + LDS_MISC + 1024);
    const unsigned* cnt = F.ctl + CW_CNT + 64 * layer;
    if (F.tid == 0) { int acc = 0; for (int e = 0; e < 32; ++e) { poff[e] = acc; acc += ((int)cnt[e] + 255) & ~255; } poff[32] = acc; }
    __syncthreads();
    const int gw = F.vcu * NWAVES + F.wave, NGW = F.G * NWAVES;
    const float* g = layer == 0 ? F.in[1] + 1024 : F.in[3];
    const bf16* Y = (const bf16*)(F.ws + WS_Y); bf16* XN = (bf16*)(F.ws + WS_ACT);
    const int* ME0 = (const int*)(F.ws + WS_META); const int* ME1 = ME0 + NT; const int* MR0 = ME1 + NT; const int* MR1 = MR0 + NT; const float* MW0 = (const float*)(MR1 + NT); const float* MW1 = MW0 + NT;
    f32x4 gv[4];
#pragma unroll
    for (int j = 0; j < 4; ++j) gv[j] = *((const f32x4*)g + 64 * j + F.lane);
    for (int m0 = gw; m0 < NT; m0 += 2 * NGW) {
        int mr[2]; mr[0] = m0; mr[1] = (m0 + NGW < NT) ? m0 + NGW : m0;
        f32x4 v[2][4]; v2u ya[2][4], yb[2][4]; float w0[2], w1[2];
#pragma unroll
        for (int r = 0; r < 2; ++r) {
            const int m = mr[r]; const int s0 = poff[ME0[m]] + MR0[m], s1 = poff[ME1[m]] + MR1[m]; w0[r] = MW0[m]; w1[r] = MW1[m];
            const v2u* xr = (const v2u*)(XRin + (size_t)m * D) + F.lane;
            const v2u* y0 = (const v2u*)(Y + (size_t)s0 * D) + F.lane; const v2u* y1 = (const v2u*)(Y + (size_t)s1 * D) + F.lane;
#pragma unroll
            for (int j = 0; j < 4; ++j) { const v2u xw = xr[64 * j]; v[r][j] = (f32x4){bf2f((bf16)(xw.x & 0xffff)), bf2f((bf16)(xw.x >> 16)), bf2f((bf16)(xw.y & 0xffff)), bf2f((bf16)(xw.y >> 16))}; ya[r][j] = y0[64 * j]; yb[r][j] = y1[64 * j]; }
        }
#pragma unroll
        for (int r = 0; r < 2; ++r) {
            const int m = mr[r]; float s = 0.f;
            f32x4* xr = (f32x4*)(F.out + (size_t)m * D) + F.lane; v2u* xo2 = (v2u*)(XRout + (size_t)m * D) + F.lane;
#pragma unroll
            for (int j = 0; j < 4; ++j) { const v2u a = ya[r][j], b = yb[r][j];
                v[r][j].x += w0[r] * bf2f((bf16)(a.x & 0xffff)) + w1[r] * bf2f((bf16)(b.x & 0xffff)); v[r][j].y += w0[r] * bf2f((bf16)(a.x >> 16)) + w1[r] * bf2f((bf16)(b.x >> 16));
                v[r][j].z += w0[r] * bf2f((bf16)(a.y & 0xffff)) + w1[r] * bf2f((bf16)(b.y & 0xffff)); v[r][j].w += w0[r] * bf2f((bf16)(a.y >> 16)) + w1[r] * bf2f((bf16)(b.y >> 16));
                s += (v[r][j].x * v[r][j].x + v[r][j].y * v[r][j].y) + (v[r][j].z * v[r][j].z + v[r][j].w * v[r][j].w); }
            const float rstd = rsqrtf(wave_sum(s) * (1.f / D) + EPS);
            if (r == 1 && mr[1] == mr[0]) continue;
            if (layer == 0) {
                v2u* o8 = (v2u*)(XN + (size_t)m * D) + F.lane;
#pragma unroll
                for (int j = 0; j < 4; ++j) { v2u xw; xw.x = pk2(v[r][j].x, v[r][j].y); xw.y = pk2(v[r][j].z, v[r][j].w); xo2[64 * j] = xw; const f32x4 n = v[r][j] * rstd * gv[j]; v2u w; w.x = pk2(n.x, n.y); w.y = pk2(n.z, n.w); o8[64 * j] = w; }
            } else {
#pragma unroll
                for (int j = 0; j < 4; ++j) xr[64 * j] = v[r][j] * rstd * gv[j];
            }
        }
    }
}


namespace mx {
typedef short s4 __attribute__((ext_vector_type(4)));
constexpr int PV = 272, PP = 144;
template <int DK> struct Lay { static constexpr int PK = DK * 2 + 16, QS = 0, KS = 64 * PK, VV = 2 * 64 * PK, ST = VV + 64 * PV, PM = ST + 128 * PK, VEC = PM + 64 * PP, PART = VEC + 3 * DK * 4, RED = PART + 8 * DK * 4, BLS = RED + 4096, END = BLS + 4096; };
static_assert(Lay<128>::END <= LDS_MISC, "mixer LDS map");
__device__ __forceinline__ bf16x8 row_frag(const LAS unsigned char* base, int pitch, int row0, int kk, int lane) {
    return *(const LAS bf16x8*)(base + (row0 + (lane & 15)) * pitch + (32 * kk + 8 * (lane >> 4)) * 2);
}
__device__ __forceinline__ bf16x8 tr_frag(const LAS unsigned char* base, int pitch, int k0, int c0, int lane) {
    const int g = lane >> 4, q = (lane & 15) >> 2, p = lane & 3;
    const LAS unsigned char* a = base + (k0 + 8 * g + q) * pitch + (c0 + 4 * p) * 2;
    const s4 lo = __builtin_amdgcn_ds_read_tr16_b64_v4i16((LAS s4*)a);
    const s4 hi = __builtin_amdgcn_ds_read_tr16_b64_v4i16((LAS s4*)(a + 4 * pitch));
    return __builtin_shufflevector(lo, hi, 0, 1, 2, 3, 4, 5, 6, 7);
}
#define MFMA16(a, b, c) __builtin_amdgcn_mfma_f32_16x16x32_bf16(a, b, c, 0, 0, 0)

struct UnitP { const bf16* PROJ; bf16* YM; const float* nw; const float* BL; const float* p0; const float* p1; const float* p2; int b, h, c0, nch; };

template <int KIND> struct KC {
    static constexpr int DK = KIND == 0 ? 128 : 64, LDP = KIND == 2 ? OD_N : EV_N;
    __device__ static __forceinline__ int qcol(int h) { return KIND == 0 ? h * 128 : (KIND == 1 ? 2048 + h * 64 : h * 64); }
    __device__ static __forceinline__ int kcol(int h) { return KIND == 0 ? 512 + h * 128 : (KIND == 1 ? 2304 + h * 64 : 256 + h * 64); }
    __device__ static __forceinline__ int vcol(int h) { return KIND == 0 ? 1024 + h * 128 : (KIND == 1 ? 2560 + h * 128 : 512 + h * 128); }
    __device__ static __forceinline__ int gcol(int h) { return KIND == 0 ? 1536 + h * 128 : (KIND == 1 ? 3072 + h * 128 : 1024 + h * 128); }
    __device__ static __forceinline__ int ocol(int h) { return KIND == 1 ? 512 + h * 128 : h * 128; }
};

template <int KIND, bool FULL>
__device__ __forceinline__ void mix_unit(LAS unsigned char* lds, float* Sg, float* Bg, const UnitP& U) {
    using K = KC<KIND>; constexpr int DK = K::DK, LDP = K::LDP, NJT = DK == 128 ? 8 : 4; using L = Lay<DK>; constexpr int PK = L::PK;
    int tid = threadIdx.x; asm volatile("" : "+v"(tid));
    const int lane = tid & 63, wave = __builtin_amdgcn_readfirstlane(tid >> 6), g = lane >> 4, c = lane & 15;
    const int h = U.h, dt = DK == 128 ? wave : (wave & 3), jt0 = DK == 128 ? 0 : 4 * (wave >> 2);
    LAS float* EM = (LAS float*)(lds + L::VEC); LAS float* EL = EM + DK; LAS float* BT = EL + DK; LAS float* PART = (LAS float*)(lds + L::PART);
    float lb0 = 0.f, lb1 = 0.f, wu[16], bu = 0.f, ci = 0.f, lgg = 0.f;
    if (KIND == 0) {
        const float* lbl = U.p0; const int col = h * 128 + 2 * lane;
#pragma unroll
        for (int x = 0; x < 2; ++x) { const float l0 = lbl[col + x], l1 = lbl[512 + col + x], l2 = lbl[1024 + col + x]; const float mx_ = fmaxf(l0, fmaxf(l1, l2));
            const float e0 = __expf(l0 - mx_), e1 = __expf(l1 - mx_), e2 = __expf(l2 - mx_); const float v = e0 / (e0 + e1 + e2); if (x == 0) lb0 = v; else lb1 = v; }
    }
    if (KIND == 1) {
#pragma unroll
        for (int r = 0; r < 16; ++r) wu[r] = U.p0[r * 256 + h * 64 + lane];
        bu = U.p1[h * 64 + lane];
    }
    if (KIND == 2) { ci = exp2f(-(float)(lane & 31) * (13.287712379549449f / 32.f)) * 0.15915494309189535f; lgg = log1pf(-exp2f(-5.f - (float)h)); }
    f32x4 S[NJT];
#pragma unroll
    for (int jt = 0; jt < NJT; ++jt) {
        if (FULL) {
#pragma unroll
            for (int i = 0; i < 4; ++i) S[jt][i] = Sg[(16 * dt + 4 * g + i) * 128 + 16 * (jt0 + jt) + c];
        } else S[jt] = (f32x4){0.f, 0.f, 0.f, 0.f};
    }
    f32x4 nw4[4];
    if (FULL) {
#pragma unroll
        for (int x = 0; x < 4; ++x) nw4[x] = *(const f32x4*)(U.nw + h * 128 + 16 * (4 * (wave >> 2) + x) + 4 * g);
    }
    if (tid < DK) BT[tid] = KIND == 0 ? 1.f : 0.f;
    v4u rv0, rv1; unsigned ra[8], rb[8]; f32x4 rbl = (f32x4){0.f, 0.f, 0.f, 0.f};
    auto load_raw = [&](int ch) {
        const size_t row0 = (size_t)U.b * SEQ + (U.c0 + ch) * 64;
        const bf16* Vp = U.PROJ + (row0 + (tid >> 3)) * LDP + K::vcol(h) + (tid & 7) * 16;
        rv0 = *(const v4u*)Vp; rv1 = *(const v4u*)(Vp + 8);
        if (KIND == 1 && tid < 256) rbl = *(const f32x4*)(U.BL + (row0 + (tid >> 2)) * 16 + (tid & 3) * 4);
        if (KIND == 0) {
            const bf16* P = U.PROJ + (row0 + 8 * wave) * LDP + 2 * lane;
#pragma unroll
            for (int tt = 0; tt < 8; ++tt) { ra[tt] = *(const unsigned*)(P + (size_t)tt * LDP + K::kcol(h)); if (FULL) rb[tt] = *(const unsigned*)(P + (size_t)tt * LDP + K::qcol(h)); }
        } else {
            const bf16* P = U.PROJ + (row0 + 8 * wave) * LDP + lane;
#pragma unroll
            for (int tt = 0; tt < 8; ++tt) { ra[tt] = P[(size_t)tt * LDP + K::kcol(h)]; if (FULL) rb[tt] = P[(size_t)tt * LDP + K::qcol(h)]; }
        }
    };
    load_raw(0);
    for (int ch = 0; ch < U.nch; ++ch) {
        const int pos0 = (U.c0 + ch) * 64; const size_t row0 = (size_t)U.b * SEQ + pos0;
        *(LAS v4u*)(lds + L::VV + (tid >> 3) * PV + (tid & 7) * 32) = rv0; *(LAS v4u*)(lds + L::VV + (tid >> 3) * PV + (tid & 7) * 32 + 16) = rv1;
        if (KIND == 0) {
            float cp0[8], cp1[8], k0[8], k1[8]; float c0 = 1.f, c1 = 1.f;
#pragma unroll
            for (int tt = 0; tt < 8; ++tt) {
                const float f0 = lb0 + (1.f - lb0) * sigmoidf_(bf2f((bf16)(ra[tt] & 0xffff))), f1 = lb1 + (1.f - lb1) * sigmoidf_(bf2f((bf16)(ra[tt] >> 16)));
                c0 *= f0; c1 *= f1; cp0[tt] = c0; cp1[tt] = c1; k0[tt] = 1.f - f0; k1[tt] = 1.f - f1;
            }
            *(LAS f32x2*)(PART + wave * 128 + 2 * lane) = (f32x2){c0, c1};
            __syncthreads();
            float pre0 = 1.f, pre1 = 1.f, mid0 = 1.f, mid1 = 1.f, hi0 = 1.f, hi1 = 1.f;
#pragma unroll
            for (int w2 = 0; w2 < 8; ++w2) { const f32x2 p = *(const LAS f32x2*)(PART + w2 * 128 + 2 * lane);
                if (w2 < 4) { mid0 *= p.x; mid1 *= p.y; } else { hi0 *= p.x; hi1 *= p.y; }
                if (wave < 4 ? (w2 > wave && w2 < 4) : (w2 >= 4 && w2 < wave)) { pre0 *= p.x; pre1 *= p.y; } }
#pragma unroll
            for (int tt = 0; tt < 8; ++tt) {
                float qs0, qs1, ks0, ks1;
                if (wave >= 4) { qs0 = pre0 * cp0[tt]; qs1 = pre1 * cp1[tt]; ks0 = __builtin_amdgcn_rcpf(fmaxf(qs0, 1e-26f)); ks1 = __builtin_amdgcn_rcpf(fmaxf(qs1, 1e-26f)); }
                else { ks0 = pre0 * c0 * __builtin_amdgcn_rcpf(fmaxf(cp0[tt], 1e-26f)); ks1 = pre1 * c1 * __builtin_amdgcn_rcpf(fmaxf(cp1[tt], 1e-26f));
                       qs0 = __builtin_amdgcn_rcpf(fmaxf(ks0, 1e-26f)); qs1 = __builtin_amdgcn_rcpf(fmaxf(ks1, 1e-26f)); }
                *(LAS unsigned*)(lds + L::KS + (8 * wave + tt) * PK + 4 * lane) = pg8::cvt_pk_bf16(k0[tt] * ks0, k1[tt] * ks1);
                if (FULL) *(LAS unsigned*)(lds + L::QS + (8 * wave + tt) * PK + 4 * lane) = pg8::cvt_pk_bf16(bf2f((bf16)(rb[tt] & 0xffff)) * qs0, bf2f((bf16)(rb[tt] >> 16)) * qs1);
            }
            if (wave == 0) { *(LAS f32x2*)(EM + 2 * lane) = (f32x2){mid0, mid1}; *(LAS f32x2*)(EL + 2 * lane) = (f32x2){hi0, hi1};
                const f32x2 o = *(const LAS f32x2*)(BT + 2 * lane); *(LAS f32x2*)(BT + 2 * lane) = (f32x2){o.x * mid0 * hi0, o.y * mid1 * hi1}; }
        } else if (KIND == 1) {
            LAS float* BLS = (LAS float*)(lds + L::BLS);
            if (tid < 256) *(LAS f32x4*)(BLS + (tid >> 2) * 16 + (tid & 3) * 4) = rbl;
            __syncthreads();
            float cs[8]; float cc = 0.f;
#pragma unroll
            for (int tt = 0; tt < 8; ++tt) {
                const LAS f32x4* bl = (const LAS f32x4*)(BLS + (8 * wave + tt) * 16); float z = bu;
#pragma unroll
                for (int r = 0; r < 4; ++r) { const f32x4 bq = bl[r]; z += (bq[0] * wu[4 * r] + bq[1] * wu[4 * r + 1]) + (bq[2] * wu[4 * r + 2] + bq[3] * wu[4 * r + 3]); }
                const float ls = fminf(z, 0.f) - __logf(1.f + __expf(-fabsf(z)));
                cc += ls * (1.f / 16.f); cs[tt] = cc;
            }
            PART[wave * 64 + lane] = cc;
            __syncthreads();
            float off = 0.f, mid = 0.f, tot = 0.f;
#pragma unroll
            for (int w2 = 0; w2 < 8; ++w2) { const float p = PART[w2 * 64 + lane]; if (w2 < wave) off += p; if (w2 < 4) mid += p; tot += p; }
#pragma unroll
            for (int tt = 0; tt < 8; ++tt) {
                const float b = off + cs[tt];
                *(LAS bf16*)(lds + L::KS + (8 * wave + tt) * PK + 2 * lane) = (bf16)f2bf(bf2f((bf16)ra[tt]) * __expf(fminf(mid - b, 60.f)));
                if (FULL) *(LAS bf16*)(lds + L::QS + (8 * wave + tt) * PK + 2 * lane) = (bf16)f2bf(bf2f((bf16)rb[tt]) * 0.125f * __expf(fminf(b - mid, 60.f)));
            }
            if (wave == 0) { EM[lane] = __expf(mid); EL[lane] = __expf(tot - mid); BT[lane] += tot; }
        } else {
#pragma unroll
            for (int tt = 0; tt < 8; ++tt) {
                const int tl = 8 * wave + tt; float rev = (float)(pos0 + tl) * ci; rev -= floorf(rev);
                const float sn = __builtin_amdgcn_sinf(rev), cs = __builtin_amdgcn_cosf(rev);
                const float e = (float)(tl - 31) * lgg;
                const float kv = bf2f((bf16)ra[tt]), kp = __shfl_xor(kv, 32);
                const float kr = (lane < 32 ? kv * cs - kp * sn : kp * sn + kv * cs) * 0.125f;
                *(LAS bf16*)(lds + L::KS + tl * PK + 2 * lane) = (bf16)f2bf(kr * __expf(-e));
                if (FULL) { const float qv = bf2f((bf16)rb[tt]), qp = __shfl_xor(qv, 32); const float qr = lane < 32 ? qv * cs - qp * sn : qp * sn + qv * cs;
                    *(LAS bf16*)(lds + L::QS + tl * PK + 2 * lane) = (bf16)f2bf(qr * __expf(e)); }
            }
            if (wave == 0) { const float e32 = __expf(32.f * lgg); EM[lane] = e32; EL[lane] = e32; BT[lane] += 64.f * lgg; }
        }
        if (ch + 1 < U.nch) load_raw(ch + 1);
        v2u gq[4];
        if (FULL) { const bf16* gp = U.PROJ + (row0 + 16 * (wave & 3) + c) * LDP + K::gcol(h) + 16 * (4 * (wave >> 2)) + 4 * g;
#pragma unroll
            for (int x = 0; x < 4; ++x) gq[x] = *(const v2u*)(gp + 16 * x); }
        __syncthreads();
        { const f32x4 em4 = *(const LAS f32x4*)(EM + 16 * dt + 4 * g);
#pragma unroll
          for (int jt = 0; jt < NJT; ++jt) { S[jt] = S[jt] * em4;
              if (FULL) { v2u w; w.x = pg8::cvt_pk_bf16(S[jt][0], S[jt][1]); w.y = pg8::cvt_pk_bf16(S[jt][2], S[jt][3]);
                  *(LAS v2u*)(lds + L::ST + (16 * (jt0 + jt) + c) * PK + (16 * dt + 4 * g) * 2) = w; } } }
        if (FULL) {
            const int st = wave & 3, tt0 = 2 * (wave >> 2);
            f32x4 p0 = (f32x4){0.f, 0.f, 0.f, 0.f}, p1 = p0;
#pragma unroll
            for (int kk = 0; kk < DK / 32; ++kk) { const bf16x8 a = row_frag(lds + L::KS, PK, 16 * st, kk, lane);
                p0 = MFMA16(a, row_frag(lds + L::QS, PK, 16 * tt0, kk, lane), p0); p1 = MFMA16(a, row_frag(lds + L::QS, PK, 16 * (tt0 + 1), kk, lane), p1); }
#pragma unroll
            for (int x = 0; x < 2; ++x) { const f32x4 p = x ? p1 : p0; const int t = 16 * (tt0 + x) + c, s = 16 * st + 4 * g;
                v2u w; w.x = pg8::cvt_pk_bf16(s <= t ? p[0] : 0.f, s + 1 <= t ? p[1] : 0.f); w.y = pg8::cvt_pk_bf16(s + 2 <= t ? p[2] : 0.f, s + 3 <= t ? p[3] : 0.f);
                *(LAS v2u*)(lds + L::PM + t * PP + s * 2) = w; }
        }
        {
#pragma unroll
          for (int kk = 0; kk < 2; ++kk) { const bf16x8 a = tr_frag(lds + L::KS, PK, 32 * kk, 16 * dt, lane);
#pragma unroll
              for (int jt = 0; jt < NJT; ++jt) S[jt] = MFMA16(a, tr_frag(lds + L::VV, PV, 32 * kk, 16 * (jt0 + jt), lane), S[jt]); }
          const f32x4 el4 = *(const LAS f32x4*)(EL + 16 * dt + 4 * g);
#pragma unroll
          for (int jt = 0; jt < NJT; ++jt) S[jt] = S[jt] * el4;
        }
        __syncthreads();
        if (FULL) {
            const int tt = wave & 3, jh = wave >> 2, t = 16 * tt + c;
            f32x4 o[4];
#pragma unroll
            for (int x = 0; x < 4; ++x) o[x] = (f32x4){0.f, 0.f, 0.f, 0.f};
#pragma unroll
            for (int kk = 0; kk < 2; ++kk) { const bf16x8 bb = row_frag(lds + L::PM, PP, 16 * tt, kk, lane);
#pragma unroll
                for (int x = 0; x < 4; ++x) o[x] = MFMA16(tr_frag(lds + L::VV, PV, 32 * kk, 16 * (4 * jh + x), lane), bb, o[x]); }
#pragma unroll
            for (int kk = 0; kk < DK / 32; ++kk) { const bf16x8 bb = row_frag(lds + L::QS, PK, 16 * tt, kk, lane);
#pragma unroll
                for (int x = 0; x < 4; ++x) o[x] = MFMA16(row_frag(lds + L::ST, PK, 16 * (4 * jh + x), kk, lane), bb, o[x]); }
            float sm = 0.f, sq = 0.f;
#pragma unroll
            for (int x = 0; x < 4; ++x)
#pragma unroll
                for (int i = 0; i < 4; ++i) { sm += o[x][i]; sq += o[x][i] * o[x][i]; }
            sm += __shfl_xor(sm, 16); sq += __shfl_xor(sq, 16); sm += __shfl_xor(sm, 32); sq += __shfl_xor(sq, 32);
            LAS f32x2* RED = (LAS f32x2*)(lds + L::RED) + (ch & 1) * 128;
            if (g == 0) RED[jh * 64 + t] = (f32x2){sm, sq};
            __syncthreads();
            const f32x2 r0 = RED[t], r1 = RED[64 + t];
            const float mean = KIND == 2 ? (r0.x + r1.x) * (1.f / 128.f) : 0.f;
            const float rstd = rsqrtf(fmaxf((r0.y + r1.y) * (1.f / 128.f) - mean * mean, 0.f) + EPS);
            bf16* yp = U.YM + (row0 + t) * 1024 + K::ocol(h) + 16 * (4 * jh) + 4 * g;
#pragma unroll
            for (int x = 0; x < 4; ++x) {
                const float g0 = bf2f((bf16)(gq[x].x & 0xffff)), g1 = bf2f((bf16)(gq[x].x >> 16)), g2 = bf2f((bf16)(gq[x].y & 0xffff)), g3 = bf2f((bf16)(gq[x].y >> 16));
                v2u w; w.x = pg8::cvt_pk_bf16((o[x][0] - mean) * rstd * nw4[x][0] * siluf_(g0), (o[x][1] - mean) * rstd * nw4[x][1] * siluf_(g1));
                w.y = pg8::cvt_pk_bf16((o[x][2] - mean) * rstd * nw4[x][2] * siluf_(g2), (o[x][3] - mean) * rstd * nw4[x][3] * siluf_(g3));
                *(v2u*)(yp + 16 * x) = w; }
        }
    }
    if (!FULL) {
#pragma unroll
        for (int jt = 0; jt < NJT; ++jt)
#pragma unroll
            for (int i = 0; i < 4; ++i) Sg[(16 * dt + 4 * g + i) * 128 + 16 * (jt0 + jt) + c] = S[jt][i];
        __syncthreads();
        if (tid < DK) Bg[tid] = KIND == 0 ? BT[tid] : __expf(BT[tid]);
    }
    __syncthreads();
}
}


namespace rg {
constexpr int PX = 272, PW = 144, XCB = 0, XCF = 64 * PX, WT = XCF + 64 * 132 * 4, END = WT + 4 * 64 * PW;
static_assert(END <= LDS_MISC, "rglru LDS map");
template <bool FULL>
__device__ __forceinline__ void unit(LAS unsigned char* lds, const bf16* PROJ, bf16* YM, const float* const* in, int b, int c0, int nch, int cg, float* RA, float* RH) {
    int tid = threadIdx.x; asm volatile("" : "+v"(tid));
    const int lane = tid & 63, wave = __builtin_amdgcn_readfirstlane(tid >> 6), g = lane >> 4, c = lane & 15;
    const int n0 = 2 * cg, chbase = cg * 128;
    const float* w_r = in[15]; const float* w_i = in[17];
    for (int i = tid; i < 4 * 4096; i += 512) { const int m = i >> 12, gate = m >> 1, nb = m & 1, d = (i >> 6) & 63, e = i & 63;
        const float v = (gate ? w_i : w_r)[((n0 + nb) * 64 + d) * 64 + e];
        *(LAS bf16*)(lds + WT + m * 64 * PW + e * PW + d * 2) = (bf16)f2bf(v); }
    float cw0[4], cw1[4]; const int cc = chbase + 2 * lane;
#pragma unroll
    for (int j = 0; j < 4; ++j) { cw0[j] = in[13][j * 512 + cc]; cw1[j] = in[13][j * 512 + cc + 1]; }
    const float cb0 = in[14][cc], cb1 = in[14][cc + 1];
    const int nb = wave >> 2, e0 = 16 * (wave & 3), chl = nb * 64 + e0 + c, chn = chbase + chl;
    const float brr = in[16][chn], bii = in[18][chn], sp = __logf(1.f + __expf(-in[19][chn]));
    float hcar = FULL ? RH[chn] : 0.f, atot = 1.f;
    unsigned xw[11];
    auto load_x = [&](int ch) {
#pragma unroll
        for (int r = 0; r < 11; ++r) { const int pos = (c0 + ch) * 64 + 8 * wave - 3 + r; xw[r] = 0u;
            if (pos >= 0) xw[r] = *(const unsigned*)(PROJ + ((size_t)b * SEQ + pos) * OD_N + 1536 + cc); }
    };
    load_x(0);
    __syncthreads();
    for (int ch = 0; ch < nch; ++ch) {
        const int pos0 = (c0 + ch) * 64; const size_t row0 = (size_t)b * SEQ + pos0;
        {
            float x0[11], x1[11];
#pragma unroll
            for (int r = 0; r < 11; ++r) { x0[r] = bf2f((bf16)(xw[r] & 0xffff)); x1[r] = bf2f((bf16)(xw[r] >> 16)); }
#pragma unroll
            for (int tt = 0; tt < 8; ++tt) {
                const float a0 = cb0 + cw0[0] * x0[tt] + cw0[1] * x0[tt + 1] + cw0[2] * x0[tt + 2] + cw0[3] * x0[tt + 3];
                const float a1 = cb1 + cw1[0] * x1[tt] + cw1[1] * x1[tt + 1] + cw1[2] * x1[tt + 2] + cw1[3] * x1[tt + 3];
                *(LAS unsigned*)(lds + XCB + (8 * wave + tt) * PX + 4 * lane) = pg8::cvt_pk_bf16(a0, a1);
                *(LAS f32x2*)(lds + XCF + ((8 * wave + tt) * 132 + 2 * lane) * 4) = (f32x2){a0, a1};
            }
        }
        if (ch + 1 < nch) load_x(ch + 1);
        bf16 gt[16];
        if (FULL) {
#pragma unroll
            for (int tt = 0; tt < 4; ++tt)
#pragma unroll
                for (int i = 0; i < 4; ++i) gt[4 * tt + i] = PROJ[(row0 + 16 * tt + 4 * g + i) * OD_N + 2048 + chn];
        }
        __syncthreads();
        f32x4 R[4], I[4];
#pragma unroll
        for (int tt = 0; tt < 4; ++tt) { R[tt] = (f32x4){0.f, 0.f, 0.f, 0.f}; I[tt] = R[tt]; }
#pragma unroll
        for (int kk = 0; kk < 2; ++kk) {
            const bf16x8 fr = mx::row_frag(lds + WT + nb * 64 * PW, PW, e0, kk, lane), fi = mx::row_frag(lds + WT + (2 + nb) * 64 * PW, PW, e0, kk, lane);
#pragma unroll
            for (int tt = 0; tt < 4; ++tt) { const bf16x8 a = mx::row_frag(lds + XCB + nb * 128, PX, 16 * tt, kk, lane); R[tt] = MFMA16(a, fr, R[tt]); I[tt] = MFMA16(a, fi, I[tt]); }
        }
#pragma unroll
        for (int tt = 0; tt < 4; ++tt) {
            float av[4], uv[4];
#pragma unroll
            for (int i = 0; i < 4; ++i) { const int t = 16 * tt + 4 * g + i;
                const float r = sigmoidf_(R[tt][i] + brr), ig = sigmoidf_(I[tt][i] + bii), la = -8.f * r * sp, a = __expf(la);
                av[i] = a; uv[i] = __builtin_amdgcn_sqrtf(fmaxf(1.f - a * a, 0.f)) * ig * *(const LAS float*)(lds + XCF + (t * 132 + chl) * 4); }
            float As = av[0] * av[1] * av[2] * av[3], Hs = ((uv[0] * av[1] + uv[1]) * av[2] + uv[2]) * av[3] + uv[3];
            float Ai = As, Hi = Hs;
            { const float Ap = __shfl(Ai, (lane - 16) & 63), Hp = __shfl(Hi, (lane - 16) & 63); if (g >= 1) { Hi = Hp * Ai + Hi; Ai = Ap * Ai; } }
            { const float Ap = __shfl(Ai, (lane - 32) & 63), Hp = __shfl(Hi, (lane - 32) & 63); if (g >= 2) { Hi = Hp * Ai + Hi; Ai = Ap * Ai; } }
            const float Ae = __shfl(Ai, (lane - 16) & 63), He = __shfl(Hi, (lane - 16) & 63), At = __shfl(Ai, 48 + c), Ht = __shfl(Hi, 48 + c);
            float h = g == 0 ? hcar : Ae * hcar + He;
            if (FULL) {
#pragma unroll
                for (int i = 0; i < 4; ++i) { const size_t row = row0 + 16 * tt + 4 * g + i; h = av[i] * h + uv[i];
                    YM[row * 1024 + 512 + chn] = (bf16)f2bf(h * gelu_tanh_(bf2f(gt[4 * tt + i]))); }
            }
            hcar = At * hcar + Ht; atot *= At;
        }
        __syncthreads();
    }
    if (!FULL && g == 0) { RA[chn] = atot; RH[chn] = hcar; }
}
}

constexpr int SEG_RET = 11, SEG_LRU = 21;
template <int SUB> __device__ __forceinline__ void phase_mix(Frame& F, int layer) {
    float* SG = (float*)(F.ws + WS_ST); float* BG = (float*)(F.ws + WS_ST + 16 * MiB);
    const bf16* PROJ = (const bf16*)(F.ws + WS_PROJ); bf16* YM = (bf16*)(F.ws + WS_ACT);
    float* RA = (float*)(F.ws + WS_ST + 16 * MiB + 256 * 1024); float* RH = RA + 2 * 32 * 512;
    const int S = layer == 0 ? 16 : SEG_RET;
    if (SUB == 1) {
        int tid = threadIdx.x; asm volatile("" : "+v"(tid));
        const int nel = (layer == 0 ? 16 : 8) * 16384;
        for (int idx = F.vcu * 512 + tid; idx < nel; idx += F.G * 512) {
            const int cidx = idx >> 14, e = idx & 16383, DK = (layer == 0 && cidx < 8) ? 128 : 64;
            if (e >= DK * 128) continue;
            const int d = e >> 7; float carry = 0.f;
            for (int seg = 0; seg < S; ++seg) { float* p = SG + (size_t)(cidx * S + seg) * 16384 + e; const float tmp = *p; *p = carry; carry = BG[(cidx * S + seg) * 128 + d] * carry + tmp; }
        }
        if (layer == 1) for (int idx = F.vcu * 512 + tid; idx < 1024; idx += F.G * 512) { const int bb = idx >> 9, cch = idx & 511; float carry = 0.f;
            for (int seg = 0; seg < SEG_LRU; ++seg) { const int o = (bb * SEG_LRU + seg) * 512 + cch; const float ta = RA[o], th = RH[o]; RH[o] = carry; carry = ta * carry + th; } }
        return;
    }
    for (int u = F.vcu; u < 256; u += F.G) {
        if (layer == 1 && u >= 8 * SEG_RET) {
            const int x = u - 8 * SEG_RET, bb = x / (4 * SEG_LRU), sg = (x >> 2) % SEG_LRU, cg = x & 3, c0 = (256 * sg) / SEG_LRU, nch = (256 * (sg + 1)) / SEG_LRU - c0;
            rg::unit<SUB == 2>(F.lds, PROJ, YM, F.in, bb, c0, nch, cg, RA + (bb * SEG_LRU + sg) * 512, RH + (bb * SEG_LRU + sg) * 512);
            continue;
        }
        const int cidx = u / S, seg = u % S, chain = cidx & 7;
        mx::UnitP U; U.PROJ = PROJ; U.YM = YM; U.BL = (const float*)(F.ws + WS_BLOW); U.b = chain >> 2; U.h = chain & 3; U.p2 = nullptr;
        U.c0 = (256 * seg) / S; U.nch = (256 * (seg + 1)) / S - U.c0;
        float* Sg = SG + (size_t)(cidx * S + seg) * 16384; float* Bg = BG + (cidx * S + seg) * 128;
        if (layer == 0) {
            if (cidx < 8) { U.nw = F.in[6]; U.p0 = F.in[5]; U.p1 = nullptr; mx::mix_unit<0, SUB == 2>(F.lds, Sg, Bg, U); }
            else { U.nw = F.in[9]; U.p0 = F.in[7]; U.p1 = F.in[8]; mx::mix_unit<1, SUB == 2>(F.lds, Sg, Bg, U); }
        } else { U.nw = F.in[12]; U.p0 = nullptr; U.p1 = nullptr; mx::mix_unit<2, SUB == 2>(F.lds, Sg, Bg, U); }
    }
}

__device__ __forceinline__ void moe_poff(Frame& F, int layer) {
    PHASE_IDS(F);
    LAS int* poff = (LAS int*)(F.lds + LDS_MISC + 1024);
    const unsigned* cnt = F.ctl + CW_CNT + 64 * layer;
    __syncthreads();
    if (F.tid == 0) { int acc = 0; for (int e = 0; e < 32; ++e) { const int n = (int)cnt[e]; poff[e] = acc; poff[33 + e] = n; acc += (n + 255) & ~255; } poff[32] = acc; }
    __syncthreads();
}
struct Args { const float* in[28]; float* out; unsigned char* ws; int ph_lo, ph_hi, li, pad; };
__global__ void __launch_bounds__(NWAVES * 64, 2) mega(Args args) {
    extern __shared__ __attribute__((aligned(16))) unsigned char lds[];
    Frame F;
    F.lds = (LAS unsigned char*)lds; F.tid = threadIdx.x; F.lane = F.tid & 63; F.wave = __builtin_amdgcn_readfirstlane(F.tid >> 6);
    F.G = gridDim.x; { const int bx = blockIdx.x; F.vcu = (F.G % 8 == 0) ? (bx % 8) * (F.G / 8) + bx / 8 : bx; }
    F.in = args.in; F.out = args.out; F.ws = args.ws; F.ctl = (unsigned*)(args.ws + WS_CTL);
    const int lo = args.ph_lo, hi = args.ph_hi;
    for (int u = F.tid; u < (LDS_BYTES - LDS_MISC) / 4; u += NWAVES * 64) ((LAS unsigned*)(F.lds + LDS_MISC))[u] = 0u;
    __syncthreads();
    XcdBarrier bar; bar.bar = F.ctl + CW_BAR + args.li * XCD_BAR_WORDS; bar.x = 0; bar.st = nullptr;
    if (hi - lo > 1) bar = xcd_barrier_post(F.ctl + CW_BAR + args.li * XCD_BAR_WORDS, (volatile LAS unsigned*)(F.lds + LDS_MISC + 32));
#ifndef ONLY_MASK
#define ONLY_MASK 0x7ffff
#endif
#define IN(k) (((ONLY_MASK >> (k)) & 1) && lo <= (k) && (k) < hi)
#define SEAM(k) do { if (IN(k) && IN((k) + 1)) xcd_barrier(bar); } while (0)
    bf16* ACT = (bf16*)(F.ws + WS_ACT); bf16* PROJ = (bf16*)(F.ws + WS_PROJ); bf16* H = (bf16*)(F.ws + WS_H); bf16* Y = (bf16*)(F.ws + WS_Y);
    const LAS int* poff = (const LAS int*)(F.lds + LDS_MISC + 1024);
    bf16* XR1 = (bf16*)F.out; bf16* XR2 = XR1 + (size_t)NT * D; bf16* XR3 = (bf16*)(F.ws + WS_W13);
    if (IN(0)) phase_prologue(F);
    SEAM(0);
#pragma unroll
    for (int l = 0; l < 2; ++l) {
        const int pb = 9 * l;
        if (IN(pb + 1)) {
            const int N = l == 0 ? EV_N : OD_N;
            pg8::DenseOrder S; S.init(ACT, F.ws + (l == 0 ? WS_WIN0 : WS_WIN1), NT, N, 1024, F.G, (int)blockIdx.x);
            pg8::EpiBf E{PROJ, N, 1.f};
            pg8::gemm_phase<pg8::EpiBf, pg8::DenseOrder, true>(F.lds, 1024, S, E);
        }
        SEAM(pb + 1);
#ifndef FAST_MIX
#define FAST_MIX 7
#endif
        if ((FAST_MIX >> l) & 1) {
            if (IN(pb + 2)) phase_mix<0>(F, l);
            SEAM(pb + 2);
            if (IN(pb + 3)) phase_mix<1>(F, l);
            SEAM(pb + 3);
            if (IN(pb + 4)) phase_mix<2>(F, l);
            SEAM(pb + 4);
        }
        if (IN(pb + 5)) {
            pg8::DenseOrder S; S.init(ACT, F.ws + (l == 0 ? WS_WOUT0 : WS_WOUT1), NT, 1024, 1024, F.G, (int)blockIdx.x);
            if (l == 0) { pg8::EpiRes<false> E{F.in[0], XR1, (float*)(F.ws + WS_SSQ)}; pg8::gemm_phase<pg8::EpiRes<false>, pg8::DenseOrder, true>(F.lds, 1024, S, E); }
            else { pg8::EpiRes<true> E{XR2, XR3, (float*)(F.ws + WS_SSQ)}; pg8::gemm_phase<pg8::EpiRes<true>, pg8::DenseOrder, true>(F.lds, 1024, S, E); }
        }
        SEAM(pb + 5);
        if (IN(pb + 6)) phase_router(F, l, l == 0 ? XR1 : XR3);
        SEAM(pb + 6);
        if (IN(pb + 7)) {
            moe_poff(F, l);
            pg8::MoeOrder S{poff, F.ctl + CW_CNT + 64 * l, (const int*)(F.ws + WS_LIST), (const char*)ACT, (const char*)(F.ws + WS_W13) + (size_t)l * 32 * 1024 * 1024 * 2, (size_t)1024 * 1024, 512, F.G, F.vcu, true};
            pg8::EpiUp E{(unsigned char*)H};
            pg8::gemm_phase<pg8::EpiUp, pg8::MoeOrder, true, true>(F.lds, 512, S, E);
        }
        SEAM(pb + 7);
        if (IN(pb + 8)) {
            moe_poff(F, l);
            pg8::MoeOrder S{poff, F.ctl + CW_CNT + 64 * l, (const int*)(F.ws + WS_LIST), (const char*)H, (const char*)(F.ws + WS_W2) + (size_t)l * 32 * 1024 * 512 * 2, (size_t)1024 * 512, 256, F.G, F.vcu, false};
            pg8::EpiBf E{Y, 1024, 1.f / 32.f};
            pg8::gemm_phase<pg8::EpiBf, pg8::MoeOrder, true, true>(F.lds, 256, S, E);
        }
        SEAM(pb + 8);
        if (IN(pb + 9)) phase_combine(F, l, l == 0 ? XR1 : XR3, XR2);
        SEAM(pb + 9);
    }
#undef IN
#undef SEAM
}

struct NG { const bf16* A; const bf16* Bt; int N, K; bf16* Ob; float* Of; const float* Res; const unsigned* cnt; const int* list; };
template <int MODE> __global__ void __launch_bounds__(256) k_gemm_naive(NG a) {
    __shared__ float As[16][68], Bs[16][68], Cs[16][68]; __shared__ int poff[33];
    const int t = threadIdx.x, tx = t & 15, ty = t >> 4, m0 = blockIdx.y * 64, n0 = blockIdx.x * 64, K = a.K;
    const bf16* Bt = a.Bt; int e = 0;
    if (MODE >= 2) {
        if (t == 0) { int acc = 0; for (int i = 0; i < 32; ++i) { poff[i] = acc; acc += ((int)a.cnt[i] + 255) & ~255; } poff[32] = acc; }
        __syncthreads();
        if (m0 >= poff[32]) return;
        while (m0 >= poff[e + 1]) ++e;
        Bt += (size_t)e * (MODE == 2 ? 1024 * 1024 : 1024 * 512);
    }
    const int lr = t >> 2, kq = (t & 3) * 4;
    int arow = m0 + lr;
    if (MODE == 2) { const int idx = arow - poff[e]; arow = idx < (int)a.cnt[e] ? a.list[(size_t)e * NT + idx] : 0; }
    const bf16* ap = a.A + (size_t)arow * K + kq;
    int br = n0 + lr, br2 = 0;
    if (MODE == 2) { br = 256 * (br >> 7) + (br & 127); br2 = br + 128; }
    const bf16* bp = Bt + (size_t)br * K + kq; const bf16* bp2 = Bt + (size_t)br2 * K + kq;
    float acc[4][4], acc2[4][4];
#pragma unroll
    for (int i = 0; i < 4; ++i)
#pragma unroll
        for (int j = 0; j < 4; ++j) { acc[i][j] = 0.f; acc2[i][j] = 0.f; }
    for (int k0 = 0; k0 < K; k0 += 16) {
        { const v2u w = *(const v2u*)(ap + k0); As[kq][lr] = bf2f((bf16)(w.x & 0xffff)); As[kq + 1][lr] = bf2f((bf16)(w.x >> 16)); As[kq + 2][lr] = bf2f((bf16)(w.y & 0xffff)); As[kq + 3][lr] = bf2f((bf16)(w.y >> 16)); }
        { const v2u w = *(const v2u*)(bp + k0); Bs[kq][lr] = bf2f((bf16)(w.x & 0xffff)); Bs[kq + 1][lr] = bf2f((bf16)(w.x >> 16)); Bs[kq + 2][lr] = bf2f((bf16)(w.y & 0xffff)); Bs[kq + 3][lr] = bf2f((bf16)(w.y >> 16)); }
        if (MODE == 2) { const v2u w = *(const v2u*)(bp2 + k0); Cs[kq][lr] = bf2f((bf16)(w.x & 0xffff)); Cs[kq + 1][lr] = bf2f((bf16)(w.x >> 16)); Cs[kq + 2][lr] = bf2f((bf16)(w.y & 0xffff)); Cs[kq + 3][lr] = bf2f((bf16)(w.y >> 16)); }
        __syncthreads();
#pragma unroll
        for (int k = 0; k < 16; ++k) {
            float av[4], bv[4], cv[4];
#pragma unroll
            for (int i = 0; i < 4; ++i) { av[i] = As[k][ty * 4 + i]; bv[i] = Bs[k][tx * 4 + i]; cv[i] = MODE == 2 ? Cs[k][tx * 4 + i] : 0.f; }
#pragma unroll
            for (int i = 0; i < 4; ++i)
#pragma unroll
                for (int j = 0; j < 4; ++j) { acc[i][j] += av[i] * bv[j]; if (MODE == 2) acc2[i][j] += av[i] * cv[j]; }
        }
        __syncthreads();
    }
#pragma unroll
    for (int i = 0; i < 4; ++i)
#pragma unroll
        for (int j = 0; j < 4; ++j) {
            const int m = m0 + ty * 4 + i, n = n0 + tx * 4 + j;
            if (MODE == 0) a.Ob[(size_t)m * a.N + n] = (bf16)f2bf(acc[i][j]);
            if (MODE == 1) a.Of[(size_t)m * a.N + n] = a.Res[(size_t)m * a.N + n] + acc[i][j];
            if (MODE == 2) a.Ob[(size_t)m * 512 + n] = (bf16)f2bf(siluf_(acc[i][j]) * acc2[i][j]);
            if (MODE == 3) a.Ob[(size_t)m * 1024 + n] = (bf16)f2bf(acc[i][j]);
        }
}

__global__ void __launch_bounds__(128) k_mix_even_naive(const bf16* PROJ, const float* blow, const float* lbl, const float* hnw, const float* wup, const float* bup, const float* gnw, bf16* Y) {
    const int bid = blockIdx.x, j = threadIdx.x, lane = j & 63, wv = j >> 6;
    __shared__ float sq[2][128], sk[2][128], sg[2][128], red[2][2];
    if (bid < 8) {
        const int b = bid >> 2, h = bid & 3, c = h * 128 + j;
        float lb; { const float l0 = lbl[c], l1 = lbl[512 + c], l2 = lbl[1024 + c]; const float mx = fmaxf(l0, fmaxf(l1, l2)); const float e0 = expf(l0 - mx), e1 = expf(l1 - mx), e2 = expf(l2 - mx); lb = e0 / (e0 + e1 + e2); }
        float s[128];
#pragma unroll
        for (int d = 0; d < 128; ++d) s[d] = 0.f;
        const float nw = hnw[c];
        for (int t = 0; t < SEQ; ++t) {
            const bf16* P = PROJ + (size_t)(b * SEQ + t) * EV_N; const int pb = t & 1;
            const float f = lb + (1.f - lb) * sigmoidf_(bf2f(P[512 + c]));
            sq[pb][j] = bf2f(P[c]); sk[pb][j] = 1.f - f; sg[pb][j] = f;
            const float v = bf2f(P[1024 + c]);
            __syncthreads();
            float o = 0.f;
#pragma unroll
            for (int d = 0; d < 128; ++d) { s[d] = sg[pb][d] * s[d] + sk[pb][d] * v; o += sq[pb][d] * s[d]; }
            const float ss = wave_sum(o * o); if (lane == 0) red[pb][wv] = ss;
            __syncthreads();
            const float rstd = rsqrtf((red[pb][0] + red[pb][1]) * (1.f / 128.f) + EPS);
            Y[(size_t)(b * SEQ + t) * 1024 + c] = (bf16)f2bf(o * rstd * nw * siluf_(bf2f(P[1536 + c])));
        }
    } else {
        const int b = (bid - 8) >> 2, h = bid & 3, c = h * 128 + j, dcol = h * 64 + (j & 63);
        float wu[16];
#pragma unroll
        for (int r = 0; r < 16; ++r) wu[r] = wup[r * 256 + dcol];
        const float bu = bup[dcol];
        float s[64];
#pragma unroll
        for (int d = 0; d < 64; ++d) s[d] = 0.f;
        const float nw = gnw[c];
        for (int t = 0; t < SEQ; ++t) {
            const size_t row = (size_t)b * SEQ + t;
            const bf16* P = PROJ + row * EV_N; const int pb = t & 1;
            if (j < 64) {
                float z = bu;
#pragma unroll
                for (int r = 0; r < 16; ++r) z += blow[row * 16 + r] * wu[r];
                const float ls = fminf(z, 0.f) - log1pf(expf(-fabsf(z)));
                sg[pb][j] = expf(ls * (1.f / 16.f)); sq[pb][j] = bf2f(P[2048 + dcol]) * 0.125f; sk[pb][j] = bf2f(P[2304 + dcol]);
            }
            const float v = bf2f(P[2560 + c]);
            __syncthreads();
            float o = 0.f;
#pragma unroll
            for (int d = 0; d < 64; ++d) { s[d] = sg[pb][d] * s[d] + sk[pb][d] * v; o += sq[pb][d] * s[d]; }
            const float ss = wave_sum(o * o); if (lane == 0) red[pb][wv] = ss;
            __syncthreads();
            const float rstd = rsqrtf((red[pb][0] + red[pb][1]) * (1.f / 128.f) + EPS);
            Y[row * 1024 + 512 + c] = (bf16)f2bf(o * rstd * nw * siluf_(bf2f(P[3072 + c])));
        }
    }
}

__global__ void __launch_bounds__(128) k_ret_naive(const bf16* PROJ, const float* rnw, bf16* Y) {
    const int bid = blockIdx.x, j = threadIdx.x, lane = j & 63, wv = j >> 6, b = bid >> 2, h = bid & 3, c = h * 128 + j;
    __shared__ float sq[2][64], sk[2][64], red[2][2], red2[2][2];
    const int d = j & 63, i = d & 31;
    const float ci = exp2f(-(float)i * (13.287712379549449f / 32.f)) * 0.15915494309189535f;
    const float gamma = 1.f - exp2f(-5.f - (float)h);
    float s[64];
#pragma unroll
    for (int dd = 0; dd < 64; ++dd) s[dd] = 0.f;
    const float nw = rnw[c];
    for (int t = 0; t < SEQ; ++t) {
        const size_t row = (size_t)b * SEQ + t; const bf16* P = PROJ + row * OD_N; const int pb = t & 1;
        if (j < 64) {
            float rev = (float)t * ci; rev -= floorf(rev);
            const float sn = __builtin_amdgcn_sinf(rev), cs = __builtin_amdgcn_cosf(rev);
            const float q1 = bf2f(P[h * 64 + i]), q2 = bf2f(P[h * 64 + 32 + i]), k1 = bf2f(P[256 + h * 64 + i]), k2 = bf2f(P[256 + h * 64 + 32 + i]);
            sq[pb][d] = d < 32 ? q1 * cs - q2 * sn : q1 * sn + q2 * cs;
            sk[pb][d] = (d < 32 ? k1 * cs - k2 * sn : k1 * sn + k2 * cs) * 0.125f;
        }
        const float v = bf2f(P[512 + c]);
        __syncthreads();
        float o = 0.f;
#pragma unroll
        for (int dd = 0; dd < 64; ++dd) { s[dd] = gamma * s[dd] + sk[pb][dd] * v; o += sq[pb][dd] * s[dd]; }
        const float sm = wave_sum(o); if (lane == 0) red[pb][wv] = sm;
        __syncthreads();
        const float oc = o - (red[pb][0] + red[pb][1]) * (1.f / 128.f);
        const float ss = wave_sum(oc * oc); if (lane == 0) red2[pb][wv] = ss;
        __syncthreads();
        const float rstd = rsqrtf((red2[pb][0] + red2[pb][1]) * (1.f / 128.f) + EPS);
        Y[row * 1024 + c] = (bf16)f2bf(oc * rstd * nw * siluf_(bf2f(P[1024 + c])));
    }
}

__global__ void __launch_bounds__(64) k_rglru_naive(const bf16* PROJ, const float* cw, const float* cb, const float* wr, const float* br, const float* wi, const float* bi, const float* lam, bf16* Y) {
    const int b = blockIdx.x >> 3, n = blockIdx.x & 7, e = threadIdx.x, c = n * 64 + e;
    float wrr[64], wii[64];
#pragma unroll
    for (int d = 0; d < 64; ++d) { wrr[d] = wr[(n * 64 + d) * 64 + e]; wii[d] = wi[(n * 64 + d) * 64 + e]; }
    const float c0 = cw[c], c1 = cw[512 + c], c2 = cw[1024 + c], c3 = cw[1536 + c], cbb = cb[c], brr = br[c], bii = bi[c];
    const float sp = log1pf(expf(-lam[c]));
    float x1 = 0.f, x2 = 0.f, x3 = 0.f, hh = 0.f;
    for (int t = 0; t < SEQ; ++t) {
        const size_t row = (size_t)b * SEQ + t; const bf16* P = PROJ + row * OD_N;
        const float dx = bf2f(P[1536 + c]);
        const float xc = cbb + c0 * x3 + c1 * x2 + c2 * x1 + c3 * dx;
        x3 = x2; x2 = x1; x1 = dx;
        float rp = brr, ip = bii;
#pragma unroll
        for (int d = 0; d < 64; ++d) { const float xd = __shfl(xc, d); rp += xd * wrr[d]; ip += xd * wii[d]; }
        const float r = sigmoidf_(rp), ig = sigmoidf_(ip), la = -8.f * r * sp, aa = expf(la);
        const float u = sqrtf(fmaxf(0.f, -expm1f(2.f * la))) * (ig * xc);
        hh = aa * hh + u;
        Y[row * 1024 + 512 + c] = (bf16)f2bf(hh * gelu_tanh_(bf2f(P[2048 + c])));
    }
}

extern "C" void kernel_launch(void* const* d_in, const int* in_sizes, int n_in, void* d_out, int out_size, void* d_ws, size_t ws_size, hipStream_t stream) {
    static int grid = 0;
    if (grid == 0) {
        if (n_in != 28 || out_size != NT * D || ws_size < WS_END) { fprintf(stderr, "kernel_launch: unexpected problem (n_in %d, out %d, ws %zu)\n", n_in, out_size, ws_size); grid = -1; return; }
        int dev = 0, cus = 0;
        if (hipGetDevice(&dev) != hipSuccess || hipDeviceGetAttribute(&cus, hipDeviceAttributeMultiprocessorCount, dev) != hipSuccess) { grid = -1; return; }
        if (hipFuncSetAttribute((const void*)mega, hipFuncAttributeMaxDynamicSharedMemorySize, LDS_BYTES) != hipSuccess) { fprintf(stderr, "kernel_launch: hipFuncSetAttribute failed\n"); grid = -1; return; }
        (void)hipGetLastError();
        grid = cus;
    }
    if (grid < 0) return;
    (void)hipMemsetAsync((char*)d_ws + WS_CTL, 0, CTL_BYTES, stream);
    Args a{};
    for (int i = 0; i < 28; ++i) a.in[i] = (const float*)d_in[i];
    a.out = (float*)d_out; a.ws = (unsigned char*)d_ws;
    unsigned char* ws = (unsigned char*)d_ws;
    const float* const* in = (const float* const*)a.in;
    int nli = 0;
    auto run = [&](int lo, int hi) { a.ph_lo = lo; a.ph_hi = hi; a.li = (hi - lo > 1) ? nli++ : 0; hipLaunchKernelGGL(mega, dim3(grid), dim3(NWAVES * 64), LDS_BYTES, stream, a); };
    bf16* ACT = (bf16*)(ws + WS_ACT); bf16* PROJ = (bf16*)(ws + WS_PROJ);
#ifndef FAST_MIX
#define FAST_MIX 7
#endif
    auto naive_even = [&]() { hipLaunchKernelGGL(k_mix_even_naive, dim3(16), dim3(128), 0, stream, PROJ, (const float*)(ws + WS_BLOW), in[5], in[6], in[7], in[8], in[9], ACT); };
    auto naive_ret = [&]() { hipLaunchKernelGGL(k_ret_naive, dim3(8), dim3(128), 0, stream, PROJ, in[12], ACT); };
    auto naive_lru = [&]() { hipLaunchKernelGGL(k_rglru_naive, dim3(16), dim3(64), 0, stream, PROJ, in[13], in[14], in[15], in[16], in[17], in[18], in[19], ACT); };
    if (FAST_MIX == 7) { run(0, 19); }
    else if (FAST_MIX == 1) { run(0, 11); naive_ret(); naive_lru(); run(14, 19); }
    else if (FAST_MIX == 3) { run(0, 14); naive_lru(); run(14, 19); }
    else { run(0, 2); naive_even(); run(5, 11); naive_ret(); naive_lru(); run(14, 19); }
}
```

```cpp
#include <hip/hip_runtime.h>
#include <cstdio>
#include <cstdint>

#define GAS __attribute__((address_space(1)))
#define LAS __attribute__((address_space(3)))
typedef unsigned short bf16;
typedef unsigned v4u __attribute__((ext_vector_type(4)));
typedef unsigned v2u __attribute__((ext_vector_type(2)));
typedef float f32x4 __attribute__((ext_vector_type(4)));
typedef float f32x2 __attribute__((ext_vector_type(2)));
typedef short bf16x8 __attribute__((ext_vector_type(8)));

constexpr int NT = 32768, D = 1024, SEQ = 16384;
constexpr int EV_N = 3584, OD_N = 2560, EV_LD = 3600;
constexpr float EPS = 1e-6f;
constexpr int NEXP = 32, SLOT_ROWS = 2 * NT + NEXP * 256;

constexpr size_t MiB = 1u << 20;
constexpr size_t WS_CTL = 0, CTL_BYTES = 1 * MiB;
constexpr size_t WS_WIN0 = 2 * MiB, WS_WOUT0 = 9 * MiB, WS_WIN1 = 11 * MiB, WS_WOUT1 = 16 * MiB, WS_W13 = 18 * MiB, WS_W2 = 146 * MiB;
constexpr size_t WS_ACT = 210 * MiB, WS_PROJ = 274 * MiB, WS_H = WS_PROJ, WS_Y = WS_PROJ + 72 * MiB;
constexpr size_t WS_BLOW = 498 * MiB, WS_META = 500 * MiB, WS_LIST = 501 * MiB, WS_ST = 505 * MiB, WS_SSQ = 522 * MiB, WS_END = 524 * MiB;
constexpr int CW_TMO = 0, CW_BAR = 4096, CW_CNT = 16384;

constexpr int NWAVES = 8;
constexpr int LDS_BYTES = 163840;
constexpr int LDS_MISC = 149504;

__device__ __forceinline__ float bf2f(bf16 b) { return __builtin_bit_cast(float, (unsigned)b << 16); }
__device__ __forceinline__ unsigned pk2(float lo, float hi) { unsigned r; asm("v_cvt_pk_bf16_f32 %0, %1, %2" : "=v"(r) : "v"(lo), "v"(hi)); return r; }
__device__ __forceinline__ unsigned f2bf(float f) { return pk2(f, f) & 0xffffu; }
__device__ __forceinline__ float sigmoidf_(float x) { return __builtin_amdgcn_rcpf(1.f + __expf(-x)); }
__device__ __forceinline__ float siluf_(float x) { return x * sigmoidf_(x); }
__device__ __forceinline__ float gelu_tanh_(float x) { const float u = 0.7978845608f * (x + 0.044715f * x * x * x); return x * sigmoidf_(2.f * u); }
__device__ __forceinline__ float wave_sum(float v) {
#pragma unroll
    for (int o = 1; o < 64; o <<= 1) v += __shfl_xor(v, o);
    return v;
}
#define LDS_WAIT() asm volatile("s_waitcnt lgkmcnt(0)" ::: "memory")

struct Frame {
    LAS unsigned char* lds;
    int tid, lane, wave, vcu, G;
    const float* const* in;
    float* out; unsigned char* ws;
    unsigned* ctl;
};


#define XB_TMO      128
#define XB_XCNT(j)  (256  + 64 * (j))
#define XB_XSUB(j)  (1280 + 64 * (j))
#define XB_XGEN(j)  (2304 + 64 * (j))
#define XB_TOP      3328
#define XB_TOPGEN   3392
#define XCD_BAR_WORDS 3456
#define XB_SPIN_CAP (1u << 18)
__device__ __forceinline__ unsigned xb_ld(unsigned* p)              { return __hip_atomic_load(p, __ATOMIC_RELAXED, __HIP_MEMORY_SCOPE_AGENT); }
__device__ __forceinline__ unsigned xb_add(unsigned* p, unsigned v) { return __hip_atomic_fetch_add(p, v, __ATOMIC_RELAXED, __HIP_MEMORY_SCOPE_AGENT); }
__device__ __forceinline__ unsigned xb_xcc_id() { return (unsigned)__builtin_amdgcn_s_getreg((3 << 11) | 20) & 0xFu; }
#define XB_SPIN(cond, bar) do { unsigned _sp = 0; while (cond) { __builtin_amdgcn_s_sleep(1); \
    if ((++_sp & 255u) == 0u) { if (xb_ld(&(bar)[XB_TMO])) break; if (_sp > XB_SPIN_CAP) { atomicAdd(&(bar)[XB_TMO], 1u); break; } } } } while (0)
struct XcdBarrier { unsigned* bar; unsigned x; volatile LAS unsigned* st; };
__device__ __forceinline__ XcdBarrier xcd_barrier_post(unsigned* bar, volatile LAS unsigned* st) {
    XcdBarrier b; b.bar = bar; b.x = xb_xcc_id(); b.st = st;
    if (threadIdx.x == 0) (void)xb_add(&bar[XB_XCNT(b.x)], 1u);
    return b;
}
__device__ __forceinline__ void xcd_barrier_complete(unsigned* bar, unsigned x, unsigned& nloc, unsigned& nx) {
    const unsigned G = gridDim.x * gridDim.y * gridDim.z;
    unsigned sum, cnt, mine, sp = 0u;
    for (;;) {
        sum = 0u; cnt = 0u; mine = 0u;
#pragma unroll
        for (unsigned j = 0; j < 16; ++j) { const unsigned c = xb_ld(&bar[XB_XCNT(j)]); sum += c; cnt += (c > 0u) ? 1u : 0u; mine = (j == x) ? c : mine; }
        if (sum == G) break;
        __builtin_amdgcn_s_sleep(1);
        if ((++sp & 255u) == 0u) { if (xb_ld(&bar[XB_TMO])) break; if (sp > XB_SPIN_CAP) { atomicAdd(&bar[XB_TMO], 1u); break; } }
    }
    nloc = mine > 0u ? mine : 1u; nx = cnt > 0u ? cnt : 1u;
}
__device__ __forceinline__ void xcd_barrier(const XcdBarrier& b) {
    asm volatile("s_waitcnt vmcnt(0)" ::: "memory");
    __syncthreads();
    if (threadIdx.x == 0) {
        unsigned* bar = b.bar;
        __builtin_amdgcn_s_waitcnt(0);
        unsigned nloc = b.st[0], nx = b.st[1];
        if (nloc == 0u) { xcd_barrier_complete(bar, b.x, nloc, nx); b.st[0] = nloc; b.st[1] = nx; }
        const unsigned old = xb_add(&bar[XB_XSUB(b.x)], 1u);
        const unsigned gen = old / nloc;
        if (old + 1u == (gen + 1u) * nloc) {
            __builtin_amdgcn_fence(__ATOMIC_RELEASE, "agent");
            asm volatile("s_waitcnt vmcnt(0)" ::: "memory");
            const unsigned og = xb_add(&bar[XB_TOP], 1u);
            const unsigned tg = og / nx;
            if (og + 1u == (tg + 1u) * nx) xb_add(&bar[XB_TOPGEN], 1u);
            else XB_SPIN(xb_ld(&bar[XB_TOPGEN]) == tg, bar);
            __builtin_amdgcn_fence(__ATOMIC_ACQUIRE, "agent");
            xb_add(&bar[XB_XGEN(b.x)], 1u);
            asm volatile("s_waitcnt vmcnt(0)" ::: "memory");
        } else {
            XB_SPIN(xb_ld(&bar[XB_XGEN(b.x)]) == gen, bar);
            __builtin_amdgcn_fence(__ATOMIC_ACQUIRE, "agent");
            asm volatile("s_waitcnt vmcnt(0)" ::: "memory");
        }
    }
    __syncthreads();
}

namespace pg8 {
typedef unsigned u32x4 __attribute__((ext_vector_type(4)));
typedef int i32x4 __attribute__((ext_vector_type(4)));
typedef int i32x8 __attribute__((ext_vector_type(8)));
constexpr int BM = 256, BK = 64, HALF = 128, HTB = HALF * BK * 2, STAGE_BYTES = 8 * HTB, NXCD = 8, WGM = 8;
__host__ __device__ __forceinline__ int lds_byte(int r, int c) { const int st = (r >> 4) * 2 + (c >> 5), rr = r & 15, cc = c & 31, ob = rr * 64 + cc * 2; return st * 1024 + (ob ^ (((ob >> 9) & 1) << 5)); }
__host__ __device__ __forceinline__ void stage_rc(int b, int& R, int& C) { const int st = b / 1024, sb = b % 1024, swz = sb ^ (((sb >> 9) & 1) << 5); R = (st >> 1) * 16 + swz / 64; C = (st & 1) * 32 + (swz % 64) / 2; }
__host__ __device__ __forceinline__ int perm32(int rho) { const int n = rho >> 4, i = rho & 15; return 8 * (i >> 2) + 4 * n + (i & 3); }
struct Unit { int pm, pn, e; };
__device__ __forceinline__ unsigned cvt_pk_bf16(float lo, float hi) { return pk2(lo, hi); }

struct DenseOrder {
    int nM, nN, nwg, G, c, K; const char* A; const char* Bt;
    __device__ __forceinline__ void init(const void* A_, const void* Bt_, int M, int N, int K_, int G_, int c_) { A = (const char*)A_; Bt = (const char*)Bt_; nM = M / BM; nN = N / BM; nwg = nM * nN; G = G_; c = c_; K = K_; }
    __device__ __forceinline__ bool next(int i, Unit& u) const {
        const long L = (long)i * G + c; if (L >= nwg) return false;
        int wgid = (int)L; { const int q = nwg / NXCD, r = nwg % NXCD, xcd = wgid % NXCD, off = wgid / NXCD; wgid = (xcd < r ? xcd * (q + 1) : r * (q + 1) + (xcd - r) * q) + off; }
        const int nig = WGM * nN, gid = wgid / nig, fm = gid * WGM, gsz = (nM - fm) < WGM ? (nM - fm) : WGM;
        u.pm = fm + ((wgid % nig) % gsz); u.pn = (wgid % nig) / gsz; u.e = 0; return true;
    }
    __device__ __forceinline__ unsigned a_off(const Unit& u, int r) const { return (unsigned)((u.pm * BM + r) * K) * 2u; }
    __device__ __forceinline__ const char* b_ptr(const Unit& u) const { return Bt + (size_t)u.pn * BM * K * 2; }
};
struct MoeOrder {
    const LAS int* poff; const unsigned* cnt; const int* list; const char* A; const char* Bt; size_t estride; int K, G, c; bool gather;
    __device__ __forceinline__ bool next(int i, Unit& u) const {
        const int L = i * G + c, np = __builtin_amdgcn_readfirstlane(poff[32]) >> 8; if (L >= np * 4) return false;
        u.pm = L >> 2; u.pn = L & 3; const int row = u.pm << 8; int e = 0;
        while (row >= __builtin_amdgcn_readfirstlane(poff[e + 1])) ++e;
        u.e = e; return true;
    }
    __device__ __forceinline__ unsigned a_off(const Unit& u, int r) const {
        if (!gather) return (unsigned)((u.pm * BM + r) * K) * 2u;
        const int idx = min(u.pm * BM + r - poff[u.e], poff[33 + u.e] - 1);
        return (unsigned)list[(size_t)u.e * NT + idx] * (unsigned)(K * 2);
    }
    __device__ __forceinline__ const char* b_ptr(const Unit& u) const { return Bt + (size_t)u.e * estride + (size_t)u.pn * BM * K * 2; }
};

struct EpiBf {
    static constexpr bool PERM = true;
    bf16* O; int ldc; float scale;
    __device__ __forceinline__ void operator()(const f32x4 (&acc)[2][2][4][2], const Unit& u, int wr, int wc, int fr, int fq) const {
        const int row0 = u.pm * BM + wr * 64 + fr, col0 = u.pn * BM + wc * 32 + 8 * fq;
#pragma unroll
        for (int ai = 0; ai < 2; ++ai)
#pragma unroll
            for (int m = 0; m < 4; ++m) { bf16* rowp = O + (size_t)(row0 + ai * HALF + m * 16) * ldc + col0;
#pragma unroll
                for (int bj = 0; bj < 2; ++bj) { const f32x4 v0 = acc[ai][bj][m][0] * scale, v1 = acc[ai][bj][m][1] * scale;
                    u32x4 w; w.x = cvt_pk_bf16(v0[0], v0[1]); w.y = cvt_pk_bf16(v0[2], v0[3]); w.z = cvt_pk_bf16(v1[0], v1[1]); w.w = cvt_pk_bf16(v1[2], v1[3]);
                    *(u32x4*)(rowp + bj * HALF) = w; } }
    }
};
template <bool RES_BF16>
struct EpiRes {
    static constexpr bool PERM = true;
    const void* res; bf16* xout; float* ssq;
    __device__ __forceinline__ void operator()(const f32x4 (&acc)[2][2][4][2], const Unit& u, int wr, int wc, int fr, int fq) const {
        const int row0 = u.pm * BM + wr * 64 + fr, col0 = u.pn * BM + wc * 32 + 8 * fq;
#pragma unroll
        for (int ai = 0; ai < 2; ++ai) {
            f32x4 r0[4][2], r1[4][2];
#pragma unroll
            for (int m = 0; m < 4; ++m) { const size_t off = (size_t)(row0 + ai * HALF + m * 16) * 1024 + col0;
#pragma unroll
                for (int bj = 0; bj < 2; ++bj) {
                    if (RES_BF16) { const u32x4 rw = *(const u32x4*)((const bf16*)res + off + bj * HALF);
                        r0[m][bj] = (f32x4){__builtin_bit_cast(float, rw.x << 16), __builtin_bit_cast(float, rw.x & 0xffff0000u), __builtin_bit_cast(float, rw.y << 16), __builtin_bit_cast(float, rw.y & 0xffff0000u)};
                        r1[m][bj] = (f32x4){__builtin_bit_cast(float, rw.z << 16), __builtin_bit_cast(float, rw.z & 0xffff0000u), __builtin_bit_cast(float, rw.w << 16), __builtin_bit_cast(float, rw.w & 0xffff0000u)}; }
                    else { r0[m][bj] = *(const f32x4*)((const float*)res + off + bj * HALF); r1[m][bj] = *(const f32x4*)((const float*)res + off + bj * HALF + 4); } } }
#pragma unroll
            for (int m = 0; m < 4; ++m) { const int row = row0 + ai * HALF + m * 16; const size_t off = (size_t)row * 1024 + col0; float ss = 0.f;
#pragma unroll
                for (int bj = 0; bj < 2; ++bj) {
                    const f32x4 v0 = r0[m][bj] + acc[ai][bj][m][0], v1 = r1[m][bj] + acc[ai][bj][m][1];
                    ss += ((v0[0] * v0[0] + v0[1] * v0[1]) + (v0[2] * v0[2] + v0[3] * v0[3])) + ((v1[0] * v1[0] + v1[1] * v1[1]) + (v1[2] * v1[2] + v1[3] * v1[3]));
                    u32x4 w; w.x = cvt_pk_bf16(v0[0], v0[1]); w.y = cvt_pk_bf16(v0[2], v0[3]); w.z = cvt_pk_bf16(v1[0], v1[1]); w.w = cvt_pk_bf16(v1[2], v1[3]);
                    *(u32x4*)(xout + off + bj * HALF) = w; }
                ss += __shfl_xor(ss, 16); ss += __shfl_xor(ss, 32);
                if (fq == 0) ssq[(size_t)row * 16 + u.pn * 4 + wc] = ss; }
            asm volatile("" ::: "memory");
        }
    }
};
__device__ __forceinline__ unsigned pk4_fp8(float a, float b, float c, float d) { int p = __builtin_amdgcn_cvt_pk_fp8_f32(a, b, 0, false); return (unsigned)__builtin_amdgcn_cvt_pk_fp8_f32(c, d, p, true); }
struct EpiUp {
    static constexpr bool PERM = true;
    unsigned char* H;
    __device__ __forceinline__ void operator()(const f32x4 (&acc)[2][2][4][2], const Unit& u, int wr, int wc, int fr, int fq) const {
        const int row0 = u.pm * BM + wr * 64 + fr, col0 = u.pn * HALF + wc * 32 + 8 * fq;
#pragma unroll
        for (int ai = 0; ai < 2; ++ai)
#pragma unroll
            for (int m = 0; m < 4; ++m) { unsigned char* rowp = H + (size_t)(row0 + ai * HALF + m * 16) * 512 + col0;
                float h[8];
#pragma unroll
                for (int n = 0; n < 2; ++n)
#pragma unroll
                    for (int i = 0; i < 4; ++i) { const float a = acc[ai][0][m][n][i] * (1.f / 32.f), b = acc[ai][1][m][n][i] * (1.f / 32.f); h[n * 4 + i] = a * __builtin_amdgcn_rcpf(1.f + __expf(-a)) * b; }
                v2u w; w.x = pk4_fp8(h[0], h[1], h[2], h[3]); w.y = pk4_fp8(h[4], h[5], h[6], h[7]);
                *(v2u*)rowp = w; }
    }
};

template <class Epi, class Sched, bool ALIGN_EPI, bool FP8 = false>
__device__ __forceinline__ void gemm_phase(LAS unsigned char* lds, const int K_, const Sched& S, const Epi& E) {
    int K = K_; asm volatile("" : "+s"(K));
    int tid = threadIdx.x; asm volatile("" : "+v"(tid));
    const int wid = __builtin_amdgcn_readfirstlane(tid >> 6), lane = tid & 63, wr = wid >> 2, wc = wid & 3, fr = lane & 15, fq = lane >> 4;
    const int nt = K / BK;
    unsigned voffB[2];
#pragma unroll
    for (int i = 0; i < 2; ++i) { int R, C; stage_rc(tid * 16 + i * 8192, R, C); const int Rb = Epi::PERM ? ((R & ~31) + perm32(R & 31)) : R; voffB[i] = (unsigned)(Rb * K + C) * 2u; }
#define PG8_AOFF(u, o0, o1, o2, o3) do { int R0_, C0_, R1_, C1_; stage_rc(tid * 16, R0_, C0_); stage_rc(tid * 16 + 8192, R1_, C1_); \
        o0 = S.a_off(u, R0_) + (unsigned)C0_ * 2u; o1 = S.a_off(u, R1_) + (unsigned)C1_ * 2u; o2 = S.a_off(u, HALF + R0_) + (unsigned)C0_ * 2u; o3 = S.a_off(u, HALF + R1_) + (unsigned)C1_ * 2u; } while (0)
    const size_t kstep = (size_t)(BK * 2);
    const size_t hstep = (size_t)HALF * K * 2;
    const unsigned ldsw = (unsigned)wid * 1024u;
    const int aoff = lds_byte(wr * 64 + fr, fq * 8), boff = lds_byte(wc * 32 + fr, fq * 8);
    const char* const A0 = S.A;
#define PG8_SA(b, h) (((b) * 2 + (h)) * HTB)
#define PG8_SB(b, h) ((4 + (b) * 2 + (h)) * HTB)
#define PG8_STAGE(bufoff, gbase, voff) do { _Pragma("unroll") for (int _i = 0; _i < 2; ++_i) \
        __builtin_amdgcn_global_load_lds((const unsigned*)((const char*)(gbase) + (voff)[_i]), (LAS unsigned*)(lds + (bufoff) + ldsw + _i * 8192), 16, 0, 0); } while (0)
#define PG8_STAGEA(bufoff, kbyte, o0, o1) do { \
        __builtin_amdgcn_global_load_lds((const unsigned*)(A0 + (kbyte) + (o0)), (LAS unsigned*)(lds + (bufoff) + ldsw), 16, 0, 0); \
        __builtin_amdgcn_global_load_lds((const unsigned*)(A0 + (kbyte) + (o1)), (LAS unsigned*)(lds + (bufoff) + ldsw + 8192), 16, 0, 0); } while (0)
#define PG8_LD8(p) __builtin_shufflevector(*(const LAS i32x4*)(p), *(const LAS i32x4*)((p) + 1024), 0, 1, 2, 3, 4, 5, 6, 7)
#define PG8_LDA(dst, b, h) do { _Pragma("unroll") for (int m = 0; m < 4; ++m) dst[m] = PG8_LD8(lds + PG8_SA(b, h) + aoff + m * 2048); } while (0)
#define PG8_LDB(dst, b, h) do { _Pragma("unroll") for (int n = 0; n < 2; ++n) dst[n] = PG8_LD8(lds + PG8_SB(b, h) + boff + n * 2048); } while (0)
#define PG8_H(x, k) __builtin_bit_cast(bf16x8, __builtin_shufflevector(x, x, 4 * (k), 4 * (k) + 1, 4 * (k) + 2, 4 * (k) + 3))
#define PG8_MMA(ai, bj, At, Bt) do { __builtin_amdgcn_s_setprio(1); _Pragma("unroll") for (int m = 0; m < 4; ++m) _Pragma("unroll") for (int n = 0; n < 2; ++n) { \
        if constexpr (FP8) acc[ai][bj][m][n] = __builtin_amdgcn_mfma_scale_f32_16x16x128_f8f6f4(Bt[n], At[m], acc[ai][bj][m][n], 0, 0, 0, 0x7f7f7f7f, 0, 0x7f7f7f7f); \
        else { acc[ai][bj][m][n] = __builtin_amdgcn_mfma_f32_16x16x32_bf16(PG8_H(Bt[n], 0), PG8_H(At[m], 0), acc[ai][bj][m][n], 0, 0, 0); \
               acc[ai][bj][m][n] = __builtin_amdgcn_mfma_f32_16x16x32_bf16(PG8_H(Bt[n], 1), PG8_H(At[m], 1), acc[ai][bj][m][n], 0, 0, 0); } } \
        __builtin_amdgcn_s_setprio(0); } while (0)
#define PG8_WAIT_V(n) asm volatile("s_waitcnt vmcnt(" #n ")" ::: "memory")
#define PG8_WAIT_L(n) asm volatile("s_waitcnt lgkmcnt(" #n ")" ::: "memory")
#define PG8_BAR __builtin_amdgcn_s_barrier()
#define PG8_SCHED __builtin_amdgcn_sched_barrier(0)
    Unit cur, nxt; int ui = 0;
    if (!S.next(0, cur)) return;
    f32x4 acc[2][2][4][2];
#pragma unroll
    for (int a = 0; a < 2; ++a)
#pragma unroll
        for (int b = 0; b < 2; ++b)
#pragma unroll
            for (int m = 0; m < 4; ++m)
#pragma unroll
                for (int n = 0; n < 2; ++n) acc[a][b][m][n] = (f32x4){0.f, 0.f, 0.f, 0.f};
    i32x8 At[4], B0[2], B1[2];
    unsigned oc00, oc01, oc10, oc11, on00, on01, on10, on11;
    PG8_AOFF(cur, oc00, oc01, oc10, oc11);
    const char* cB = S.b_ptr(cur);
    PG8_STAGE(PG8_SB(0, 0), cB, voffB); PG8_STAGE(PG8_SB(0, 1), cB + hstep, voffB); PG8_STAGEA(PG8_SA(0, 0), 0, oc00, oc01); PG8_STAGEA(PG8_SA(0, 1), 0, oc10, oc11);
    if (wr == 1) PG8_BAR;
    PG8_WAIT_V(2); PG8_BAR;
    PG8_STAGE(PG8_SB(1, 0), cB + kstep, voffB); PG8_STAGEA(PG8_SA(1, 0), kstep, oc00, oc01); PG8_STAGE(PG8_SB(1, 1), cB + hstep + kstep, voffB);
    PG8_WAIT_V(6); PG8_BAR;
    for (;;) {
        const bool has_next = S.next(ui + 1, nxt);
        const char* nB = cB;
        on00 = oc00; on01 = oc01; on10 = oc10; on11 = oc11;
        if (has_next) { nB = S.b_ptr(nxt); PG8_AOFF(nxt, on00, on01, on10, on11); }
#pragma unroll 1
        for (int t = 0; t < nt; t += 2) {
            const bool last = (t == nt - 2);
            const size_t k1 = (size_t)(t + 1) * kstep, k2 = last ? 0 : (size_t)(t + 2) * kstep, k3 = k2 + kstep;
            const char* b2 = last ? nB : cB + (size_t)(t + 2) * kstep; const char* b3 = b2 + kstep;
            PG8_LDB(B0, 0, 0); PG8_LDB(B1, 0, 1); PG8_SCHED; PG8_LDA(At, 0, 0); PG8_STAGEA(PG8_SA(1, 1), k1, oc10, oc11);
            if (last) { oc00 = on00; oc01 = on01; oc10 = on10; oc11 = on11; }
            PG8_WAIT_V(8); PG8_WAIT_L(0); PG8_BAR; PG8_MMA(0, 0, At, B0); PG8_MMA(0, 1, At, B1); PG8_BAR; PG8_SCHED;
            PG8_LDA(At, 0, 1); PG8_STAGE(PG8_SB(0, 0), b2, voffB); PG8_STAGE(PG8_SB(0, 1), b2 + hstep, voffB); PG8_STAGEA(PG8_SA(0, 0), k2, oc00, oc01);
            PG8_WAIT_V(8); PG8_WAIT_L(0); PG8_BAR; PG8_MMA(1, 0, At, B0); PG8_MMA(1, 1, At, B1); PG8_BAR; PG8_SCHED;
            PG8_LDB(B0, 1, 0); PG8_LDB(B1, 1, 1); PG8_SCHED; PG8_LDA(At, 1, 0); PG8_STAGEA(PG8_SA(0, 1), k2, oc10, oc11);
            PG8_WAIT_V(8); PG8_WAIT_L(0); PG8_BAR; PG8_MMA(0, 0, At, B0); PG8_MMA(0, 1, At, B1); PG8_BAR; PG8_SCHED;
            PG8_LDA(At, 1, 1); PG8_STAGE(PG8_SB(1, 0), b3, voffB); PG8_STAGE(PG8_SB(1, 1), b3 + hstep, voffB); PG8_STAGEA(PG8_SA(1, 0), k3, oc00, oc01);
            PG8_WAIT_V(8); PG8_WAIT_L(0); PG8_BAR; PG8_MMA(1, 0, At, B0); PG8_MMA(1, 1, At, B1); PG8_BAR; PG8_SCHED;
        }
        if constexpr (ALIGN_EPI) { if (wr == 0) PG8_BAR; }
        E(acc, cur, wr, wc, fr, fq);
        if (!has_next) break;
#pragma unroll
        for (int a = 0; a < 2; ++a)
#pragma unroll
            for (int b = 0; b < 2; ++b)
#pragma unroll
                for (int m = 0; m < 4; ++m)
#pragma unroll
                    for (int n = 0; n < 2; ++n) acc[a][b][m][n] = (f32x4){0.f, 0.f, 0.f, 0.f};
        cur = nxt; cB = nB; ++ui;
        if constexpr (ALIGN_EPI) { if (wr == 1) PG8_BAR; }
    }
    PG8_WAIT_V(0);
    if constexpr (!ALIGN_EPI) { if (wr == 0) PG8_BAR; }
    PG8_BAR;
#undef PG8_SA
#undef PG8_SB
#undef PG8_STAGE
#undef PG8_STAGEA
#undef PG8_AOFF
#undef PG8_LDA
#undef PG8_LDB
#undef PG8_MMA
#undef PG8_LD8
#undef PG8_H
#undef PG8_WAIT_V
#undef PG8_WAIT_L
#undef PG8_BAR
#undef PG8_SCHED
}
}

#define PHASE_IDS(F) do { int _t = threadIdx.x; asm volatile("" : "+v"(_t)); (F).tid = _t; (F).lane = _t & 63; (F).wave = __builtin_amdgcn_readfirstlane(_t >> 6); } while (0)
struct TrItem { const float* W; bf16* WT; int ldw, K, mode, f8; };
__device__ __forceinline__ void tr_load(float (&tv)[32], const TrItem& t, int wave, int lane) {
#pragma unroll
    for (int i = 0; i < 32; ++i) tv[i] = t.W[(size_t)(8 * wave + (i >> 2)) * t.ldw + 64 * (i & 3) + lane];
}
__device__ __forceinline__ void tr_store(const float (&tv)[32], const TrItem& t, LAS float* scr, int wave, int lane) {
#pragma unroll
    for (int i = 0; i < 32; ++i) scr[(8 * wave + (i >> 2)) * 257 + 64 * (i & 3) + lane] = tv[i];
    __syncthreads();
    const int c = lane & 7;
#pragma unroll
    for (int j = 0; j < 4; ++j) { const int n = 32 * wave + 8 * j + (lane >> 3); const LAS float* s = scr + (8 * c) * 257 + n;
        v4u o; o.x = pk2(s[0 * 257], s[1 * 257]); o.y = pk2(s[2 * 257], s[3 * 257]); o.z = pk2(s[4 * 257], s[5 * 257]); o.w = pk2(s[6 * 257], s[7 * 257]);
        const int drow = t.mode ? 256 * (n >> 7) + (n & 127) : n;
        if (t.f8) { v2u o8; o8.x = pg8::pk4_fp8(s[0 * 257] * 32.f, s[1 * 257] * 32.f, s[2 * 257] * 32.f, s[3 * 257] * 32.f); o8.y = pg8::pk4_fp8(s[4 * 257] * 32.f, s[5 * 257] * 32.f, s[6 * 257] * 32.f, s[7 * 257] * 32.f);
            *(v2u*)((unsigned char*)t.WT + (size_t)drow * t.K + 8 * c) = o8; }
        else *(v4u*)(t.WT + (size_t)drow * t.K + 8 * c) = o; }
    __syncthreads();
}

__device__ __forceinline__ void phase_prologue(Frame& F) {
    PHASE_IDS(F);
    LAS float* WL = (LAS float*)F.lds;
    LAS float* scr = (LAS float*)(F.lds + 65536);
    const float* w_in0 = F.in[4];
    for (int s0 = F.tid; s0 < 16 * 1024; s0 += 512 * 16) { float t[16];
#pragma unroll
        for (int i = 0; i < 16; ++i) { const int s = s0 + 512 * i; t[i] = w_in0[(size_t)(s >> 4) * EV_LD + 3072 + (s & 15)]; }
#pragma unroll
        for (int i = 0; i < 16; ++i) { const int s = s0 + 512 * i; WL[(s & 15) * 1024 + (s >> 4)] = t[i]; } }
    const int gw = F.vcu * NWAVES + F.wave, NGW = F.G * NWAVES;
    bf16* WIN0 = (bf16*)(F.ws + WS_WIN0); bf16* WOUT0 = (bf16*)(F.ws + WS_WOUT0); bf16* WIN1 = (bf16*)(F.ws + WS_WIN1); bf16* WOUT1 = (bf16*)(F.ws + WS_WOUT1);
    bf16* W13 = (bf16*)(F.ws + WS_W13); bf16* W2 = (bf16*)(F.ws + WS_W2);
    constexpr int I_A = 16 * 12, I_B = 16 * 2, I_C = 16 * 4, I_D = 16 * 10, I_E = 16 * 4, I_F = 2 * 32 * 2 * 32, I_G = 2 * 32 * 32;
    constexpr int NITEMS = I_A + I_B + I_C + I_D + I_E + I_F + I_G;
    auto decode = [&](int it) {
        TrItem t; int r = it; t.mode = 0; t.f8 = 0;
        if (r < I_A) { const int kb = r / 12, nb = r % 12; t.ldw = EV_LD; t.K = 1024; t.W = w_in0 + (size_t)(64 * kb) * EV_LD + 256 * nb; t.WT = WIN0 + (size_t)(256 * nb) * 1024 + 64 * kb; return t; } r -= I_A;
        if (r < I_B) { const int kb = r / 2, nb = r % 2; t.ldw = EV_LD; t.K = 1024; t.W = w_in0 + (size_t)(64 * kb) * EV_LD + 3088 + 256 * nb; t.WT = WIN0 + (size_t)(3072 + 256 * nb) * 1024 + 64 * kb; return t; } r -= I_B;
        if (r < I_C) { const int kb = r / 4, nb = r % 4; t.ldw = 1024; t.K = 1024; t.W = F.in[10] + (size_t)(64 * kb) * 1024 + 256 * nb; t.WT = WOUT0 + (size_t)(256 * nb) * 1024 + 64 * kb; return t; } r -= I_C;
        if (r < I_D) { const int kb = r / 10, nb = r % 10; t.ldw = OD_N; t.K = 1024; t.W = F.in[11] + (size_t)(64 * kb) * OD_N + 256 * nb; t.WT = WIN1 + (size_t)(256 * nb) * 1024 + 64 * kb; return t; } r -= I_D;
        if (r < I_E) { const int kb = r / 4, nb = r % 4; t.ldw = 1024; t.K = 1024; t.W = F.in[20] + (size_t)(64 * kb) * 1024 + 256 * nb; t.WT = WOUT1 + (size_t)(256 * nb) * 1024 + 64 * kb; return t; } r -= I_E;
        if (r < I_F) { const int le = r / 64, q = r % 64, which = q / 32, kb = (q % 32) / 2, nb = q % 2;
            t.ldw = 512; t.K = 1024; t.mode = 1; t.f8 = 1; t.W = (which ? F.in[26] : F.in[25]) + (size_t)le * 1024 * 512 + (size_t)(64 * kb) * 512 + 256 * nb;
            t.WT = (bf16*)((unsigned char*)(W13 + (size_t)(le >> 5) * 32 * 1024 * 1024) + (size_t)(le & 31) * 1024 * 1024 + (size_t)(512 * nb + which * 128) * 1024 + 64 * kb); return t; } r -= I_F;
        { const int le = r / 32, q = r % 32, kb = q / 4, nb = q % 4;
            t.ldw = 1024; t.K = 512; t.f8 = 1; t.W = F.in[27] + (size_t)le * 512 * 1024 + (size_t)(64 * kb) * 1024 + 256 * nb;
            t.WT = (bf16*)((unsigned char*)(W2 + (size_t)(le >> 5) * 32 * 1024 * 512) + (size_t)(le & 31) * 1024 * 512 + (size_t)(256 * nb) * 512 + 64 * kb); return t; }
    };
    __syncthreads();
    {
        float ta[32], tb[32]; TrItem da, db; int it = F.vcu;
        if (it < NITEMS) { da = decode(it); tr_load(ta, da, F.wave, F.lane); }
        while (it < NITEMS) {
            const int i1 = it + F.G, i2 = it + 2 * F.G;
            if (i1 < NITEMS) { db = decode(i1); tr_load(tb, db, F.wave, F.lane); }
            tr_store(ta, da, scr, F.wave, F.lane);
            if (i1 >= NITEMS) break;
            if (i2 < NITEMS) { da = decode(i2); tr_load(ta, da, F.wave, F.lane); }
            tr_store(tb, db, scr, F.wave, F.lane);
            it = i2;
        }
    }
    __syncthreads();
    const float* x = F.in[0]; const float* g = F.in[1];
    bf16* XN = (bf16*)(F.ws + WS_ACT); float* BL = (float*)(F.ws + WS_BLOW);
    f32x4 gv[4];
#pragma unroll
    for (int j = 0; j < 4; ++j) gv[j] = *((const f32x4*)g + 64 * j + F.lane);
    for (int m = gw; m < NT; m += NGW) {
        asm volatile("" ::: "memory");
        const f32x4* xr = (const f32x4*)(x + (size_t)m * D) + F.lane;
        f32x4 v[4]; float s = 0.f;
#pragma unroll
        for (int j = 0; j < 4; ++j) { v[j] = xr[64 * j]; s += (v[j].x * v[j].x + v[j].y * v[j].y) + (v[j].z * v[j].z + v[j].w * v[j].w); }
        const float rstd = rsqrtf(wave_sum(s) * (1.f / D) + EPS);
        v2u* o8 = (v2u*)(XN + (size_t)m * D) + F.lane;
#pragma unroll
        for (int j = 0; j < 4; ++j) { v[j] = v[j] * rstd * gv[j]; v2u w; w.x = pk2(v[j].x, v[j].y); w.y = pk2(v[j].z, v[j].w); o8[64 * j] = w; }
        float p[16];
#pragma unroll
        for (int o = 0; o < 16; ++o) {
            const LAS f32x4* wl = (const LAS f32x4*)(WL + o * 1024) + F.lane; float a = 0.f;
#pragma unroll
            for (int j = 0; j < 4; ++j) { const f32x4 w = wl[64 * j]; a += (v[j].x * w.x + v[j].y * w.y) + (v[j].z * w.z + v[j].w * w.w); }
            p[o] = a;
        }
#pragma unroll
        for (int o = 0; o < 8; ++o) { const bool hi = (F.lane & 32) != 0; const float snd = hi ? p[o] : p[o + 8], kp = hi ? p[o + 8] : p[o]; p[o] = kp + __shfl_xor(snd, 32); }
#pragma unroll
        for (int o = 0; o < 4; ++o) { const bool hi = (F.lane & 16) != 0; const float snd = hi ? p[o] : p[o + 4], kp = hi ? p[o + 4] : p[o]; p[o] = kp + __shfl_xor(snd, 16); }
#pragma unroll
        for (int o = 0; o < 2; ++o) { const bool hi = (F.lane & 8) != 0; const float snd = hi ? p[o] : p[o + 2], kp = hi ? p[o + 2] : p[o]; p[o] = kp + __shfl_xor(snd, 8); }
        { const bool hi = (F.lane & 4) != 0; const float snd = hi ? p[0] : p[1], kp = hi ? p[1] : p[0]; p[0] = kp + __shfl_xor(snd, 4); }
        p[0] += __shfl_xor(p[0], 2); p[0] += __shfl_xor(p[0], 1);
        if ((F.lane & 3) == 0) BL[(size_t)m * 16 + ((F.lane >> 5) & 1) * 8 + ((F.lane >> 4) & 1) * 4 + ((F.lane >> 3) & 1) * 2 + ((F.lane >> 2) & 1)] = p[0];
    }
}

__device__ __forceinline__ float row16_max(float v) { v = fmaxf(v, __shfl_xor(v, 1)); v = fmaxf(v, __shfl_xor(v, 2)); v = fmaxf(v, __shfl_xor(v, 4)); return fmaxf(v, __shfl_xor(v, 8)); }
__device__ __forceinline__ float row16_sum(float v) { v += __shfl_xor(v, 1); v += __shfl_xor(v, 2); v += __shfl_xor(v, 4); return v + __shfl_xor(v, 8); }
__device__ __forceinline__ int row16_min(int v) { v = min(v, __shfl_xor(v, 1)); v = min(v, __shfl_xor(v, 2)); v = min(v, __shfl_xor(v, 4)); return min(v, __shfl_xor(v, 8)); }
__device__ __forceinline__ void phase_router(Frame& F, int layer, const bf16* XR) {
    PHASE_IDS(F);
    constexpr int PW = 2064;
    LAS unsigned char* WH = F.lds; LAS unsigned char* WLO = F.lds + 36 * PW;
    LAS float* GL = (LAS float*)(F.lds + LDS_MISC + 1024);
    LAS int* hist = (LAS int*)(F.lds + LDS_MISC + 1024 + 4096); LAS int* base = hist + 32;
    LAS int* s_e0 = base + 32; LAS int* s_e1 = s_e0 + 128; LAS int* s_r0 = s_e1 + 128; LAS int* s_r1 = s_r0 + 128;
    LAS float* s_w0 = (LAS float*)(s_r1 + 128); LAS float* s_w1 = s_w0 + 128;
    const float* wg = F.in[21] + (size_t)layer * 1024 * 4; const float* we = F.in[23] + (size_t)layer * 1024 * 32;
    const float* g = F.in[2] + layer * 1024;
    for (int s = F.tid; s < 1024; s += 512) GL[s] = g[s];
    __syncthreads();
    for (int s0 = F.tid; s0 < 4096 + 32768; s0 += 512 * 18) {
        float t[18];
#pragma unroll
        for (int i = 0; i < 18; ++i) { const int s = s0 + 512 * i; t[i] = s < 4096 ? wg[s] : we[s - 4096]; }
#pragma unroll
        for (int i = 0; i < 18; ++i) { const int s = s0 + 512 * i; const int k = s < 4096 ? (s >> 2) : ((s - 4096) >> 5), o = s < 4096 ? (s & 3) : 4 + ((s - 4096) & 31);
            const float w = t[i] * GL[k]; const unsigned hb = f2bf(w);
            *(LAS bf16*)(WH + o * PW + k * 2) = (bf16)hb; *(LAS bf16*)(WLO + o * PW + k * 2) = (bf16)f2bf(w - bf2f((bf16)hb)); } }
    const int c = F.lane & 15, q = F.lane >> 4;
    float bias[3];
#pragma unroll
    for (int jt = 0; jt < 3; ++jt) { const int col = 16 * jt + c; bias[jt] = col < 4 ? F.in[22][layer * 4 + col] : (col < 36 ? F.in[24][layer * 32 + col - 4] : 0.f); }
    unsigned* cnt = F.ctl + CW_CNT + 64 * layer;
    bf16* XN = (bf16*)(F.ws + WS_ACT); const float* SSQ = (const float*)(F.ws + WS_SSQ);
    int* ME0 = (int*)(F.ws + WS_META); int* ME1 = ME0 + NT; int* MR0 = ME1 + NT; int* MR1 = MR0 + NT; float* MW0 = (float*)(MR1 + NT); float* MW1 = MW0 + NT;
    int* LIST = (int*)(F.ws + WS_LIST);
    int wrow[3];
#pragma unroll
    for (int jt = 0; jt < 3; ++jt) wrow[jt] = min(16 * jt + c, 35) * PW + 16 * q;
    __syncthreads();
    for (int row0 = 128 * F.vcu; row0 < NT; row0 += 128 * F.G) {
        if (F.tid < 32) hist[F.tid] = 0;
        __syncthreads();
        const int rl = F.wave * 16, row = row0 + rl + c;
        float rstd; { const f32x4 sp = *(const f32x4*)(SSQ + (size_t)row * 16 + 4 * q); float s = (sp[0] + sp[1]) + (sp[2] + sp[3]); s += __shfl_xor(s, 16); s += __shfl_xor(s, 32); rstd = rsqrtf(s * (1.f / D) + EPS); }
        const bf16* xr = XR + (size_t)row * D + 8 * q; unsigned char* xo = (unsigned char*)XN + (size_t)row * D + 8 * q;
        f32x4 acc[3];
#pragma unroll
        for (int jt = 0; jt < 3; ++jt) acc[jt] = (f32x4){0.f, 0.f, 0.f, 0.f};
        for (int k4 = 0; k4 < 32; k4 += 8) {
            v4u xw[8];
#pragma unroll
            for (int u = 0; u < 8; ++u) xw[u] = *(const v4u*)(xr + 32 * (k4 + u));
#pragma unroll
            for (int u = 0; u < 8; ++u) {
                const int kk = k4 + u;
                const f32x4 ga = *(const LAS f32x4*)(GL + 32 * kk + 8 * q), gb = *(const LAS f32x4*)(GL + 32 * kk + 8 * q + 4);
                const v4u w = xw[u];
#define BLO(x) __builtin_bit_cast(float, (x) << 16)
#define BHI(x) __builtin_bit_cast(float, (x) & 0xffff0000u)
                v2u xn; xn.x = pg8::pk4_fp8(BLO(w.x) * rstd * ga[0], BHI(w.x) * rstd * ga[1], BLO(w.y) * rstd * ga[2], BHI(w.y) * rstd * ga[3]);
                xn.y = pg8::pk4_fp8(BLO(w.z) * rstd * gb[0], BHI(w.z) * rstd * gb[1], BLO(w.w) * rstd * gb[2], BHI(w.w) * rstd * gb[3]);
#undef BLO
#undef BHI
                *(v2u*)(xo + 32 * kk) = xn;
                const bf16x8 ah = __builtin_bit_cast(bf16x8, w);
#pragma unroll
                for (int jt = 0; jt < 3; ++jt) { const bf16x8 bh = *(const LAS bf16x8*)(WH + wrow[jt] + 64 * kk), bl = *(const LAS bf16x8*)(WLO + wrow[jt] + 64 * kk);
                    acc[jt] = __builtin_amdgcn_mfma_f32_16x16x32_bf16(ah, bh, acc[jt], 0, 0, 0); acc[jt] = __builtin_amdgcn_mfma_f32_16x16x32_bf16(ah, bl, acc[jt], 0, 0, 0); }
            }
        }
#pragma unroll
        for (int i = 0; i < 4; ++i) {
            const float rs = __shfl(rstd, 4 * q + i);
            const float l0 = acc[0][i] * rs + bias[0], l1 = acc[1][i] * rs + bias[1], l2 = acc[2][i] * rs + bias[2];
            const float gvl = c < 4 ? l0 : -3.0e38f;
            const float gmax = row16_max(gvl); const int gi = row16_min(gvl == gmax ? c : 99);
            const float gwt = 1.f / row16_sum(c < 4 ? __expf(gvl - gmax) : 0.f);
            const int jt = c < 4 ? (gi == 1 ? 1 : 2) : (c < 12 ? (gi == 0 ? 0 : 1) : (gi == 1 ? 0 : 1));
            const bool valid = c < 4 ? (gi == 1 || gi == 3) : (c < 12 ? (gi == 0 || gi == 2) : (gi == 1 || gi == 3));
            const int eidx = 16 * jt + c - 4 - 8 * gi;
            float cv = jt == 0 ? l0 : (jt == 1 ? l1 : l2); cv = (valid && eidx >= 0 && eidx < 8) ? cv : -3.0e38f;
            const float v0 = row16_max(cv); const int i0 = row16_min(cv == v0 ? eidx : 99);
            const float cv2 = eidx == i0 ? -3.0e38f : cv;
            const float v1 = row16_max(cv2); const int i1 = row16_min(cv2 == v1 ? eidx : 99);
            const float ex = __expf(v1 - v0), tw0 = 1.f / (1.f + ex), tw1 = ex / (1.f + ex);
            if (c == 0) { const int r = rl + 4 * q + i, e0 = gi * 8 + i0, e1 = gi * 8 + i1;
                s_e0[r] = e0; s_e1[r] = e1; s_w0[r] = gwt * tw0; s_w1[r] = gwt * tw1;
                s_r0[r] = atomicAdd((int*)&hist[e0], 1); s_r1[r] = atomicAdd((int*)&hist[e1], 1); }
        }
        __syncthreads();
        if (F.tid < 32) base[F.tid] = (int)atomicAdd(cnt + F.tid, (unsigned)hist[F.tid]);
        __syncthreads();
        if (F.tid < 128) {
            const int m = row0 + F.tid, e0 = s_e0[F.tid], e1 = s_e1[F.tid], r0 = base[e0] + s_r0[F.tid], r1 = base[e1] + s_r1[F.tid];
            ME0[m] = e0; ME1[m] = e1; MR0[m] = r0; MR1[m] = r1; MW0[m] = s_w0[F.tid]; MW1[m] = s_w1[F.tid];
            LIST[(size_t)e0 * NT + r0] = m; LIST[(size_t)e1 * NT + r1] = m;
        }
        __syncthreads();
    }
}

__device__ __forceinline__ void phase_combine(Frame& F, int layer, const bf16* XRin, bf16* XRout) {
    PHASE_IDS(F);
    LAS int* poff = (LAS int*)(F.lds + LDS_MISC + 1024);
    const unsigned* cnt = F.ctl + CW_CNT + 64 * layer;
    if (F.tid < 32) poff[33 + F.tid] = (int)cnt[F.tid];
    __syncthreads();
    if (F.tid == 0) { int acc = 0; for (int e = 0; e < 32; ++e) { poff[e] = acc; acc += (poff[33 + e] + 255) & ~255; } poff[32] = acc; }
    __syncthreads();
    const int gw = F.vcu * NWAVES + F.wave, NGW = F.G * NWAVES;
    const float* g = layer == 0 ? F.in[1] + 1024 : F.in[3];
    const bf16* Y = (const bf16*)(F.ws + WS_Y); bf16* XN = (bf16*)(F.ws + WS_ACT);
    const int* ME0 = (const int*)(F.ws + WS_META); const int* ME1 = ME0 + NT; const int* MR0 = ME1 + NT; const int* MR1 = MR0 + NT; const float* MW0 = (const float*)(MR1 + NT); const float* MW1 = MW0 + NT;
    f32x4 gv[4];
#pragma unroll
    for (int j = 0; j < 4; ++j) gv[j] = *((const f32x4*)g + 64 * j + F.lane);
    for (int m0 = gw; m0 < NT; m0 += 2 * NGW) {
        int mr[2]; mr[0] = m0; mr[1] = (m0 + NGW < NT) ? m0 + NGW : m0;
        f32x4 v[2][4]; v2u ya[2][4], yb[2][4]; float w0[2], w1[2];
#pragma unroll
        for (int r = 0; r < 2; ++r) {
            const int m = mr[r]; const int s0 = poff[ME0[m]] + MR0[m], s1 = poff[ME1[m]] + MR1[m]; w0[r] = MW0[m]; w1[r] = MW1[m];
            const v2u* xr = (const v2u*)(XRin + (size_t)m * D) + F.lane;
            const v2u* y0 = (const v2u*)(Y + (size_t)s0 * D) + F.lane; const v2u* y1 = (const v2u*)(Y + (size_t)s1 * D) + F.lane;
#pragma unroll
            for (int j = 0; j < 4; ++j) { const v2u xw = xr[64 * j]; v[r][j] = (f32x4){bf2f((bf16)(xw.x & 0xffff)), bf2f((bf16)(xw.x >> 16)), bf2f((bf16)(xw.y & 0xffff)), bf2f((bf16)(xw.y >> 16))}; ya[r][j] = y0[64 * j]; yb[r][j] = y1[64 * j]; }
        }
#pragma unroll
        for (int r = 0; r < 2; ++r) {
            const int m = mr[r]; float s = 0.f;
            f32x4* xr = (f32x4*)(F.out + (size_t)m * D) + F.lane; v2u* xo2 = (v2u*)(XRout + (size_t)m * D) + F.lane;
#pragma unroll
            for (int j = 0; j < 4; ++j) { const v2u a = ya[r][j], b = yb[r][j];
                v[r][j].x += w0[r] * bf2f((bf16)(a.x & 0xffff)) + w1[r] * bf2f((bf16)(b.x & 0xffff)); v[r][j].y += w0[r] * bf2f((bf16)(a.x >> 16)) + w1[r] * bf2f((bf16)(b.x >> 16));
                v[r][j].z += w0[r] * bf2f((bf16)(a.y & 0xffff)) + w1[r] * bf2f((bf16)(b.y & 0xffff)); v[r][j].w += w0[r] * bf2f((bf16)(a.y >> 16)) + w1[r] * bf2f((bf16)(b.y >> 16));
                s += (v[r][j].x * v[r][j].x + v[r][j].y * v[r][j].y) + (v[r][j].z * v[r][j].z + v[r][j].w * v[r][j].w); }
            const float rstd = rsqrtf(wave_sum(s) * (1.f / D) + EPS);
            if (r == 1 && mr[1] == mr[0]) continue;
            if (layer == 0) {
                v2u* o8 = (v2u*)(XN + (size_t)m * D) + F.lane;
#pragma unroll
                for (int j = 0; j < 4; ++j) { v2u xw; xw.x = pk2(v[r][j].x, v[r][j].y); xw.y = pk2(v[r][j].z, v[r][j].w); xo2[64 * j] = xw; const f32x4 n = v[r][j] * rstd * gv[j]; v2u w; w.x = pk2(n.x, n.y); w.y = pk2(n.z, n.w); o8[64 * j] = w; }
            } else {
#pragma unroll
                for (int j = 0; j < 4; ++j) xr[64 * j] = v[r][j] * rstd * gv[j];
            }
        }
    }
}


namespace mx {
typedef short s4 __attribute__((ext_vector_type(4)));
constexpr int PV = 272, PP = 144;
template <int DK> struct Lay { static constexpr int PK = DK * 2 + 16, QS = 0, KS = 64 * PK, VV = 2 * 64 * PK, ST = VV + 64 * PV, PM = ST + 128 * PK, VEC = PM + 64 * PP, PART = VEC + 3 * DK * 4, RED = PART + 8 * DK * 4, BLS = RED + 4096, END = BLS + 4096; };
static_assert(Lay<128>::END <= LDS_MISC, "mixer LDS map");
__device__ __forceinline__ bf16x8 row_frag(const LAS unsigned char* base, int pitch, int row0, int kk, int lane) {
    return *(const LAS bf16x8*)(base + (row0 + (lane & 15)) * pitch + (32 * kk + 8 * (lane >> 4)) * 2);
}
__device__ __forceinline__ bf16x8 tr_frag(const LAS unsigned char* base, int pitch, int k0, int c0, int lane) {
    const int g = lane >> 4, q = (lane & 15) >> 2, p = lane & 3;
    const LAS unsigned char* a = base + (k0 + 8 * g + q) * pitch + (c0 + 4 * p) * 2;
    const s4 lo = __builtin_amdgcn_ds_read_tr16_b64_v4i16((LAS s4*)a);
    const s4 hi = __builtin_amdgcn_ds_read_tr16_b64_v4i16((LAS s4*)(a + 4 * pitch));
    return __builtin_shufflevector(lo, hi, 0, 1, 2, 3, 4, 5, 6, 7);
}
#define MFMA16(a, b, c) __builtin_amdgcn_mfma_f32_16x16x32_bf16(a, b, c, 0, 0, 0)

struct UnitP { const bf16* PROJ; bf16* YM; const float* nw; const float* BL; const float* p0; const float* p1; const float* p2; int b, h, c0, nch, seg; };

template <int KIND> struct KC {
    static constexpr int DK = KIND == 0 ? 128 : 64, LDP = KIND == 2 ? OD_N : EV_N;
    __device__ static __forceinline__ int qcol(int h) { return KIND == 0 ? h * 128 : (KIND == 1 ? 2048 + h * 64 : h * 64); }
    __device__ static __forceinline__ int kcol(int h) { return KIND == 0 ? 512 + h * 128 : (KIND == 1 ? 2304 + h * 64 : 256 + h * 64); }
    __device__ static __forceinline__ int vcol(int h) { return KIND == 0 ? 1024 + h * 128 : (KIND == 1 ? 2560 + h * 128 : 512 + h * 128); }
    __device__ static __forceinline__ int gcol(int h) { return KIND == 0 ? 1536 + h * 128 : (KIND == 1 ? 3072 + h * 128 : 1024 + h * 128); }
    __device__ static __forceinline__ int ocol(int h) { return KIND == 1 ? 512 + h * 128 : h * 128; }
};

template <int KIND, bool FULL>
__device__ __forceinline__ void mix_unit(LAS unsigned char* lds, float* Sg, float* Bg, const UnitP& U) {
    using K = KC<KIND>; constexpr int DK = K::DK, LDP = K::LDP, NJT = DK == 128 ? 8 : 4; using L = Lay<DK>; constexpr int PK = L::PK;
    int tid = threadIdx.x; asm volatile("" : "+v"(tid));
    const int lane = tid & 63, wave = __builtin_amdgcn_readfirstlane(tid >> 6), g = lane >> 4, c = lane & 15;
    const int h = U.h, dt = DK == 128 ? wave : (wave & 3), jt0 = DK == 128 ? 0 : 4 * (wave >> 2);
    LAS float* EM = (LAS float*)(lds + L::VEC); LAS float* EL = EM + DK; LAS float* BT = EL + DK; LAS float* PART = (LAS float*)(lds + L::PART);
    float lb0 = 0.f, lb1 = 0.f, wu[16], bu = 0.f, ci = 0.f, lgg = 0.f;
    if (KIND == 0) {
        const float* lbl = U.p0; const int col = h * 128 + 2 * lane;
#pragma unroll
        for (int x = 0; x < 2; ++x) { const float l0 = lbl[col + x], l1 = lbl[512 + col + x], l2 = lbl[1024 + col + x]; const float mx_ = fmaxf(l0, fmaxf(l1, l2));
            const float e0 = __expf(l0 - mx_), e1 = __expf(l1 - mx_), e2 = __expf(l2 - mx_); const float v = e0 / (e0 + e1 + e2); if (x == 0) lb0 = v; else lb1 = v; }
    }
    if (KIND == 1) {
#pragma unroll
        for (int r = 0; r < 16; ++r) wu[r] = U.p0[r * 256 + h * 64 + lane];
        bu = U.p1[h * 64 + lane];
    }
    if (KIND == 2) { ci = exp2f(-(float)(lane & 31) * (13.287712379549449f / 32.f)) * 0.15915494309189535f; lgg = log1pf(-exp2f(-5.f - (float)h)); }
    f32x4 S[NJT];
#pragma unroll
    for (int jt = 0; jt < NJT; ++jt) {
        S[jt] = (f32x4){0.f, 0.f, 0.f, 0.f};
    }
    if (FULL) {
        f32x4 L[NJT], D4 = (f32x4){0.f, 0.f, 0.f, 0.f};
        auto ldseg = [&](int s) { const float* Sp = Sg + (ptrdiff_t)s * 16384; D4 = *(const f32x4*)(Bg + s * 128 + 16 * dt + 4 * g);
#pragma unroll
            for (int jt = 0; jt < NJT; ++jt)
#pragma unroll
                for (int i = 0; i < 4; ++i) L[jt][i] = Sp[(16 * dt + 4 * g + i) * 128 + 16 * (jt0 + jt) + c]; };
        if (U.seg > 0) ldseg(-U.seg);
        for (int s = -U.seg; s < 0; ++s) {
            f32x4 Lc[NJT]; const f32x4 Dc = D4;
#pragma unroll
            for (int jt = 0; jt < NJT; ++jt) Lc[jt] = L[jt];
            if (s + 1 < 0) ldseg(s + 1);
#pragma unroll
            for (int jt = 0; jt < NJT; ++jt) S[jt] = Dc * S[jt] + Lc[jt];
        }
    }
    f32x4 nw4[4];
    if (FULL) {
#pragma unroll
        for (int x = 0; x < 4; ++x) nw4[x] = *(const f32x4*)(U.nw + h * 128 + 16 * (4 * (wave >> 2) + x) + 4 * g);
    }
    if (tid < DK) BT[tid] = KIND == 0 ? 1.f : 0.f;
    v4u rv0, rv1; unsigned ra[8], rb[8]; f32x4 rbl = (f32x4){0.f, 0.f, 0.f, 0.f};
    auto load_raw = [&](int ch) {
        const size_t row0 = (size_t)U.b * SEQ + (U.c0 + ch) * 64;
        const bf16* Vp = U.PROJ + (row0 + (tid >> 3)) * LDP + K::vcol(h) + (tid & 7) * 16;
        rv0 = *(const v4u*)Vp; rv1 = *(const v4u*)(Vp + 8);
        if (KIND == 1 && tid < 256) rbl = *(const f32x4*)(U.BL + (row0 + (tid >> 2)) * 16 + (tid & 3) * 4);
        if (KIND == 0) {
            const bf16* P = U.PROJ + (row0 + 8 * wave) * LDP + 2 * lane;
#pragma unroll
            for (int tt = 0; tt < 8; ++tt) { ra[tt] = *(const unsigned*)(P + (size_t)tt * LDP + K::kcol(h)); if (FULL) rb[tt] = *(const unsigned*)(P + (size_t)tt * LDP + K::qcol(h)); }
        } else {
            const bf16* P = U.PROJ + (row0 + 8 * wave) * LDP + lane;
#pragma unroll
            for (int tt = 0; tt < 8; ++tt) { ra[tt] = P[(size_t)tt * LDP + K::kcol(h)]; if (FULL) rb[tt] = P[(size_t)tt * LDP + K::qcol(h)]; }
        }
    };
    load_raw(0);
    for (int ch = 0; ch < U.nch; ++ch) {
        const int pos0 = (U.c0 + ch) * 64; const size_t row0 = (size_t)U.b * SEQ + pos0;
        *(LAS v4u*)(lds + L::VV + (tid >> 3) * PV + (tid & 7) * 32) = rv0; *(LAS v4u*)(lds + L::VV + (tid >> 3) * PV + (tid & 7) * 32 + 16) = rv1;
        if (KIND == 0) {
            float cp0[8], cp1[8], k0[8], k1[8]; float c0 = 1.f, c1 = 1.f;
#pragma unroll
            for (int tt = 0; tt < 8; ++tt) {
                const float f0 = lb0 + (1.f - lb0) * sigmoidf_(bf2f((bf16)(ra[tt] & 0xffff))), f1 = lb1 + (1.f - lb1) * sigmoidf_(bf2f((bf16)(ra[tt] >> 16)));
                c0 *= f0; c1 *= f1; cp0[tt] = c0; cp1[tt] = c1; k0[tt] = 1.f - f0; k1[tt] = 1.f - f1;
            }
            *(LAS f32x2*)(PART + wave * 128 + 2 * lane) = (f32x2){c0, c1};
            __syncthreads();
            float pre0 = 1.f, pre1 = 1.f, mid0 = 1.f, mid1 = 1.f, hi0 = 1.f, hi1 = 1.f;
#pragma unroll
            for (int w2 = 0; w2 < 8; ++w2) { const f32x2 p = *(const LAS f32x2*)(PART + w2 * 128 + 2 * lane);
                if (w2 < 4) { mid0 *= p.x; mid1 *= p.y; } else { hi0 *= p.x; hi1 *= p.y; }
                if (wave < 4 ? (w2 > wave && w2 < 4) : (w2 >= 4 && w2 < wave)) { pre0 *= p.x; pre1 *= p.y; } }
#pragma unroll
            for (int tt = 0; tt < 8; ++tt) {
                float qs0, qs1, ks0, ks1;
                if (wave >= 4) { qs0 = pre0 * cp0[tt]; qs1 = pre1 * cp1[tt]; ks0 = __builtin_amdgcn_rcpf(fmaxf(qs0, 1e-26f)); ks1 = __builtin_amdgcn_rcpf(fmaxf(qs1, 1e-26f)); }
                else { ks0 = pre0 * c0 * __builtin_amdgcn_rcpf(fmaxf(cp0[tt], 1e-26f)); ks1 = pre1 * c1 * __builtin_amdgcn_rcpf(fmaxf(cp1[tt], 1e-26f));
                       qs0 = __builtin_amdgcn_rcpf(fmaxf(ks0, 1e-26f)); qs1 = __builtin_amdgcn_rcpf(fmaxf(ks1, 1e-26f)); }
                *(LAS unsigned*)(lds + L::KS + (8 * wave + tt) * PK + 4 * lane) = pg8::cvt_pk_bf16(k0[tt] * ks0, k1[tt] * ks1);
                if (FULL) *(LAS unsigned*)(lds + L::QS + (8 * wave + tt) * PK + 4 * lane) = pg8::cvt_pk_bf16(bf2f((bf16)(rb[tt] & 0xffff)) * qs0, bf2f((bf16)(rb[tt] >> 16)) * qs1);
            }
            if (wave == 0) { *(LAS f32x2*)(EM + 2 * lane) = (f32x2){mid0, mid1}; *(LAS f32x2*)(EL + 2 * lane) = (f32x2){hi0, hi1};
                const f32x2 o = *(const LAS f32x2*)(BT + 2 * lane); *(LAS f32x2*)(BT + 2 * lane) = (f32x2){o.x * mid0 * hi0, o.y * mid1 * hi1}; }
        } else if (KIND == 1) {
            LAS float* BLS = (LAS float*)(lds + L::BLS);
            if (tid < 256) *(LAS f32x4*)(BLS + (tid >> 2) * 16 + (tid & 3) * 4) = rbl;
            __syncthreads();
            float cs[8]; float cc = 0.f;
#pragma unroll
            for (int tt = 0; tt < 8; ++tt) {
                const LAS f32x4* bl = (const LAS f32x4*)(BLS + (8 * wave + tt) * 16); float z = bu;
#pragma unroll
                for (int r = 0; r < 4; ++r) { const f32x4 bq = bl[r]; z += (bq[0] * wu[4 * r] + bq[1] * wu[4 * r + 1]) + (bq[2] * wu[4 * r + 2] + bq[3] * wu[4 * r + 3]); }
                const float ls = fminf(z, 0.f) - __logf(1.f + __expf(-fabsf(z)));
                cc += ls * (1.f / 16.f); cs[tt] = cc;
            }
            PART[wave * 64 + lane] = cc;
            __syncthreads();
            float off = 0.f, mid = 0.f, tot = 0.f;
#pragma unroll
            for (int w2 = 0; w2 < 8; ++w2) { const float p = PART[w2 * 64 + lane]; if (w2 < wave) off += p; if (w2 < 4) mid += p; tot += p; }
#pragma unroll
            for (int tt = 0; tt < 8; ++tt) {
                const float b = off + cs[tt];
                *(LAS bf16*)(lds + L::KS + (8 * wave + tt) * PK + 2 * lane) = (bf16)f2bf(bf2f((bf16)ra[tt]) * __expf(fminf(mid - b, 60.f)));
                if (FULL) *(LAS bf16*)(lds + L::QS + (8 * wave + tt) * PK + 2 * lane) = (bf16)f2bf(bf2f((bf16)rb[tt]) * 0.125f * __expf(fminf(b - mid, 60.f)));
            }
            if (wave == 0) { EM[lane] = __expf(mid); EL[lane] = __expf(tot - mid); BT[lane] += tot; }
        } else {
#pragma unroll
            for (int tt = 0; tt < 8; ++tt) {
                const int tl = 8 * wave + tt; float rev = (float)(pos0 + tl) * ci; rev -= floorf(rev);
                const float sn = __builtin_amdgcn_sinf(rev), cs = __builtin_amdgcn_cosf(rev);
                const float e = (float)(tl - 31) * lgg;
                const float kv = bf2f((bf16)ra[tt]), kp = __shfl_xor(kv, 32);
                const float kr = (lane < 32 ? kv * cs - kp * sn : kp * sn + kv * cs) * 0.125f;
                *(LAS bf16*)(lds + L::KS + tl * PK + 2 * lane) = (bf16)f2bf(kr * __expf(-e));
                if (FULL) { const float qv = bf2f((bf16)rb[tt]), qp = __shfl_xor(qv, 32); const float qr = lane < 32 ? qv * cs - qp * sn : qp * sn + qv * cs;
                    *(LAS bf16*)(lds + L::QS + tl * PK + 2 * lane) = (bf16)f2bf(qr * __expf(e)); }
            }
            if (wave == 0) { const float e32 = __expf(32.f * lgg); EM[lane] = e32; EL[lane] = e32; BT[lane] += 64.f * lgg; }
        }
        if (ch + 1 < U.nch) load_raw(ch + 1);
        v2u gq[4];
        if (FULL) { const bf16* gp = U.PROJ + (row0 + 16 * (wave & 3) + c) * LDP + K::gcol(h) + 16 * (4 * (wave >> 2)) + 4 * g;
#pragma unroll
            for (int x = 0; x < 4; ++x) gq[x] = *(const v2u*)(gp + 16 * x); }
        __syncthreads();
        { const f32x4 em4 = *(const LAS f32x4*)(EM + 16 * dt + 4 * g);
#pragma unroll
          for (int jt = 0; jt < NJT; ++jt) { S[jt] = S[jt] * em4;
              if (FULL) { v2u w; w.x = pg8::cvt_pk_bf16(S[jt][0], S[jt][1]); w.y = pg8::cvt_pk_bf16(S[jt][2], S[jt][3]);
                  *(LAS v2u*)(lds + L::ST + (16 * (jt0 + jt) + c) * PK + (16 * dt + 4 * g) * 2) = w; } } }
        if (FULL) {
            const int st = wave & 3, tt0 = 2 * (wave >> 2);
            f32x4 p0 = (f32x4){0.f, 0.f, 0.f, 0.f}, p1 = p0;
#pragma unroll
            for (int kk = 0; kk < DK / 32; ++kk) { const bf16x8 a = row_frag(lds + L::KS, PK, 16 * st, kk, lane);
                p0 = MFMA16(a, row_frag(lds + L::QS, PK, 16 * tt0, kk, lane), p0); p1 = MFMA16(a, row_frag(lds + L::QS, PK, 16 * (tt0 + 1), kk, lane), p1); }
#pragma unroll
            for (int x = 0; x < 2; ++x) { const f32x4 p = x ? p1 : p0; const int t = 16 * (tt0 + x) + c, s = 16 * st + 4 * g;
                v2u w; w.x = pg8::cvt_pk_bf16(s <= t ? p[0] : 0.f, s + 1 <= t ? p[1] : 0.f); w.y = pg8::cvt_pk_bf16(s + 2 <= t ? p[2] : 0.f, s + 3 <= t ? p[3] : 0.f);
                *(LAS v2u*)(lds + L::PM + t * PP + s * 2) = w; }
        }
        {
#pragma unroll
          for (int kk = 0; kk < 2; ++kk) { const bf16x8 a = tr_frag(lds + L::KS, PK, 32 * kk, 16 * dt, lane);
#pragma unroll
              for (int jt = 0; jt < NJT; ++jt) S[jt] = MFMA16(a, tr_frag(lds + L::VV, PV, 32 * kk, 16 * (jt0 + jt), lane), S[jt]); }
          const f32x4 el4 = *(const LAS f32x4*)(EL + 16 * dt + 4 * g);
#pragma unroll
          for (int jt = 0; jt < NJT; ++jt) S[jt] = S[jt] * el4;
        }
        __syncthreads();
        if (FULL) {
            const int tt = wave & 3, jh = wave >> 2, t = 16 * tt + c;
            f32x4 o[4];
#pragma unroll
            for (int x = 0; x < 4; ++x) o[x] = (f32x4){0.f, 0.f, 0.f, 0.f};
#pragma unroll
            for (int kk = 0; kk < 2; ++kk) { const bf16x8 bb = row_frag(lds + L::PM, PP, 16 * tt, kk, lane);
#pragma unroll
                for (int x = 0; x < 4; ++x) o[x] = MFMA16(tr_frag(lds + L::VV, PV, 32 * kk, 16 * (4 * jh + x), lane), bb, o[x]); }
#pragma unroll
            for (int kk = 0; kk < DK / 32; ++kk) { const bf16x8 bb = row_frag(lds + L::QS, PK, 16 * tt, kk, lane);
#pragma unroll
                for (int x = 0; x < 4; ++x) o[x] = MFMA16(row_frag(lds + L::ST, PK, 16 * (4 * jh + x), kk, lane), bb, o[x]); }
            float sm = 0.f, sq = 0.f;
#pragma unroll
            for (int x = 0; x < 4; ++x)
#pragma unroll
                for (int i = 0; i < 4; ++i) { sm += o[x][i]; sq += o[x][i] * o[x][i]; }
            sm += __shfl_xor(sm, 16); sq += __shfl_xor(sq, 16); sm += __shfl_xor(sm, 32); sq += __shfl_xor(sq, 32);
            LAS f32x2* RED = (LAS f32x2*)(lds + L::RED) + (ch & 1) * 128;
            if (g == 0) RED[jh * 64 + t] = (f32x2){sm, sq};
            __syncthreads();
            const f32x2 r0 = RED[t], r1 = RED[64 + t];
            const float mean = KIND == 2 ? (r0.x + r1.x) * (1.f / 128.f) : 0.f;
            const float rstd = rsqrtf(fmaxf((r0.y + r1.y) * (1.f / 128.f) - mean * mean, 0.f) + EPS);
            bf16* yp = U.YM + (row0 + t) * 1024 + K::ocol(h) + 16 * (4 * jh) + 4 * g;
#pragma unroll
            for (int x = 0; x < 4; ++x) {
                const float g0 = bf2f((bf16)(gq[x].x & 0xffff)), g1 = bf2f((bf16)(gq[x].x >> 16)), g2 = bf2f((bf16)(gq[x].y & 0xffff)), g3 = bf2f((bf16)(gq[x].y >> 16));
                v2u w; w.x = pg8::cvt_pk_bf16((o[x][0] - mean) * rstd * nw4[x][0] * siluf_(g0), (o[x][1] - mean) * rstd * nw4[x][1] * siluf_(g1));
                w.y = pg8::cvt_pk_bf16((o[x][2] - mean) * rstd * nw4[x][2] * siluf_(g2), (o[x][3] - mean) * rstd * nw4[x][3] * siluf_(g3));
                *(v2u*)(yp + 16 * x) = w; }
        }
    }
    if (!FULL) {
#pragma unroll
        for (int jt = 0; jt < NJT; ++jt)
#pragma unroll
            for (int i = 0; i < 4; ++i) Sg[(16 * dt + 4 * g + i) * 128 + 16 * (jt0 + jt) + c] = S[jt][i];
        __syncthreads();
        if (tid < DK) Bg[tid] = KIND == 0 ? BT[tid] : __expf(BT[tid]);
    }
    __syncthreads();
}
}


namespace rg {
constexpr int SEGMAX = 21;
constexpr int PX = 272, PW = 144, XCB = 0, XCF = 64 * PX, WT = XCF + 64 * 132 * 4, END = WT + 4 * 64 * PW;
static_assert(END <= LDS_MISC, "rglru LDS map");
template <bool FULL>
__device__ __forceinline__ void unit(LAS unsigned char* lds, const bf16* PROJ, bf16* YM, const float* const* in, int b, int c0, int nch, int sgi, int cg, float* RA, float* RH) {
    int tid = threadIdx.x; asm volatile("" : "+v"(tid));
    const int lane = tid & 63, wave = __builtin_amdgcn_readfirstlane(tid >> 6), g = lane >> 4, c = lane & 15;
    const int n0 = 2 * cg, chbase = cg * 128;
    const float* w_r = in[15]; const float* w_i = in[17];
    for (int i0 = tid; i0 < 4 * 4096; i0 += 512 * 16) { float t[16];
#pragma unroll
        for (int x = 0; x < 16; ++x) { const int i = i0 + 512 * x, m = i >> 12, gate = m >> 1, nb = m & 1, d = (i >> 6) & 63, e = i & 63; t[x] = (gate ? w_i : w_r)[((n0 + nb) * 64 + d) * 64 + e]; }
#pragma unroll
        for (int x = 0; x < 16; ++x) { const int i = i0 + 512 * x, m = i >> 12, d = (i >> 6) & 63, e = i & 63; *(LAS bf16*)(lds + WT + m * 64 * PW + e * PW + d * 2) = (bf16)f2bf(t[x]); } }
    float cw0[4], cw1[4]; const int cc = chbase + 2 * lane;
#pragma unroll
    for (int j = 0; j < 4; ++j) { cw0[j] = in[13][j * 512 + cc]; cw1[j] = in[13][j * 512 + cc + 1]; }
    const float cb0 = in[14][cc], cb1 = in[14][cc + 1];
    const int nb = wave >> 2, e0 = 16 * (wave & 3), chl = nb * 64 + e0 + c, chn = chbase + chl;
    const float brr = in[16][chn], bii = in[18][chn], sp = __logf(1.f + __expf(-in[19][chn]));
    float hcar = 0.f, atot = 1.f;
    if (FULL) {
        float fa[SEGMAX], fh[SEGMAX];
#pragma unroll
        for (int s = 0; s < SEGMAX; ++s) { const bool ok = s < sgi; fa[s] = ok ? RA[(s - sgi) * 512 + chn] : 1.f; fh[s] = ok ? RH[(s - sgi) * 512 + chn] : 0.f; }
#pragma unroll
        for (int s = 0; s < SEGMAX; ++s) hcar = s < sgi ? fa[s] * hcar + fh[s] : hcar;
    }
    unsigned xw[11];
    auto load_x = [&](int ch) {
#pragma unroll
        for (int r = 0; r < 11; ++r) { const int pos = (c0 + ch) * 64 + 8 * wave - 3 + r; xw[r] = 0u;
            if (pos >= 0) xw[r] = *(const unsigned*)(PROJ + ((size_t)b * SEQ + pos) * OD_N + 1536 + cc); }
    };
    load_x(0);
    __syncthreads();
    for (int ch = 0; ch < nch; ++ch) {
        const int pos0 = (c0 + ch) * 64; const size_t row0 = (size_t)b * SEQ + pos0;
        {
            float x0[11], x1[11];
#pragma unroll
            for (int r = 0; r < 11; ++r) { x0[r] = bf2f((bf16)(xw[r] & 0xffff)); x1[r] = bf2f((bf16)(xw[r] >> 16)); }
#pragma unroll
            for (int tt = 0; tt < 8; ++tt) {
                const float a0 = cb0 + cw0[0] * x0[tt] + cw0[1] * x0[tt + 1] + cw0[2] * x0[tt + 2] + cw0[3] * x0[tt + 3];
                const float a1 = cb1 + cw1[0] * x1[tt] + cw1[1] * x1[tt + 1] + cw1[2] * x1[tt + 2] + cw1[3] * x1[tt + 3];
                *(LAS unsigned*)(lds + XCB + (8 * wave + tt) * PX + 4 * lane) = pg8::cvt_pk_bf16(a0, a1);
                *(LAS f32x2*)(lds + XCF + ((8 * wave + tt) * 132 + 2 * lane) * 4) = (f32x2){a0, a1};
            }
        }
        if (ch + 1 < nch) load_x(ch + 1);
        bf16 gt[16];
        if (FULL) {
#pragma unroll
            for (int tt = 0; tt < 4; ++tt)
#pragma unroll
                for (int i = 0; i < 4; ++i) gt[4 * tt + i] = PROJ[(row0 + 16 * tt + 4 * g + i) * OD_N + 2048 + chn];
        }
        __syncthreads();
        f32x4 R[4], I[4];
#pragma unroll
        for (int tt = 0; tt < 4; ++tt) { R[tt] = (f32x4){0.f, 0.f, 0.f, 0.f}; I[tt] = R[tt]; }
#pragma unroll
        for (int kk = 0; kk < 2; ++kk) {
            const bf16x8 fr = mx::row_frag(lds + WT + nb * 64 * PW, PW, e0, kk, lane), fi = mx::row_frag(lds + WT + (2 + nb) * 64 * PW, PW, e0, kk, lane);
#pragma unroll
            for (int tt = 0; tt < 4; ++tt) { const bf16x8 a = mx::row_frag(lds + XCB + nb * 128, PX, 16 * tt, kk, lane); R[tt] = MFMA16(a, fr, R[tt]); I[tt] = MFMA16(a, fi, I[tt]); }
        }
#pragma unroll
        for (int tt = 0; tt < 4; ++tt) {
            float av[4], uv[4];
#pragma unroll
            for (int i = 0; i < 4; ++i) { const int t = 16 * tt + 4 * g + i;
                const float r = sigmoidf_(R[tt][i] + brr), ig = sigmoidf_(I[tt][i] + bii), la = -8.f * r * sp, a = __expf(la);
                av[i] = a; uv[i] = __builtin_amdgcn_sqrtf(fmaxf(1.f - a * a, 0.f)) * ig * *(const LAS float*)(lds + XCF + (t * 132 + chl) * 4); }
            float As = av[0] * av[1] * av[2] * av[3], Hs = ((uv[0] * av[1] + uv[1]) * av[2] + uv[2]) * av[3] + uv[3];
            float Ai = As, Hi = Hs;
            { const float Ap = __shfl(Ai, (lane - 16) & 63), Hp = __shfl(Hi, (lane - 16) & 63); if (g >= 1) { Hi = Hp * Ai + Hi; Ai = Ap * Ai; } }
            { const float Ap = __shfl(Ai, (lane - 32) & 63), Hp = __shfl(Hi, (lane - 32) & 63); if (g >= 2) { Hi = Hp * Ai + Hi; Ai = Ap * Ai; } }
            const float Ae = __shfl(Ai, (lane - 16) & 63), He = __shfl(Hi, (lane - 16) & 63), At = __shfl(Ai, 48 + c), Ht = __shfl(Hi, 48 + c);
            float h = g == 0 ? hcar : Ae * hcar + He;
            if (FULL) {
#pragma unroll
                for (int i = 0; i < 4; ++i) { const size_t row = row0 + 16 * tt + 4 * g + i; h = av[i] * h + uv[i];
                    YM[row * 1024 + 512 + chn] = (bf16)f2bf(h * gelu_tanh_(bf2f(gt[4 * tt + i]))); }
            }
            hcar = At * hcar + Ht; atot *= At;
        }
        __syncthreads();
    }
    if (!FULL && g == 0) { RA[chn] = atot; RH[chn] = hcar; }
}
}

constexpr int SEG_RET = 11, SEG_LRU = 21;
static_assert(SEG_LRU <= rg::SEGMAX, "RG-LRU segment count");
template <int SUB> __device__ __forceinline__ void phase_mix(Frame& F, int layer) {
    float* SG = (float*)(F.ws + WS_ST); float* BG = (float*)(F.ws + WS_ST + 16 * MiB);
    const bf16* PROJ = (const bf16*)(F.ws + WS_PROJ); bf16* YM = (bf16*)(F.ws + WS_ACT);
    float* RA = (float*)(F.ws + WS_ST + 16 * MiB + 256 * 1024); float* RH = RA + 2 * 32 * 512;
    const int S = layer == 0 ? 16 : SEG_RET;
    if (SUB == 1) {
        int tid = threadIdx.x; asm volatile("" : "+v"(tid));
        const int nel = (layer == 0 ? 16 : 8) * 16384;
        for (int idx = F.vcu * 512 + tid; idx < nel; idx += F.G * 512) {
            const int cidx = idx >> 14, e = idx & 16383, DK = (layer == 0 && cidx < 8) ? 128 : 64;
            if (e >= DK * 128) continue;
            const int d = e >> 7; float carry = 0.f;
            for (int seg = 0; seg < S; ++seg) { float* p = SG + (size_t)(cidx * S + seg) * 16384 + e; const float tmp = *p; *p = carry; carry = BG[(cidx * S + seg) * 128 + d] * carry + tmp; }
        }
        if (layer == 1) for (int idx = F.vcu * 512 + tid; idx < 1024; idx += F.G * 512) { const int bb = idx >> 9, cch = idx & 511; float carry = 0.f;
            for (int seg = 0; seg < SEG_LRU; ++seg) { const int o = (bb * SEG_LRU + seg) * 512 + cch; const float ta = RA[o], th = RH[o]; RH[o] = carry; carry = ta * carry + th; } }
        return;
    }
    for (int u = F.vcu; u < 256; u += F.G) {
        if (layer == 1 && u >= 8 * SEG_RET) {
            const int x = u - 8 * SEG_RET, bb = x / (4 * SEG_LRU), sg = (x >> 2) % SEG_LRU, cg = x & 3, c0 = (256 * sg) / SEG_LRU, nch = (256 * (sg + 1)) / SEG_LRU - c0;
            rg::unit<SUB == 2>(F.lds, PROJ, YM, F.in, bb, c0, nch, sg, cg, RA + (bb * SEG_LRU + sg) * 512, RH + (bb * SEG_LRU + sg) * 512);
            continue;
        }
        const int cidx = u / S, seg = u % S, chain = cidx & 7;
        mx::UnitP U; U.PROJ = PROJ; U.YM = YM; U.BL = (const float*)(F.ws + WS_BLOW); U.b = chain >> 2; U.h = chain & 3; U.p2 = nullptr;
        U.c0 = (256 * seg) / S; U.nch = (256 * (seg + 1)) / S - U.c0; U.seg = seg;
        float* Sg = SG + (size_t)(cidx * S + seg) * 16384; float* Bg = BG + (cidx * S + seg) * 128;
        if (layer == 0) {
            if (cidx < 8) { U.nw = F.in[6]; U.p0 = F.in[5]; U.p1 = nullptr; mx::mix_unit<0, SUB == 2>(F.lds, Sg, Bg, U); }
            else { U.nw = F.in[9]; U.p0 = F.in[7]; U.p1 = F.in[8]; mx::mix_unit<1, SUB == 2>(F.lds, Sg, Bg, U); }
        } else { U.nw = F.in[12]; U.p0 = nullptr; U.p1 = nullptr; mx::mix_unit<2, SUB == 2>(F.lds, Sg, Bg, U); }
    }
}

__device__ __forceinline__ void moe_poff(Frame& F, int layer) {
    PHASE_IDS(F);
    LAS int* poff = (LAS int*)(F.lds + LDS_MISC + 1024);
    const unsigned* cnt = F.ctl + CW_CNT + 64 * layer;
    __syncthreads();
    if (F.tid < 32) poff[33 + F.tid] = (int)cnt[F.tid];
    __syncthreads();
    if (F.tid == 0) { int acc = 0; for (int e = 0; e < 32; ++e) { poff[e] = acc; acc += (poff[33 + e] + 255) & ~255; } poff[32] = acc; }
    __syncthreads();
}
struct Args { const float* in[28]; float* out; unsigned char* ws; int ph_lo, ph_hi, li, pad; };
__global__ void __launch_bounds__(NWAVES * 64, 2) mega(Args args) {
    extern __shared__ __attribute__((aligned(16))) unsigned char lds[];
    Frame F;
    F.lds = (LAS unsigned char*)lds; F.tid = threadIdx.x; F.lane = F.tid & 63; F.wave = __builtin_amdgcn_readfirstlane(F.tid >> 6);
    F.G = gridDim.x; { const int bx = blockIdx.x; F.vcu = (F.G % 8 == 0) ? (bx % 8) * (F.G / 8) + bx / 8 : bx; }
    F.in = args.in; F.out = args.out; F.ws = args.ws; F.ctl = (unsigned*)(args.ws + WS_CTL);
    const int lo = args.ph_lo, hi = args.ph_hi;
    for (int u = F.tid; u < (LDS_BYTES - LDS_MISC) / 4; u += NWAVES * 64) ((LAS unsigned*)(F.lds + LDS_MISC))[u] = 0u;
    __syncthreads();
    XcdBarrier bar; bar.bar = F.ctl + CW_BAR + args.li * XCD_BAR_WORDS; bar.x = 0; bar.st = nullptr;
    if (hi - lo > 1) bar = xcd_barrier_post(F.ctl + CW_BAR + args.li * XCD_BAR_WORDS, (volatile LAS unsigned*)(F.lds + LDS_MISC + 32));
#ifndef ONLY_MASK
#define ONLY_MASK 0x7ffff
#endif
#define IN(k) (((ONLY_MASK >> (k)) & 1) && lo <= (k) && (k) < hi)
#define SEAM(k) do { if (IN(k) && IN((k) + 1)) xcd_barrier(bar); } while (0)
    bf16* ACT = (bf16*)(F.ws + WS_ACT); bf16* PROJ = (bf16*)(F.ws + WS_PROJ); bf16* H = (bf16*)(F.ws + WS_H); bf16* Y = (bf16*)(F.ws + WS_Y);
    const LAS int* poff = (const LAS int*)(F.lds + LDS_MISC + 1024);
    bf16* XR1 = (bf16*)F.out; bf16* XR2 = XR1 + (size_t)NT * D; bf16* XR3 = (bf16*)(F.ws + WS_W13);
    if (IN(0)) phase_prologue(F);
    SEAM(0);
#pragma unroll
    for (int l = 0; l < 2; ++l) {
        const int pb = 9 * l;
        if (IN(pb + 1)) {
            const int N = l == 0 ? EV_N : OD_N;
            pg8::DenseOrder S; S.init(ACT, F.ws + (l == 0 ? WS_WIN0 : WS_WIN1), NT, N, 1024, F.G, (int)blockIdx.x);
            pg8::EpiBf E{PROJ, N, 1.f};
            pg8::gemm_phase<pg8::EpiBf, pg8::DenseOrder, true>(F.lds, 1024, S, E);
        }
        SEAM(pb + 1);
#ifndef FAST_MIX
#define FAST_MIX 7
#endif
        if ((FAST_MIX >> l) & 1) {
            if (IN(pb + 2)) phase_mix<0>(F, l);
            SEAM(pb + 2);
            if (IN(pb + 4)) phase_mix<2>(F, l);
            SEAM(pb + 4);
        }
        if (IN(pb + 5)) {
            pg8::DenseOrder S; S.init(ACT, F.ws + (l == 0 ? WS_WOUT0 : WS_WOUT1), NT, 1024, 1024, F.G, (int)blockIdx.x);
            if (l == 0) { pg8::EpiRes<false> E{F.in[0], XR1, (float*)(F.ws + WS_SSQ)}; pg8::gemm_phase<pg8::EpiRes<false>, pg8::DenseOrder, true>(F.lds, 1024, S, E); }
            else { pg8::EpiRes<true> E{XR2, XR3, (float*)(F.ws + WS_SSQ)}; pg8::gemm_phase<pg8::EpiRes<true>, pg8::DenseOrder, true>(F.lds, 1024, S, E); }
        }
        SEAM(pb + 5);
        if (IN(pb + 6)) phase_router(F, l, l == 0 ? XR1 : XR3);
        SEAM(pb + 6);
        if (IN(pb + 7)) {
            moe_poff(F, l);
            pg8::MoeOrder S{poff, F.ctl + CW_CNT + 64 * l, (const int*)(F.ws + WS_LIST), (const char*)ACT, (const char*)(F.ws + WS_W13) + (size_t)l * 32 * 1024 * 1024 * 2, (size_t)1024 * 1024, 512, F.G, F.vcu, true};
            pg8::EpiUp E{(unsigned char*)H};
            pg8::gemm_phase<pg8::EpiUp, pg8::MoeOrder, true, true>(F.lds, 512, S, E);
        }
        SEAM(pb + 7);
        if (IN(pb + 8)) {
            moe_poff(F, l);
            pg8::MoeOrder S{poff, F.ctl + CW_CNT + 64 * l, (const int*)(F.ws + WS_LIST), (const char*)H, (const char*)(F.ws + WS_W2) + (size_t)l * 32 * 1024 * 512 * 2, (size_t)1024 * 512, 256, F.G, F.vcu, false};
            pg8::EpiBf E{Y, 1024, 1.f / 32.f};
            pg8::gemm_phase<pg8::EpiBf, pg8::MoeOrder, true, true>(F.lds, 256, S, E);
        }
        SEAM(pb + 8);
        if (IN(pb + 9)) phase_combine(F, l, l == 0 ? XR1 : XR3, XR2);
        SEAM(pb + 9);
    }
#undef IN
#undef SEAM
}

struct NG { const bf16* A; const bf16* Bt; int N, K; bf16* Ob; float* Of; const float* Res; const unsigned* cnt; const int* list; };
template <int MODE> __global__ void __launch_bounds__(256) k_gemm_naive(NG a) {
    __shared__ float As[16][68], Bs[16][68], Cs[16][68]; __shared__ int poff[33];
    const int t = threadIdx.x, tx = t & 15, ty = t >> 4, m0 = blockIdx.y * 64, n0 = blockIdx.x * 64, K = a.K;
    const bf16* Bt = a.Bt; int e = 0;
    if (MODE >= 2) {
        if (t == 0) { int acc = 0; for (int i = 0; i < 32; ++i) { poff[i] = acc; acc += ((int)a.cnt[i] + 255) & ~255; } poff[32] = acc; }
        __syncthreads();
        if (m0 >= poff[32]) return;
        while (m0 >= poff[e + 1]) ++e;
        Bt += (size_t)e * (MODE == 2 ? 1024 * 1024 : 1024 * 512);
    }
    const int lr = t >> 2, kq = (t & 3) * 4;
    int arow = m0 + lr;
    if (MODE == 2) { const int idx = arow - poff[e]; arow = idx < (int)a.cnt[e] ? a.list[(size_t)e * NT + idx] : 0; }
    const bf16* ap = a.A + (size_t)arow * K + kq;
    int br = n0 + lr, br2 = 0;
    if (MODE == 2) { br = 256 * (br >> 7) + (br & 127); br2 = br + 128; }
    const bf16* bp = Bt + (size_t)br * K + kq; const bf16* bp2 = Bt + (size_t)br2 * K + kq;
    float acc[4][4], acc2[4][4];
#pragma unroll
    for (int i = 0; i < 4; ++i)
#pragma unroll
        for (int j = 0; j < 4; ++j) { acc[i][j] = 0.f; acc2[i][j] = 0.f; }
    for (int k0 = 0; k0 < K; k0 += 16) {
        { const v2u w = *(const v2u*)(ap + k0); As[kq][lr] = bf2f((bf16)(w.x & 0xffff)); As[kq + 1][lr] = bf2f((bf16)(w.x >> 16)); As[kq + 2][lr] = bf2f((bf16)(w.y & 0xffff)); As[kq + 3][lr] = bf2f((bf16)(w.y >> 16)); }
        { const v2u w = *(const v2u*)(bp + k0); Bs[kq][lr] = bf2f((bf16)(w.x & 0xffff)); Bs[kq + 1][lr] = bf2f((bf16)(w.x >> 16)); Bs[kq + 2][lr] = bf2f((bf16)(w.y & 0xffff)); Bs[kq + 3][lr] = bf2f((bf16)(w.y >> 16)); }
        if (MODE == 2) { const v2u w = *(const v2u*)(bp2 + k0); Cs[kq][lr] = bf2f((bf16)(w.x & 0xffff)); Cs[kq + 1][lr] = bf2f((bf16)(w.x >> 16)); Cs[kq + 2][lr] = bf2f((bf16)(w.y & 0xffff)); Cs[kq + 3][lr] = bf2f((bf16)(w.y >> 16)); }
        __syncthreads();
#pragma unroll
        for (int k = 0; k < 16; ++k) {
            float av[4], bv[4], cv[4];
#pragma unroll
            for (int i = 0; i < 4; ++i) { av[i] = As[k][ty * 4 + i]; bv[i] = Bs[k][tx * 4 + i]; cv[i] = MODE == 2 ? Cs[k][tx * 4 + i] : 0.f; }
#pragma unroll
            for (int i = 0; i < 4; ++i)
#pragma unroll
                for (int j = 0; j < 4; ++j) { acc[i][j] += av[i] * bv[j]; if (MODE == 2) acc2[i][j] += av[i] * cv[j]; }
        }
        __syncthreads();
    }
#pragma unroll
    for (int i = 0; i < 4; ++i)
#pragma unroll
        for (int j = 0; j < 4; ++j) {
            const int m = m0 + ty * 4 + i, n = n0 + tx * 4 + j;
            if (MODE == 0) a.Ob[(size_t)m * a.N + n] = (bf16)f2bf(acc[i][j]);
            if (MODE == 1) a.Of[(size_t)m * a.N + n] = a.Res[(size_t)m * a.N + n] + acc[i][j];
            if (MODE == 2) a.Ob[(size_t)m * 512 + n] = (bf16)f2bf(siluf_(acc[i][j]) * acc2[i][j]);
            if (MODE == 3) a.Ob[(size_t)m * 1024 + n] = (bf16)f2bf(acc[i][j]);
        }
}

__global__ void __launch_bounds__(128) k_mix_even_naive(const bf16* PROJ, const float* blow, const float* lbl, const float* hnw, const float* wup, const float* bup, const float* gnw, bf16* Y) {
    const int bid = blockIdx.x, j = threadIdx.x, lane = j & 63, wv = j >> 6;
    __shared__ float sq[2][128], sk[2][128], sg[2][128], red[2][2];
    if (bid < 8) {
        const int b = bid >> 2, h = bid & 3, c = h * 128 + j;
        float lb; { const float l0 = lbl[c], l1 = lbl[512 + c], l2 = lbl[1024 + c]; const float mx = fmaxf(l0, fmaxf(l1, l2)); const float e0 = expf(l0 - mx), e1 = expf(l1 - mx), e2 = expf(l2 - mx); lb = e0 / (e0 + e1 + e2); }
        float s[128];
#pragma unroll
        for (int d = 0; d < 128; ++d) s[d] = 0.f;
        const float nw = hnw[c];
        for (int t = 0; t < SEQ; ++t) {
            const bf16* P = PROJ + (size_t)(b * SEQ + t) * EV_N; const int pb = t & 1;
            const float f = lb + (1.f - lb) * sigmoidf_(bf2f(P[512 + c]));
            sq[pb][j] = bf2f(P[c]); sk[pb][j] = 1.f - f; sg[pb][j] = f;
            const float v = bf2f(P[1024 + c]);
            __syncthreads();
            float o = 0.f;
#pragma unroll
            for (int d = 0; d < 128; ++d) { s[d] = sg[pb][d] * s[d] + sk[pb][d] * v; o += sq[pb][d] * s[d]; }
            const float ss = wave_sum(o * o); if (lane == 0) red[pb][wv] = ss;
            __syncthreads();
            const float rstd = rsqrtf((red[pb][0] + red[pb][1]) * (1.f / 128.f) + EPS);
            Y[(size_t)(b * SEQ + t) * 1024 + c] = (bf16)f2bf(o * rstd * nw * siluf_(bf2f(P[1536 + c])));
        }
    } else {
        const int b = (bid - 8) >> 2, h = bid & 3, c = h * 128 + j, dcol = h * 64 + (j & 63);
        float wu[16];
#pragma unroll
        for (int r = 0; r < 16; ++r) wu[r] = wup[r * 256 + dcol];
        const float bu = bup[dcol];
        float s[64];
#pragma unroll
        for (int d = 0; d < 64; ++d) s[d] = 0.f;
        const float nw = gnw[c];
        for (int t = 0; t < SEQ; ++t) {
            const size_t row = (size_t)b * SEQ + t;
            const bf16* P = PROJ + row * EV_N; const int pb = t & 1;
            if (j < 64) {
                float z = bu;
#pragma unroll
                for (int r = 0; r < 16; ++r) z += blow[row * 16 + r] * wu[r];
                const float ls = fminf(z, 0.f) - log1pf(expf(-fabsf(z)));
                sg[pb][j] = expf(ls * (1.f / 16.f)); sq[pb][j] = bf2f(P[2048 + dcol]) * 0.125f; sk[pb][j] = bf2f(P[2304 + dcol]);
            }
            const float v = bf2f(P[2560 + c]);
            __syncthreads();
            float o = 0.f;
#pragma unroll
            for (int d = 0; d < 64; ++d) { s[d] = sg[pb][d] * s[d] + sk[pb][d] * v; o += sq[pb][d] * s[d]; }
            const float ss = wave_sum(o * o); if (lane == 0) red[pb][wv] = ss;
            __syncthreads();
            const float rstd = rsqrtf((red[pb][0] + red[pb][1]) * (1.f / 128.f) + EPS);
            Y[row * 1024 + 512 + c] = (bf16)f2bf(o * rstd * nw * siluf_(bf2f(P[3072 + c])));
        }
    }
}

__global__ void __launch_bounds__(128) k_ret_naive(const bf16* PROJ, const float* rnw, bf16* Y) {
    const int bid = blockIdx.x, j = threadIdx.x, lane = j & 63, wv = j >> 6, b = bid >> 2, h = bid & 3, c = h * 128 + j;
    __shared__ float sq[2][64], sk[2][64], red[2][2], red2[2][2];
    const int d = j & 63, i = d & 31;
    const float ci = exp2f(-(float)i * (13.287712379549449f / 32.f)) * 0.15915494309189535f;
    const float gamma = 1.f - exp2f(-5.f - (float)h);
    float s[64];
#pragma unroll
    for (int dd = 0; dd < 64; ++dd) s[dd] = 0.f;
    const float nw = rnw[c];
    for (int t = 0; t < SEQ; ++t) {
        const size_t row = (size_t)b * SEQ + t; const bf16* P = PROJ + row * OD_N; const int pb = t & 1;
        if (j < 64) {
            float rev = (float)t * ci; rev -= floorf(rev);
            const float sn = __builtin_amdgcn_sinf(rev), cs = __builtin_amdgcn_cosf(rev);
            const float q1 = bf2f(P[h * 64 + i]), q2 = bf2f(P[h * 64 + 32 + i]), k1 = bf2f(P[256 + h * 64 + i]), k2 = bf2f(P[256 + h * 64 + 32 + i]);
            sq[pb][d] = d < 32 ? q1 * cs - q2 * sn : q1 * sn + q2 * cs;
            sk[pb][d] = (d < 32 ? k1 * cs - k2 * sn : k1 * sn + k2 * cs) * 0.125f;
        }
        const float v = bf2f(P[512 + c]);
        __syncthreads();
        float o = 0.f;
#pragma unroll
        for (int dd = 0; dd < 64; ++dd) { s[dd] = gamma * s[dd] + sk[pb][dd] * v; o += sq[pb][dd] * s[dd]; }
        const float sm = wave_sum(o); if (lane == 0) red[pb][wv] = sm;
        __syncthreads();
        const float oc = o - (red[pb][0] + red[pb][1]) * (1.f / 128.f);
        const float ss = wave_sum(oc * oc); if (lane == 0) red2[pb][wv] = ss;
        __syncthreads();
        const float rstd = rsqrtf((red2[pb][0] + red2[pb][1]) * (1.f / 128.f) + EPS);
        Y[row * 1024 + c] = (bf16)f2bf(oc * rstd * nw * siluf_(bf2f(P[1024 + c])));
    }
}

__global__ void __launch_bounds__(64) k_rglru_naive(const bf16* PROJ, const float* cw, const float* cb, const float* wr, const float* br, const float* wi, const float* bi, const float* lam, bf16* Y) {
    const int b = blockIdx.x >> 3, n = blockIdx.x & 7, e = threadIdx.x, c = n * 64 + e;
    float wrr[64], wii[64];
#pragma unroll
    for (int d = 0; d < 64; ++d) { wrr[d] = wr[(n * 64 + d) * 64 + e]; wii[d] = wi[(n * 64 + d) * 64 + e]; }
    const float c0 = cw[c], c1 = cw[512 + c], c2 = cw[1024 + c], c3 = cw[1536 + c], cbb = cb[c], brr = br[c], bii = bi[c];
    const float sp = log1pf(expf(-lam[c]));
    float x1 = 0.f, x2 = 0.f, x3 = 0.f, hh = 0.f;
    for (int t = 0; t < SEQ; ++t) {
        const size_t row = (size_t)b * SEQ + t; const bf16* P = PROJ + row * OD_N;
        const float dx = bf2f(P[1536 + c]);
        const float xc = cbb + c0 * x3 + c1 * x2 + c2 * x1 + c3 * dx;
        x3 = x2; x2 = x1; x1 = dx;
        float rp = brr, ip = bii;
#pragma unroll
        for (int d = 0; d < 64; ++d) { const float xd = __shfl(xc, d); rp += xd * wrr[d]; ip += xd * wii[d]; }
        const float r = sigmoidf_(rp), ig = sigmoidf_(ip), la = -8.f * r * sp, aa = expf(la);
        const float u = sqrtf(fmaxf(0.f, -expm1f(2.f * la))) * (ig * xc);
        hh = aa * hh + u;
        Y[row * 1024 + 512 + c] = (bf16)f2bf(hh * gelu_tanh_(bf2f(P[2048 + c])));
    }
}

extern "C" void kernel_launch(void* const* d_in, const int* in_sizes, int n_in, void* d_out, int out_size, void* d_ws, size_t ws_size, hipStream_t stream) {
    static int grid = 0;
    if (grid == 0) {
        if (n_in != 28 || out_size != NT * D || ws_size < WS_END) { fprintf(stderr, "kernel_launch: unexpected problem (n_in %d, out %d, ws %zu)\n", n_in, out_size, ws_size); grid = -1; return; }
        int dev = 0, cus = 0;
        if (hipGetDevice(&dev) != hipSuccess || hipDeviceGetAttribute(&cus, hipDeviceAttributeMultiprocessorCount, dev) != hipSuccess) { grid = -1; return; }
        if (hipFuncSetAttribute((const void*)mega, hipFuncAttributeMaxDynamicSharedMemorySize, LDS_BYTES) != hipSuccess) { fprintf(stderr, "kernel_launch: hipFuncSetAttribute failed\n"); grid = -1; return; }
        (void)hipGetLastError();
        grid = cus;
    }
    if (grid < 0) return;
    (void)hipMemsetAsync((char*)d_ws + WS_CTL, 0, CTL_BYTES, stream);
    Args a{};
    for (int i = 0; i < 28; ++i) a.in[i] = (const float*)d_in[i];
    a.out = (float*)d_out; a.ws = (unsigned char*)d_ws;
    unsigned char* ws = (unsigned char*)d_ws;
    const float* const* in = (const float* const*)a.in;
    int nli = 0;
    auto run = [&](int lo, int hi) { a.ph_lo = lo; a.ph_hi = hi; a.li = (hi - lo > 1) ? nli++ : 0; hipLaunchKernelGGL(mega, dim3(grid), dim3(NWAVES * 64), LDS_BYTES, stream, a); };
    bf16* ACT = (bf16*)(ws + WS_ACT); bf16* PROJ = (bf16*)(ws + WS_PROJ);
#ifndef FAST_MIX
#define FAST_MIX 7
#endif
    auto naive_even = [&]() { hipLaunchKernelGGL(k_mix_even_naive, dim3(16), dim3(128), 0, stream, PROJ, (const float*)(ws + WS_BLOW), in[5], in[6], in[7], in[8], in[9], ACT); };
    auto naive_ret = [&]() { hipLaunchKernelGGL(k_ret_naive, dim3(8), dim3(128), 0, stream, PROJ, in[12], ACT); };
    auto naive_lru = [&]() { hipLaunchKernelGGL(k_rglru_naive, dim3(16), dim3(64), 0, stream, PROJ, in[13], in[14], in[15], in[16], in[17], in[18], in[19], ACT); };
    if (FAST_MIX == 7) { run(0, 19); }
    else if (FAST_MIX == 1) { run(0, 11); naive_ret(); naive_lru(); run(14, 19); }
    else if (FAST_MIX == 3) { run(0, 14); naive_lru(); run(14, 19); }
    else { run(0, 2); naive_even(); run(5, 11); naive_ret(); naive_lru(); run(14, 19); }
}
```

```cpp
#include <hip/hip_runtime.h>
#include <cstdio>
#include <cstdint>

#define GAS __attribute__((address_space(1)))
#define LAS __attribute__((address_space(3)))
typedef unsigned short bf16;
typedef unsigned v4u __attribute__((ext_vector_type(4)));
typedef unsigned v2u __attribute__((ext_vector_type(2)));
typedef float f32x4 __attribute__((ext_vector_type(4)));
typedef float f32x2 __attribute__((ext_vector_type(2)));
typedef short bf16x8 __attribute__((ext_vector_type(8)));

constexpr int NT = 32768, D = 1024, SEQ = 16384;
constexpr int EV_N = 3584, OD_N = 2560, EV_LD = 3600;
constexpr float EPS = 1e-6f;
constexpr int NEXP = 32, SLOT_ROWS = 2 * NT + NEXP * 256;

constexpr size_t MiB = 1u << 20;
constexpr size_t WS_CTL = 0, CTL_BYTES = 1 * MiB;
constexpr size_t WS_WIN0 = 2 * MiB, WS_WOUT0 = 9 * MiB, WS_WIN1 = 11 * MiB, WS_WOUT1 = 16 * MiB, WS_W13 = 18 * MiB, WS_W2 = 146 * MiB;
constexpr size_t WS_ACT = 210 * MiB, WS_PROJ = 274 * MiB, WS_H = WS_PROJ, WS_Y = WS_PROJ + 72 * MiB;
constexpr size_t WS_BLOW = 498 * MiB, WS_META = 500 * MiB, WS_LIST = 501 * MiB, WS_ST = 505 * MiB, WS_SSQ = 522 * MiB, WS_END = 524 * MiB;
constexpr int CW_TMO = 0, CW_BAR = 4096, CW_CNT = 16384;

constexpr int NWAVES = 8;
constexpr int LDS_BYTES = 163840;
constexpr int LDS_MISC = 149504;

__device__ __forceinline__ float bf2f(bf16 b) { return __builtin_bit_cast(float, (unsigned)b << 16); }
__device__ __forceinline__ unsigned pk2(float lo, float hi) { unsigned r; asm("v_cvt_pk_bf16_f32 %0, %1, %2" : "=v"(r) : "v"(lo), "v"(hi)); return r; }
__device__ __forceinline__ unsigned f2bf(float f) { return pk2(f, f) & 0xffffu; }
__device__ __forceinline__ float sigmoidf_(float x) { return __builtin_amdgcn_rcpf(1.f + __expf(-x)); }
__device__ __forceinline__ float siluf_(float x) { return x * sigmoidf_(x); }
__device__ __forceinline__ float gelu_tanh_(float x) { const float u = 0.7978845608f * (x + 0.044715f * x * x * x); return x * sigmoidf_(2.f * u); }
__device__ __forceinline__ float wave_sum(float v) {
#pragma unroll
    for (int o = 1; o < 64; o <<= 1) v += __shfl_xor(v, o);
    return v;
}
#define LDS_WAIT() asm volatile("s_waitcnt lgkmcnt(0)" ::: "memory")

struct Frame {
    LAS unsigned char* lds;
    int tid, lane, wave, vcu, G;
    const float* const* in;
    float* out; unsigned char* ws;
    unsigned* ctl;
};


#define XB_TMO      128
#define XB_XCNT(j)  (256  + 64 * (j))
#define XB_XSUB(j)  (1280 + 64 * (j))
#define XB_XGEN(j)  (2304 + 64 * (j))
#define XB_TOP      3328
#define XB_TOPGEN   3392
#define XCD_BAR_WORDS 3456
#define XB_SPIN_CAP (1u << 18)
__device__ __forceinline__ unsigned xb_ld(unsigned* p)              { return __hip_atomic_load(p, __ATOMIC_RELAXED, __HIP_MEMORY_SCOPE_AGENT); }
__device__ __forceinline__ unsigned xb_add(unsigned* p, unsigned v) { return __hip_atomic_fetch_add(p, v, __ATOMIC_RELAXED, __HIP_MEMORY_SCOPE_AGENT); }
__device__ __forceinline__ unsigned xb_xcc_id() { return (unsigned)__builtin_amdgcn_s_getreg((3 << 11) | 20) & 0xFu; }
#define XB_SPIN(cond, bar) do { unsigned _sp = 0; while (cond) { __builtin_amdgcn_s_sleep(1); \
    if ((++_sp & 255u) == 0u) { if (xb_ld(&(bar)[XB_TMO])) break; if (_sp > XB_SPIN_CAP) { atomicAdd(&(bar)[XB_TMO], 1u); break; } } } } while (0)
struct XcdBarrier { unsigned* bar; unsigned x; volatile LAS unsigned* st; };
__device__ __forceinline__ XcdBarrier xcd_barrier_post(unsigned* bar, volatile LAS unsigned* st) {
    XcdBarrier b; b.bar = bar; b.x = xb_xcc_id(); b.st = st;
    if (threadIdx.x == 0) (void)xb_add(&bar[XB_XCNT(b.x)], 1u);
    return b;
}
__device__ __forceinline__ void xcd_barrier_complete(unsigned* bar, unsigned x, unsigned& nloc, unsigned& nx) {
    const unsigned G = gridDim.x * gridDim.y * gridDim.z;
    unsigned sum, cnt, mine, sp = 0u;
    for (;;) {
        sum = 0u; cnt = 0u; mine = 0u;
#pragma unroll
        for (unsigned j = 0; j < 16; ++j) { const unsigned c = xb_ld(&bar[XB_XCNT(j)]); sum += c; cnt += (c > 0u) ? 1u : 0u; mine = (j == x) ? c : mine; }
        if (sum == G) break;
        __builtin_amdgcn_s_sleep(1);
        if ((++sp & 255u) == 0u) { if (xb_ld(&bar[XB_TMO])) break; if (sp > XB_SPIN_CAP) { atomicAdd(&bar[XB_TMO], 1u); break; } }
    }
    nloc = mine > 0u ? mine : 1u; nx = cnt > 0u ? cnt : 1u;
}
__device__ __forceinline__ void xcd_barrier(const XcdBarrier& b) {
    asm volatile("s_waitcnt vmcnt(0)" ::: "memory");
    __syncthreads();
    if (threadIdx.x == 0) {
        unsigned* bar = b.bar;
        __builtin_amdgcn_s_waitcnt(0);
        unsigned nloc = b.st[0], nx = b.st[1];
        if (nloc == 0u) { xcd_barrier_complete(bar, b.x, nloc, nx); b.st[0] = nloc; b.st[1] = nx; }
        const unsigned old = xb_add(&bar[XB_XSUB(b.x)], 1u);
        const unsigned gen = old / nloc;
        if (old + 1u == (gen + 1u) * nloc) {
            __builtin_amdgcn_fence(__ATOMIC_RELEASE, "agent");
            asm volatile("s_waitcnt vmcnt(0)" ::: "memory");
            const unsigned og = xb_add(&bar[XB_TOP], 1u);
            const unsigned tg = og / nx;
            if (og + 1u == (tg + 1u) * nx) xb_add(&bar[XB_TOPGEN], 1u);
            else XB_SPIN(xb_ld(&bar[XB_TOPGEN]) == tg, bar);
            __builtin_amdgcn_fence(__ATOMIC_ACQUIRE, "agent");
            xb_add(&bar[XB_XGEN(b.x)], 1u);
            asm volatile("s_waitcnt vmcnt(0)" ::: "memory");
        } else {
            XB_SPIN(xb_ld(&bar[XB_XGEN(b.x)]) == gen, bar);
            __builtin_amdgcn_fence(__ATOMIC_ACQUIRE, "agent");
            asm volatile("s_waitcnt vmcnt(0)" ::: "memory");
        }
    }
    __syncthreads();
}

namespace pg8 {
typedef unsigned u32x4 __attribute__((ext_vector_type(4)));
typedef int i32x4 __attribute__((ext_vector_type(4)));
typedef int i32x8 __attribute__((ext_vector_type(8)));
constexpr int BM = 256, BK = 64, HALF = 128, HTB = HALF * BK * 2, STAGE_BYTES = 8 * HTB, NXCD = 8, WGM = 8;
__host__ __device__ __forceinline__ int lds_byte(int r, int c) { const int st = (r >> 4) * 2 + (c >> 5), rr = r & 15, cc = c & 31, ob = rr * 64 + cc * 2; return st * 1024 + (ob ^ (((ob >> 9) & 1) << 5)); }
__host__ __device__ __forceinline__ void stage_rc(int b, int& R, int& C) { const int st = b / 1024, sb = b % 1024, swz = sb ^ (((sb >> 9) & 1) << 5); R = (st >> 1) * 16 + swz / 64; C = (st & 1) * 32 + (swz % 64) / 2; }
__host__ __device__ __forceinline__ int perm32(int rho) { const int n = rho >> 4, i = rho & 15; return 8 * (i >> 2) + 4 * n + (i & 3); }
struct Unit { int pm, pn, e; };
__device__ __forceinline__ unsigned cvt_pk_bf16(float lo, float hi) { return pk2(lo, hi); }

struct DenseOrder {
    int nM, nN, nwg, G, c, K; const char* A; const char* Bt;
    __device__ __forceinline__ void init(const void* A_, const void* Bt_, int M, int N, int K_, int G_, int c_) { A = (const char*)A_; Bt = (const char*)Bt_; nM = M / BM; nN = N / BM; nwg = nM * nN; G = G_; c = c_; K = K_; }
    __device__ __forceinline__ bool next(int i, Unit& u) const {
        const long L = (long)i * G + c; if (L >= nwg) return false;
        int wgid = (int)L; { const int q = nwg / NXCD, r = nwg % NXCD, xcd = wgid % NXCD, off = wgid / NXCD; wgid = (xcd < r ? xcd * (q + 1) : r * (q + 1) + (xcd - r) * q) + off; }
        const int nig = WGM * nN, gid = wgid / nig, fm = gid * WGM, gsz = (nM - fm) < WGM ? (nM - fm) : WGM;
        u.pm = fm + ((wgid % nig) % gsz); u.pn = (wgid % nig) / gsz; u.e = 0; return true;
    }
    __device__ __forceinline__ unsigned a_off(const Unit& u, int r) const { return (unsigned)((u.pm * BM + r) * K) * 2u; }
    __device__ __forceinline__ const char* b_ptr(const Unit& u) const { return Bt + (size_t)u.pn * BM * K * 2; }
};
struct MoeOrder {
    const LAS int* poff; const unsigned* cnt; const int* list; const char* A; const char* Bt; size_t estride; int K, G, c; bool gather;
    __device__ __forceinline__ bool next(int i, Unit& u) const {
        const int L = i * G + c, np = __builtin_amdgcn_readfirstlane(poff[32]) >> 8; if (L >= np * 4) return false;
        u.pm = L >> 2; u.pn = L & 3; const int row = u.pm << 8; int e = 0;
        while (row >= __builtin_amdgcn_readfirstlane(poff[e + 1])) ++e;
        u.e = e; return true;
    }
    __device__ __forceinline__ unsigned a_off(const Unit& u, int r) const {
        if (!gather) return (unsigned)((u.pm * BM + r) * K) * 2u;
        const int idx = min(u.pm * BM + r - poff[u.e], poff[33 + u.e] - 1);
        return (unsigned)list[(size_t)u.e * NT + idx] * (unsigned)(K * 2);
    }
    __device__ __forceinline__ const char* b_ptr(const Unit& u) const { return Bt + (size_t)u.e * estride + (size_t)u.pn * BM * K * 2; }
};

struct EpiBf {
    static constexpr bool PERM = true;
    bf16* O; int ldc; float scale;
    __device__ __forceinline__ void operator()(const f32x4 (&acc)[2][2][4][2], const Unit& u, int wr, int wc, int fr, int fq) const {
        const int row0 = u.pm * BM + wr * 64 + fr, col0 = u.pn * BM + wc * 32 + 8 * fq;
#pragma unroll
        for (int ai = 0; ai < 2; ++ai)
#pragma unroll
            for (int m = 0; m < 4; ++m) { bf16* rowp = O + (size_t)(row0 + ai * HALF + m * 16) * ldc + col0;
#pragma unroll
                for (int bj = 0; bj < 2; ++bj) { const f32x4 v0 = acc[ai][bj][m][0] * scale, v1 = acc[ai][bj][m][1] * scale;
                    u32x4 w; w.x = cvt_pk_bf16(v0[0], v0[1]); w.y = cvt_pk_bf16(v0[2], v0[3]); w.z = cvt_pk_bf16(v1[0], v1[1]); w.w = cvt_pk_bf16(v1[2], v1[3]);
                    *(u32x4*)(rowp + bj * HALF) = w; } }
    }
};
template <bool RES_BF16>
struct EpiRes {
    static constexpr bool PERM = true;
    const void* res; bf16* xout; float* ssq;
    __device__ __forceinline__ void operator()(const f32x4 (&acc)[2][2][4][2], const Unit& u, int wr, int wc, int fr, int fq) const {
        const int row0 = u.pm * BM + wr * 64 + fr, col0 = u.pn * BM + wc * 32 + 8 * fq;
#pragma unroll
        for (int ai = 0; ai < 2; ++ai) {
            f32x4 r0[4][2], r1[4][2];
#pragma unroll
            for (int m = 0; m < 4; ++m) { const size_t off = (size_t)(row0 + ai * HALF + m * 16) * 1024 + col0;
#pragma unroll
                for (int bj = 0; bj < 2; ++bj) {
                    if (RES_BF16) { const u32x4 rw = *(const u32x4*)((const bf16*)res + off + bj * HALF);
                        r0[m][bj] = (f32x4){__builtin_bit_cast(float, rw.x << 16), __builtin_bit_cast(float, rw.x & 0xffff0000u), __builtin_bit_cast(float, rw.y << 16), __builtin_bit_cast(float, rw.y & 0xffff0000u)};
                        r1[m][bj] = (f32x4){__builtin_bit_cast(float, rw.z << 16), __builtin_bit_cast(float, rw.z & 0xffff0000u), __builtin_bit_cast(float, rw.w << 16), __builtin_bit_cast(float, rw.w & 0xffff0000u)}; }
                    else { r0[m][bj] = *(const f32x4*)((const float*)res + off + bj * HALF); r1[m][bj] = *(const f32x4*)((const float*)res + off + bj * HALF + 4); } } }
#pragma unroll
            for (int m = 0; m < 4; ++m) { const int row = row0 + ai * HALF + m * 16; const size_t off = (size_t)row * 1024 + col0; float ss = 0.f;
#pragma unroll
                for (int bj = 0; bj < 2; ++bj) {
                    const f32x4 v0 = r0[m][bj] + acc[ai][bj][m][0], v1 = r1[m][bj] + acc[ai][bj][m][1];
                    ss += ((v0[0] * v0[0] + v0[1] * v0[1]) + (v0[2] * v0[2] + v0[3] * v0[3])) + ((v1[0] * v1[0] + v1[1] * v1[1]) + (v1[2] * v1[2] + v1[3] * v1[3]));
                    u32x4 w; w.x = cvt_pk_bf16(v0[0], v0[1]); w.y = cvt_pk_bf16(v0[2], v0[3]); w.z = cvt_pk_bf16(v1[0], v1[1]); w.w = cvt_pk_bf16(v1[2], v1[3]);
                    *(u32x4*)(xout + off + bj * HALF) = w; }
                ss += __shfl_xor(ss, 16); ss += __shfl_xor(ss, 32);
                if (fq == 0) ssq[(size_t)row * 16 + u.pn * 4 + wc] = ss; }
            asm volatile("" ::: "memory");
        }
    }
};
__device__ __forceinline__ unsigned pk4_fp8(float a, float b, float c, float d) { int p = __builtin_amdgcn_cvt_pk_fp8_f32(a, b, 0, false); return (unsigned)__builtin_amdgcn_cvt_pk_fp8_f32(c, d, p, true); }
struct EpiF8 {
    static constexpr bool PERM = true;
    unsigned char* O; int ldc; float scale;
    __device__ __forceinline__ void operator()(const f32x4 (&acc)[2][2][4][2], const Unit& u, int wr, int wc, int fr, int fq) const {
        const int row0 = u.pm * BM + wr * 64 + fr, col0 = u.pn * BM + wc * 32 + 8 * fq;
#pragma unroll
        for (int ai = 0; ai < 2; ++ai)
#pragma unroll
            for (int m = 0; m < 4; ++m) { unsigned char* rowp = O + (size_t)(row0 + ai * HALF + m * 16) * ldc + col0;
#pragma unroll
                for (int bj = 0; bj < 2; ++bj) { const f32x4 v0 = acc[ai][bj][m][0] * scale, v1 = acc[ai][bj][m][1] * scale;
                    v2u w; w.x = pk4_fp8(v0[0], v0[1], v0[2], v0[3]); w.y = pk4_fp8(v1[0], v1[1], v1[2], v1[3]);
                    *(v2u*)(rowp + bj * HALF) = w; } }
    }
};
struct EpiUp {
    static constexpr bool PERM = true;
    unsigned char* H;
    __device__ __forceinline__ void operator()(const f32x4 (&acc)[2][2][4][2], const Unit& u, int wr, int wc, int fr, int fq) const {
        const int row0 = u.pm * BM + wr * 64 + fr, col0 = u.pn * HALF + wc * 32 + 8 * fq;
#pragma unroll
        for (int ai = 0; ai < 2; ++ai)
#pragma unroll
            for (int m = 0; m < 4; ++m) { unsigned char* rowp = H + (size_t)(row0 + ai * HALF + m * 16) * 512 + col0;
                float h[8];
#pragma unroll
                for (int n = 0; n < 2; ++n)
#pragma unroll
                    for (int i = 0; i < 4; ++i) { const float a = acc[ai][0][m][n][i] * (1.f / 32.f), b = acc[ai][1][m][n][i] * (1.f / 32.f); h[n * 4 + i] = a * __builtin_amdgcn_rcpf(1.f + __expf(-a)) * b; }
                v2u w; w.x = pk4_fp8(h[0], h[1], h[2], h[3]); w.y = pk4_fp8(h[4], h[5], h[6], h[7]);
                *(v2u*)rowp = w; }
    }
};

template <class Epi, class Sched, bool ALIGN_EPI, bool FP8 = false>
__device__ __forceinline__ void gemm_phase(LAS unsigned char* lds, const int K_, const Sched& S, const Epi& E) {
    int K = K_; asm volatile("" : "+s"(K));
    int tid = threadIdx.x; asm volatile("" : "+v"(tid));
    const int wid = __builtin_amdgcn_readfirstlane(tid >> 6), lane = tid & 63, wr = wid >> 2, wc = wid & 3, fr = lane & 15, fq = lane >> 4;
    const int nt = K / BK;
    unsigned voffB[2];
#pragma unroll
    for (int i = 0; i < 2; ++i) { int R, C; stage_rc(tid * 16 + i * 8192, R, C); const int Rb = Epi::PERM ? ((R & ~31) + perm32(R & 31)) : R; voffB[i] = (unsigned)(Rb * K + C) * 2u; }
#define PG8_AOFF(u, o0, o1, o2, o3) do { int R0_, C0_, R1_, C1_; stage_rc(tid * 16, R0_, C0_); stage_rc(tid * 16 + 8192, R1_, C1_); \
        o0 = S.a_off(u, R0_) + (unsigned)C0_ * 2u; o1 = S.a_off(u, R1_) + (unsigned)C1_ * 2u; o2 = S.a_off(u, HALF + R0_) + (unsigned)C0_ * 2u; o3 = S.a_off(u, HALF + R1_) + (unsigned)C1_ * 2u; } while (0)
    const size_t kstep = (size_t)(BK * 2);
    const size_t hstep = (size_t)HALF * K * 2;
    const unsigned ldsw = (unsigned)wid * 1024u;
    const int aoff = lds_byte(wr * 64 + fr, fq * 8), boff = lds_byte(wc * 32 + fr, fq * 8);
    const char* const A0 = S.A;
#define PG8_SA(b, h) (((b) * 2 + (h)) * HTB)
#define PG8_SB(b, h) ((4 + (b) * 2 + (h)) * HTB)
#define PG8_STAGE(bufoff, gbase, voff) do { _Pragma("unroll") for (int _i = 0; _i < 2; ++_i) \
        __builtin_amdgcn_global_load_lds((const unsigned*)((const char*)(gbase) + (voff)[_i]), (LAS unsigned*)(lds + (bufoff) + ldsw + _i * 8192), 16, 0, 0); } while (0)
#define PG8_STAGEA(bufoff, kbyte, o0, o1) do { \
        __builtin_amdgcn_global_load_lds((const unsigned*)(A0 + (kbyte) + (o0)), (LAS unsigned*)(lds + (bufoff) + ldsw), 16, 0, 0); \
        __builtin_amdgcn_global_load_lds((const unsigned*)(A0 + (kbyte) + (o1)), (LAS unsigned*)(lds + (bufoff) + ldsw + 8192), 16, 0, 0); } while (0)
#define PG8_LD8(p) __builtin_shufflevector(*(const LAS i32x4*)(p), *(const LAS i32x4*)((p) + 1024), 0, 1, 2, 3, 4, 5, 6, 7)
#define PG8_LDA(dst, b, h) do { _Pragma("unroll") for (int m = 0; m < 4; ++m) dst[m] = PG8_LD8(lds + PG8_SA(b, h) + aoff + m * 2048); } while (0)
#define PG8_LDB(dst, b, h) do { _Pragma("unroll") for (int n = 0; n < 2; ++n) dst[n] = PG8_LD8(lds + PG8_SB(b, h) + boff + n * 2048); } while (0)
#define PG8_H(x, k) __builtin_bit_cast(bf16x8, __builtin_shufflevector(x, x, 4 * (k), 4 * (k) + 1, 4 * (k) + 2, 4 * (k) + 3))
#define PG8_MMA(ai, bj, At, Bt) do { __builtin_amdgcn_s_setprio(1); _Pragma("unroll") for (int m = 0; m < 4; ++m) _Pragma("unroll") for (int n = 0; n < 2; ++n) { \
        if constexpr (FP8) acc[ai][bj][m][n] = __builtin_amdgcn_mfma_scale_f32_16x16x128_f8f6f4(Bt[n], At[m], acc[ai][bj][m][n], 0, 0, 0, 0x7f7f7f7f, 0, 0x7f7f7f7f); \
        else { acc[ai][bj][m][n] = __builtin_amdgcn_mfma_f32_16x16x32_bf16(PG8_H(Bt[n], 0), PG8_H(At[m], 0), acc[ai][bj][m][n], 0, 0, 0); \
               acc[ai][bj][m][n] = __builtin_amdgcn_mfma_f32_16x16x32_bf16(PG8_H(Bt[n], 1), PG8_H(At[m], 1), acc[ai][bj][m][n], 0, 0, 0); } } \
        __builtin_amdgcn_s_setprio(0); } while (0)
#define PG8_WAIT_V(n) asm volatile("s_waitcnt vmcnt(" #n ")" ::: "memory")
#define PG8_WAIT_L(n) asm volatile("s_waitcnt lgkmcnt(" #n ")" ::: "memory")
#define PG8_BAR __builtin_amdgcn_s_barrier()
#define PG8_SCHED __builtin_amdgcn_sched_barrier(0)
    Unit cur, nxt; int ui = 0;
    if (!S.next(0, cur)) return;
    f32x4 acc[2][2][4][2];
#pragma unroll
    for (int a = 0; a < 2; ++a)
#pragma unroll
        for (int b = 0; b < 2; ++b)
#pragma unroll
            for (int m = 0; m < 4; ++m)
#pragma unroll
                for (int n = 0; n < 2; ++n) acc[a][b][m][n] = (f32x4){0.f, 0.f, 0.f, 0.f};
    i32x8 At[4], B0[2], B1[2];
    unsigned oc00, oc01, oc10, oc11, on00, on01, on10, on11;
    PG8_AOFF(cur, oc00, oc01, oc10, oc11);
    const char* cB = S.b_ptr(cur);
    PG8_STAGE(PG8_SB(0, 0), cB, voffB); PG8_STAGE(PG8_SB(0, 1), cB + hstep, voffB); PG8_STAGEA(PG8_SA(0, 0), 0, oc00, oc01); PG8_STAGEA(PG8_SA(0, 1), 0, oc10, oc11);
    if (wr == 1) PG8_BAR;
    PG8_WAIT_V(2); PG8_BAR;
    PG8_STAGE(PG8_SB(1, 0), cB + kstep, voffB); PG8_STAGEA(PG8_SA(1, 0), kstep, oc00, oc01); PG8_STAGE(PG8_SB(1, 1), cB + hstep + kstep, voffB);
    PG8_WAIT_V(6); PG8_BAR;
    for (;;) {
        const bool has_next = S.next(ui + 1, nxt);
        const char* nB = cB;
        on00 = oc00; on01 = oc01; on10 = oc10; on11 = oc11;
        if (has_next) { nB = S.b_ptr(nxt); PG8_AOFF(nxt, on00, on01, on10, on11); }
#pragma unroll 1
        for (int t = 0; t < nt; t += 2) {
            const bool last = (t == nt - 2);
            const size_t k1 = (size_t)(t + 1) * kstep, k2 = last ? 0 : (size_t)(t + 2) * kstep, k3 = k2 + kstep;
            const char* b2 = last ? nB : cB + (size_t)(t + 2) * kstep; const char* b3 = b2 + kstep;
            PG8_LDB(B0, 0, 0); PG8_LDB(B1, 0, 1); PG8_SCHED; PG8_LDA(At, 0, 0); PG8_STAGEA(PG8_SA(1, 1), k1, oc10, oc11);
            if (last) { oc00 = on00; oc01 = on01; oc10 = on10; oc11 = on11; }
            PG8_WAIT_V(8); PG8_WAIT_L(0); PG8_BAR; PG8_MMA(0, 0, At, B0); PG8_MMA(0, 1, At, B1); PG8_BAR; PG8_SCHED;
            PG8_LDA(At, 0, 1); PG8_STAGE(PG8_SB(0, 0), b2, voffB); PG8_STAGE(PG8_SB(0, 1), b2 + hstep, voffB); PG8_STAGEA(PG8_SA(0, 0), k2, oc00, oc01);
            PG8_WAIT_V(8); PG8_WAIT_L(0); PG8_BAR; PG8_MMA(1, 0, At, B0); PG8_MMA(1, 1, At, B1); PG8_BAR; PG8_SCHED;
            PG8_LDB(B0, 1, 0); PG8_LDB(B1, 1, 1); PG8_SCHED; PG8_LDA(At, 1, 0); PG8_STAGEA(PG8_SA(0, 1), k2, oc10, oc11);
            PG8_WAIT_V(8); PG8_WAIT_L(0); PG8_BAR; PG8_MMA(0, 0, At, B0); PG8_MMA(0, 1, At, B1); PG8_BAR; PG8_SCHED;
            PG8_LDA(At, 1, 1); PG8_STAGE(PG8_SB(1, 0), b3, voffB); PG8_STAGE(PG8_SB(1, 1), b3 + hstep, voffB); PG8_STAGEA(PG8_SA(1, 0), k3, oc00, oc01);
            PG8_WAIT_V(8); PG8_WAIT_L(0); PG8_BAR; PG8_MMA(1, 0, At, B0); PG8_MMA(1, 1, At, B1); PG8_BAR; PG8_SCHED;
        }
        if constexpr (ALIGN_EPI) { if (wr == 0) PG8_BAR; }
        E(acc, cur, wr, wc, fr, fq);
        if (!has_next) break;
#pragma unroll
        for (int a = 0; a < 2; ++a)
#pragma unroll
            for (int b = 0; b < 2; ++b)
#pragma unroll
                for (int m = 0; m < 4; ++m)
#pragma unroll
                    for (int n = 0; n < 2; ++n) acc[a][b][m][n] = (f32x4){0.f, 0.f, 0.f, 0.f};
        cur = nxt; cB = nB; ++ui;
        if constexpr (ALIGN_EPI) { if (wr == 1) PG8_BAR; }
    }
    PG8_WAIT_V(0);
    if constexpr (!ALIGN_EPI) { if (wr == 0) PG8_BAR; }
    PG8_BAR;
#undef PG8_SA
#undef PG8_SB
#undef PG8_STAGE
#undef PG8_STAGEA
#undef PG8_AOFF
#undef PG8_LDA
#undef PG8_LDB
#undef PG8_MMA
#undef PG8_LD8
#undef PG8_H
#undef PG8_WAIT_V
#undef PG8_WAIT_L
#undef PG8_BAR
#undef PG8_SCHED
}
}

#define PHASE_IDS(F) do { int _t = threadIdx.x; asm volatile("" : "+v"(_t)); (F).tid = _t; (F).lane = _t & 63; (F).wave = __builtin_amdgcn_readfirstlane(_t >> 6); } while (0)
struct TrItem { const float* W; bf16* WT; int ldw, K, mode, f8; };
__device__ __forceinline__ void tr_load(float (&tv)[32], const TrItem& t, int wave, int lane) {
#pragma unroll
    for (int i = 0; i < 32; ++i) tv[i] = t.W[(size_t)(8 * wave + (i >> 2)) * t.ldw + 64 * (i & 3) + lane];
}
__device__ __forceinline__ void tr_store(const float (&tv)[32], const TrItem& t, LAS float* scr, int wave, int lane) {
#pragma unroll
    for (int i = 0; i < 32; ++i) scr[(8 * wave + (i >> 2)) * 257 + 64 * (i & 3) + lane] = tv[i];
    __syncthreads();
    const int c = lane & 7;
#pragma unroll
    for (int j = 0; j < 4; ++j) { const int n = 32 * wave + 8 * j + (lane >> 3); const LAS float* s = scr + (8 * c) * 257 + n;
        v4u o; o.x = pk2(s[0 * 257], s[1 * 257]); o.y = pk2(s[2 * 257], s[3 * 257]); o.z = pk2(s[4 * 257], s[5 * 257]); o.w = pk2(s[6 * 257], s[7 * 257]);
        const int drow = t.mode ? 256 * (n >> 7) + (n & 127) : n;
        if (t.f8) { v2u o8; o8.x = pg8::pk4_fp8(s[0 * 257] * 32.f, s[1 * 257] * 32.f, s[2 * 257] * 32.f, s[3 * 257] * 32.f); o8.y = pg8::pk4_fp8(s[4 * 257] * 32.f, s[5 * 257] * 32.f, s[6 * 257] * 32.f, s[7 * 257] * 32.f);
            *(v2u*)((unsigned char*)t.WT + (size_t)drow * t.K + 8 * c) = o8; }
        else *(v4u*)(t.WT + (size_t)drow * t.K + 8 * c) = o; }
    __syncthreads();
}

__device__ __forceinline__ void phase_prologue(Frame& F) {
    PHASE_IDS(F);
    LAS float* WL = (LAS float*)F.lds;
    LAS float* scr = (LAS float*)(F.lds + 65536);
    const float* w_in0 = F.in[4];
    for (int s0 = F.tid; s0 < 16 * 1024; s0 += 512 * 16) { float t[16];
#pragma unroll
        for (int i = 0; i < 16; ++i) { const int s = s0 + 512 * i; t[i] = w_in0[(size_t)(s >> 4) * EV_LD + 3072 + (s & 15)]; }
#pragma unroll
        for (int i = 0; i < 16; ++i) { const int s = s0 + 512 * i; WL[(s & 15) * 1024 + (s >> 4)] = t[i]; } }
    const int gw = F.vcu * NWAVES + F.wave, NGW = F.G * NWAVES;
    bf16* WIN0 = (bf16*)(F.ws + WS_WIN0); bf16* WOUT0 = (bf16*)(F.ws + WS_WOUT0); bf16* WIN1 = (bf16*)(F.ws + WS_WIN1); bf16* WOUT1 = (bf16*)(F.ws + WS_WOUT1);
    bf16* W13 = (bf16*)(F.ws + WS_W13); bf16* W2 = (bf16*)(F.ws + WS_W2);
    constexpr int I_A = 16 * 12, I_B = 16 * 2, I_C = 16 * 4, I_D = 16 * 10, I_E = 16 * 4, I_F = 2 * 32 * 2 * 32, I_G = 2 * 32 * 32;
    constexpr int NITEMS = I_A + I_B + I_C + I_D + I_E + I_F + I_G;
    auto decode = [&](int it) {
        TrItem t; int r = it; t.mode = 0; t.f8 = 0;
        if (r < I_A) { const int kb = r / 12, nb = r % 12; t.ldw = EV_LD; t.K = 1024; t.W = w_in0 + (size_t)(64 * kb) * EV_LD + 256 * nb; t.WT = WIN0 + (size_t)(256 * nb) * 1024 + 64 * kb; return t; } r -= I_A;
        if (r < I_B) { const int kb = r / 2, nb = r % 2; t.ldw = EV_LD; t.K = 1024; t.W = w_in0 + (size_t)(64 * kb) * EV_LD + 3088 + 256 * nb; t.WT = WIN0 + (size_t)(3072 + 256 * nb) * 1024 + 64 * kb; return t; } r -= I_B;
        if (r < I_C) { const int kb = r / 4, nb = r % 4; t.ldw = 1024; t.K = 1024; t.W = F.in[10] + (size_t)(64 * kb) * 1024 + 256 * nb; t.WT = WOUT0 + (size_t)(256 * nb) * 1024 + 64 * kb; return t; } r -= I_C;
        if (r < I_D) { const int kb = r / 10, nb = r % 10; t.ldw = OD_N; t.K = 1024; t.W = F.in[11] + (size_t)(64 * kb) * OD_N + 256 * nb; t.WT = WIN1 + (size_t)(256 * nb) * 1024 + 64 * kb; return t; } r -= I_D;
        if (r < I_E) { const int kb = r / 4, nb = r % 4; t.ldw = 1024; t.K = 1024; t.W = F.in[20] + (size_t)(64 * kb) * 1024 + 256 * nb; t.WT = WOUT1 + (size_t)(256 * nb) * 1024 + 64 * kb; return t; } r -= I_E;
        if (r < I_F) { const int le = r / 64, q = r % 64, which = q / 32, kb = (q % 32) / 2, nb = q % 2;
            t.ldw = 512; t.K = 1024; t.mode = 1; t.f8 = 1; t.W = (which ? F.in[26] : F.in[25]) + (size_t)le * 1024 * 512 + (size_t)(64 * kb) * 512 + 256 * nb;
            t.WT = (bf16*)((unsigned char*)(W13 + (size_t)(le >> 5) * 32 * 1024 * 1024) + (size_t)(le & 31) * 1024 * 1024 + (size_t)(512 * nb + which * 128) * 1024 + 64 * kb); return t; } r -= I_F;
        { const int le = r / 32, q = r % 32, kb = q / 4, nb = q % 4;
            t.ldw = 1024; t.K = 512; t.f8 = 1; t.W = F.in[27] + (size_t)le * 512 * 1024 + (size_t)(64 * kb) * 1024 + 256 * nb;
            t.WT = (bf16*)((unsigned char*)(W2 + (size_t)(le >> 5) * 32 * 1024 * 512) + (size_t)(le & 31) * 1024 * 512 + (size_t)(256 * nb) * 512 + 64 * kb); return t; }
    };
    __syncthreads();
    {
        float ta[32], tb[32]; TrItem da, db; int it = F.vcu;
        if (it < NITEMS) { da = decode(it); tr_load(ta, da, F.wave, F.lane); }
        while (it < NITEMS) {
            const int i1 = it + F.G, i2 = it + 2 * F.G;
            if (i1 < NITEMS) { db = decode(i1); tr_load(tb, db, F.wave, F.lane); }
            tr_store(ta, da, scr, F.wave, F.lane);
            if (i1 >= NITEMS) break;
            if (i2 < NITEMS) { da = decode(i2); tr_load(ta, da, F.wave, F.lane); }
            tr_store(tb, db, scr, F.wave, F.lane);
            it = i2;
        }
    }
    __syncthreads();
    const float* x = F.in[0]; const float* g = F.in[1];
    bf16* XN = (bf16*)(F.ws + WS_ACT); float* BL = (float*)(F.ws + WS_BLOW);
    f32x4 gv[4];
#pragma unroll
    for (int j = 0; j < 4; ++j) gv[j] = *((const f32x4*)g + 64 * j + F.lane);
    for (int m = gw; m < NT; m += NGW) {
        asm volatile("" ::: "memory");
        const f32x4* xr = (const f32x4*)(x + (size_t)m * D) + F.lane;
        f32x4 v[4]; float s = 0.f;
#pragma unroll
        for (int j = 0; j < 4; ++j) { v[j] = xr[64 * j]; s += (v[j].x * v[j].x + v[j].y * v[j].y) + (v[j].z * v[j].z + v[j].w * v[j].w); }
        const float rstd = rsqrtf(wave_sum(s) * (1.f / D) + EPS);
        v2u* o8 = (v2u*)(XN + (size_t)m * D) + F.lane;
#pragma unroll
        for (int j = 0; j < 4; ++j) { v[j] = v[j] * rstd * gv[j]; v2u w; w.x = pk2(v[j].x, v[j].y); w.y = pk2(v[j].z, v[j].w); o8[64 * j] = w; }
        float p[16];
#pragma unroll
        for (int o = 0; o < 16; ++o) {
            const LAS f32x4* wl = (const LAS f32x4*)(WL + o * 1024) + F.lane; float a = 0.f;
#pragma unroll
            for (int j = 0; j < 4; ++j) { const f32x4 w = wl[64 * j]; a += (v[j].x * w.x + v[j].y * w.y) + (v[j].z * w.z + v[j].w * w.w); }
            p[o] = a;
        }
#pragma unroll
        for (int o = 0; o < 8; ++o) { const bool hi = (F.lane & 32) != 0; const float snd = hi ? p[o] : p[o + 8], kp = hi ? p[o + 8] : p[o]; p[o] = kp + __shfl_xor(snd, 32); }
#pragma unroll
        for (int o = 0; o < 4; ++o) { const bool hi = (F.lane & 16) != 0; const float snd = hi ? p[o] : p[o + 4], kp = hi ? p[o + 4] : p[o]; p[o] = kp + __shfl_xor(snd, 16); }
#pragma unroll
        for (int o = 0; o < 2; ++o) { const bool hi = (F.lane & 8) != 0; const float snd = hi ? p[o] : p[o + 2], kp = hi ? p[o + 2] : p[o]; p[o] = kp + __shfl_xor(snd, 8); }
        { const bool hi = (F.lane & 4) != 0; const float snd = hi ? p[0] : p[1], kp = hi ? p[1] : p[0]; p[0] = kp + __shfl_xor(snd, 4); }
        p[0] += __shfl_xor(p[0], 2); p[0] += __shfl_xor(p[0], 1);
        if ((F.lane & 3) == 0) BL[(size_t)m * 16 + ((F.lane >> 5) & 1) * 8 + ((F.lane >> 4) & 1) * 4 + ((F.lane >> 3) & 1) * 2 + ((F.lane >> 2) & 1)] = p[0];
    }
}

__device__ __forceinline__ float row16_max(float v) { v = fmaxf(v, __shfl_xor(v, 1)); v = fmaxf(v, __shfl_xor(v, 2)); v = fmaxf(v, __shfl_xor(v, 4)); return fmaxf(v, __shfl_xor(v, 8)); }
__device__ __forceinline__ float row16_sum(float v) { v += __shfl_xor(v, 1); v += __shfl_xor(v, 2); v += __shfl_xor(v, 4); return v + __shfl_xor(v, 8); }
__device__ __forceinline__ int row16_min(int v) { v = min(v, __shfl_xor(v, 1)); v = min(v, __shfl_xor(v, 2)); v = min(v, __shfl_xor(v, 4)); return min(v, __shfl_xor(v, 8)); }
__device__ __forceinline__ void phase_router(Frame& F, int layer, const bf16* XR) {
    PHASE_IDS(F);
    constexpr int PW = 2064;
    LAS unsigned char* WH = F.lds; LAS unsigned char* WLO = F.lds + 36 * PW;
    LAS float* GL = (LAS float*)(F.lds + LDS_MISC + 1024);
    LAS int* hist = (LAS int*)(F.lds + LDS_MISC + 1024 + 4096); LAS int* base = hist + 32;
    LAS int* s_e0 = base + 32; LAS int* s_e1 = s_e0 + 128; LAS int* s_r0 = s_e1 + 128; LAS int* s_r1 = s_r0 + 128;
    LAS float* s_w0 = (LAS float*)(s_r1 + 128); LAS float* s_w1 = s_w0 + 128;
    const float* wg = F.in[21] + (size_t)layer * 1024 * 4; const float* we = F.in[23] + (size_t)layer * 1024 * 32;
    const float* g = F.in[2] + layer * 1024;
    for (int s = F.tid; s < 1024; s += 512) GL[s] = g[s];
    __syncthreads();
    for (int s0 = F.tid; s0 < 4096 + 32768; s0 += 512 * 18) {
        float t[18];
#pragma unroll
        for (int i = 0; i < 18; ++i) { const int s = s0 + 512 * i; t[i] = s < 4096 ? wg[s] : we[s - 4096]; }
#pragma unroll
        for (int i = 0; i < 18; ++i) { const int s = s0 + 512 * i; const int k = s < 4096 ? (s >> 2) : ((s - 4096) >> 5), o = s < 4096 ? (s & 3) : 4 + ((s - 4096) & 31);
            const float w = t[i] * GL[k]; const unsigned hb = f2bf(w);
            *(LAS bf16*)(WH + o * PW + k * 2) = (bf16)hb; *(LAS bf16*)(WLO + o * PW + k * 2) = (bf16)f2bf(w - bf2f((bf16)hb)); } }
    const int c = F.lane & 15, q = F.lane >> 4;
    float bias[3];
#pragma unroll
    for (int jt = 0; jt < 3; ++jt) { const int col = 16 * jt + c; bias[jt] = col < 4 ? F.in[22][layer * 4 + col] : (col < 36 ? F.in[24][layer * 32 + col - 4] : 0.f); }
    unsigned* cnt = F.ctl + CW_CNT + 64 * layer;
    bf16* XN = (bf16*)(F.ws + WS_ACT); const float* SSQ = (const float*)(F.ws + WS_SSQ);
    int* ME0 = (int*)(F.ws + WS_META); int* ME1 = ME0 + NT; int* MR0 = ME1 + NT; int* MR1 = MR0 + NT; float* MW0 = (float*)(MR1 + NT); float* MW1 = MW0 + NT;
    int* LIST = (int*)(F.ws + WS_LIST);
    int wrow[3];
#pragma unroll
    for (int jt = 0; jt < 3; ++jt) wrow[jt] = min(16 * jt + c, 35) * PW + 16 * q;
    __syncthreads();
    for (int row0 = 128 * F.vcu; row0 < NT; row0 += 128 * F.G) {
        if (F.tid < 32) hist[F.tid] = 0;
        __syncthreads();
        const int rl = F.wave * 16, row = row0 + rl + c;
        float rstd; { const f32x4 sp = *(const f32x4*)(SSQ + (size_t)row * 16 + 4 * q); float s = (sp[0] + sp[1]) + (sp[2] + sp[3]); s += __shfl_xor(s, 16); s += __shfl_xor(s, 32); rstd = rsqrtf(s * (1.f / D) + EPS); }
        const bf16* xr = XR + (size_t)row * D + 8 * q; unsigned char* xo = (unsigned char*)XN + (size_t)row * D + 8 * q;
        f32x4 acc[3];
#pragma unroll
        for (int jt = 0; jt < 3; ++jt) acc[jt] = (f32x4){0.f, 0.f, 0.f, 0.f};
        for (int k4 = 0; k4 < 32; k4 += 8) {
            v4u xw[8];
#pragma unroll
            for (int u = 0; u < 8; ++u) xw[u] = *(const v4u*)(xr + 32 * (k4 + u));
#pragma unroll
            for (int u = 0; u < 8; ++u) {
                const int kk = k4 + u;
                const f32x4 ga = *(const LAS f32x4*)(GL + 32 * kk + 8 * q), gb = *(const LAS f32x4*)(GL + 32 * kk + 8 * q + 4);
                const v4u w = xw[u];
#define BLO(x) __builtin_bit_cast(float, (x) << 16)
#define BHI(x) __builtin_bit_cast(float, (x) & 0xffff0000u)
                v2u xn; xn.x = pg8::pk4_fp8(BLO(w.x) * rstd * ga[0], BHI(w.x) * rstd * ga[1], BLO(w.y) * rstd * ga[2], BHI(w.y) * rstd * ga[3]);
                xn.y = pg8::pk4_fp8(BLO(w.z) * rstd * gb[0], BHI(w.z) * rstd * gb[1], BLO(w.w) * rstd * gb[2], BHI(w.w) * rstd * gb[3]);
#undef BLO
#undef BHI
                *(v2u*)(xo + 32 * kk) = xn;
                const bf16x8 ah = __builtin_bit_cast(bf16x8, w);
#pragma unroll
                for (int jt = 0; jt < 3; ++jt) { const bf16x8 bh = *(const LAS bf16x8*)(WH + wrow[jt] + 64 * kk), bl = *(const LAS bf16x8*)(WLO + wrow[jt] + 64 * kk);
                    acc[jt] = __builtin_amdgcn_mfma_f32_16x16x32_bf16(ah, bh, acc[jt], 0, 0, 0); acc[jt] = __builtin_amdgcn_mfma_f32_16x16x32_bf16(ah, bl, acc[jt], 0, 0, 0); }
            }
        }
#pragma unroll
        for (int i = 0; i < 4; ++i) {
            const float rs = __shfl(rstd, 4 * q + i);
            const float l0 = acc[0][i] * rs + bias[0], l1 = acc[1][i] * rs + bias[1], l2 = acc[2][i] * rs + bias[2];
            const float gvl = c < 4 ? l0 : -3.0e38f;
            const float gmax = row16_max(gvl); const int gi = row16_min(gvl == gmax ? c : 99);
            const float gwt = 1.f / row16_sum(c < 4 ? __expf(gvl - gmax) : 0.f);
            const int jt = c < 4 ? (gi == 1 ? 1 : 2) : (c < 12 ? (gi == 0 ? 0 : 1) : (gi == 1 ? 0 : 1));
            const bool valid = c < 4 ? (gi == 1 || gi == 3) : (c < 12 ? (gi == 0 || gi == 2) : (gi == 1 || gi == 3));
            const int eidx = 16 * jt + c - 4 - 8 * gi;
            float cv = jt == 0 ? l0 : (jt == 1 ? l1 : l2); cv = (valid && eidx >= 0 && eidx < 8) ? cv : -3.0e38f;
            const float v0 = row16_max(cv); const int i0 = row16_min(cv == v0 ? eidx : 99);
            const float cv2 = eidx == i0 ? -3.0e38f : cv;
            const float v1 = row16_max(cv2); const int i1 = row16_min(cv2 == v1 ? eidx : 99);
            const float ex = __expf(v1 - v0), tw0 = 1.f / (1.f + ex), tw1 = ex / (1.f + ex);
            if (c == 0) { const int r = rl + 4 * q + i, e0 = gi * 8 + i0, e1 = gi * 8 + i1;
                s_e0[r] = e0; s_e1[r] = e1; s_w0[r] = gwt * tw0; s_w1[r] = gwt * tw1;
                s_r0[r] = atomicAdd((int*)&hist[e0], 1); s_r1[r] = atomicAdd((int*)&hist[e1], 1); }
        }
        __syncthreads();
        if (F.tid < 32) base[F.tid] = (int)atomicAdd(cnt + F.tid, (unsigned)hist[F.tid]);
        __syncthreads();
        if (F.tid < 128) {
            const int m = row0 + F.tid, e0 = s_e0[F.tid], e1 = s_e1[F.tid], r0 = base[e0] + s_r0[F.tid], r1 = base[e1] + s_r1[F.tid];
            ME0[m] = e0; ME1[m] = e1; MR0[m] = r0; MR1[m] = r1; MW0[m] = s_w0[F.tid]; MW1[m] = s_w1[F.tid];
            LIST[(size_t)e0 * NT + r0] = m; LIST[(size_t)e1 * NT + r1] = m;
        }
        __syncthreads();
    }
}

__device__ __forceinline__ void phase_combine(Frame& F, int layer, const bf16* XRin, bf16* XRout) {
    PHASE_IDS(F);
    LAS int* poff = (LAS int*)(F.lds + LDS_MISC + 1024);
    const unsigned* cnt = F.ctl + CW_CNT + 64 * layer;
    if (F.tid < 32) poff[33 + F.tid] = (int)cnt[F.tid];
    __syncthreads();
    if (F.tid == 0) { int acc = 0; for (int e = 0; e < 32; ++e) { poff[e] = acc; acc += (poff[33 + e] + 255) & ~255; } poff[32] = acc; }
    __syncthreads();
    const int gw = F.vcu * NWAVES + F.wave, NGW = F.G * NWAVES;
    const float* g = layer == 0 ? F.in[1] + 1024 : F.in[3];
    const bf16* Y = (const bf16*)(F.ws + WS_Y); bf16* XN = (bf16*)(F.ws + WS_ACT);
    const int* ME0 = (const int*)(F.ws + WS_META); const int* ME1 = ME0 + NT; const int* MR0 = ME1 + NT; const int* MR1 = MR0 + NT; const float* MW0 = (const float*)(MR1 + NT); const float* MW1 = MW0 + NT;
    f32x4 gv[4];
#pragma unroll
    for (int j = 0; j < 4; ++j) gv[j] = *((const f32x4*)g + 64 * j + F.lane);
    for (int m0 = gw; m0 < NT; m0 += 2 * NGW) {
        int mr[2]; mr[0] = m0; mr[1] = (m0 + NGW < NT) ? m0 + NGW : m0;
        f32x4 v[2][4]; unsigned ya[2][4], yb[2][4]; float w0[2], w1[2];
#pragma unroll
        for (int r = 0; r < 2; ++r) {
            const int m = mr[r]; const int s0 = poff[ME0[m]] + MR0[m], s1 = poff[ME1[m]] + MR1[m]; w0[r] = MW0[m] * (1.f / 16.f); w1[r] = MW1[m] * (1.f / 16.f);
            const v2u* xr = (const v2u*)(XRin + (size_t)m * D) + F.lane;
            const unsigned* y0 = (const unsigned*)((const unsigned char*)Y + (size_t)s0 * D) + F.lane; const unsigned* y1 = (const unsigned*)((const unsigned char*)Y + (size_t)s1 * D) + F.lane;
#pragma unroll
            for (int j = 0; j < 4; ++j) { const v2u xw = xr[64 * j]; v[r][j] = (f32x4){bf2f((bf16)(xw.x & 0xffff)), bf2f((bf16)(xw.x >> 16)), bf2f((bf16)(xw.y & 0xffff)), bf2f((bf16)(xw.y >> 16))}; ya[r][j] = y0[64 * j]; yb[r][j] = y1[64 * j]; }
        }
#pragma unroll
        for (int r = 0; r < 2; ++r) {
            const int m = mr[r]; float s = 0.f;
            f32x4* xr = (f32x4*)(F.out + (size_t)m * D) + F.lane; v2u* xo2 = (v2u*)(XRout + (size_t)m * D) + F.lane;
#pragma unroll
            for (int j = 0; j < 4; ++j) { const f32x2 a0 = __builtin_amdgcn_cvt_pk_f32_fp8((int)ya[r][j], false), a1 = __builtin_amdgcn_cvt_pk_f32_fp8((int)ya[r][j], true), b0 = __builtin_amdgcn_cvt_pk_f32_fp8((int)yb[r][j], false), b1 = __builtin_amdgcn_cvt_pk_f32_fp8((int)yb[r][j], true);
                v[r][j].x += w0[r] * a0.x + w1[r] * b0.x; v[r][j].y += w0[r] * a0.y + w1[r] * b0.y;
                v[r][j].z += w0[r] * a1.x + w1[r] * b1.x; v[r][j].w += w0[r] * a1.y + w1[r] * b1.y;
                s += (v[r][j].x * v[r][j].x + v[r][j].y * v[r][j].y) + (v[r][j].z * v[r][j].z + v[r][j].w * v[r][j].w); }
            const float rstd = rsqrtf(wave_sum(s) * (1.f / D) + EPS);
            if (r == 1 && mr[1] == mr[0]) continue;
            if (layer == 0) {
                v2u* o8 = (v2u*)(XN + (size_t)m * D) + F.lane;
#pragma unroll
                for (int j = 0; j < 4; ++j) { v2u xw; xw.x = pk2(v[r][j].x, v[r][j].y); xw.y = pk2(v[r][j].z, v[r][j].w); xo2[64 * j] = xw; const f32x4 n = v[r][j] * rstd * gv[j]; v2u w; w.x = pk2(n.x, n.y); w.y = pk2(n.z, n.w); o8[64 * j] = w; }
            } else {
#pragma unroll
                for (int j = 0; j < 4; ++j) xr[64 * j] = v[r][j] * rstd * gv[j];
            }
        }
    }
}


namespace mx {
typedef short s4 __attribute__((ext_vector_type(4)));
constexpr int PV = 272, PP = 144;
template <int DK> struct Lay { static constexpr int PK = DK * 2 + 16, QS = 0, KS = 64 * PK, VV = 2 * 64 * PK, ST = VV + 64 * PV, PM = ST + 128 * PK, VEC = PM + 64 * PP, PART = VEC + 3 * DK * 4, RED = PART + 8 * DK * 4, BLS = RED + 4096, END = BLS + 4096; };
static_assert(Lay<128>::END <= LDS_MISC, "mixer LDS map");
__device__ __forceinline__ bf16x8 row_frag(const LAS unsigned char* base, int pitch, int row0, int kk, int lane) {
    return *(const LAS bf16x8*)(base + (row0 + (lane & 15)) * pitch + (32 * kk + 8 * (lane >> 4)) * 2);
}
__device__ __forceinline__ bf16x8 tr_frag(const LAS unsigned char* base, int pitch, int k0, int c0, int lane) {
    const int g = lane >> 4, q = (lane & 15) >> 2, p = lane & 3;
    const LAS unsigned char* a = base + (k0 + 8 * g + q) * pitch + (c0 + 4 * p) * 2;
    const s4 lo = __builtin_amdgcn_ds_read_tr16_b64_v4i16((LAS s4*)a);
    const s4 hi = __builtin_amdgcn_ds_read_tr16_b64_v4i16((LAS s4*)(a + 4 * pitch));
    return __builtin_shufflevector(lo, hi, 0, 1, 2, 3, 4, 5, 6, 7);
}
#define MFMA16(a, b, c) __builtin_amdgcn_mfma_f32_16x16x32_bf16(a, b, c, 0, 0, 0)

struct UnitP { const bf16* PROJ; bf16* YM; const float* nw; const float* BL; const float* p0; const float* p1; const float* p2; int b, h, c0, nch, seg; };

template <int KIND> struct KC {
    static constexpr int DK = KIND == 0 ? 128 : 64, LDP = KIND == 2 ? OD_N : EV_N;
    __device__ static __forceinline__ int qcol(int h) { return KIND == 0 ? h * 128 : (KIND == 1 ? 2048 + h * 64 : h * 64); }
    __device__ static __forceinline__ int kcol(int h) { return KIND == 0 ? 512 + h * 128 : (KIND == 1 ? 2304 + h * 64 : 256 + h * 64); }
    __device__ static __forceinline__ int vcol(int h) { return KIND == 0 ? 1024 + h * 128 : (KIND == 1 ? 2560 + h * 128 : 512 + h * 128); }
    __device__ static __forceinline__ int gcol(int h) { return KIND == 0 ? 1536 + h * 128 : (KIND == 1 ? 3072 + h * 128 : 1024 + h * 128); }
    __device__ static __forceinline__ int ocol(int h) { return KIND == 1 ? 512 + h * 128 : h * 128; }
};

template <int KIND, bool FULL>
__device__ __forceinline__ void mix_unit(LAS unsigned char* lds, float* Sg, float* Bg, const UnitP& U) {
    using K = KC<KIND>; constexpr int DK = K::DK, LDP = K::LDP, NJT = DK == 128 ? 8 : 4; using L = Lay<DK>; constexpr int PK = L::PK;
    int tid = threadIdx.x; asm volatile("" : "+v"(tid));
    const int lane = tid & 63, wave = __builtin_amdgcn_readfirstlane(tid >> 6), g = lane >> 4, c = lane & 15;
    const int h = U.h, dt = DK == 128 ? wave : (wave & 3), jt0 = DK == 128 ? 0 : 4 * (wave >> 2);
    LAS float* EM = (LAS float*)(lds + L::VEC); LAS float* EL = EM + DK; LAS float* BT = EL + DK; LAS float* PART = (LAS float*)(lds + L::PART);
    float lb0 = 0.f, lb1 = 0.f, wu[16], bu = 0.f, ci = 0.f, lgg = 0.f;
    if (KIND == 0) {
        const float* lbl = U.p0; const int col = h * 128 + 2 * lane;
#pragma unroll
        for (int x = 0; x < 2; ++x) { const float l0 = lbl[col + x], l1 = lbl[512 + col + x], l2 = lbl[1024 + col + x]; const float mx_ = fmaxf(l0, fmaxf(l1, l2));
            const float e0 = __expf(l0 - mx_), e1 = __expf(l1 - mx_), e2 = __expf(l2 - mx_); const float v = e0 / (e0 + e1 + e2); if (x == 0) lb0 = v; else lb1 = v; }
    }
    if (KIND == 1) {
#pragma unroll
        for (int r = 0; r < 16; ++r) wu[r] = U.p0[r * 256 + h * 64 + lane];
        bu = U.p1[h * 64 + lane];
    }
    if (KIND == 2) { ci = exp2f(-(float)(lane & 31) * (13.287712379549449f / 32.f)) * 0.15915494309189535f; lgg = log1pf(-exp2f(-5.f - (float)h)); }
    f32x4 S[NJT];
#pragma unroll
    for (int jt = 0; jt < NJT; ++jt) {
        S[jt] = (f32x4){0.f, 0.f, 0.f, 0.f};
    }
    if (FULL) {
        f32x4 L[NJT], D4 = (f32x4){0.f, 0.f, 0.f, 0.f};
        auto ldseg = [&](int s) { const float* Sp = Sg + (ptrdiff_t)s * 16384; D4 = *(const f32x4*)(Bg + s * 128 + 16 * dt + 4 * g);
#pragma unroll
            for (int jt = 0; jt < NJT; ++jt)
#pragma unroll
                for (int i = 0; i < 4; ++i) L[jt][i] = Sp[(16 * dt + 4 * g + i) * 128 + 16 * (jt0 + jt) + c]; };
        if (U.seg > 0) ldseg(-U.seg);
        for (int s = -U.seg; s < 0; ++s) {
            f32x4 Lc[NJT]; const f32x4 Dc = D4;
#pragma unroll
            for (int jt = 0; jt < NJT; ++jt) Lc[jt] = L[jt];
            if (s + 1 < 0) ldseg(s + 1);
#pragma unroll
            for (int jt = 0; jt < NJT; ++jt) S[jt] = Dc * S[jt] + Lc[jt];
        }
    }
    f32x4 nw4[4];
    if (FULL) {
#pragma unroll
        for (int x = 0; x < 4; ++x) nw4[x] = *(const f32x4*)(U.nw + h * 128 + 16 * (4 * (wave >> 2) + x) + 4 * g);
    }
    if (tid < DK) BT[tid] = KIND == 0 ? 1.f : 0.f;
    v4u rv0, rv1; unsigned ra[8], rb[8]; f32x4 rbl = (f32x4){0.f, 0.f, 0.f, 0.f};
    auto load_raw = [&](int ch) {
        const size_t row0 = (size_t)U.b * SEQ + (U.c0 + ch) * 64;
        const bf16* Vp = U.PROJ + (row0 + (tid >> 3)) * LDP + K::vcol(h) + (tid & 7) * 16;
        rv0 = *(const v4u*)Vp; rv1 = *(const v4u*)(Vp + 8);
        if (KIND == 1 && tid < 256) rbl = *(const f32x4*)(U.BL + (row0 + (tid >> 2)) * 16 + (tid & 3) * 4);
        if (KIND == 0) {
            const bf16* P = U.PROJ + (row0 + 8 * wave) * LDP + 2 * lane;
#pragma unroll
            for (int tt = 0; tt < 8; ++tt) { ra[tt] = *(const unsigned*)(P + (size_t)tt * LDP + K::kcol(h)); if (FULL) rb[tt] = *(const unsigned*)(P + (size_t)tt * LDP + K::qcol(h)); }
        } else {
            const bf16* P = U.PROJ + (row0 + 8 * wave) * LDP + lane;
#pragma unroll
            for (int tt = 0; tt < 8; ++tt) { ra[tt] = P[(size_t)tt * LDP + K::kcol(h)]; if (FULL) rb[tt] = P[(size_t)tt * LDP + K::qcol(h)]; }
        }
    };
    load_raw(0);
    for (int ch = 0; ch < U.nch; ++ch) {
        const int pos0 = (U.c0 + ch) * 64; const size_t row0 = (size_t)U.b * SEQ + pos0;
        *(LAS v4u*)(lds + L::VV + (tid >> 3) * PV + (tid & 7) * 32) = rv0; *(LAS v4u*)(lds + L::VV + (tid >> 3) * PV + (tid & 7) * 32 + 16) = rv1;
        if (KIND == 0) {
            float cp0[8], cp1[8], k0[8], k1[8]; float c0 = 1.f, c1 = 1.f;
#pragma unroll
            for (int tt = 0; tt < 8; ++tt) {
                const float f0 = lb0 + (1.f - lb0) * sigmoidf_(bf2f((bf16)(ra[tt] & 0xffff))), f1 = lb1 + (1.f - lb1) * sigmoidf_(bf2f((bf16)(ra[tt] >> 16)));
                c0 *= f0; c1 *= f1; cp0[tt] = c0; cp1[tt] = c1; k0[tt] = 1.f - f0; k1[tt] = 1.f - f1;
            }
            *(LAS f32x2*)(PART + wave * 128 + 2 * lane) = (f32x2){c0, c1};
            __syncthreads();
            float pre0 = 1.f, pre1 = 1.f, mid0 = 1.f, mid1 = 1.f, hi0 = 1.f, hi1 = 1.f;
#pragma unroll
            for (int w2 = 0; w2 < 8; ++w2) { const f32x2 p = *(const LAS f32x2*)(PART + w2 * 128 + 2 * lane);
                if (w2 < 4) { mid0 *= p.x; mid1 *= p.y; } else { hi0 *= p.x; hi1 *= p.y; }
                if (wave < 4 ? (w2 > wave && w2 < 4) : (w2 >= 4 && w2 < wave)) { pre0 *= p.x; pre1 *= p.y; } }
#pragma unroll
            for (int tt = 0; tt < 8; ++tt) {
                float qs0, qs1, ks0, ks1;
                if (wave >= 4) { qs0 = pre0 * cp0[tt]; qs1 = pre1 * cp1[tt]; ks0 = __builtin_amdgcn_rcpf(fmaxf(qs0, 1e-26f)); ks1 = __builtin_amdgcn_rcpf(fmaxf(qs1, 1e-26f)); }
                else { ks0 = pre0 * c0 * __builtin_amdgcn_rcpf(fmaxf(cp0[tt], 1e-26f)); ks1 = pre1 * c1 * __builtin_amdgcn_rcpf(fmaxf(cp1[tt], 1e-26f));
                       qs0 = __builtin_amdgcn_rcpf(fmaxf(ks0, 1e-26f)); qs1 = __builtin_amdgcn_rcpf(fmaxf(ks1, 1e-26f)); }
                *(LAS unsigned*)(lds + L::KS + (8 * wave + tt) * PK + 4 * lane) = pg8::cvt_pk_bf16(k0[tt] * ks0, k1[tt] * ks1);
                if (FULL) *(LAS unsigned*)(lds + L::QS + (8 * wave + tt) * PK + 4 * lane) = pg8::cvt_pk_bf16(bf2f((bf16)(rb[tt] & 0xffff)) * qs0, bf2f((bf16)(rb[tt] >> 16)) * qs1);
            }
            if (wave == 0) { *(LAS f32x2*)(EM + 2 * lane) = (f32x2){mid0, mid1}; *(LAS f32x2*)(EL + 2 * lane) = (f32x2){hi0, hi1};
                const f32x2 o = *(const LAS f32x2*)(BT + 2 * lane); *(LAS f32x2*)(BT + 2 * lane) = (f32x2){o.x * mid0 * hi0, o.y * mid1 * hi1}; }
        } else if (KIND == 1) {
            LAS float* BLS = (LAS float*)(lds + L::BLS);
            if (tid < 256) *(LAS f32x4*)(BLS + (tid >> 2) * 16 + (tid & 3) * 4) = rbl;
            __syncthreads();
            float cs[8]; float cc = 0.f;
#pragma unroll
            for (int tt = 0; tt < 8; ++tt) {
                const LAS f32x4* bl = (const LAS f32x4*)(BLS + (8 * wave + tt) * 16); float z = bu;
#pragma unroll
                for (int r = 0; r < 4; ++r) { const f32x4 bq = bl[r]; z += (bq[0] * wu[4 * r] + bq[1] * wu[4 * r + 1]) + (bq[2] * wu[4 * r + 2] + bq[3] * wu[4 * r + 3]); }
                const float ls = fminf(z, 0.f) - __logf(1.f + __expf(-fabsf(z)));
                cc += ls * (1.f / 16.f); cs[tt] = cc;
            }
            PART[wave * 64 + lane] = cc;
            __syncthreads();
            float off = 0.f, mid = 0.f, tot = 0.f;
#pragma unroll
            for (int w2 = 0; w2 < 8; ++w2) { const float p = PART[w2 * 64 + lane]; if (w2 < wave) off += p; if (w2 < 4) mid += p; tot += p; }
#pragma unroll
            for (int tt = 0; tt < 8; ++tt) {
                const float b = off + cs[tt];
                *(LAS bf16*)(lds + L::KS + (8 * wave + tt) * PK + 2 * lane) = (bf16)f2bf(bf2f((bf16)ra[tt]) * __expf(fminf(mid - b, 60.f)));
                if (FULL) *(LAS bf16*)(lds + L::QS + (8 * wave + tt) * PK + 2 * lane) = (bf16)f2bf(bf2f((bf16)rb[tt]) * 0.125f * __expf(fminf(b - mid, 60.f)));
            }
            if (wave == 0) { EM[lane] = __expf(mid); EL[lane] = __expf(tot - mid); BT[lane] += tot; }
        } else {
#pragma unroll
            for (int tt = 0; tt < 8; ++tt) {
                const int tl = 8 * wave + tt; float rev = (float)(pos0 + tl) * ci; rev -= floorf(rev);
                const float sn = __builtin_amdgcn_sinf(rev), cs = __builtin_amdgcn_cosf(rev);
                const float e = (float)(tl - 31) * lgg;
                const float kv = bf2f((bf16)ra[tt]), kp = __shfl_xor(kv, 32);
                const float kr = (lane < 32 ? kv * cs - kp * sn : kp * sn + kv * cs) * 0.125f;
                *(LAS bf16*)(lds + L::KS + tl * PK + 2 * lane) = (bf16)f2bf(kr * __expf(-e));
                if (FULL) { const float qv = bf2f((bf16)rb[tt]), qp = __shfl_xor(qv, 32); const float qr = lane < 32 ? qv * cs - qp * sn : qp * sn + qv * cs;
                    *(LAS bf16*)(lds + L::QS + tl * PK + 2 * lane) = (bf16)f2bf(qr * __expf(e)); }
            }
            if (wave == 0) { const float e32 = __expf(32.f * lgg); EM[lane] = e32; EL[lane] = e32; BT[lane] += 64.f * lgg; }
        }
        if (ch + 1 < U.nch) load_raw(ch + 1);
        v2u gq[4];
        if (FULL) { const bf16* gp = U.PROJ + (row0 + 16 * (wave & 3) + c) * LDP + K::gcol(h) + 16 * (4 * (wave >> 2)) + 4 * g;
#pragma unroll
            for (int x = 0; x < 4; ++x) gq[x] = *(const v2u*)(gp + 16 * x); }
        __syncthreads();
        { const f32x4 em4 = *(const LAS f32x4*)(EM + 16 * dt + 4 * g);
#pragma unroll
          for (int jt = 0; jt < NJT; ++jt) { S[jt] = S[jt] * em4;
              if (FULL) { v2u w; w.x = pg8::cvt_pk_bf16(S[jt][0], S[jt][1]); w.y = pg8::cvt_pk_bf16(S[jt][2], S[jt][3]);
                  *(LAS v2u*)(lds + L::ST + (16 * (jt0 + jt) + c) * PK + (16 * dt + 4 * g) * 2) = w; } } }
        if (FULL) {
            const int st = wave & 3, tt0 = 2 * (wave >> 2);
            f32x4 p0 = (f32x4){0.f, 0.f, 0.f, 0.f}, p1 = p0;
#pragma unroll
            for (int kk = 0; kk < DK / 32; ++kk) { const bf16x8 a = row_frag(lds + L::KS, PK, 16 * st, kk, lane);
                p0 = MFMA16(a, row_frag(lds + L::QS, PK, 16 * tt0, kk, lane), p0); p1 = MFMA16(a, row_frag(lds + L::QS, PK, 16 * (tt0 + 1), kk, lane), p1); }
#pragma unroll
            for (int x = 0; x < 2; ++x) { const f32x4 p = x ? p1 : p0; const int t = 16 * (tt0 + x) + c, s = 16 * st + 4 * g;
                v2u w; w.x = pg8::cvt_pk_bf16(s <= t ? p[0] : 0.f, s + 1 <= t ? p[1] : 0.f); w.y = pg8::cvt_pk_bf16(s + 2 <= t ? p[2] : 0.f, s + 3 <= t ? p[3] : 0.f);
                *(LAS v2u*)(lds + L::PM + t * PP + s * 2) = w; }
        }
        {
#pragma unroll
          for (int kk = 0; kk < 2; ++kk) { const bf16x8 a = tr_frag(lds + L::KS, PK, 32 * kk, 16 * dt, lane);
#pragma unroll
              for (int jt = 0; jt < NJT; ++jt) S[jt] = MFMA16(a, tr_frag(lds + L::VV, PV, 32 * kk, 16 * (jt0 + jt), lane), S[jt]); }
          const f32x4 el4 = *(const LAS f32x4*)(EL + 16 * dt + 4 * g);
#pragma unroll
          for (int jt = 0; jt < NJT; ++jt) S[jt] = S[jt] * el4;
        }
        __syncthreads();
        if (FULL) {
            const int tt = wave & 3, jh = wave >> 2, t = 16 * tt + c;
            f32x4 o[4];
#pragma unroll
            for (int x = 0; x < 4; ++x) o[x] = (f32x4){0.f, 0.f, 0.f, 0.f};
#pragma unroll
            for (int kk = 0; kk < 2; ++kk) { const bf16x8 bb = row_frag(lds + L::PM, PP, 16 * tt, kk, lane);
#pragma unroll
                for (int x = 0; x < 4; ++x) o[x] = MFMA16(tr_frag(lds + L::VV, PV, 32 * kk, 16 * (4 * jh + x), lane), bb, o[x]); }
#pragma unroll
            for (int kk = 0; kk < DK / 32; ++kk) { const bf16x8 bb = row_frag(lds + L::QS, PK, 16 * tt, kk, lane);
#pragma unroll
                for (int x = 0; x < 4; ++x) o[x] = MFMA16(row_frag(lds + L::ST, PK, 16 * (4 * jh + x), kk, lane), bb, o[x]); }
            float sm = 0.f, sq = 0.f;
#pragma unroll
            for (int x = 0; x < 4; ++x)
#pragma unroll
                for (int i = 0; i < 4; ++i) { sm += o[x][i]; sq += o[x][i] * o[x][i]; }
            sm += __shfl_xor(sm, 16); sq += __shfl_xor(sq, 16); sm += __shfl_xor(sm, 32); sq += __shfl_xor(sq, 32);
            LAS f32x2* RED = (LAS f32x2*)(lds + L::RED) + (ch & 1) * 128;
            if (g == 0) RED[jh * 64 + t] = (f32x2){sm, sq};
            __syncthreads();
            const f32x2 r0 = RED[t], r1 = RED[64 + t];
            const float mean = KIND == 2 ? (r0.x + r1.x) * (1.f / 128.f) : 0.f;
            const float rstd = rsqrtf(fmaxf((r0.y + r1.y) * (1.f / 128.f) - mean * mean, 0.f) + EPS);
            bf16* yp = U.YM + (row0 + t) * 1024 + K::ocol(h) + 16 * (4 * jh) + 4 * g;
#pragma unroll
            for (int x = 0; x < 4; ++x) {
                const float g0 = bf2f((bf16)(gq[x].x & 0xffff)), g1 = bf2f((bf16)(gq[x].x >> 16)), g2 = bf2f((bf16)(gq[x].y & 0xffff)), g3 = bf2f((bf16)(gq[x].y >> 16));
                v2u w; w.x = pg8::cvt_pk_bf16((o[x][0] - mean) * rstd * nw4[x][0] * siluf_(g0), (o[x][1] - mean) * rstd * nw4[x][1] * siluf_(g1));
                w.y = pg8::cvt_pk_bf16((o[x][2] - mean) * rstd * nw4[x][2] * siluf_(g2), (o[x][3] - mean) * rstd * nw4[x][3] * siluf_(g3));
                *(v2u*)(yp + 16 * x) = w; }
        }
    }
    if (!FULL) {
#pragma unroll
        for (int jt = 0; jt < NJT; ++jt)
#pragma unroll
            for (int i = 0; i < 4; ++i) Sg[(16 * dt + 4 * g + i) * 128 + 16 * (jt0 + jt) + c] = S[jt][i];
        __syncthreads();
        if (tid < DK) Bg[tid] = KIND == 0 ? BT[tid] : __expf(BT[tid]);
    }
    __syncthreads();
}
}


namespace rg {
constexpr int SEGMAX = 16;
constexpr int PX = 272, PW = 144, XCB = 0, XCF = 64 * PX, WT = XCF + 64 * 132 * 4, END = WT + 4 * 64 * PW;
static_assert(END <= LDS_MISC, "rglru LDS map");
template <bool FULL>
__device__ __forceinline__ void unit(LAS unsigned char* lds, const bf16* PROJ, bf16* YM, const float* const* in, int b, int c0, int nch, int sgi, int cg, float* RA, float* RH) {
    int tid = threadIdx.x; asm volatile("" : "+v"(tid));
    const int lane = tid & 63, wave = __builtin_amdgcn_readfirstlane(tid >> 6), g = lane >> 4, c = lane & 15;
    const int n0 = 2 * cg, chbase = cg * 128;
    const float* w_r = in[15]; const float* w_i = in[17];
    for (int i0 = tid; i0 < 4 * 4096; i0 += 512 * 16) { float t[16];
#pragma unroll
        for (int x = 0; x < 16; ++x) { const int i = i0 + 512 * x, m = i >> 12, gate = m >> 1, nb = m & 1, d = (i >> 6) & 63, e = i & 63; t[x] = (gate ? w_i : w_r)[((n0 + nb) * 64 + d) * 64 + e]; }
#pragma unroll
        for (int x = 0; x < 16; ++x) { const int i = i0 + 512 * x, m = i >> 12, d = (i >> 6) & 63, e = i & 63; *(LAS bf16*)(lds + WT + m * 64 * PW + e * PW + d * 2) = (bf16)f2bf(t[x]); } }
    float cw0[4], cw1[4]; const int cc = chbase + 2 * lane;
#pragma unroll
    for (int j = 0; j < 4; ++j) { cw0[j] = in[13][j * 512 + cc]; cw1[j] = in[13][j * 512 + cc + 1]; }
    const float cb0 = in[14][cc], cb1 = in[14][cc + 1];
    const int nb = wave >> 2, e0 = 16 * (wave & 3), chl = nb * 64 + e0 + c, chn = chbase + chl;
    const float brr = in[16][chn], bii = in[18][chn], sp = __logf(1.f + __expf(-in[19][chn]));
    float hcar = 0.f, atot = 1.f;
    if (FULL) {
        float fa[SEGMAX], fh[SEGMAX];
#pragma unroll
        for (int s = 0; s < SEGMAX; ++s) { const bool ok = s < sgi; fa[s] = ok ? RA[(s - sgi) * 512 + chn] : 1.f; fh[s] = ok ? RH[(s - sgi) * 512 + chn] : 0.f; }
#pragma unroll
        for (int s = 0; s < SEGMAX; ++s) hcar = s < sgi ? fa[s] * hcar + fh[s] : hcar;
    }
    unsigned xw[11];
    auto load_x = [&](int ch) {
#pragma unroll
        for (int r = 0; r < 11; ++r) { const int pos = (c0 + ch) * 64 + 8 * wave - 3 + r; xw[r] = 0u;
            if (pos >= 0) xw[r] = *(const unsigned*)(PROJ + ((size_t)b * SEQ + pos) * OD_N + 1536 + cc); }
    };
    load_x(0);
    __syncthreads();
    for (int ch = 0; ch < nch; ++ch) {
        const int pos0 = (c0 + ch) * 64; const size_t row0 = (size_t)b * SEQ + pos0;
        {
            float x0[11], x1[11];
#pragma unroll
            for (int r = 0; r < 11; ++r) { x0[r] = bf2f((bf16)(xw[r] & 0xffff)); x1[r] = bf2f((bf16)(xw[r] >> 16)); }
#pragma unroll
            for (int tt = 0; tt < 8; ++tt) {
                const float a0 = cb0 + cw0[0] * x0[tt] + cw0[1] * x0[tt + 1] + cw0[2] * x0[tt + 2] + cw0[3] * x0[tt + 3];
                const float a1 = cb1 + cw1[0] * x1[tt] + cw1[1] * x1[tt + 1] + cw1[2] * x1[tt + 2] + cw1[3] * x1[tt + 3];
                *(LAS unsigned*)(lds + XCB + (8 * wave + tt) * PX + 4 * lane) = pg8::cvt_pk_bf16(a0, a1);
                *(LAS f32x2*)(lds + XCF + ((8 * wave + tt) * 132 + 2 * lane) * 4) = (f32x2){a0, a1};
            }
        }
        if (ch + 1 < nch) load_x(ch + 1);
        bf16 gt[16];
        if (FULL) {
#pragma unroll
            for (int tt = 0; tt < 4; ++tt)
#pragma unroll
                for (int i = 0; i < 4; ++i) gt[4 * tt + i] = PROJ[(row0 + 16 * tt + 4 * g + i) * OD_N + 2048 + chn];
        }
        __syncthreads();
        f32x4 R[4], I[4];
#pragma unroll
        for (int tt = 0; tt < 4; ++tt) { R[tt] = (f32x4){0.f, 0.f, 0.f, 0.f}; I[tt] = R[tt]; }
#pragma unroll
        for (int kk = 0; kk < 2; ++kk) {
            const bf16x8 fr = mx::row_frag(lds + WT + nb * 64 * PW, PW, e0, kk, lane), fi = mx::row_frag(lds + WT + (2 + nb) * 64 * PW, PW, e0, kk, lane);
#pragma unroll
            for (int tt = 0; tt < 4; ++tt) { const bf16x8 a = mx::row_frag(lds + XCB + nb * 128, PX, 16 * tt, kk, lane); R[tt] = MFMA16(a, fr, R[tt]); I[tt] = MFMA16(a, fi, I[tt]); }
        }
#pragma unroll
        for (int tt = 0; tt < 4; ++tt) {
            float av[4], uv[4];
#pragma unroll
            for (int i = 0; i < 4; ++i) { const int t = 16 * tt + 4 * g + i;
                const float r = sigmoidf_(R[tt][i] + brr), ig = sigmoidf_(I[tt][i] + bii), la = -8.f * r * sp, a = __expf(la);
                av[i] = a; uv[i] = __builtin_amdgcn_sqrtf(fmaxf(1.f - a * a, 0.f)) * ig * *(const LAS float*)(lds + XCF + (t * 132 + chl) * 4); }
            float As = av[0] * av[1] * av[2] * av[3], Hs = ((uv[0] * av[1] + uv[1]) * av[2] + uv[2]) * av[3] + uv[3];
            float Ai = As, Hi = Hs;
            { const float Ap = __shfl(Ai, (lane - 16) & 63), Hp = __shfl(Hi, (lane - 16) & 63); if (g >= 1) { Hi = Hp * Ai + Hi; Ai = Ap * Ai; } }
            { const float Ap = __shfl(Ai, (lane - 32) & 63), Hp = __shfl(Hi, (lane - 32) & 63); if (g >= 2) { Hi = Hp * Ai + Hi; Ai = Ap * Ai; } }
            const float Ae = __shfl(Ai, (lane - 16) & 63), He = __shfl(Hi, (lane - 16) & 63), At = __shfl(Ai, 48 + c), Ht = __shfl(Hi, 48 + c);
            float h = g == 0 ? hcar : Ae * hcar + He;
            if (FULL) {
#pragma unroll
                for (int i = 0; i < 4; ++i) { const size_t row = row0 + 16 * tt + 4 * g + i; h = av[i] * h + uv[i];
                    YM[row * 1024 + 512 + chn] = (bf16)f2bf(h * gelu_tanh_(bf2f(gt[4 * tt + i]))); }
            }
            hcar = At * hcar + Ht; atot *= At;
        }
        __syncthreads();
    }
    if (!FULL && g == 0) { RA[chn] = atot; RH[chn] = hcar; }
}
}

constexpr int SEG_RET = 16, SEG_LRU = 16;
static_assert(SEG_LRU <= rg::SEGMAX, "RG-LRU segment count");
template <int SUB> __device__ __forceinline__ void phase_mix(Frame& F, int layer) {
    float* SG = (float*)(F.ws + WS_ST); float* BG = (float*)(F.ws + WS_ST + 16 * MiB);
    const bf16* PROJ = (const bf16*)(F.ws + WS_PROJ); bf16* YM = (bf16*)(F.ws + WS_ACT);
    float* RA = (float*)(F.ws + WS_ST + 16 * MiB + 256 * 1024); float* RH = RA + 2 * 32 * 512;
    const int S = layer == 0 ? 16 : SEG_RET;
    if (SUB == 1) {
        int tid = threadIdx.x; asm volatile("" : "+v"(tid));
        const int nel = (layer == 0 ? 16 : 8) * 16384;
        for (int idx = F.vcu * 512 + tid; idx < nel; idx += F.G * 512) {
            const int cidx = idx >> 14, e = idx & 16383, DK = (layer == 0 && cidx < 8) ? 128 : 64;
            if (e >= DK * 128) continue;
            const int d = e >> 7; float carry = 0.f;
            for (int seg = 0; seg < S; ++seg) { float* p = SG + (size_t)(cidx * S + seg) * 16384 + e; const float tmp = *p; *p = carry; carry = BG[(cidx * S + seg) * 128 + d] * carry + tmp; }
        }
        if (layer == 1) for (int idx = F.vcu * 512 + tid; idx < 1024; idx += F.G * 512) { const int bb = idx >> 9, cch = idx & 511; float carry = 0.f;
            for (int seg = 0; seg < SEG_LRU; ++seg) { const int o = (bb * SEG_LRU + seg) * 512 + cch; const float ta = RA[o], th = RH[o]; RH[o] = carry; carry = ta * carry + th; } }
        return;
    }
    for (int u = F.vcu; u < 256; u += F.G) {
        if (layer == 1 && u >= 8 * SEG_RET) {
            const int x = u - 8 * SEG_RET, bb = x / (4 * SEG_LRU), sg = (x >> 2) % SEG_LRU, cg = x & 3, c0 = (256 * sg) / SEG_LRU, nch = (256 * (sg + 1)) / SEG_LRU - c0;
            rg::unit<SUB == 2>(F.lds, PROJ, YM, F.in, bb, c0, nch, sg, cg, RA + (bb * SEG_LRU + sg) * 512, RH + (bb * SEG_LRU + sg) * 512);
            continue;
        }
        const int cidx = u / S, seg = u % S, chain = cidx & 7;
        mx::UnitP U; U.PROJ = PROJ; U.YM = YM; U.BL = (const float*)(F.ws + WS_BLOW); U.b = chain >> 2; U.h = chain & 3; U.p2 = nullptr;
        U.c0 = (256 * seg) / S; U.nch = (256 * (seg + 1)) / S - U.c0; U.seg = seg;
        float* Sg = SG + (size_t)(cidx * S + seg) * 16384; float* Bg = BG + (cidx * S + seg) * 128;
        if (layer == 0) {
            if (cidx < 8) { U.nw = F.in[6]; U.p0 = F.in[5]; U.p1 = nullptr; mx::mix_unit<0, SUB == 2>(F.lds, Sg, Bg, U); }
            else { U.nw = F.in[9]; U.p0 = F.in[7]; U.p1 = F.in[8]; mx::mix_unit<1, SUB == 2>(F.lds, Sg, Bg, U); }
        } else { U.nw = F.in[12]; U.p0 = nullptr; U.p1 = nullptr; mx::mix_unit<2, SUB == 2>(F.lds, Sg, Bg, U); }
    }
}

__device__ __forceinline__ void moe_poff(Frame& F, int layer) {
    PHASE_IDS(F);
    LAS int* poff = (LAS int*)(F.lds + LDS_MISC + 1024);
    const unsigned* cnt = F.ctl + CW_CNT + 64 * layer;
    __syncthreads();
    if (F.tid < 32) poff[33 + F.tid] = (int)cnt[F.tid];
    __syncthreads();
    if (F.tid == 0) { int acc = 0; for (int e = 0; e < 32; ++e) { poff[e] = acc; acc += (poff[33 + e] + 255) & ~255; } poff[32] = acc; }
    __syncthreads();
}
struct Args { const float* in[28]; float* out; unsigned char* ws; int ph_lo, ph_hi, li, pad; };
__global__ void __launch_bounds__(NWAVES * 64, 2) mega(Args args) {
    extern __shared__ __attribute__((aligned(16))) unsigned char lds[];
    Frame F;
    F.lds = (LAS unsigned char*)lds; F.tid = threadIdx.x; F.lane = F.tid & 63; F.wave = __builtin_amdgcn_readfirstlane(F.tid >> 6);
    F.G = gridDim.x; { const int bx = blockIdx.x; F.vcu = (F.G % 8 == 0) ? (bx % 8) * (F.G / 8) + bx / 8 : bx; }
    F.in = args.in; F.out = args.out; F.ws = args.ws; F.ctl = (unsigned*)(args.ws + WS_CTL);
    const int lo = args.ph_lo, hi = args.ph_hi;
    for (int u = F.tid; u < (LDS_BYTES - LDS_MISC) / 4; u += NWAVES * 64) ((LAS unsigned*)(F.lds + LDS_MISC))[u] = 0u;
    __syncthreads();
    XcdBarrier bar; bar.bar = F.ctl + CW_BAR + args.li * XCD_BAR_WORDS; bar.x = 0; bar.st = nullptr;
    if (hi - lo > 1) bar = xcd_barrier_post(F.ctl + CW_BAR + args.li * XCD_BAR_WORDS, (volatile LAS unsigned*)(F.lds + LDS_MISC + 32));
#ifndef ONLY_MASK
#define ONLY_MASK 0x7ffff
#endif
#define IN(k) (((ONLY_MASK >> (k)) & 1) && lo <= (k) && (k) < hi)
#define SEAM(k) do { if (IN(k) && IN((k) + 1)) xcd_barrier(bar); } while (0)
    bf16* ACT = (bf16*)(F.ws + WS_ACT); bf16* PROJ = (bf16*)(F.ws + WS_PROJ); bf16* H = (bf16*)(F.ws + WS_H); bf16* Y = (bf16*)(F.ws + WS_Y);
    const LAS int* poff = (const LAS int*)(F.lds + LDS_MISC + 1024);
    bf16* XR1 = (bf16*)F.out; bf16* XR2 = XR1 + (size_t)NT * D; bf16* XR3 = (bf16*)(F.ws + WS_W13);
    if (IN(0)) phase_prologue(F);
    SEAM(0);
#pragma unroll
    for (int l = 0; l < 2; ++l) {
        const int pb = 9 * l;
        if (IN(pb + 1)) {
            const int N = l == 0 ? EV_N : OD_N;
            pg8::DenseOrder S; S.init(ACT, F.ws + (l == 0 ? WS_WIN0 : WS_WIN1), NT, N, 1024, F.G, (int)blockIdx.x);
            pg8::EpiBf E{PROJ, N, 1.f};
            pg8::gemm_phase<pg8::EpiBf, pg8::DenseOrder, true>(F.lds, 1024, S, E);
        }
        SEAM(pb + 1);
        {
            if (IN(pb + 2)) phase_mix<0>(F, l);
            SEAM(pb + 2);
            if (IN(pb + 4)) phase_mix<2>(F, l);
            SEAM(pb + 4);
        }
        if (IN(pb + 5)) {
            pg8::DenseOrder S; S.init(ACT, F.ws + (l == 0 ? WS_WOUT0 : WS_WOUT1), NT, 1024, 1024, F.G, (int)blockIdx.x);
            if (l == 0) { pg8::EpiRes<false> E{F.in[0], XR1, (float*)(F.ws + WS_SSQ)}; pg8::gemm_phase<pg8::EpiRes<false>, pg8::DenseOrder, true>(F.lds, 1024, S, E); }
            else { pg8::EpiRes<true> E{XR2, XR3, (float*)(F.ws + WS_SSQ)}; pg8::gemm_phase<pg8::EpiRes<true>, pg8::DenseOrder, true>(F.lds, 1024, S, E); }
        }
        SEAM(pb + 5);
        if (IN(pb + 6)) phase_router(F, l, l == 0 ? XR1 : XR3);
        SEAM(pb + 6);
        if (IN(pb + 7)) {
            moe_poff(F, l);
            pg8::MoeOrder S{poff, F.ctl + CW_CNT + 64 * l, (const int*)(F.ws + WS_LIST), (const char*)ACT, (const char*)(F.ws + WS_W13) + (size_t)l * 32 * 1024 * 1024 * 2, (size_t)1024 * 1024, 512, F.G, F.vcu, true};
            pg8::EpiUp E{(unsigned char*)H};
            pg8::gemm_phase<pg8::EpiUp, pg8::MoeOrder, true, true>(F.lds, 512, S, E);
        }
        SEAM(pb + 7);
        if (IN(pb + 8)) {
            moe_poff(F, l);
            pg8::MoeOrder S{poff, F.ctl + CW_CNT + 64 * l, (const int*)(F.ws + WS_LIST), (const char*)H, (const char*)(F.ws + WS_W2) + (size_t)l * 32 * 1024 * 512 * 2, (size_t)1024 * 512, 256, F.G, F.vcu, false};
            pg8::EpiF8 E{(unsigned char*)Y, 1024, 0.5f};
            pg8::gemm_phase<pg8::EpiF8, pg8::MoeOrder, true, true>(F.lds, 256, S, E);
        }
        SEAM(pb + 8);
        if (IN(pb + 9)) phase_combine(F, l, l == 0 ? XR1 : XR3, XR2);
        SEAM(pb + 9);
    }
#undef IN
#undef SEAM
}

extern "C" void kernel_launch(void* const* d_in, const int* in_sizes, int n_in, void* d_out, int out_size, void* d_ws, size_t ws_size, hipStream_t stream) {
    static int grid = 0;
    if (grid == 0) {
        if (n_in != 28 || out_size != NT * D || ws_size < WS_END) { fprintf(stderr, "kernel_launch: unexpected problem (n_in %d, out %d, ws %zu)\n", n_in, out_size, ws_size); grid = -1; return; }
        int dev = 0, cus = 0;
        if (hipGetDevice(&dev) != hipSuccess || hipDeviceGetAttribute(&cus, hipDeviceAttributeMultiprocessorCount, dev) != hipSuccess) { grid = -1; return; }
        if (hipFuncSetAttribute((const void*)mega, hipFuncAttributeMaxDynamicSharedMemorySize, LDS_BYTES) != hipSuccess) { fprintf(stderr, "kernel_launch: hipFuncSetAttribute failed\n"); grid = -1; return; }
        (void)hipGetLastError();
        grid = cus;
    }
    if (grid < 0) return;
    (void)hipMemsetAsync((char*)d_ws + WS_CTL, 0, CTL_BYTES, stream);
    Args a{};
    for (int i = 0; i < 28; ++i) a.in[i] = (const float*)d_in[i];
    a.out = (float*)d_out; a.ws = (unsigned char*)d_ws;
    int nli = 0;
    auto run = [&](int lo, int hi) { a.ph_lo = lo; a.ph_hi = hi; a.li = (hi - lo > 1) ? nli++ : 0; hipLaunchKernelGGL(mega, dim3(grid), dim3(NWAVES * 64), LDS_BYTES, stream, a); };
    run(0, 19);
}
```

```cpp
#include <hip/hip_runtime.h>
#include <cstdio>
#include <cstdint>

#define GAS __attribute__((address_space(1)))
#define LAS __attribute__((address_space(3)))
typedef unsigned short bf16;
typedef unsigned v4u __attribute__((ext_vector_type(4)));
typedef unsigned v2u __attribute__((ext_vector_type(2)));
typedef float f32x4 __attribute__((ext_vector_type(4)));
typedef float f32x2 __attribute__((ext_vector_type(2)));
typedef short bf16x8 __attribute__((ext_vector_type(8)));

constexpr int NT = 32768, D = 1024, SEQ = 16384;
constexpr int EV_N = 3584, OD_N = 2560, EV_LD = 3600;
constexpr float EPS = 1e-6f;
constexpr int NEXP = 32, SLOT_ROWS = 2 * NT + NEXP * 256;

constexpr size_t MiB = 1u << 20;
constexpr size_t WS_CTL = 0, CTL_BYTES = 1 * MiB;
constexpr size_t WS_WIN0 = 2 * MiB, WS_WOUT0 = 9 * MiB, WS_WIN1 = 11 * MiB, WS_WOUT1 = 16 * MiB, WS_W13 = 18 * MiB, WS_W2 = 146 * MiB;
constexpr size_t WS_ACT = 210 * MiB, WS_PROJ = 274 * MiB, WS_H = WS_PROJ, WS_Y = WS_PROJ + 72 * MiB;
constexpr size_t WS_BLOW = 498 * MiB, WS_META = 500 * MiB, WS_LIST = 501 * MiB, WS_ST = 505 * MiB, WS_SSQ = 522 * MiB, WS_END = 524 * MiB;
constexpr int CW_TMO = 0, CW_BAR = 4096, CW_CNT = 16384;

constexpr int NWAVES = 8;
constexpr int LDS_BYTES = 163840;
constexpr int LDS_MISC = 149504;

__device__ __forceinline__ float bf2f(bf16 b) { return __builtin_bit_cast(float, (unsigned)b << 16); }
__device__ __forceinline__ unsigned pk2(float lo, float hi) { unsigned r; asm("v_cvt_pk_bf16_f32 %0, %1, %2" : "=v"(r) : "v"(lo), "v"(hi)); return r; }
__device__ __forceinline__ unsigned f2bf(float f) { return pk2(f, f) & 0xffffu; }
__device__ __forceinline__ float sigmoidf_(float x) { return __builtin_amdgcn_rcpf(1.f + __expf(-x)); }
__device__ __forceinline__ float siluf_(float x) { return x * sigmoidf_(x); }
__device__ __forceinline__ float gelu_tanh_(float x) { const float u = 0.7978845608f * (x + 0.044715f * x * x * x); return x * sigmoidf_(2.f * u); }
__device__ __forceinline__ float wave_sum(float v) {
#pragma unroll
    for (int o = 1; o < 64; o <<= 1) v += __shfl_xor(v, o);
    return v;
}
#define LDS_WAIT() asm volatile("s_waitcnt lgkmcnt(0)" ::: "memory")

struct Frame {
    LAS unsigned char* lds;
    int tid, lane, wave, vcu, G;
    const float* const* in;
    float* out; unsigned char* ws;
    unsigned* ctl;
};


#define XB_TMO      128
#define XB_XCNT(j)  (256  + 64 * (j))
#define XB_XSUB(j)  (1280 + 64 * (j))
#define XB_XGEN(j)  (2304 + 64 * (j))
#define XB_TOP      3328
#define XB_TOPGEN   3392
#define XCD_BAR_WORDS 3456
#define XB_SPIN_CAP (1u << 18)
__device__ __forceinline__ unsigned xb_ld(unsigned* p)              { return __hip_atomic_load(p, __ATOMIC_RELAXED, __HIP_MEMORY_SCOPE_AGENT); }
__device__ __forceinline__ unsigned xb_add(unsigned* p, unsigned v) { return __hip_atomic_fetch_add(p, v, __ATOMIC_RELAXED, __HIP_MEMORY_SCOPE_AGENT); }
__device__ __forceinline__ unsigned xb_xcc_id() { return (unsigned)__builtin_amdgcn_s_getreg((3 << 11) | 20) & 0xFu; }
#define XB_SPIN(cond, bar) do { unsigned _sp = 0; while (cond) { __builtin_amdgcn_s_sleep(1); \
    if ((++_sp & 255u) == 0u) { if (xb_ld(&(bar)[XB_TMO])) break; if (_sp > XB_SPIN_CAP) { atomicAdd(&(bar)[XB_TMO], 1u); break; } } } } while (0)
struct XcdBarrier { unsigned* bar; unsigned x; volatile LAS unsigned* st; };
__device__ __forceinline__ XcdBarrier xcd_barrier_post(unsigned* bar, volatile LAS unsigned* st) {
    XcdBarrier b; b.bar = bar; b.x = xb_xcc_id(); b.st = st;
    if (threadIdx.x == 0) (void)xb_add(&bar[XB_XCNT(b.x)], 1u);
    return b;
}
__device__ __forceinline__ void xcd_barrier_complete(unsigned* bar, unsigned x, unsigned& nloc, unsigned& nx) {
    const unsigned G = gridDim.x * gridDim.y * gridDim.z;
    unsigned sum, cnt, mine, sp = 0u;
    for (;;) {
        sum = 0u; cnt = 0u; mine = 0u;
#pragma unroll
        for (unsigned j = 0; j < 16; ++j) { const unsigned c = xb_ld(&bar[XB_XCNT(j)]); sum += c; cnt += (c > 0u) ? 1u : 0u; mine = (j == x) ? c : mine; }
        if (sum == G) break;
        __builtin_amdgcn_s_sleep(1);
        if ((++sp & 255u) == 0u) { if (xb_ld(&bar[XB_TMO])) break; if (sp > XB_SPIN_CAP) { atomicAdd(&bar[XB_TMO], 1u); break; } }
    }
    nloc = mine > 0u ? mine : 1u; nx = cnt > 0u ? cnt : 1u;
}
__device__ __forceinline__ void xcd_barrier(const XcdBarrier& b) {
    asm volatile("s_waitcnt vmcnt(0)" ::: "memory");
    __syncthreads();
    if (threadIdx.x == 0) {
        unsigned* bar = b.bar;
        __builtin_amdgcn_s_waitcnt(0);
        unsigned nloc = b.st[0], nx = b.st[1];
        if (nloc == 0u) { xcd_barrier_complete(bar, b.x, nloc, nx); b.st[0] = nloc; b.st[1] = nx; }
        const unsigned old = xb_add(&bar[XB_XSUB(b.x)], 1u);
        const unsigned gen = old / nloc;
        if (old + 1u == (gen + 1u) * nloc) {
            __builtin_amdgcn_fence(__ATOMIC_RELEASE, "agent");
            asm volatile("s_waitcnt vmcnt(0)" ::: "memory");
            const unsigned og = xb_add(&bar[XB_TOP], 1u);
            const unsigned tg = og / nx;
            if (og + 1u == (tg + 1u) * nx) xb_add(&bar[XB_TOPGEN], 1u);
            else XB_SPIN(xb_ld(&bar[XB_TOPGEN]) == tg, bar);
            __builtin_amdgcn_fence(__ATOMIC_ACQUIRE, "agent");
            xb_add(&bar[XB_XGEN(b.x)], 1u);
            asm volatile("s_waitcnt vmcnt(0)" ::: "memory");
        } else {
            XB_SPIN(xb_ld(&bar[XB_XGEN(b.x)]) == gen, bar);
            __builtin_amdgcn_fence(__ATOMIC_ACQUIRE, "agent");
            asm volatile("s_waitcnt vmcnt(0)" ::: "memory");
        }
    }
    __syncthreads();
}

namespace pg8 {
typedef unsigned u32x4 __attribute__((ext_vector_type(4)));
typedef int i32x4 __attribute__((ext_vector_type(4)));
typedef int i32x8 __attribute__((ext_vector_type(8)));
constexpr int BM = 256, BK = 64, HALF = 128, HTB = HALF * BK * 2, STAGE_BYTES = 8 * HTB, NXCD = 8, WGM = 8;
__host__ __device__ __forceinline__ int lds_byte(int r, int c) { const int st = (r >> 4) * 2 + (c >> 5), rr = r & 15, cc = c & 31, ob = rr * 64 + cc * 2; return st * 1024 + (ob ^ (((ob >> 9) & 1) << 5)); }
__host__ __device__ __forceinline__ void stage_rc(int b, int& R, int& C) { const int st = b / 1024, sb = b % 1024, swz = sb ^ (((sb >> 9) & 1) << 5); R = (st >> 1) * 16 + swz / 64; C = (st & 1) * 32 + (swz % 64) / 2; }
__host__ __device__ __forceinline__ int perm32(int rho) { const int n = rho >> 4, i = rho & 15; return 8 * (i >> 2) + 4 * n + (i & 3); }
struct Unit { int pm, pn, e; };
__device__ __forceinline__ unsigned cvt_pk_bf16(float lo, float hi) { return pk2(lo, hi); }

struct DenseOrder {
    int nM, nN, nwg, G, c, K; const char* A; const char* Bt;
    __device__ __forceinline__ void init(const void* A_, const void* Bt_, int M, int N, int K_, int G_, int c_) { A = (const char*)A_; Bt = (const char*)Bt_; nM = M / BM; nN = N / BM; nwg = nM * nN; G = G_; c = c_; K = K_; }
    __device__ __forceinline__ bool next(int i, Unit& u) const {
        const long L = (long)i * G + c; if (L >= nwg) return false;
        int wgid = (int)L; { const int q = nwg / NXCD, r = nwg % NXCD, xcd = wgid % NXCD, off = wgid / NXCD; wgid = (xcd < r ? xcd * (q + 1) : r * (q + 1) + (xcd - r) * q) + off; }
        const int nig = WGM * nN, gid = wgid / nig, fm = gid * WGM, gsz = (nM - fm) < WGM ? (nM - fm) : WGM;
        u.pm = fm + ((wgid % nig) % gsz); u.pn = (wgid % nig) / gsz; u.e = 0; return true;
    }
    __device__ __forceinline__ unsigned a_off(const Unit& u, int r) const { return (unsigned)((u.pm * BM + r) * K) * 2u; }
    __device__ __forceinline__ const char* b_ptr(const Unit& u) const { return Bt + (size_t)u.pn * BM * K * 2; }
};
struct MoeOrder {
    const LAS int* poff; const unsigned* cnt; const int* list; const char* A; const char* Bt; size_t estride; int K, G, c; bool gather;
    __device__ __forceinline__ bool next(int i, Unit& u) const {
        const int L = i * G + c, np = __builtin_amdgcn_readfirstlane(poff[32]) >> 8; if (L >= np * 4) return false;
        u.pm = L >> 2; u.pn = L & 3; const int row = u.pm << 8; int e = 0;
        while (row >= __builtin_amdgcn_readfirstlane(poff[e + 1])) ++e;
        u.e = e; return true;
    }
    __device__ __forceinline__ unsigned a_off(const Unit& u, int r) const {
        if (!gather) return (unsigned)((u.pm * BM + r) * K) * 2u;
        const int idx = min(u.pm * BM + r - poff[u.e], poff[33 + u.e] - 1);
        return (unsigned)list[(size_t)u.e * NT + idx] * (unsigned)(K * 2);
    }
    __device__ __forceinline__ const char* b_ptr(const Unit& u) const { return Bt + (size_t)u.e * estride + (size_t)u.pn * BM * K * 2; }
};

struct EpiBf {
    static constexpr bool PERM = true;
    bf16* O; int ldc; float scale;
    __device__ __forceinline__ void operator()(const f32x4 (&acc)[2][2][4][2], const Unit& u, int wr, int wc, int fr, int fq) const {
        const int row0 = u.pm * BM + wr * 64 + fr, col0 = u.pn * BM + wc * 32 + 8 * fq;
#pragma unroll
        for (int ai = 0; ai < 2; ++ai)
#pragma unroll
            for (int m = 0; m < 4; ++m) { bf16* rowp = O + (size_t)(row0 + ai * HALF + m * 16) * ldc + col0;
#pragma unroll
                for (int bj = 0; bj < 2; ++bj) { const f32x4 v0 = acc[ai][bj][m][0] * scale, v1 = acc[ai][bj][m][1] * scale;
                    u32x4 w; w.x = cvt_pk_bf16(v0[0], v0[1]); w.y = cvt_pk_bf16(v0[2], v0[3]); w.z = cvt_pk_bf16(v1[0], v1[1]); w.w = cvt_pk_bf16(v1[2], v1[3]);
                    *(u32x4*)(rowp + bj * HALF) = w; } }
    }
};
template <bool RES_BF16>
struct EpiRes {
    static constexpr bool PERM = true;
    const void* res; bf16* xout; float* ssq;
    __device__ __forceinline__ void operator()(const f32x4 (&acc)[2][2][4][2], const Unit& u, int wr, int wc, int fr, int fq) const {
        const int row0 = u.pm * BM + wr * 64 + fr, col0 = u.pn * BM + wc * 32 + 8 * fq;
#pragma unroll
        for (int ai = 0; ai < 2; ++ai) {
            f32x4 r0[4][2], r1[4][2];
#pragma unroll
            for (int m = 0; m < 4; ++m) { const size_t off = (size_t)(row0 + ai * HALF + m * 16) * 1024 + col0;
#pragma unroll
                for (int bj = 0; bj < 2; ++bj) {
                    if (RES_BF16) { const u32x4 rw = *(const u32x4*)((const bf16*)res + off + bj * HALF);
                        r0[m][bj] = (f32x4){__builtin_bit_cast(float, rw.x << 16), __builtin_bit_cast(float, rw.x & 0xffff0000u), __builtin_bit_cast(float, rw.y << 16), __builtin_bit_cast(float, rw.y & 0xffff0000u)};
                        r1[m][bj] = (f32x4){__builtin_bit_cast(float, rw.z << 16), __builtin_bit_cast(float, rw.z & 0xffff0000u), __builtin_bit_cast(float, rw.w << 16), __builtin_bit_cast(float, rw.w & 0xffff0000u)}; }
                    else { r0[m][bj] = *(const f32x4*)((const float*)res + off + bj * HALF); r1[m][bj] = *(const f32x4*)((const float*)res + off + bj * HALF + 4); } } }
#pragma unroll
            for (int m = 0; m < 4; ++m) { const int row = row0 + ai * HALF + m * 16; const size_t off = (size_t)row * 1024 + col0; float ss = 0.f;
#pragma unroll
                for (int bj = 0; bj < 2; ++bj) {
                    const f32x4 v0 = r0[m][bj] + acc[ai][bj][m][0], v1 = r1[m][bj] + acc[ai][bj][m][1];
                    ss += ((v0[0] * v0[0] + v0[1] * v0[1]) + (v0[2] * v0[2] + v0[3] * v0[3])) + ((v1[0] * v1[0] + v1[1] * v1[1]) + (v1[2] * v1[2] + v1[3] * v1[3]));
                    u32x4 w; w.x = cvt_pk_bf16(v0[0], v0[1]); w.y = cvt_pk_bf16(v0[2], v0[3]); w.z = cvt_pk_bf16(v1[0], v1[1]); w.w = cvt_pk_bf16(v1[2], v1[3]);
                    *(u32x4*)(xout + off + bj * HALF) = w; }
                ss += __shfl_xor(ss, 16); ss += __shfl_xor(ss, 32);
                if (fq == 0) ssq[(size_t)row * 16 + u.pn * 4 + wc] = ss; }
            asm volatile("" ::: "memory");
        }
    }
};
__device__ __forceinline__ unsigned pk4_fp8(float a, float b, float c, float d) { int p = __builtin_amdgcn_cvt_pk_fp8_f32(a, b, 0, false); return (unsigned)__builtin_amdgcn_cvt_pk_fp8_f32(c, d, p, true); }
struct EpiF8 {
    static constexpr bool PERM = true;
    unsigned char* O; int ldc; float scale;
    __device__ __forceinline__ void operator()(const f32x4 (&acc)[2][2][4][2], const Unit& u, int wr, int wc, int fr, int fq) const {
        const int row0 = u.pm * BM + wr * 64 + fr, col0 = u.pn * BM + wc * 32 + 8 * fq;
#pragma unroll
        for (int ai = 0; ai < 2; ++ai)
#pragma unroll
            for (int m = 0; m < 4; ++m) { unsigned char* rowp = O + (size_t)(row0 + ai * HALF + m * 16) * ldc + col0;
#pragma unroll
                for (int bj = 0; bj < 2; ++bj) { const f32x4 v0 = acc[ai][bj][m][0] * scale, v1 = acc[ai][bj][m][1] * scale;
                    v2u w; w.x = pk4_fp8(v0[0], v0[1], v0[2], v0[3]); w.y = pk4_fp8(v1[0], v1[1], v1[2], v1[3]);
                    *(v2u*)(rowp + bj * HALF) = w; } }
    }
};
struct EpiUp {
    static constexpr bool PERM = true;
    unsigned char* H;
    __device__ __forceinline__ void operator()(const f32x4 (&acc)[2][2][4][2], const Unit& u, int wr, int wc, int fr, int fq) const {
        const int row0 = u.pm * BM + wr * 64 + fr, col0 = u.pn * HALF + wc * 32 + 8 * fq;
#pragma unroll
        for (int ai = 0; ai < 2; ++ai)
#pragma unroll
            for (int m = 0; m < 4; ++m) { unsigned char* rowp = H + (size_t)(row0 + ai * HALF + m * 16) * 512 + col0;
                float h[8];
#pragma unroll
                for (int n = 0; n < 2; ++n)
#pragma unroll
                    for (int i = 0; i < 4; ++i) { const float a = acc[ai][0][m][n][i] * (1.f / 32.f), b = acc[ai][1][m][n][i] * (1.f / 32.f); h[n * 4 + i] = a * __builtin_amdgcn_rcpf(1.f + __expf(-a)) * b; }
                v2u w; w.x = pk4_fp8(h[0], h[1], h[2], h[3]); w.y = pk4_fp8(h[4], h[5], h[6], h[7]);
                *(v2u*)rowp = w; }
    }
};

template <class Epi, class Sched, bool ALIGN_EPI, bool FP8 = false>
__device__ __forceinline__ void gemm_phase(LAS unsigned char* lds, const int K_, const Sched& S, const Epi& E) {
    int K = K_; asm volatile("" : "+s"(K));
    int tid = threadIdx.x; asm volatile("" : "+v"(tid));
    const int wid = __builtin_amdgcn_readfirstlane(tid >> 6), lane = tid & 63, wr = wid >> 2, wc = wid & 3, fr = lane & 15, fq = lane >> 4;
    const int nt = K / BK;
    unsigned voffB[2];
#pragma unroll
    for (int i = 0; i < 2; ++i) { int R, C; stage_rc(tid * 16 + i * 8192, R, C); const int Rb = Epi::PERM ? ((R & ~31) + perm32(R & 31)) : R; voffB[i] = (unsigned)(Rb * K + C) * 2u; }
#define PG8_AOFF(u, o0, o1, o2, o3) do { int R0_, C0_, R1_, C1_; stage_rc(tid * 16, R0_, C0_); stage_rc(tid * 16 + 8192, R1_, C1_); \
        o0 = S.a_off(u, R0_) + (unsigned)C0_ * 2u; o1 = S.a_off(u, R1_) + (unsigned)C1_ * 2u; o2 = S.a_off(u, HALF + R0_) + (unsigned)C0_ * 2u; o3 = S.a_off(u, HALF + R1_) + (unsigned)C1_ * 2u; } while (0)
    const size_t kstep = (size_t)(BK * 2);
    const size_t hstep = (size_t)HALF * K * 2;
    const unsigned ldsw = (unsigned)wid * 1024u;
    const int aoff = lds_byte(wr * 64 + fr, fq * 8), boff = lds_byte(wc * 32 + fr, fq * 8);
    const char* const A0 = S.A;
#define PG8_SA(b, h) (((b) * 2 + (h)) * HTB)
#define PG8_SB(b, h) ((4 + (b) * 2 + (h)) * HTB)
#define PG8_STAGE(bufoff, gbase, voff) do { _Pragma("unroll") for (int _i = 0; _i < 2; ++_i) \
        __builtin_amdgcn_global_load_lds((const unsigned*)((const char*)(gbase) + (voff)[_i]), (LAS unsigned*)(lds + (bufoff) + ldsw + _i * 8192), 16, 0, 0); } while (0)
#define PG8_STAGEA(bufoff, kbyte, o0, o1) do { \
        __builtin_amdgcn_global_load_lds((const unsigned*)(A0 + (kbyte) + (o0)), (LAS unsigned*)(lds + (bufoff) + ldsw), 16, 0, 0); \
        __builtin_amdgcn_global_load_lds((const unsigned*)(A0 + (kbyte) + (o1)), (LAS unsigned*)(lds + (bufoff) + ldsw + 8192), 16, 0, 0); } while (0)
#define PG8_LD8(p) __builtin_shufflevector(*(const LAS i32x4*)(p), *(const LAS i32x4*)((p) + 1024), 0, 1, 2, 3, 4, 5, 6, 7)
#define PG8_LDA(dst, b, h) do { _Pragma("unroll") for (int m = 0; m < 4; ++m) dst[m] = PG8_LD8(lds + PG8_SA(b, h) + aoff + m * 2048); } while (0)
#define PG8_LDB(dst, b, h) do { _Pragma("unroll") for (int n = 0; n < 2; ++n) dst[n] = PG8_LD8(lds + PG8_SB(b, h) + boff + n * 2048); } while (0)
#define PG8_H(x, k) __builtin_bit_cast(bf16x8, __builtin_shufflevector(x, x, 4 * (k), 4 * (k) + 1, 4 * (k) + 2, 4 * (k) + 3))
#define PG8_MMA(ai, bj, At, Bt) do { __builtin_amdgcn_s_setprio(1); _Pragma("unroll") for (int m = 0; m < 4; ++m) _Pragma("unroll") for (int n = 0; n < 2; ++n) { \
        if constexpr (FP8) acc[ai][bj][m][n] = __builtin_amdgcn_mfma_scale_f32_16x16x128_f8f6f4(Bt[n], At[m], acc[ai][bj][m][n], 0, 0, 0, 0x7f7f7f7f, 0, 0x7f7f7f7f); \
        else { acc[ai][bj][m][n] = __builtin_amdgcn_mfma_f32_16x16x32_bf16(PG8_H(Bt[n], 0), PG8_H(At[m], 0), acc[ai][bj][m][n], 0, 0, 0); \
               acc[ai][bj][m][n] = __builtin_amdgcn_mfma_f32_16x16x32_bf16(PG8_H(Bt[n], 1), PG8_H(At[m], 1), acc[ai][bj][m][n], 0, 0, 0); } } \
        __builtin_amdgcn_s_setprio(0); } while (0)
#define PG8_WAIT_V(n) asm volatile("s_waitcnt vmcnt(" #n ")" ::: "memory")
#define PG8_WAIT_L(n) asm volatile("s_waitcnt lgkmcnt(" #n ")" ::: "memory")
#define PG8_BAR __builtin_amdgcn_s_barrier()
#define PG8_SCHED __builtin_amdgcn_sched_barrier(0)
    Unit cur, nxt; int ui = 0;
    if (!S.next(0, cur)) return;
    f32x4 acc[2][2][4][2];
#pragma unroll
    for (int a = 0; a < 2; ++a)
#pragma unroll
        for (int b = 0; b < 2; ++b)
#pragma unroll
            for (int m = 0; m < 4; ++m)
#pragma unroll
                for (int n = 0; n < 2; ++n) acc[a][b][m][n] = (f32x4){0.f, 0.f, 0.f, 0.f};
    i32x8 At[4], B0[2], B1[2];
    unsigned oc00, oc01, oc10, oc11, on00, on01, on10, on11;
    PG8_AOFF(cur, oc00, oc01, oc10, oc11);
    const char* cB = S.b_ptr(cur);
    PG8_STAGE(PG8_SB(0, 0), cB, voffB); PG8_STAGE(PG8_SB(0, 1), cB + hstep, voffB); PG8_STAGEA(PG8_SA(0, 0), 0, oc00, oc01); PG8_STAGEA(PG8_SA(0, 1), 0, oc10, oc11);
    if (wr == 1) PG8_BAR;
    PG8_WAIT_V(2); PG8_BAR;
    PG8_STAGE(PG8_SB(1, 0), cB + kstep, voffB); PG8_STAGEA(PG8_SA(1, 0), kstep, oc00, oc01); PG8_STAGE(PG8_SB(1, 1), cB + hstep + kstep, voffB);
    PG8_WAIT_V(6); PG8_BAR;
    for (;;) {
        const bool has_next = S.next(ui + 1, nxt);
        const char* nB = cB;
        on00 = oc00; on01 = oc01; on10 = oc10; on11 = oc11;
        if (has_next) { nB = S.b_ptr(nxt); PG8_AOFF(nxt, on00, on01, on10, on11); }
#pragma unroll 1
        for (int t = 0; t < nt; t += 2) {
            const bool last = (t == nt - 2);
            const size_t k1 = (size_t)(t + 1) * kstep, k2 = last ? 0 : (size_t)(t + 2) * kstep, k3 = k2 + kstep;
            const char* b2 = last ? nB : cB + (size_t)(t + 2) * kstep; const char* b3 = b2 + kstep;
            PG8_LDB(B0, 0, 0); PG8_LDB(B1, 0, 1); PG8_SCHED; PG8_LDA(At, 0, 0); PG8_STAGEA(PG8_SA(1, 1), k1, oc10, oc11);
            if (last) { oc00 = on00; oc01 = on01; oc10 = on10; oc11 = on11; }
            PG8_WAIT_V(8); PG8_WAIT_L(0); PG8_BAR; PG8_MMA(0, 0, At, B0); PG8_MMA(0, 1, At, B1); PG8_BAR; PG8_SCHED;
            PG8_LDA(At, 0, 1); PG8_STAGE(PG8_SB(0, 0), b2, voffB); PG8_STAGE(PG8_SB(0, 1), b2 + hstep, voffB); PG8_STAGEA(PG8_SA(0, 0), k2, oc00, oc01);
            PG8_WAIT_V(8); PG8_WAIT_L(0); PG8_BAR; PG8_MMA(1, 0, At, B0); PG8_MMA(1, 1, At, B1); PG8_BAR; PG8_SCHED;
            PG8_LDB(B0, 1, 0); PG8_LDB(B1, 1, 1); PG8_SCHED; PG8_LDA(At, 1, 0); PG8_STAGEA(PG8_SA(0, 1), k2, oc10, oc11);
            PG8_WAIT_V(8); PG8_WAIT_L(0); PG8_BAR; PG8_MMA(0, 0, At, B0); PG8_MMA(0, 1, At, B1); PG8_BAR; PG8_SCHED;
            PG8_LDA(At, 1, 1); PG8_STAGE(PG8_SB(1, 0), b3, voffB); PG8_STAGE(PG8_SB(1, 1), b3 + hstep, voffB); PG8_STAGEA(PG8_SA(1, 0), k3, oc00, oc01);
            PG8_WAIT_V(8); PG8_WAIT_L(0); PG8_BAR; PG8_MMA(1, 0, At, B0); PG8_MMA(1, 1, At, B1); PG8_BAR; PG8_SCHED;
        }
        if constexpr (ALIGN_EPI) { if (wr == 0) PG8_BAR; }
        E(acc, cur, wr, wc, fr, fq);
        if (!has_next) break;
#pragma unroll
        for (int a = 0; a < 2; ++a)
#pragma unroll
            for (int b = 0; b < 2; ++b)
#pragma unroll
                for (int m = 0; m < 4; ++m)
#pragma unroll
                    for (int n = 0; n < 2; ++n) acc[a][b][m][n] = (f32x4){0.f, 0.f, 0.f, 0.f};
        cur = nxt; cB = nB; ++ui;
        if constexpr (ALIGN_EPI) { if (wr == 1) PG8_BAR; }
    }
    PG8_WAIT_V(0);
    if constexpr (!ALIGN_EPI) { if (wr == 0) PG8_BAR; }
    PG8_BAR;
#undef PG8_SA
#undef PG8_SB
#undef PG8_STAGE
#undef PG8_STAGEA
#undef PG8_AOFF
#undef PG8_LDA
#undef PG8_LDB
#undef PG8_MMA
#undef PG8_LD8
#undef PG8_H
#undef PG8_WAIT_V
#undef PG8_WAIT_L
#undef PG8_BAR
#undef PG8_SCHED
}
}

#define PHASE_IDS(F) do { int _t = threadIdx.x; asm volatile("" : "+v"(_t)); (F).tid = _t; (F).lane = _t & 63; (F).wave = __builtin_amdgcn_readfirstlane(_t >> 6); } while (0)
struct TrItem { const float* W; bf16* WT; int ldw, K, mode, f8; };
__device__ __forceinline__ void tr_load(float (&tv)[32], const TrItem& t, int wave, int lane) {
#pragma unroll
    for (int i = 0; i < 32; ++i) tv[i] = __builtin_nontemporal_load(t.W + (size_t)(8 * wave + (i >> 2)) * t.ldw + 64 * (i & 3) + lane);
}
__device__ __forceinline__ void tr_store(const float (&tv)[32], const TrItem& t, LAS float* scr, int wave, int lane) {
#pragma unroll
    for (int i = 0; i < 32; ++i) scr[(8 * wave + (i >> 2)) * 257 + 64 * (i & 3) + lane] = tv[i];
    __syncthreads();
    const int c = lane & 7;
#pragma unroll
    for (int j = 0; j < 4; ++j) { const int n = 32 * wave + 8 * j + (lane >> 3); const LAS float* s = scr + (8 * c) * 257 + n;
        v4u o; o.x = pk2(s[0 * 257], s[1 * 257]); o.y = pk2(s[2 * 257], s[3 * 257]); o.z = pk2(s[4 * 257], s[5 * 257]); o.w = pk2(s[6 * 257], s[7 * 257]);
        const int drow = t.mode ? 256 * (n >> 7) + (n & 127) : n;
        if (t.f8) { v2u o8; o8.x = pg8::pk4_fp8(s[0 * 257] * 32.f, s[1 * 257] * 32.f, s[2 * 257] * 32.f, s[3 * 257] * 32.f); o8.y = pg8::pk4_fp8(s[4 * 257] * 32.f, s[5 * 257] * 32.f, s[6 * 257] * 32.f, s[7 * 257] * 32.f);
            *(v2u*)((unsigned char*)t.WT + (size_t)drow * t.K + 8 * c) = o8; }
        else *(v4u*)(t.WT + (size_t)drow * t.K + 8 * c) = o; }
    __syncthreads();
}

__device__ __forceinline__ void phase_prologue(Frame& F) {
    PHASE_IDS(F);
    LAS float* WL = (LAS float*)F.lds;
    LAS float* scr = (LAS float*)(F.lds + 65536);
    const float* w_in0 = F.in[4];
    for (int s0 = F.tid; s0 < 16 * 1024; s0 += 512 * 16) { float t[16];
#pragma unroll
        for (int i = 0; i < 16; ++i) { const int s = s0 + 512 * i; t[i] = w_in0[(size_t)(s >> 4) * EV_LD + 3072 + (s & 15)]; }
#pragma unroll
        for (int i = 0; i < 16; ++i) { const int s = s0 + 512 * i; WL[(s & 15) * 1024 + (s >> 4)] = t[i]; } }
    const int gw = F.vcu * NWAVES + F.wave, NGW = F.G * NWAVES;
    bf16* WIN0 = (bf16*)(F.ws + WS_WIN0); bf16* WOUT0 = (bf16*)(F.ws + WS_WOUT0); bf16* WIN1 = (bf16*)(F.ws + WS_WIN1); bf16* WOUT1 = (bf16*)(F.ws + WS_WOUT1);
    bf16* W13 = (bf16*)(F.ws + WS_W13); bf16* W2 = (bf16*)(F.ws + WS_W2);
    constexpr int I_A = 16 * 12, I_B = 16 * 2, I_C = 16 * 4, I_D = 16 * 10, I_E = 16 * 4, I_F = 2 * 32 * 2 * 32, I_G = 2 * 32 * 32;
    constexpr int NITEMS = I_A + I_B + I_C + I_D + I_E + I_F + I_G;
    auto decode = [&](int it) {
        TrItem t; int r = it; t.mode = 0; t.f8 = 0;
        if (r < I_A) { const int kb = r / 12, nb = r % 12; t.ldw = EV_LD; t.K = 1024; t.W = w_in0 + (size_t)(64 * kb) * EV_LD + 256 * nb; t.WT = WIN0 + (size_t)(256 * nb) * 1024 + 64 * kb; return t; } r -= I_A;
        if (r < I_B) { const int kb = r / 2, nb = r % 2; t.ldw = EV_LD; t.K = 1024; t.W = w_in0 + (size_t)(64 * kb) * EV_LD + 3088 + 256 * nb; t.WT = WIN0 + (size_t)(3072 + 256 * nb) * 1024 + 64 * kb; return t; } r -= I_B;
        if (r < I_C) { const int kb = r / 4, nb = r % 4; t.ldw = 1024; t.K = 1024; t.W = F.in[10] + (size_t)(64 * kb) * 1024 + 256 * nb; t.WT = WOUT0 + (size_t)(256 * nb) * 1024 + 64 * kb; return t; } r -= I_C;
        if (r < I_D) { const int kb = r / 10, nb = r % 10; t.ldw = OD_N; t.K = 1024; t.W = F.in[11] + (size_t)(64 * kb) * OD_N + 256 * nb; t.WT = WIN1 + (size_t)(256 * nb) * 1024 + 64 * kb; return t; } r -= I_D;
        if (r < I_E) { const int kb = r / 4, nb = r % 4; t.ldw = 1024; t.K = 1024; t.W = F.in[20] + (size_t)(64 * kb) * 1024 + 256 * nb; t.WT = WOUT1 + (size_t)(256 * nb) * 1024 + 64 * kb; return t; } r -= I_E;
        if (r < I_F) { const int le = r / 64, q = r % 64, which = q / 32, kb = (q % 32) / 2, nb = q % 2;
            t.ldw = 512; t.K = 1024; t.mode = 1; t.f8 = 1; t.W = (which ? F.in[26] : F.in[25]) + (size_t)le * 1024 * 512 + (size_t)(64 * kb) * 512 + 256 * nb;
            t.WT = (bf16*)((unsigned char*)(W13 + (size_t)(le >> 5) * 32 * 1024 * 1024) + (size_t)(le & 31) * 1024 * 1024 + (size_t)(512 * nb + which * 128) * 1024 + 64 * kb); return t; } r -= I_F;
        { const int le = r / 32, q = r % 32, kb = q / 4, nb = q % 4;
            t.ldw = 1024; t.K = 512; t.f8 = 1; t.W = F.in[27] + (size_t)le * 512 * 1024 + (size_t)(64 * kb) * 1024 + 256 * nb;
            t.WT = (bf16*)((unsigned char*)(W2 + (size_t)(le >> 5) * 32 * 1024 * 512) + (size_t)(le & 31) * 1024 * 512 + (size_t)(256 * nb) * 512 + 64 * kb); return t; }
    };
    __syncthreads();
    {
        float ta[32], tb[32]; TrItem da, db; int it = F.vcu;
        if (it < NITEMS) { da = decode(it); tr_load(ta, da, F.wave, F.lane); }
        while (it < NITEMS) {
            const int i1 = it + F.G, i2 = it + 2 * F.G;
            if (i1 < NITEMS) { db = decode(i1); tr_load(tb, db, F.wave, F.lane); }
            tr_store(ta, da, scr, F.wave, F.lane);
            if (i1 >= NITEMS) break;
            if (i2 < NITEMS) { da = decode(i2); tr_load(ta, da, F.wave, F.lane); }
            tr_store(tb, db, scr, F.wave, F.lane);
            it = i2;
        }
    }
    __syncthreads();
    const float* x = F.in[0]; const float* g = F.in[1];
    bf16* XN = (bf16*)(F.ws + WS_ACT); float* BL = (float*)(F.ws + WS_BLOW);
    f32x4 gv[4];
#pragma unroll
    for (int j = 0; j < 4; ++j) gv[j] = *((const f32x4*)g + 64 * j + F.lane);
    for (int m = gw; m < NT; m += NGW) {
        asm volatile("" ::: "memory");
        const f32x4* xr = (const f32x4*)(x + (size_t)m * D) + F.lane;
        f32x4 v[4]; float s = 0.f;
#pragma unroll
        for (int j = 0; j < 4; ++j) { v[j] = xr[64 * j]; s += (v[j].x * v[j].x + v[j].y * v[j].y) + (v[j].z * v[j].z + v[j].w * v[j].w); }
        const float rstd = rsqrtf(wave_sum(s) * (1.f / D) + EPS);
        v2u* o8 = (v2u*)(XN + (size_t)m * D) + F.lane;
#pragma unroll
        for (int j = 0; j < 4; ++j) { v[j] = v[j] * rstd * gv[j]; v2u w; w.x = pk2(v[j].x, v[j].y); w.y = pk2(v[j].z, v[j].w); o8[64 * j] = w; }
        float p[16];
#pragma unroll
        for (int o = 0; o < 16; ++o) {
            const LAS f32x4* wl = (const LAS f32x4*)(WL + o * 1024) + F.lane; float a = 0.f;
#pragma unroll
            for (int j = 0; j < 4; ++j) { const f32x4 w = wl[64 * j]; a += (v[j].x * w.x + v[j].y * w.y) + (v[j].z * w.z + v[j].w * w.w); }
            p[o] = a;
        }
#pragma unroll
        for (int o = 0; o < 8; ++o) { const bool hi = (F.lane & 32) != 0; const float snd = hi ? p[o] : p[o + 8], kp = hi ? p[o + 8] : p[o]; p[o] = kp + __shfl_xor(snd, 32); }
#pragma unroll
        for (int o = 0; o < 4; ++o) { const bool hi = (F.lane & 16) != 0; const float snd = hi ? p[o] : p[o + 4], kp = hi ? p[o + 4] : p[o]; p[o] = kp + __shfl_xor(snd, 16); }
#pragma unroll
        for (int o = 0; o < 2; ++o) { const bool hi = (F.lane & 8) != 0; const float snd = hi ? p[o] : p[o + 2], kp = hi ? p[o + 2] : p[o]; p[o] = kp + __shfl_xor(snd, 8); }
        { const bool hi = (F.lane & 4) != 0; const float snd = hi ? p[0] : p[1], kp = hi ? p[1] : p[0]; p[0] = kp + __shfl_xor(snd, 4); }
        p[0] += __shfl_xor(p[0], 2); p[0] += __shfl_xor(p[0], 1);
        if ((F.lane & 3) == 0) BL[(size_t)m * 16 + ((F.lane >> 5) & 1) * 8 + ((F.lane >> 4) & 1) * 4 + ((F.lane >> 3) & 1) * 2 + ((F.lane >> 2) & 1)] = p[0];
    }
}

__device__ __forceinline__ float row16_max(float v) { v = fmaxf(v, __shfl_xor(v, 1)); v = fmaxf(v, __shfl_xor(v, 2)); v = fmaxf(v, __shfl_xor(v, 4)); return fmaxf(v, __shfl_xor(v, 8)); }
__device__ __forceinline__ float row16_sum(float v) { v += __shfl_xor(v, 1); v += __shfl_xor(v, 2); v += __shfl_xor(v, 4); return v + __shfl_xor(v, 8); }
__device__ __forceinline__ int row16_min(int v) { v = min(v, __shfl_xor(v, 1)); v = min(v, __shfl_xor(v, 2)); v = min(v, __shfl_xor(v, 4)); return min(v, __shfl_xor(v, 8)); }
__device__ __forceinline__ void phase_router(Frame& F, int layer, const bf16* XR) {
    PHASE_IDS(F);
    constexpr int PW = 2064;
    LAS unsigned char* WH = F.lds; LAS unsigned char* WLO = F.lds + 36 * PW;
    LAS float* GL = (LAS float*)(F.lds + LDS_MISC + 1024);
    LAS int* hist = (LAS int*)(F.lds + LDS_MISC + 1024 + 4096); LAS int* base = hist + 32;
    LAS int* s_e0 = base + 32; LAS int* s_e1 = s_e0 + 128; LAS int* s_r0 = s_e1 + 128; LAS int* s_r1 = s_r0 + 128;
    LAS float* s_w0 = (LAS float*)(s_r1 + 128); LAS float* s_w1 = s_w0 + 128;
    const float* wg = F.in[21] + (size_t)layer * 1024 * 4; const float* we = F.in[23] + (size_t)layer * 1024 * 32;
    const float* g = F.in[2] + layer * 1024;
    for (int s = F.tid; s < 1024; s += 512) GL[s] = g[s];
    __syncthreads();
    for (int s0 = F.tid; s0 < 4096 + 32768; s0 += 512 * 18) {
        float t[18];
#pragma unroll
        for (int i = 0; i < 18; ++i) { const int s = s0 + 512 * i; t[i] = s < 4096 ? wg[s] : we[s - 4096]; }
#pragma unroll
        for (int i = 0; i < 18; ++i) { const int s = s0 + 512 * i; const int k = s < 4096 ? (s >> 2) : ((s - 4096) >> 5), o = s < 4096 ? (s & 3) : 4 + ((s - 4096) & 31);
            const float w = t[i] * GL[k]; const unsigned hb = f2bf(w);
            *(LAS bf16*)(WH + o * PW + k * 2) = (bf16)hb; *(LAS bf16*)(WLO + o * PW + k * 2) = (bf16)f2bf(w - bf2f((bf16)hb)); } }
    const int c = F.lane & 15, q = F.lane >> 4;
    float bias[3];
#pragma unroll
    for (int jt = 0; jt < 3; ++jt) { const int col = 16 * jt + c; bias[jt] = col < 4 ? F.in[22][layer * 4 + col] : (col < 36 ? F.in[24][layer * 32 + col - 4] : 0.f); }
    unsigned* cnt = F.ctl + CW_CNT + 64 * layer;
    bf16* XN = (bf16*)(F.ws + WS_ACT); const float* SSQ = (const float*)(F.ws + WS_SSQ);
    int* ME0 = (int*)(F.ws + WS_META); int* ME1 = ME0 + NT; int* MR0 = ME1 + NT; int* MR1 = MR0 + NT; float* MW0 = (float*)(MR1 + NT); float* MW1 = MW0 + NT;
    int* LIST = (int*)(F.ws + WS_LIST);
    int wrow[3];
#pragma unroll
    for (int jt = 0; jt < 3; ++jt) wrow[jt] = min(16 * jt + c, 35) * PW + 16 * q;
    __syncthreads();
    for (int row0 = 128 * F.vcu; row0 < NT; row0 += 128 * F.G) {
        if (F.tid < 32) hist[F.tid] = 0;
        __syncthreads();
        const int rl = F.wave * 16, row = row0 + rl + c;
        float rstd; { const f32x4 sp = *(const f32x4*)(SSQ + (size_t)row * 16 + 4 * q); float s = (sp[0] + sp[1]) + (sp[2] + sp[3]); s += __shfl_xor(s, 16); s += __shfl_xor(s, 32); rstd = rsqrtf(s * (1.f / D) + EPS); }
        const bf16* xr = XR + (size_t)row * D + 8 * q; unsigned char* xo = (unsigned char*)XN + (size_t)row * D + 8 * q;
        f32x4 acc[3];
#pragma unroll
        for (int jt = 0; jt < 3; ++jt) acc[jt] = (f32x4){0.f, 0.f, 0.f, 0.f};
        for (int k4 = 0; k4 < 32; k4 += 8) {
            v4u xw[8];
#pragma unroll
            for (int u = 0; u < 8; ++u) xw[u] = *(const v4u*)(xr + 32 * (k4 + u));
#pragma unroll
            for (int u = 0; u < 8; ++u) {
                const int kk = k4 + u;
                const f32x4 ga = *(const LAS f32x4*)(GL + 32 * kk + 8 * q), gb = *(const LAS f32x4*)(GL + 32 * kk + 8 * q + 4);
                const v4u w = xw[u];
#define BLO(x) __builtin_bit_cast(float, (x) << 16)
#define BHI(x) __builtin_bit_cast(float, (x) & 0xffff0000u)
                v2u xn; xn.x = pg8::pk4_fp8(BLO(w.x) * rstd * ga[0], BHI(w.x) * rstd * ga[1], BLO(w.y) * rstd * ga[2], BHI(w.y) * rstd * ga[3]);
                xn.y = pg8::pk4_fp8(BLO(w.z) * rstd * gb[0], BHI(w.z) * rstd * gb[1], BLO(w.w) * rstd * gb[2], BHI(w.w) * rstd * gb[3]);
#undef BLO
#undef BHI
                *(v2u*)(xo + 32 * kk) = xn;
                const bf16x8 ah = __builtin_bit_cast(bf16x8, w);
#pragma unroll
                for (int jt = 0; jt < 3; ++jt) { const bf16x8 bh = *(const LAS bf16x8*)(WH + wrow[jt] + 64 * kk), bl = *(const LAS bf16x8*)(WLO + wrow[jt] + 64 * kk);
                    acc[jt] = __builtin_amdgcn_mfma_f32_16x16x32_bf16(ah, bh, acc[jt], 0, 0, 0); acc[jt] = __builtin_amdgcn_mfma_f32_16x16x32_bf16(ah, bl, acc[jt], 0, 0, 0); }
            }
        }
#pragma unroll
        for (int i = 0; i < 4; ++i) {
            const float rs = __shfl(rstd, 4 * q + i);
            const float l0 = acc[0][i] * rs + bias[0], l1 = acc[1][i] * rs + bias[1], l2 = acc[2][i] * rs + bias[2];
            const float gvl = c < 4 ? l0 : -3.0e38f;
            const float gmax = row16_max(gvl); const int gi = row16_min(gvl == gmax ? c : 99);
            const float gwt = 1.f / row16_sum(c < 4 ? __expf(gvl - gmax) : 0.f);
            const int jt = c < 4 ? (gi == 1 ? 1 : 2) : (c < 12 ? (gi == 0 ? 0 : 1) : (gi == 1 ? 0 : 1));
            const bool valid = c < 4 ? (gi == 1 || gi == 3) : (c < 12 ? (gi == 0 || gi == 2) : (gi == 1 || gi == 3));
            const int eidx = 16 * jt + c - 4 - 8 * gi;
            float cv = jt == 0 ? l0 : (jt == 1 ? l1 : l2); cv = (valid && eidx >= 0 && eidx < 8) ? cv : -3.0e38f;
            const float v0 = row16_max(cv); const int i0 = row16_min(cv == v0 ? eidx : 99);
            const float cv2 = eidx == i0 ? -3.0e38f : cv;
            const float v1 = row16_max(cv2); const int i1 = row16_min(cv2 == v1 ? eidx : 99);
            const float ex = __expf(v1 - v0), tw0 = 1.f / (1.f + ex), tw1 = ex / (1.f + ex);
            if (c == 0) { const int r = rl + 4 * q + i, e0 = gi * 8 + i0, e1 = gi * 8 + i1;
                s_e0[r] = e0; s_e1[r] = e1; s_w0[r] = gwt * tw0; s_w1[r] = gwt * tw1;
                s_r0[r] = atomicAdd((int*)&hist[e0], 1); s_r1[r] = atomicAdd((int*)&hist[e1], 1); }
        }
        __syncthreads();
        if (F.tid < 32) base[F.tid] = (int)atomicAdd(cnt + F.tid, (unsigned)hist[F.tid]);
        __syncthreads();
        if (F.tid < 128) {
            const int m = row0 + F.tid, e0 = s_e0[F.tid], e1 = s_e1[F.tid], r0 = base[e0] + s_r0[F.tid], r1 = base[e1] + s_r1[F.tid];
            ME0[m] = e0; ME1[m] = e1; MR0[m] = r0; MR1[m] = r1; MW0[m] = s_w0[F.tid]; MW1[m] = s_w1[F.tid];
            LIST[(size_t)e0 * NT + r0] = m; LIST[(size_t)e1 * NT + r1] = m;
        }
        __syncthreads();
    }
}

__device__ __forceinline__ void phase_combine(Frame& F, int layer, const bf16* XRin, bf16* XRout) {
    PHASE_IDS(F);
    LAS int* poff = (LAS int*)(F.lds + LDS_MISC + 1024);
    const unsigned* cnt = F.ctl + CW_CNT + 64 * layer;
    if (F.tid < 32) poff[33 + F.tid] = (int)cnt[F.tid];
    __syncthreads();
    if (F.tid == 0) { int acc = 0; for (int e = 0; e < 32; ++e) { poff[e] = acc; acc += (poff[33 + e] + 255) & ~255; } poff[32] = acc; }
    __syncthreads();
    const int gw = F.vcu * NWAVES + F.wave, NGW = F.G * NWAVES;
    const float* g = layer == 0 ? F.in[1] + 1024 : F.in[3];
    const bf16* Y = (const bf16*)(F.ws + WS_Y); bf16* XN = (bf16*)(F.ws + WS_ACT);
    const int* ME0 = (const int*)(F.ws + WS_META); const int* ME1 = ME0 + NT; const int* MR0 = ME1 + NT; const int* MR1 = MR0 + NT; const float* MW0 = (const float*)(MR1 + NT); const float* MW1 = MW0 + NT;
    f32x4 gv[4];
#pragma unroll
    for (int j = 0; j < 4; ++j) gv[j] = *((const f32x4*)g + 64 * j + F.lane);
    for (int m0 = gw; m0 < NT; m0 += 2 * NGW) {
        int mr[2]; mr[0] = m0; mr[1] = (m0 + NGW < NT) ? m0 + NGW : m0;
        f32x4 v[2][4]; unsigned ya[2][4], yb[2][4]; float w0[2], w1[2];
#pragma unroll
        for (int r = 0; r < 2; ++r) {
            const int m = mr[r]; const int s0 = poff[ME0[m]] + MR0[m], s1 = poff[ME1[m]] + MR1[m]; w0[r] = MW0[m] * (1.f / 16.f); w1[r] = MW1[m] * (1.f / 16.f);
            const v2u* xr = (const v2u*)(XRin + (size_t)m * D) + F.lane;
            const unsigned* y0 = (const unsigned*)((const unsigned char*)Y + (size_t)s0 * D) + F.lane; const unsigned* y1 = (const unsigned*)((const unsigned char*)Y + (size_t)s1 * D) + F.lane;
#pragma unroll
            for (int j = 0; j < 4; ++j) { const v2u xw = xr[64 * j]; v[r][j] = (f32x4){bf2f((bf16)(xw.x & 0xffff)), bf2f((bf16)(xw.x >> 16)), bf2f((bf16)(xw.y & 0xffff)), bf2f((bf16)(xw.y >> 16))}; ya[r][j] = y0[64 * j]; yb[r][j] = y1[64 * j]; }
        }
#pragma unroll
        for (int r = 0; r < 2; ++r) {
            const int m = mr[r]; float s = 0.f;
            f32x4* xr = (f32x4*)(F.out + (size_t)m * D) + F.lane; v2u* xo2 = (v2u*)(XRout + (size_t)m * D) + F.lane;
#pragma unroll
            for (int j = 0; j < 4; ++j) { const f32x2 a0 = __builtin_amdgcn_cvt_pk_f32_fp8((int)ya[r][j], false), a1 = __builtin_amdgcn_cvt_pk_f32_fp8((int)ya[r][j], true), b0 = __builtin_amdgcn_cvt_pk_f32_fp8((int)yb[r][j], false), b1 = __builtin_amdgcn_cvt_pk_f32_fp8((int)yb[r][j], true);
                v[r][j].x += w0[r] * a0.x + w1[r] * b0.x; v[r][j].y += w0[r] * a0.y + w1[r] * b0.y;
                v[r][j].z += w0[r] * a1.x + w1[r] * b1.x; v[r][j].w += w0[r] * a1.y + w1[r] * b1.y;
                s += (v[r][j].x * v[r][j].x + v[r][j].y * v[r][j].y) + (v[r][j].z * v[r][j].z + v[r][j].w * v[r][j].w); }
            const float rstd = rsqrtf(wave_sum(s) * (1.f / D) + EPS);
            if (r == 1 && mr[1] == mr[0]) continue;
            if (layer == 0) {
                v2u* o8 = (v2u*)(XN + (size_t)m * D) + F.lane;
#pragma unroll
                for (int j = 0; j < 4; ++j) { v2u xw; xw.x = pk2(v[r][j].x, v[r][j].y); xw.y = pk2(v[r][j].z, v[r][j].w); xo2[64 * j] = xw; const f32x4 n = v[r][j] * rstd * gv[j]; v2u w; w.x = pk2(n.x, n.y); w.y = pk2(n.z, n.w); o8[64 * j] = w; }
            } else {
#pragma unroll
                for (int j = 0; j < 4; ++j) xr[64 * j] = v[r][j] * rstd * gv[j];
            }
        }
    }
}


namespace mx {
typedef short s4 __attribute__((ext_vector_type(4)));
constexpr int PV = 272, PP = 144;
template <int DK> struct Lay { static constexpr int PK = DK * 2 + 16, QS = 0, KS = 64 * PK, VV = 2 * 64 * PK, ST = VV + 64 * PV, PM = ST + 128 * PK, VEC = PM + 64 * PP, PART = VEC + 3 * DK * 4, RED = PART + 8 * DK * 4, BLS = RED + 4096, END = BLS + 4096; };
static_assert(Lay<128>::END <= LDS_MISC, "mixer LDS map");
__device__ __forceinline__ bf16x8 row_frag(const LAS unsigned char* base, int pitch, int row0, int kk, int lane) {
    return *(const LAS bf16x8*)(base + (row0 + (lane & 15)) * pitch + (32 * kk + 8 * (lane >> 4)) * 2);
}
__device__ __forceinline__ bf16x8 tr_frag(const LAS unsigned char* base, int pitch, int k0, int c0, int lane) {
    const int g = lane >> 4, q = (lane & 15) >> 2, p = lane & 3;
    const LAS unsigned char* a = base + (k0 + 8 * g + q) * pitch + (c0 + 4 * p) * 2;
    const s4 lo = __builtin_amdgcn_ds_read_tr16_b64_v4i16((LAS s4*)a);
    const s4 hi = __builtin_amdgcn_ds_read_tr16_b64_v4i16((LAS s4*)(a + 4 * pitch));
    return __builtin_shufflevector(lo, hi, 0, 1, 2, 3, 4, 5, 6, 7);
}
#define MFMA16(a, b, c) __builtin_amdgcn_mfma_f32_16x16x32_bf16(a, b, c, 0, 0, 0)

struct UnitP { const bf16* PROJ; bf16* YM; const float* nw; const float* BL; const float* p0; const float* p1; const float* p2; int b, h, c0, nch, seg; };

template <int KIND> struct KC {
    static constexpr int DK = KIND == 0 ? 128 : 64, LDP = KIND == 2 ? OD_N : EV_N;
    __device__ static __forceinline__ int qcol(int h) { return KIND == 0 ? h * 128 : (KIND == 1 ? 2048 + h * 64 : h * 64); }
    __device__ static __forceinline__ int kcol(int h) { return KIND == 0 ? 512 + h * 128 : (KIND == 1 ? 2304 + h * 64 : 256 + h * 64); }
    __device__ static __forceinline__ int vcol(int h) { return KIND == 0 ? 1024 + h * 128 : (KIND == 1 ? 2560 + h * 128 : 512 + h * 128); }
    __device__ static __forceinline__ int gcol(int h) { return KIND == 0 ? 1536 + h * 128 : (KIND == 1 ? 3072 + h * 128 : 1024 + h * 128); }
    __device__ static __forceinline__ int ocol(int h) { return KIND == 1 ? 512 + h * 128 : h * 128; }
};

template <int KIND, bool FULL>
__device__ __forceinline__ void mix_unit(LAS unsigned char* lds, float* Sg, float* Bg, const UnitP& U) {
    using K = KC<KIND>; constexpr int DK = K::DK, LDP = K::LDP, NJT = DK == 128 ? 8 : 4; using L = Lay<DK>; constexpr int PK = L::PK;
    int tid = threadIdx.x; asm volatile("" : "+v"(tid));
    const int lane = tid & 63, wave = __builtin_amdgcn_readfirstlane(tid >> 6), g = lane >> 4, c = lane & 15;
    const int h = U.h, dt = DK == 128 ? wave : (wave & 3), jt0 = DK == 128 ? 0 : 4 * (wave >> 2);
    LAS float* EM = (LAS float*)(lds + L::VEC); LAS float* EL = EM + DK; LAS float* BT = EL + DK; LAS float* PART = (LAS float*)(lds + L::PART);
    float lb0 = 0.f, lb1 = 0.f, wu[16], bu = 0.f, ci = 0.f, lgg = 0.f;
    if (KIND == 0) {
        const float* lbl = U.p0; const int col = h * 128 + 2 * lane;
#pragma unroll
        for (int x = 0; x < 2; ++x) { const float l0 = lbl[col + x], l1 = lbl[512 + col + x], l2 = lbl[1024 + col + x]; const float mx_ = fmaxf(l0, fmaxf(l1, l2));
            const float e0 = __expf(l0 - mx_), e1 = __expf(l1 - mx_), e2 = __expf(l2 - mx_); const float v = e0 / (e0 + e1 + e2); if (x == 0) lb0 = v; else lb1 = v; }
    }
    if (KIND == 1) {
#pragma unroll
        for (int r = 0; r < 16; ++r) wu[r] = U.p0[r * 256 + h * 64 + lane];
        bu = U.p1[h * 64 + lane];
    }
    if (KIND == 2) { ci = exp2f(-(float)(lane & 31) * (13.287712379549449f / 32.f)) * 0.15915494309189535f; lgg = log1pf(-exp2f(-5.f - (float)h)); }
    f32x4 S[NJT];
#pragma unroll
    for (int jt = 0; jt < NJT; ++jt) {
        S[jt] = (f32x4){0.f, 0.f, 0.f, 0.f};
    }
    if (FULL) {
        f32x4 L[NJT], D4 = (f32x4){0.f, 0.f, 0.f, 0.f};
        auto ldseg = [&](int s) { const float* Sp = Sg + (ptrdiff_t)s * 16384; D4 = *(const f32x4*)(Bg + s * 128 + 16 * dt + 4 * g);
#pragma unroll
            for (int jt = 0; jt < NJT; ++jt)
#pragma unroll
                for (int i = 0; i < 4; ++i) L[jt][i] = Sp[(16 * dt + 4 * g + i) * 128 + 16 * (jt0 + jt) + c]; };
        if (U.seg > 0) ldseg(-U.seg);
        for (int s = -U.seg; s < 0; ++s) {
            f32x4 Lc[NJT]; const f32x4 Dc = D4;
#pragma unroll
            for (int jt = 0; jt < NJT; ++jt) Lc[jt] = L[jt];
            if (s + 1 < 0) ldseg(s + 1);
#pragma unroll
            for (int jt = 0; jt < NJT; ++jt) S[jt] = Dc * S[jt] + Lc[jt];
        }
    }
    f32x4 nw4[4];
    if (FULL) {
#pragma unroll
        for (int x = 0; x < 4; ++x) nw4[x] = *(const f32x4*)(U.nw + h * 128 + 16 * (4 * (wave >> 2) + x) + 4 * g);
    }
    if (tid < DK) BT[tid] = KIND == 0 ? 1.f : 0.f;
    v4u rv0, rv1; unsigned ra[8], rb[8]; f32x4 rbl = (f32x4){0.f, 0.f, 0.f, 0.f};
    auto load_raw = [&](int ch) {
        const size_t row0 = (size_t)U.b * SEQ + (U.c0 + ch) * 64;
        const bf16* Vp = U.PROJ + (row0 + (tid >> 3)) * LDP + K::vcol(h) + (tid & 7) * 16;
        rv0 = *(const v4u*)Vp; rv1 = *(const v4u*)(Vp + 8);
        if (KIND == 1 && tid < 256) rbl = *(const f32x4*)(U.BL + (row0 + (tid >> 2)) * 16 + (tid & 3) * 4);
        if (KIND == 0) {
            const bf16* P = U.PROJ + (row0 + 8 * wave) * LDP + 2 * lane;
#pragma unroll
            for (int tt = 0; tt < 8; ++tt) { ra[tt] = *(const unsigned*)(P + (size_t)tt * LDP + K::kcol(h)); if (FULL) rb[tt] = *(const unsigned*)(P + (size_t)tt * LDP + K::qcol(h)); }
        } else {
            const bf16* P = U.PROJ + (row0 + 8 * wave) * LDP + lane;
#pragma unroll
            for (int tt = 0; tt < 8; ++tt) { ra[tt] = P[(size_t)tt * LDP + K::kcol(h)]; if (FULL) rb[tt] = P[(size_t)tt * LDP + K::qcol(h)]; }
        }
    };
    load_raw(0);
    for (int ch = 0; ch < U.nch; ++ch) {
        const int pos0 = (U.c0 + ch) * 64; const size_t row0 = (size_t)U.b * SEQ + pos0;
        *(LAS v4u*)(lds + L::VV + (tid >> 3) * PV + (tid & 7) * 32) = rv0; *(LAS v4u*)(lds + L::VV + (tid >> 3) * PV + (tid & 7) * 32 + 16) = rv1;
        if (KIND == 0) {
            float cp0[8], cp1[8], k0[8], k1[8]; float c0 = 1.f, c1 = 1.f;
#pragma unroll
            for (int tt = 0; tt < 8; ++tt) {
                const float f0 = lb0 + (1.f - lb0) * sigmoidf_(bf2f((bf16)(ra[tt] & 0xffff))), f1 = lb1 + (1.f - lb1) * sigmoidf_(bf2f((bf16)(ra[tt] >> 16)));
                c0 *= f0; c1 *= f1; cp0[tt] = c0; cp1[tt] = c1; k0[tt] = 1.f - f0; k1[tt] = 1.f - f1;
            }
            *(LAS f32x2*)(PART + wave * 128 + 2 * lane) = (f32x2){c0, c1};
            __syncthreads();
            float pre0 = 1.f, pre1 = 1.f, mid0 = 1.f, mid1 = 1.f, hi0 = 1.f, hi1 = 1.f;
#pragma unroll
            for (int w2 = 0; w2 < 8; ++w2) { const f32x2 p = *(const LAS f32x2*)(PART + w2 * 128 + 2 * lane);
                if (w2 < 4) { mid0 *= p.x; mid1 *= p.y; } else { hi0 *= p.x; hi1 *= p.y; }
                if (wave < 4 ? (w2 > wave && w2 < 4) : (w2 >= 4 && w2 < wave)) { pre0 *= p.x; pre1 *= p.y; } }
#pragma unroll
            for (int tt = 0; tt < 8; ++tt) {
                float qs0, qs1, ks0, ks1;
                if (wave >= 4) { qs0 = pre0 * cp0[tt]; qs1 = pre1 * cp1[tt]; ks0 = __builtin_amdgcn_rcpf(fmaxf(qs0, 1e-26f)); ks1 = __builtin_amdgcn_rcpf(fmaxf(qs1, 1e-26f)); }
                else { ks0 = pre0 * c0 * __builtin_amdgcn_rcpf(fmaxf(cp0[tt], 1e-26f)); ks1 = pre1 * c1 * __builtin_amdgcn_rcpf(fmaxf(cp1[tt], 1e-26f));
                       qs0 = __builtin_amdgcn_rcpf(fmaxf(ks0, 1e-26f)); qs1 = __builtin_amdgcn_rcpf(fmaxf(ks1, 1e-26f)); }
                *(LAS unsigned*)(lds + L::KS + (8 * wave + tt) * PK + 4 * lane) = pg8::cvt_pk_bf16(k0[tt] * ks0, k1[tt] * ks1);
                if (FULL) *(LAS unsigned*)(lds + L::QS + (8 * wave + tt) * PK + 4 * lane) = pg8::cvt_pk_bf16(bf2f((bf16)(rb[tt] & 0xffff)) * qs0, bf2f((bf16)(rb[tt] >> 16)) * qs1);
            }
            if (wave == 0) { *(LAS f32x2*)(EM + 2 * lane) = (f32x2){mid0, mid1}; *(LAS f32x2*)(EL + 2 * lane) = (f32x2){hi0, hi1};
                const f32x2 o = *(const LAS f32x2*)(BT + 2 * lane); *(LAS f32x2*)(BT + 2 * lane) = (f32x2){o.x * mid0 * hi0, o.y * mid1 * hi1}; }
        } else if (KIND == 1) {
            LAS float* BLS = (LAS float*)(lds + L::BLS);
            if (tid < 256) *(LAS f32x4*)(BLS + (tid >> 2) * 16 + (tid & 3) * 4) = rbl;
            __syncthreads();
            float cs[8]; float cc = 0.f;
#pragma unroll
            for (int tt = 0; tt < 8; ++tt) {
                const LAS f32x4* bl = (const LAS f32x4*)(BLS + (8 * wave + tt) * 16); float z = bu;
#pragma unroll
                for (int r = 0; r < 4; ++r) { const f32x4 bq = bl[r]; z += (bq[0] * wu[4 * r] + bq[1] * wu[4 * r + 1]) + (bq[2] * wu[4 * r + 2] + bq[3] * wu[4 * r + 3]); }
                const float ls = fminf(z, 0.f) - __logf(1.f + __expf(-fabsf(z)));
                cc += ls * (1.f / 16.f); cs[tt] = cc;
            }
            PART[wave * 64 + lane] = cc;
            __syncthreads();
            float off = 0.f, mid = 0.f, tot = 0.f;
#pragma unroll
            for (int w2 = 0; w2 < 8; ++w2) { const float p = PART[w2 * 64 + lane]; if (w2 < wave) off += p; if (w2 < 4) mid += p; tot += p; }
#pragma unroll
            for (int tt = 0; tt < 8; ++tt) {
                const float b = off + cs[tt];
                *(LAS bf16*)(lds + L::KS + (8 * wave + tt) * PK + 2 * lane) = (bf16)f2bf(bf2f((bf16)ra[tt]) * __expf(fminf(mid - b, 60.f)));
                if (FULL) *(LAS bf16*)(lds + L::QS + (8 * wave + tt) * PK + 2 * lane) = (bf16)f2bf(bf2f((bf16)rb[tt]) * 0.125f * __expf(fminf(b - mid, 60.f)));
            }
            if (wave == 0) { EM[lane] = __expf(mid); EL[lane] = __expf(tot - mid); BT[lane] += tot; }
        } else {
#pragma unroll
            for (int tt = 0; tt < 8; ++tt) {
                const int tl = 8 * wave + tt; float rev = (float)(pos0 + tl) * ci; rev -= floorf(rev);
                const float sn = __builtin_amdgcn_sinf(rev), cs = __builtin_amdgcn_cosf(rev);
                const float e = (float)(tl - 31) * lgg;
                const float kv = bf2f((bf16)ra[tt]), kp = __shfl_xor(kv, 32);
                const float kr = (lane < 32 ? kv * cs - kp * sn : kp * sn + kv * cs) * 0.125f;
                *(LAS bf16*)(lds + L::KS + tl * PK + 2 * lane) = (bf16)f2bf(kr * __expf(-e));
                if (FULL) { const float qv = bf2f((bf16)rb[tt]), qp = __shfl_xor(qv, 32); const float qr = lane < 32 ? qv * cs - qp * sn : qp * sn + qv * cs;
                    *(LAS bf16*)(lds + L::QS + tl * PK + 2 * lane) = (bf16)f2bf(qr * __expf(e)); }
            }
            if (wave == 0) { const float e32 = __expf(32.f * lgg); EM[lane] = e32; EL[lane] = e32; BT[lane] += 64.f * lgg; }
        }
        if (ch + 1 < U.nch) load_raw(ch + 1);
        v2u gq[4];
        if (FULL) { const bf16* gp = U.PROJ + (row0 + 16 * (wave & 3) + c) * LDP + K::gcol(h) + 16 * (4 * (wave >> 2)) + 4 * g;
#pragma unroll
            for (int x = 0; x < 4; ++x) gq[x] = *(const v2u*)(gp + 16 * x); }
        __syncthreads();
        { const f32x4 em4 = *(const LAS f32x4*)(EM + 16 * dt + 4 * g);
#pragma unroll
          for (int jt = 0; jt < NJT; ++jt) { S[jt] = S[jt] * em4;
              if (FULL) { v2u w; w.x = pg8::cvt_pk_bf16(S[jt][0], S[jt][1]); w.y = pg8::cvt_pk_bf16(S[jt][2], S[jt][3]);
                  *(LAS v2u*)(lds + L::ST + (16 * (jt0 + jt) + c) * PK + (16 * dt + 4 * g) * 2) = w; } } }
        if (FULL) {
            const int st = wave & 3, tt0 = 2 * (wave >> 2);
            f32x4 p0 = (f32x4){0.f, 0.f, 0.f, 0.f}, p1 = p0;
#pragma unroll
            for (int kk = 0; kk < DK / 32; ++kk) { const bf16x8 a = row_frag(lds + L::KS, PK, 16 * st, kk, lane);
                p0 = MFMA16(a, row_frag(lds + L::QS, PK, 16 * tt0, kk, lane), p0); p1 = MFMA16(a, row_frag(lds + L::QS, PK, 16 * (tt0 + 1), kk, lane), p1); }
#pragma unroll
            for (int x = 0; x < 2; ++x) { const f32x4 p = x ? p1 : p0; const int t = 16 * (tt0 + x) + c, s = 16 * st + 4 * g;
                v2u w; w.x = pg8::cvt_pk_bf16(s <= t ? p[0] : 0.f, s + 1 <= t ? p[1] : 0.f); w.y = pg8::cvt_pk_bf16(s + 2 <= t ? p[2] : 0.f, s + 3 <= t ? p[3] : 0.f);
                *(LAS v2u*)(lds + L::PM + t * PP + s * 2) = w; }
        }
        {
#pragma unroll
          for (int kk = 0; kk < 2; ++kk) { const bf16x8 a = tr_frag(lds + L::KS, PK, 32 * kk, 16 * dt, lane);
#pragma unroll
              for (int jt = 0; jt < NJT; ++jt) S[jt] = MFMA16(a, tr_frag(lds + L::VV, PV, 32 * kk, 16 * (jt0 + jt), lane), S[jt]); }
          const f32x4 el4 = *(const LAS f32x4*)(EL + 16 * dt + 4 * g);
#pragma unroll
          for (int jt = 0; jt < NJT; ++jt) S[jt] = S[jt] * el4;
        }
        __syncthreads();
        if (FULL) {
            const int tt = wave & 3, jh = wave >> 2, t = 16 * tt + c;
            f32x4 o[4];
#pragma unroll
            for (int x = 0; x < 4; ++x) o[x] = (f32x4){0.f, 0.f, 0.f, 0.f};
#pragma unroll
            for (int kk = 0; kk < 2; ++kk) { const bf16x8 bb = row_frag(lds + L::PM, PP, 16 * tt, kk, lane);
#pragma unroll
                for (int x = 0; x < 4; ++x) o[x] = MFMA16(tr_frag(lds + L::VV, PV, 32 * kk, 16 * (4 * jh + x), lane), bb, o[x]); }
#pragma unroll
            for (int kk = 0; kk < DK / 32; ++kk) { const bf16x8 bb = row_frag(lds + L::QS, PK, 16 * tt, kk, lane);
#pragma unroll
                for (int x = 0; x < 4; ++x) o[x] = MFMA16(row_frag(lds + L::ST, PK, 16 * (4 * jh + x), kk, lane), bb, o[x]); }
            float sm = 0.f, sq = 0.f;
#pragma unroll
            for (int x = 0; x < 4; ++x)
#pragma unroll
                for (int i = 0; i < 4; ++i) { sm += o[x][i]; sq += o[x][i] * o[x][i]; }
            sm += __shfl_xor(sm, 16); sq += __shfl_xor(sq, 16); sm += __shfl_xor(sm, 32); sq += __shfl_xor(sq, 32);
            LAS f32x2* RED = (LAS f32x2*)(lds + L::RED) + (ch & 1) * 128;
            if (g == 0) RED[jh * 64 + t] = (f32x2){sm, sq};
            __syncthreads();
            const f32x2 r0 = RED[t], r1 = RED[64 + t];
            const float mean = KIND == 2 ? (r0.x + r1.x) * (1.f / 128.f) : 0.f;
            const float rstd = rsqrtf(fmaxf((r0.y + r1.y) * (1.f / 128.f) - mean * mean, 0.f) + EPS);
            bf16* yp = U.YM + (row0 + t) * 1024 + K::ocol(h) + 16 * (4 * jh) + 4 * g;
#pragma unroll
            for (int x = 0; x < 4; ++x) {
                const float g0 = bf2f((bf16)(gq[x].x & 0xffff)), g1 = bf2f((bf16)(gq[x].x >> 16)), g2 = bf2f((bf16)(gq[x].y & 0xffff)), g3 = bf2f((bf16)(gq[x].y >> 16));
                v2u w; w.x = pg8::cvt_pk_bf16((o[x][0] - mean) * rstd * nw4[x][0] * siluf_(g0), (o[x][1] - mean) * rstd * nw4[x][1] * siluf_(g1));
                w.y = pg8::cvt_pk_bf16((o[x][2] - mean) * rstd * nw4[x][2] * siluf_(g2), (o[x][3] - mean) * rstd * nw4[x][3] * siluf_(g3));
                *(v2u*)(yp + 16 * x) = w; }
        }
    }
    if (!FULL) {
#pragma unroll
        for (int jt = 0; jt < NJT; ++jt)
#pragma unroll
            for (int i = 0; i < 4; ++i) Sg[(16 * dt + 4 * g + i) * 128 + 16 * (jt0 + jt) + c] = S[jt][i];
        __syncthreads();
        if (tid < DK) Bg[tid] = KIND == 0 ? BT[tid] : __expf(BT[tid]);
    }
    __syncthreads();
}
}


namespace rg {
constexpr int SEGMAX = 16;
constexpr int PX = 272, PW = 144, XCB = 0, XCF = 64 * PX, WT = XCF + 64 * 132 * 4, END = WT + 4 * 64 * PW;
static_assert(END <= LDS_MISC, "rglru LDS map");
template <bool FULL>
__device__ __forceinline__ void unit(LAS unsigned char* lds, const bf16* PROJ, bf16* YM, const float* const* in, int b, int c0, int nch, int sgi, int cg, float* RA, float* RH) {
    int tid = threadIdx.x; asm volatile("" : "+v"(tid));
    const int lane = tid & 63, wave = __builtin_amdgcn_readfirstlane(tid >> 6), g = lane >> 4, c = lane & 15;
    const int n0 = 2 * cg, chbase = cg * 128;
    const float* w_r = in[15]; const float* w_i = in[17];
    for (int i0 = tid; i0 < 4 * 4096; i0 += 512 * 16) { float t[16];
#pragma unroll
        for (int x = 0; x < 16; ++x) { const int i = i0 + 512 * x, m = i >> 12, gate = m >> 1, nb = m & 1, d = (i >> 6) & 63, e = i & 63; t[x] = (gate ? w_i : w_r)[((n0 + nb) * 64 + d) * 64 + e]; }
#pragma unroll
        for (int x = 0; x < 16; ++x) { const int i = i0 + 512 * x, m = i >> 12, d = (i >> 6) & 63, e = i & 63; *(LAS bf16*)(lds + WT + m * 64 * PW + e * PW + d * 2) = (bf16)f2bf(t[x]); } }
    float cw0[4], cw1[4]; const int cc = chbase + 2 * lane;
#pragma unroll
    for (int j = 0; j < 4; ++j) { cw0[j] = in[13][j * 512 + cc]; cw1[j] = in[13][j * 512 + cc + 1]; }
    const float cb0 = in[14][cc], cb1 = in[14][cc + 1];
    const int nb = wave >> 2, e0 = 16 * (wave & 3), chl = nb * 64 + e0 + c, chn = chbase + chl;
    const float brr = in[16][chn], bii = in[18][chn], sp = __logf(1.f + __expf(-in[19][chn]));
    float hcar = 0.f, atot = 1.f;
    if (FULL) {
        float fa[SEGMAX], fh[SEGMAX];
#pragma unroll
        for (int s = 0; s < SEGMAX; ++s) { const bool ok = s < sgi; fa[s] = ok ? RA[(s - sgi) * 512 + chn] : 1.f; fh[s] = ok ? RH[(s - sgi) * 512 + chn] : 0.f; }
#pragma unroll
        for (int s = 0; s < SEGMAX; ++s) hcar = s < sgi ? fa[s] * hcar + fh[s] : hcar;
    }
    unsigned xw[11];
    auto load_x = [&](int ch) {
#pragma unroll
        for (int r = 0; r < 11; ++r) { const int pos = (c0 + ch) * 64 + 8 * wave - 3 + r; xw[r] = 0u;
            if (pos >= 0) xw[r] = *(const unsigned*)(PROJ + ((size_t)b * SEQ + pos) * OD_N + 1536 + cc); }
    };
    load_x(0);
    __syncthreads();
    for (int ch = 0; ch < nch; ++ch) {
        const int pos0 = (c0 + ch) * 64; const size_t row0 = (size_t)b * SEQ + pos0;
        {
            float x0[11], x1[11];
#pragma unroll
            for (int r = 0; r < 11; ++r) { x0[r] = bf2f((bf16)(xw[r] & 0xffff)); x1[r] = bf2f((bf16)(xw[r] >> 16)); }
#pragma unroll
            for (int tt = 0; tt < 8; ++tt) {
                const float a0 = cb0 + cw0[0] * x0[tt] + cw0[1] * x0[tt + 1] + cw0[2] * x0[tt + 2] + cw0[3] * x0[tt + 3];
                const float a1 = cb1 + cw1[0] * x1[tt] + cw1[1] * x1[tt + 1] + cw1[2] * x1[tt + 2] + cw1[3] * x1[tt + 3];
                *(LAS unsigned*)(lds + XCB + (8 * wave + tt) * PX + 4 * lane) = pg8::cvt_pk_bf16(a0, a1);
                *(LAS f32x2*)(lds + XCF + ((8 * wave + tt) * 132 + 2 * lane) * 4) = (f32x2){a0, a1};
            }
        }
        if (ch + 1 < nch) load_x(ch + 1);
        bf16 gt[16];
        if (FULL) {
#pragma unroll
            for (int tt = 0; tt < 4; ++tt)
#pragma unroll
                for (int i = 0; i < 4; ++i) gt[4 * tt + i] = PROJ[(row0 + 16 * tt + 4 * g + i) * OD_N + 2048 + chn];
        }
        __syncthreads();
        f32x4 R[4], I[4];
#pragma unroll
        for (int tt = 0; tt < 4; ++tt) { R[tt] = (f32x4){0.f, 0.f, 0.f, 0.f}; I[tt] = R[tt]; }
#pragma unroll
        for (int kk = 0; kk < 2; ++kk) {
            const bf16x8 fr = mx::row_frag(lds + WT + nb * 64 * PW, PW, e0, kk, lane), fi = mx::row_frag(lds + WT + (2 + nb) * 64 * PW, PW, e0, kk, lane);
#pragma unroll
            for (int tt = 0; tt < 4; ++tt) { const bf16x8 a = mx::row_frag(lds + XCB + nb * 128, PX, 16 * tt, kk, lane); R[tt] = MFMA16(a, fr, R[tt]); I[tt] = MFMA16(a, fi, I[tt]); }
        }
#pragma unroll
        for (int tt = 0; tt < 4; ++tt) {
            float av[4], uv[4];
#pragma unroll
            for (int i = 0; i < 4; ++i) { const int t = 16 * tt + 4 * g + i;
                const float r = sigmoidf_(R[tt][i] + brr), ig = sigmoidf_(I[tt][i] + bii), la = -8.f * r * sp, a = __expf(la);
                av[i] = a; uv[i] = __builtin_amdgcn_sqrtf(fmaxf(1.f - a * a, 0.f)) * ig * *(const LAS float*)(lds + XCF + (t * 132 + chl) * 4); }
            float As = av[0] * av[1] * av[2] * av[3], Hs = ((uv[0] * av[1] + uv[1]) * av[2] + uv[2]) * av[3] + uv[3];
            float Ai = As, Hi = Hs;
            { const float Ap = __shfl(Ai, (lane - 16) & 63), Hp = __shfl(Hi, (lane - 16) & 63); if (g >= 1) { Hi = Hp * Ai + Hi; Ai = Ap * Ai; } }
            { const float Ap = __shfl(Ai, (lane - 32) & 63), Hp = __shfl(Hi, (lane - 32) & 63); if (g >= 2) { Hi = Hp * Ai + Hi; Ai = Ap * Ai; } }
            const float Ae = __shfl(Ai, (lane - 16) & 63), He = __shfl(Hi, (lane - 16) & 63), At = __shfl(Ai, 48 + c), Ht = __shfl(Hi, 48 + c);
            float h = g == 0 ? hcar : Ae * hcar + He;
            if (FULL) {
#pragma unroll
                for (int i = 0; i < 4; ++i) { const size_t row = row0 + 16 * tt + 4 * g + i; h = av[i] * h + uv[i];
                    YM[row * 1024 + 512 + chn] = (bf16)f2bf(h * gelu_tanh_(bf2f(gt[4 * tt + i]))); }
            }
            hcar = At * hcar + Ht; atot *= At;
        }
        __syncthreads();
    }
    if (!FULL && g == 0) { RA[chn] = atot; RH[chn] = hcar; }
}
}

constexpr int SEG_RET = 16, SEG_LRU = 16;
static_assert(SEG_LRU <= rg::SEGMAX, "RG-LRU segment count");
template <int SUB> __device__ __forceinline__ void phase_mix(Frame& F, int layer) {
    float* SG = (float*)(F.ws + WS_ST); float* BG = (float*)(F.ws + WS_ST + 16 * MiB);
    const bf16* PROJ = (const bf16*)(F.ws + WS_PROJ); bf16* YM = (bf16*)(F.ws + WS_ACT);
    float* RA = (float*)(F.ws + WS_ST + 16 * MiB + 256 * 1024); float* RH = RA + 2 * 32 * 512;
    const int S = layer == 0 ? 16 : SEG_RET;
    if (SUB == 1) {
        int tid = threadIdx.x; asm volatile("" : "+v"(tid));
        const int nel = (layer == 0 ? 16 : 8) * 16384;
        for (int idx = F.vcu * 512 + tid; idx < nel; idx += F.G * 512) {
            const int cidx = idx >> 14, e = idx & 16383, DK = (layer == 0 && cidx < 8) ? 128 : 64;
            if (e >= DK * 128) continue;
            const int d = e >> 7; float carry = 0.f;
            for (int seg = 0; seg < S; ++seg) { float* p = SG + (size_t)(cidx * S + seg) * 16384 + e; const float tmp = *p; *p = carry; carry = BG[(cidx * S + seg) * 128 + d] * carry + tmp; }
        }
        if (layer == 1) for (int idx = F.vcu * 512 + tid; idx < 1024; idx += F.G * 512) { const int bb = idx >> 9, cch = idx & 511; float carry = 0.f;
            for (int seg = 0; seg < SEG_LRU; ++seg) { const int o = (bb * SEG_LRU + seg) * 512 + cch; const float ta = RA[o], th = RH[o]; RH[o] = carry; carry = ta * carry + th; } }
        return;
    }
    for (int u = F.vcu; u < 256; u += F.G) {
        if (layer == 1 && u >= 8 * SEG_RET) {
            const int x = u - 8 * SEG_RET, bb = x / (4 * SEG_LRU), sg = (x >> 2) % SEG_LRU, cg = x & 3, c0 = (256 * sg) / SEG_LRU, nch = (256 * (sg + 1)) / SEG_LRU - c0;
            rg::unit<SUB == 2>(F.lds, PROJ, YM, F.in, bb, c0, nch, sg, cg, RA + (bb * SEG_LRU + sg) * 512, RH + (bb * SEG_LRU + sg) * 512);
            continue;
        }
        const int cidx = u / S, seg = u % S, chain = cidx & 7;
        mx::UnitP U; U.PROJ = PROJ; U.YM = YM; U.BL = (const float*)(F.ws + WS_BLOW); U.b = chain >> 2; U.h = chain & 3; U.p2 = nullptr;
        U.c0 = (256 * seg) / S; U.nch = (256 * (seg + 1)) / S - U.c0; U.seg = seg;
        float* Sg = SG + (size_t)(cidx * S + seg) * 16384; float* Bg = BG + (cidx * S + seg) * 128;
        if (layer == 0) {
            if (cidx < 8) { U.nw = F.in[6]; U.p0 = F.in[5]; U.p1 = nullptr; mx::mix_unit<0, SUB == 2>(F.lds, Sg, Bg, U); }
            else { U.nw = F.in[9]; U.p0 = F.in[7]; U.p1 = F.in[8]; mx::mix_unit<1, SUB == 2>(F.lds, Sg, Bg, U); }
        } else { U.nw = F.in[12]; U.p0 = nullptr; U.p1 = nullptr; mx::mix_unit<2, SUB == 2>(F.lds, Sg, Bg, U); }
    }
}

__device__ __forceinline__ void moe_poff(Frame& F, int layer) {
    PHASE_IDS(F);
    LAS int* poff = (LAS int*)(F.lds + LDS_MISC + 1024);
    const unsigned* cnt = F.ctl + CW_CNT + 64 * layer;
    __syncthreads();
    if (F.tid < 32) poff[33 + F.tid] = (int)cnt[F.tid];
    __syncthreads();
    if (F.tid == 0) { int acc = 0; for (int e = 0; e < 32; ++e) { poff[e] = acc; acc += (poff[33 + e] + 255) & ~255; } poff[32] = acc; }
    __syncthreads();
}
struct Args { const float* in[28]; float* out; unsigned char* ws; int ph_lo, ph_hi, li, pad; };
__global__ void __launch_bounds__(NWAVES * 64, 2) mega(Args args) {
    extern __shared__ __attribute__((aligned(16))) unsigned char lds[];
    Frame F;
    F.lds = (LAS unsigned char*)lds; F.tid = threadIdx.x; F.lane = F.tid & 63; F.wave = __builtin_amdgcn_readfirstlane(F.tid >> 6);
    F.G = gridDim.x; { const int bx = blockIdx.x; F.vcu = (F.G % 8 == 0) ? (bx % 8) * (F.G / 8) + bx / 8 : bx; }
    F.in = args.in; F.out = args.out; F.ws = args.ws; F.ctl = (unsigned*)(args.ws + WS_CTL);
    const int lo = args.ph_lo, hi = args.ph_hi;
    for (int u = F.tid; u < (LDS_BYTES - LDS_MISC) / 4; u += NWAVES * 64) ((LAS unsigned*)(F.lds + LDS_MISC))[u] = 0u;
    __syncthreads();
    XcdBarrier bar; bar.bar = F.ctl + CW_BAR + args.li * XCD_BAR_WORDS; bar.x = 0; bar.st = nullptr;
    if (hi - lo > 1) bar = xcd_barrier_post(F.ctl + CW_BAR + args.li * XCD_BAR_WORDS, (volatile LAS unsigned*)(F.lds + LDS_MISC + 32));
#ifndef ONLY_MASK
#define ONLY_MASK 0x7ffff
#endif
#define IN(k) (((ONLY_MASK >> (k)) & 1) && lo <= (k) && (k) < hi)
#define SEAM(k) do { if (IN(k) && IN((k) + 1)) xcd_barrier(bar); } while (0)
    bf16* ACT = (bf16*)(F.ws + WS_ACT); bf16* PROJ = (bf16*)(F.ws + WS_PROJ); bf16* H = (bf16*)(F.ws + WS_H); bf16* Y = (bf16*)(F.ws + WS_Y);
    const LAS int* poff = (const LAS int*)(F.lds + LDS_MISC + 1024);
    bf16* XR1 = (bf16*)F.out; bf16* XR2 = XR1 + (size_t)NT * D; bf16* XR3 = (bf16*)(F.ws + WS_W13);
    if (IN(0)) phase_prologue(F);
    SEAM(0);
#pragma unroll
    for (int l = 0; l < 2; ++l) {
        const int pb = 9 * l;
        if (IN(pb + 1)) {
            const int N = l == 0 ? EV_N : OD_N;
            pg8::DenseOrder S; S.init(ACT, F.ws + (l == 0 ? WS_WIN0 : WS_WIN1), NT, N, 1024, F.G, (int)blockIdx.x);
            pg8::EpiBf E{PROJ, N, 1.f};
            pg8::gemm_phase<pg8::EpiBf, pg8::DenseOrder, true>(F.lds, 1024, S, E);
        }
        SEAM(pb + 1);
        {
            if (IN(pb + 2)) phase_mix<0>(F, l);
            SEAM(pb + 2);
            if (IN(pb + 4)) phase_mix<2>(F, l);
            SEAM(pb + 4);
        }
        if (IN(pb + 5)) {
            pg8::DenseOrder S; S.init(ACT, F.ws + (l == 0 ? WS_WOUT0 : WS_WOUT1), NT, 1024, 1024, F.G, (int)blockIdx.x);
            if (l == 0) { pg8::EpiRes<false> E{F.in[0], XR1, (float*)(F.ws + WS_SSQ)}; pg8::gemm_phase<pg8::EpiRes<false>, pg8::DenseOrder, true>(F.lds, 1024, S, E); }
            else { pg8::EpiRes<true> E{XR2, XR3, (float*)(F.ws + WS_SSQ)}; pg8::gemm_phase<pg8::EpiRes<true>, pg8::DenseOrder, true>(F.lds, 1024, S, E); }
        }
        SEAM(pb + 5);
        if (IN(pb + 6)) phase_router(F, l, l == 0 ? XR1 : XR3);
        SEAM(pb + 6);
        if (IN(pb + 7)) {
            moe_poff(F, l);
            pg8::MoeOrder S{poff, F.ctl + CW_CNT + 64 * l, (const int*)(F.ws + WS_LIST), (const char*)ACT, (const char*)(F.ws + WS_W13) + (size_t)l * 32 * 1024 * 1024 * 2, (size_t)1024 * 1024, 512, F.G, F.vcu, true};
            pg8::EpiUp E{(unsigned char*)H};
            pg8::gemm_phase<pg8::EpiUp, pg8::MoeOrder, true, true>(F.lds, 512, S, E);
        }
        SEAM(pb + 7);
        if (IN(pb + 8)) {
            moe_poff(F, l);
            pg8::MoeOrder S{poff, F.ctl + CW_CNT + 64 * l, (const int*)(F.ws + WS_LIST), (const char*)H, (const char*)(F.ws + WS_W2) + (size_t)l * 32 * 1024 * 512 * 2, (size_t)1024 * 512, 256, F.G, F.vcu, false};
            pg8::EpiF8 E{(unsigned char*)Y, 1024, 0.5f};
            pg8::gemm_phase<pg8::EpiF8, pg8::MoeOrder, true, true>(F.lds, 256, S, E);
        }
        SEAM(pb + 8);
        if (IN(pb + 9)) phase_combine(F, l, l == 0 ? XR1 : XR3, XR2);
        SEAM(pb + 9);
    }
#undef IN
#undef SEAM
}

extern "C" void kernel_launch(void* const* d_in, const int* in_sizes, int n_in, void* d_out, int out_size, void* d_ws, size_t ws_size, hipStream_t stream) {
    static int grid = 0;
    if (grid == 0) {
        if (n_in != 28 || out_size != NT * D || ws_size < WS_END) { fprintf(stderr, "kernel_launch: unexpected problem (n_in %d, out %d, ws %zu)\n", n_in, out_size, ws_size); grid = -1; return; }
        int dev = 0, cus = 0;
        if (hipGetDevice(&dev) != hipSuccess || hipDeviceGetAttribute(&cus, hipDeviceAttributeMultiprocessorCount, dev) != hipSuccess) { grid = -1; return; }
        if (hipFuncSetAttribute((const void*)mega, hipFuncAttributeMaxDynamicSharedMemorySize, LDS_BYTES) != hipSuccess) { fprintf(stderr, "kernel_launch: hipFuncSetAttribute failed\n"); grid = -1; return; }
        (void)hipGetLastError();
        grid = cus;
    }
    if (grid < 0) return;
    (void)hipMemsetAsync((char*)d_ws + WS_CTL, 0, CTL_BYTES, stream);
    Args a{};
    for (int i = 0; i < 28; ++i) a.in[i] = (const float*)d_in[i];
    a.out = (float*)d_out; a.ws = (unsigned char*)d_ws;
    int nli = 0;
    auto run = [&](int lo, int hi) { a.ph_lo = lo; a.ph_hi = hi; a.li = (hi - lo > 1) ? nli++ : 0; hipLaunchKernelGGL(mega, dim3(grid), dim3(NWAVES * 64), LDS_BYTES, stream, a); };
    run(0, 19);
}
```

```cpp
#include <hip/hip_runtime.h>
#include <cstdio>
#include <cstdint>

#define GAS __attribute__((address_space(1)))
#define LAS __attribute__((address_space(3)))
typedef unsigned short bf16;
typedef unsigned v4u __attribute__((ext_vector_type(4)));
typedef unsigned v2u __attribute__((ext_vector_type(2)));
typedef float f32x4 __attribute__((ext_vector_type(4)));
typedef float f32x2 __attribute__((ext_vector_type(2)));
typedef short bf16x8 __attribute__((ext_vector_type(8)));

constexpr int NT = 32768, D = 1024, SEQ = 16384;
constexpr int EV_N = 3584, OD_N = 2560, EV_LD = 3600;
constexpr float EPS = 1e-6f;
constexpr int NEXP = 32, SLOT_ROWS = 2 * NT + NEXP * 256;

constexpr size_t MiB = 1u << 20;
constexpr size_t WS_CTL = 0, CTL_BYTES = 1 * MiB;
constexpr size_t WS_WIN0 = 2 * MiB, WS_WOUT0 = 9 * MiB, WS_WIN1 = 11 * MiB, WS_WOUT1 = 16 * MiB, WS_W13 = 18 * MiB, WS_W2 = 146 * MiB;
constexpr size_t WS_ACT = 210 * MiB, WS_PROJ = 274 * MiB, WS_H = WS_PROJ, WS_Y = WS_PROJ + 72 * MiB;
constexpr size_t WS_BLOW = 498 * MiB, WS_META = 500 * MiB, WS_LIST = 501 * MiB, WS_ST = 505 * MiB, WS_SSQ = 522 * MiB, WS_END = 524 * MiB;
constexpr int CW_TMO = 0, CW_BAR = 4096, CW_CNT = 16384;

constexpr int NWAVES = 8;
constexpr int LDS_BYTES = 163840;
constexpr int LDS_MISC = 149504;

__device__ __forceinline__ float bf2f(bf16 b) { return __builtin_bit_cast(float, (unsigned)b << 16); }
__device__ __forceinline__ unsigned pk2(float lo, float hi) { unsigned r; asm("v_cvt_pk_bf16_f32 %0, %1, %2" : "=v"(r) : "v"(lo), "v"(hi)); return r; }
__device__ __forceinline__ unsigned f2bf(float f) { return pk2(f, f) & 0xffffu; }
__device__ __forceinline__ float sigmoidf_(float x) { return __builtin_amdgcn_rcpf(1.f + __expf(-x)); }
__device__ __forceinline__ float siluf_(float x) { return x * sigmoidf_(x); }
__device__ __forceinline__ float gelu_tanh_(float x) { const float u = 0.7978845608f * (x + 0.044715f * x * x * x); return x * sigmoidf_(2.f * u); }
__device__ __forceinline__ float wave_sum(float v) {
#pragma unroll
    for (int o = 1; o < 64; o <<= 1) v += __shfl_xor(v, o);
    return v;
}
#define LDS_WAIT() asm volatile("s_waitcnt lgkmcnt(0)" ::: "memory")

struct Frame {
    LAS unsigned char* lds;
    int tid, lane, wave, vcu, G;
    const float* const* in;
    float* out; unsigned char* ws;
    unsigned* ctl;
};


#define XB_TMO      128
#define XB_XCNT(j)  (256  + 64 * (j))
#define XB_XSUB(j)  (1280 + 64 * (j))
#define XB_XGEN(j)  (2304 + 64 * (j))
#define XB_TOP      3328
#define XB_TOPGEN   3392
#define XCD_BAR_WORDS 3456
#define XB_SPIN_CAP (1u << 18)
__device__ __forceinline__ unsigned xb_ld(unsigned* p)              { return __hip_atomic_load(p, __ATOMIC_RELAXED, __HIP_MEMORY_SCOPE_AGENT); }
__device__ __forceinline__ unsigned xb_add(unsigned* p, unsigned v) { return __hip_atomic_fetch_add(p, v, __ATOMIC_RELAXED, __HIP_MEMORY_SCOPE_AGENT); }
__device__ __forceinline__ unsigned xb_xcc_id() { return (unsigned)__builtin_amdgcn_s_getreg((3 << 11) | 20) & 0xFu; }
#define XB_SPIN(cond, bar) do { unsigned _sp = 0; while (cond) { __builtin_amdgcn_s_sleep(1); \
    if ((++_sp & 255u) == 0u) { if (xb_ld(&(bar)[XB_TMO])) break; if (_sp > XB_SPIN_CAP) { atomicAdd(&(bar)[XB_TMO], 1u); break; } } } } while (0)
struct XcdBarrier { unsigned* bar; unsigned x; volatile LAS unsigned* st; };
__device__ __forceinline__ XcdBarrier xcd_barrier_post(unsigned* bar, volatile LAS unsigned* st) {
    XcdBarrier b; b.bar = bar; b.x = xb_xcc_id(); b.st = st;
    if (threadIdx.x == 0) (void)xb_add(&bar[XB_XCNT(b.x)], 1u);
    return b;
}
__device__ __forceinline__ void xcd_barrier_complete(unsigned* bar, unsigned x, unsigned& nloc, unsigned& nx) {
    const unsigned G = gridDim.x * gridDim.y * gridDim.z;
    unsigned sum, cnt, mine, sp = 0u;
    for (;;) {
        sum = 0u; cnt = 0u; mine = 0u;
#pragma unroll
        for (unsigned j = 0; j < 16; ++j) { const unsigned c = xb_ld(&bar[XB_XCNT(j)]); sum += c; cnt += (c > 0u) ? 1u : 0u; mine = (j == x) ? c : mine; }
        if (sum == G) break;
        __builtin_amdgcn_s_sleep(1);
        if ((++sp & 255u) == 0u) { if (xb_ld(&bar[XB_TMO])) break; if (sp > XB_SPIN_CAP) { atomicAdd(&bar[XB_TMO], 1u); break; } }
    }
    nloc = mine > 0u ? mine : 1u; nx = cnt > 0u ? cnt : 1u;
}
__device__ __forceinline__ void xcd_barrier(const XcdBarrier& b) {
    asm volatile("s_waitcnt vmcnt(0)" ::: "memory");
    __syncthreads();
    if (threadIdx.x == 0) {
        unsigned* bar = b.bar;
        __builtin_amdgcn_s_waitcnt(0);
        unsigned nloc = b.st[0], nx = b.st[1];
        if (nloc == 0u) { xcd_barrier_complete(bar, b.x, nloc, nx); b.st[0] = nloc; b.st[1] = nx; }
        const unsigned old = xb_add(&bar[XB_XSUB(b.x)], 1u);
        const unsigned gen = old / nloc;
        if (old + 1u == (gen + 1u) * nloc) {
            __builtin_amdgcn_fence(__ATOMIC_RELEASE, "agent");
            asm volatile("s_waitcnt vmcnt(0)" ::: "memory");
            const unsigned og = xb_add(&bar[XB_TOP], 1u);
            const unsigned tg = og / nx;
            if (og + 1u == (tg + 1u) * nx) xb_add(&bar[XB_TOPGEN], 1u);
            else XB_SPIN(xb_ld(&bar[XB_TOPGEN]) == tg, bar);
            __builtin_amdgcn_fence(__ATOMIC_ACQUIRE, "agent");
            xb_add(&bar[XB_XGEN(b.x)], 1u);
            asm volatile("s_waitcnt vmcnt(0)" ::: "memory");
        } else {
            XB_SPIN(xb_ld(&bar[XB_XGEN(b.x)]) == gen, bar);
            __builtin_amdgcn_fence(__ATOMIC_ACQUIRE, "agent");
            asm volatile("s_waitcnt vmcnt(0)" ::: "memory");
        }
    }
    __syncthreads();
}

namespace pg8 {
typedef unsigned u32x4 __attribute__((ext_vector_type(4)));
typedef int i32x4 __attribute__((ext_vector_type(4)));
typedef int i32x8 __attribute__((ext_vector_type(8)));
constexpr int BM = 256, BK = 64, HALF = 128, HTB = HALF * BK * 2, STAGE_BYTES = 8 * HTB, NXCD = 8, WGM = 8;
__host__ __device__ __forceinline__ int lds_byte(int r, int c) { const int st = (r >> 4) * 2 + (c >> 5), rr = r & 15, cc = c & 31, ob = rr * 64 + cc * 2; return st * 1024 + (ob ^ (((ob >> 9) & 1) << 5)); }
__host__ __device__ __forceinline__ void stage_rc(int b, int& R, int& C) { const int st = b / 1024, sb = b % 1024, swz = sb ^ (((sb >> 9) & 1) << 5); R = (st >> 1) * 16 + swz / 64; C = (st & 1) * 32 + (swz % 64) / 2; }
__host__ __device__ __forceinline__ int perm32(int rho) { const int n = rho >> 4, i = rho & 15; return 8 * (i >> 2) + 4 * n + (i & 3); }
struct Unit { int pm, pn, e; };
__device__ __forceinline__ unsigned cvt_pk_bf16(float lo, float hi) { return pk2(lo, hi); }

struct DenseOrder {
    int nM, nN, nwg, G, c, K; const char* A; const char* Bt;
    __device__ __forceinline__ void init(const void* A_, const void* Bt_, int M, int N, int K_, int G_, int c_) { A = (const char*)A_; Bt = (const char*)Bt_; nM = M / BM; nN = N / BM; nwg = nM * nN; G = G_; c = c_; K = K_; }
    __device__ __forceinline__ bool next(int i, Unit& u) const {
        const long L = (long)i * G + c; if (L >= nwg) return false;
        int wgid = (int)L; { const int q = nwg / NXCD, r = nwg % NXCD, xcd = wgid % NXCD, off = wgid / NXCD; wgid = (xcd < r ? xcd * (q + 1) : r * (q + 1) + (xcd - r) * q) + off; }
        const int nig = WGM * nN, gid = wgid / nig, fm = gid * WGM, gsz = (nM - fm) < WGM ? (nM - fm) : WGM;
        u.pm = fm + ((wgid % nig) % gsz); u.pn = (wgid % nig) / gsz; u.e = 0; return true;
    }
    __device__ __forceinline__ unsigned a_off(const Unit& u, int r) const { return (unsigned)((u.pm * BM + r) * K) * 2u; }
    __device__ __forceinline__ const char* b_ptr(const Unit& u) const { return Bt + (size_t)u.pn * BM * K * 2; }
};
struct MoeOrder {
    const LAS int* poff; const unsigned* cnt; const int* list; const char* A; const char* Bt; size_t estride; int K, G, c; bool gather;
    __device__ __forceinline__ bool next(int i, Unit& u) const {
        const int L = i * G + c, np = __builtin_amdgcn_readfirstlane(poff[32]) >> 8; if (L >= np * 4) return false;
        u.pm = L >> 2; u.pn = L & 3; const int row = u.pm << 8; int e = 0;
        while (row >= __builtin_amdgcn_readfirstlane(poff[e + 1])) ++e;
        u.e = e; return true;
    }
    __device__ __forceinline__ unsigned a_off(const Unit& u, int r) const {
        if (!gather) return (unsigned)((u.pm * BM + r) * K) * 2u;
        const int idx = min(u.pm * BM + r - poff[u.e], poff[33 + u.e] - 1);
        return (unsigned)list[(size_t)u.e * NT + idx] * (unsigned)(K * 2);
    }
    __device__ __forceinline__ const char* b_ptr(const Unit& u) const { return Bt + (size_t)u.e * estride + (size_t)u.pn * BM * K * 2; }
};

struct EpiBf {
    static constexpr bool PERM = true;
    bf16* O; int ldc; float scale;
    __device__ __forceinline__ void operator()(const f32x4 (&acc)[2][2][4][2], const Unit& u, int wr, int wc, int fr, int fq) const {
        const int row0 = u.pm * BM + wr * 64 + fr, col0 = u.pn * BM + wc * 32 + 8 * fq;
#pragma unroll
        for (int ai = 0; ai < 2; ++ai)
#pragma unroll
            for (int m = 0; m < 4; ++m) { bf16* rowp = O + (size_t)(row0 + ai * HALF + m * 16) * ldc + col0;
#pragma unroll
                for (int bj = 0; bj < 2; ++bj) { const f32x4 v0 = acc[ai][bj][m][0] * scale, v1 = acc[ai][bj][m][1] * scale;
                    u32x4 w; w.x = cvt_pk_bf16(v0[0], v0[1]); w.y = cvt_pk_bf16(v0[2], v0[3]); w.z = cvt_pk_bf16(v1[0], v1[1]); w.w = cvt_pk_bf16(v1[2], v1[3]);
                    *(u32x4*)(rowp + bj * HALF) = w; } }
    }
};
template <bool RES_BF16>
struct EpiRes {
    static constexpr bool PERM = true;
    const void* res; bf16* xout; float* ssq;
    __device__ __forceinline__ void operator()(const f32x4 (&acc)[2][2][4][2], const Unit& u, int wr, int wc, int fr, int fq) const {
        const int row0 = u.pm * BM + wr * 64 + fr, col0 = u.pn * BM + wc * 32 + 8 * fq;
#pragma unroll
        for (int ai = 0; ai < 2; ++ai) {
            f32x4 r0[4][2], r1[4][2];
#pragma unroll
            for (int m = 0; m < 4; ++m) { const size_t off = (size_t)(row0 + ai * HALF + m * 16) * 1024 + col0;
#pragma unroll
                for (int bj = 0; bj < 2; ++bj) {
                    if (RES_BF16) { const u32x4 rw = *(const u32x4*)((const bf16*)res + off + bj * HALF);
                        r0[m][bj] = (f32x4){__builtin_bit_cast(float, rw.x << 16), __builtin_bit_cast(float, rw.x & 0xffff0000u), __builtin_bit_cast(float, rw.y << 16), __builtin_bit_cast(float, rw.y & 0xffff0000u)};
                        r1[m][bj] = (f32x4){__builtin_bit_cast(float, rw.z << 16), __builtin_bit_cast(float, rw.z & 0xffff0000u), __builtin_bit_cast(float, rw.w << 16), __builtin_bit_cast(float, rw.w & 0xffff0000u)}; }
                    else { r0[m][bj] = *(const f32x4*)((const float*)res + off + bj * HALF); r1[m][bj] = *(const f32x4*)((const float*)res + off + bj * HALF + 4); } } }
#pragma unroll
            for (int m = 0; m < 4; ++m) { const int row = row0 + ai * HALF + m * 16; const size_t off = (size_t)row * 1024 + col0; float ss = 0.f;
#pragma unroll
                for (int bj = 0; bj < 2; ++bj) {
                    const f32x4 v0 = r0[m][bj] + acc[ai][bj][m][0], v1 = r1[m][bj] + acc[ai][bj][m][1];
                    ss += ((v0[0] * v0[0] + v0[1] * v0[1]) + (v0[2] * v0[2] + v0[3] * v0[3])) + ((v1[0] * v1[0] + v1[1] * v1[1]) + (v1[2] * v1[2] + v1[3] * v1[3]));
                    u32x4 w; w.x = cvt_pk_bf16(v0[0], v0[1]); w.y = cvt_pk_bf16(v0[2], v0[3]); w.z = cvt_pk_bf16(v1[0], v1[1]); w.w = cvt_pk_bf16(v1[2], v1[3]);
                    *(u32x4*)(xout + off + bj * HALF) = w; }
                ss += __shfl_xor(ss, 16); ss += __shfl_xor(ss, 32);
                if (fq == 0) ssq[(size_t)row * 16 + u.pn * 4 + wc] = ss; }
            asm volatile("" ::: "memory");
        }
    }
};
__device__ __forceinline__ unsigned pk4_fp8(float a, float b, float c, float d) { int p = __builtin_amdgcn_cvt_pk_fp8_f32(a, b, 0, false); return (unsigned)__builtin_amdgcn_cvt_pk_fp8_f32(c, d, p, true); }
struct EpiF8 {
    static constexpr bool PERM = true;
    unsigned char* O; int ldc; float scale;
    __device__ __forceinline__ void operator()(const f32x4 (&acc)[2][2][4][2], const Unit& u, int wr, int wc, int fr, int fq) const {
        const int row0 = u.pm * BM + wr * 64 + fr, col0 = u.pn * BM + wc * 32 + 8 * fq;
#pragma unroll
        for (int ai = 0; ai < 2; ++ai)
#pragma unroll
            for (int m = 0; m < 4; ++m) { unsigned char* rowp = O + (size_t)(row0 + ai * HALF + m * 16) * ldc + col0;
#pragma unroll
                for (int bj = 0; bj < 2; ++bj) { const f32x4 v0 = acc[ai][bj][m][0] * scale, v1 = acc[ai][bj][m][1] * scale;
                    v2u w; w.x = pk4_fp8(v0[0], v0[1], v0[2], v0[3]); w.y = pk4_fp8(v1[0], v1[1], v1[2], v1[3]);
                    *(v2u*)(rowp + bj * HALF) = w; } }
    }
};
struct EpiUp {
    static constexpr bool PERM = true;
    unsigned char* H;
    __device__ __forceinline__ void operator()(const f32x4 (&acc)[2][2][4][2], const Unit& u, int wr, int wc, int fr, int fq) const {
        const int row0 = u.pm * BM + wr * 64 + fr, col0 = u.pn * HALF + wc * 32 + 8 * fq;
#pragma unroll
        for (int ai = 0; ai < 2; ++ai)
#pragma unroll
            for (int m = 0; m < 4; ++m) { unsigned char* rowp = H + (size_t)(row0 + ai * HALF + m * 16) * 512 + col0;
                float h[8];
#pragma unroll
                for (int n = 0; n < 2; ++n)
#pragma unroll
                    for (int i = 0; i < 4; ++i) { const float a = acc[ai][0][m][n][i] * (1.f / 32.f), b = acc[ai][1][m][n][i] * (1.f / 32.f); h[n * 4 + i] = a * __builtin_amdgcn_rcpf(1.f + __expf(-a)) * b; }
                v2u w; w.x = pk4_fp8(h[0], h[1], h[2], h[3]); w.y = pk4_fp8(h[4], h[5], h[6], h[7]);
                *(v2u*)rowp = w; }
    }
};

template <class Epi, class Sched, bool ALIGN_EPI, bool FP8 = false>
__device__ __forceinline__ void gemm_phase(LAS unsigned char* lds, const int K_, const Sched& S, const Epi& E) {
    int K = K_; asm volatile("" : "+s"(K));
    int tid = threadIdx.x; asm volatile("" : "+v"(tid));
    const int wid = __builtin_amdgcn_readfirstlane(tid >> 6), lane = tid & 63, wr = wid >> 2, wc = wid & 3, fr = lane & 15, fq = lane >> 4;
    const int nt = K / BK;
    unsigned voffB[2];
#pragma unroll
    for (int i = 0; i < 2; ++i) { int R, C; stage_rc(tid * 16 + i * 8192, R, C); const int Rb = Epi::PERM ? ((R & ~31) + perm32(R & 31)) : R; voffB[i] = (unsigned)(Rb * K + C) * 2u; }
#define PG8_AOFF(u, o0, o1, o2, o3) do { int R0_, C0_, R1_, C1_; stage_rc(tid * 16, R0_, C0_); stage_rc(tid * 16 + 8192, R1_, C1_); \
        o0 = S.a_off(u, R0_) + (unsigned)C0_ * 2u; o1 = S.a_off(u, R1_) + (unsigned)C1_ * 2u; o2 = S.a_off(u, HALF + R0_) + (unsigned)C0_ * 2u; o3 = S.a_off(u, HALF + R1_) + (unsigned)C1_ * 2u; } while (0)
    const size_t kstep = (size_t)(BK * 2);
    const size_t hstep = (size_t)HALF * K * 2;
    const unsigned ldsw = (unsigned)wid * 1024u;
    const int aoff = lds_byte(wr * 64 + fr, fq * 8), boff = lds_byte(wc * 32 + fr, fq * 8);
    const char* const A0 = S.A;
#define PG8_SA(b, h) (((b) * 2 + (h)) * HTB)
#define PG8_SB(b, h) ((4 + (b) * 2 + (h)) * HTB)
#define PG8_STAGE(bufoff, gbase, voff) do { _Pragma("unroll") for (int _i = 0; _i < 2; ++_i) \
        __builtin_amdgcn_global_load_lds((const unsigned*)((const char*)(gbase) + (voff)[_i]), (LAS unsigned*)(lds + (bufoff) + ldsw + _i * 8192), 16, 0, 0); } while (0)
#define PG8_STAGEA(bufoff, kbyte, o0, o1) do { \
        __builtin_amdgcn_global_load_lds((const unsigned*)(A0 + (kbyte) + (o0)), (LAS unsigned*)(lds + (bufoff) + ldsw), 16, 0, 0); \
        __builtin_amdgcn_global_load_lds((const unsigned*)(A0 + (kbyte) + (o1)), (LAS unsigned*)(lds + (bufoff) + ldsw + 8192), 16, 0, 0); } while (0)
#define PG8_LD8(p) __builtin_shufflevector(*(const LAS i32x4*)(p), *(const LAS i32x4*)((p) + 1024), 0, 1, 2, 3, 4, 5, 6, 7)
#define PG8_LDA(dst, b, h) do { _Pragma("unroll") for (int m = 0; m < 4; ++m) dst[m] = PG8_LD8(lds + PG8_SA(b, h) + aoff + m * 2048); } while (0)
#define PG8_LDB(dst, b, h) do { _Pragma("unroll") for (int n = 0; n < 2; ++n) dst[n] = PG8_LD8(lds + PG8_SB(b, h) + boff + n * 2048); } while (0)
#define PG8_H(x, k) __builtin_bit_cast(bf16x8, __builtin_shufflevector(x, x, 4 * (k), 4 * (k) + 1, 4 * (k) + 2, 4 * (k) + 3))
#define PG8_MMA(ai, bj, At, Bt) do { __builtin_amdgcn_s_setprio(1); _Pragma("unroll") for (int m = 0; m < 4; ++m) _Pragma("unroll") for (int n = 0; n < 2; ++n) { \
        if constexpr (FP8) acc[ai][bj][m][n] = __builtin_amdgcn_mfma_scale_f32_16x16x128_f8f6f4(Bt[n], At[m], acc[ai][bj][m][n], 0, 0, 0, 0x7f7f7f7f, 0, 0x7f7f7f7f); \
        else { acc[ai][bj][m][n] = __builtin_amdgcn_mfma_f32_16x16x32_bf16(PG8_H(Bt[n], 0), PG8_H(At[m], 0), acc[ai][bj][m][n], 0, 0, 0); \
               acc[ai][bj][m][n] = __builtin_amdgcn_mfma_f32_16x16x32_bf16(PG8_H(Bt[n], 1), PG8_H(At[m], 1), acc[ai][bj][m][n], 0, 0, 0); } } \
        __builtin_amdgcn_s_setprio(0); } while (0)
#define PG8_WAIT_V(n) asm volatile("s_waitcnt vmcnt(" #n ")" ::: "memory")
#define PG8_WAIT_L(n) asm volatile("s_waitcnt lgkmcnt(" #n ")" ::: "memory")
#define PG8_BAR __builtin_amdgcn_s_barrier()
#define PG8_SCHED __builtin_amdgcn_sched_barrier(0)
    Unit cur, nxt; int ui = 0;
    if (!S.next(0, cur)) return;
    f32x4 acc[2][2][4][2];
#pragma unroll
    for (int a = 0; a < 2; ++a)
#pragma unroll
        for (int b = 0; b < 2; ++b)
#pragma unroll
            for (int m = 0; m < 4; ++m)
#pragma unroll
                for (int n = 0; n < 2; ++n) acc[a][b][m][n] = (f32x4){0.f, 0.f, 0.f, 0.f};
    i32x8 At[4], B0[2], B1[2];
    unsigned oc00, oc01, oc10, oc11, on00, on01, on10, on11;
    PG8_AOFF(cur, oc00, oc01, oc10, oc11);
    const char* cB = S.b_ptr(cur);
    PG8_STAGE(PG8_SB(0, 0), cB, voffB); PG8_STAGE(PG8_SB(0, 1), cB + hstep, voffB); PG8_STAGEA(PG8_SA(0, 0), 0, oc00, oc01); PG8_STAGEA(PG8_SA(0, 1), 0, oc10, oc11);
    if (wr == 1) PG8_BAR;
    PG8_WAIT_V(2); PG8_BAR;
    PG8_STAGE(PG8_SB(1, 0), cB + kstep, voffB); PG8_STAGEA(PG8_SA(1, 0), kstep, oc00, oc01); PG8_STAGE(PG8_SB(1, 1), cB + hstep + kstep, voffB);
    PG8_WAIT_V(6); PG8_BAR;
    for (;;) {
        const bool has_next = S.next(ui + 1, nxt);
        const char* nB = cB;
        on00 = oc00; on01 = oc01; on10 = oc10; on11 = oc11;
        if (has_next) { nB = S.b_ptr(nxt); PG8_AOFF(nxt, on00, on01, on10, on11); }
#pragma unroll 1
        for (int t = 0; t < nt; t += 2) {
            const bool last = (t == nt - 2);
            const size_t k1 = (size_t)(t + 1) * kstep, k2 = last ? 0 : (size_t)(t + 2) * kstep, k3 = k2 + kstep;
            const char* b2 = last ? nB : cB + (size_t)(t + 2) * kstep; const char* b3 = b2 + kstep;
            PG8_LDB(B0, 0, 0); PG8_LDB(B1, 0, 1); PG8_SCHED; PG8_LDA(At, 0, 0); PG8_STAGEA(PG8_SA(1, 1), k1, oc10, oc11);
            if (last) { oc00 = on00; oc01 = on01; oc10 = on10; oc11 = on11; }
            PG8_WAIT_V(8); PG8_WAIT_L(0); PG8_BAR; PG8_MMA(0, 0, At, B0); PG8_MMA(0, 1, At, B1); PG8_BAR; PG8_SCHED;
            PG8_LDA(At, 0, 1); PG8_STAGE(PG8_SB(0, 0), b2, voffB); PG8_STAGE(PG8_SB(0, 1), b2 + hstep, voffB); PG8_STAGEA(PG8_SA(0, 0), k2, oc00, oc01);
            PG8_WAIT_V(8); PG8_WAIT_L(0); PG8_BAR; PG8_MMA(1, 0, At, B0); PG8_MMA(1, 1, At, B1); PG8_BAR; PG8_SCHED;
            PG8_LDB(B0, 1, 0); PG8_LDB(B1, 1, 1); PG8_SCHED; PG8_LDA(At, 1, 0); PG8_STAGEA(PG8_SA(0, 1), k2, oc10, oc11);
            PG8_WAIT_V(8); PG8_WAIT_L(0); PG8_BAR; PG8_MMA(0, 0, At, B0); PG8_MMA(0, 1, At, B1); PG8_BAR; PG8_SCHED;
            PG8_LDA(At, 1, 1); PG8_STAGE(PG8_SB(1, 0), b3, voffB); PG8_STAGE(PG8_SB(1, 1), b3 + hstep, voffB); PG8_STAGEA(PG8_SA(1, 0), k3, oc00, oc01);
            PG8_WAIT_V(8); PG8_WAIT_L(0); PG8_BAR; PG8_MMA(1, 0, At, B0); PG8_MMA(1, 1, At, B1); PG8_BAR; PG8_SCHED;
        }
        if constexpr (ALIGN_EPI) { if (wr == 0) PG8_BAR; }
        E(acc, cur, wr, wc, fr, fq);
        if (!has_next) break;
#pragma unroll
        for (int a = 0; a < 2; ++a)
#pragma unroll
            for (int b = 0; b < 2; ++b)
#pragma unroll
                for (int m = 0; m < 4; ++m)
#pragma unroll
                    for (int n = 0; n < 2; ++n) acc[a][b][m][n] = (f32x4){0.f, 0.f, 0.f, 0.f};
        cur = nxt; cB = nB; ++ui;
        if constexpr (ALIGN_EPI) { if (wr == 1) PG8_BAR; }
    }
    PG8_WAIT_V(0);
    if constexpr (!ALIGN_EPI) { if (wr == 0) PG8_BAR; }
    PG8_BAR;
#undef PG8_SA
#undef PG8_SB
#undef PG8_STAGE
#undef PG8_STAGEA
#undef PG8_AOFF
#undef PG8_LDA
#undef PG8_LDB
#undef PG8_MMA
#undef PG8_LD8
#undef PG8_H
#undef PG8_WAIT_V
#undef PG8_WAIT_L
#undef PG8_BAR
#undef PG8_SCHED
}
}

#define PHASE_IDS(F) do { int _t = threadIdx.x; asm volatile("" : "+v"(_t)); (F).tid = _t; (F).lane = _t & 63; (F).wave = __builtin_amdgcn_readfirstlane(_t >> 6); } while (0)
struct TrItem { const float* W; bf16* WT; int ldw, K, mode, f8; };
__device__ __forceinline__ void tr_load(float (&tv)[32], const TrItem& t, int wave, int lane) {
#pragma unroll
    for (int i = 0; i < 32; ++i) tv[i] = __builtin_nontemporal_load(t.W + (size_t)(8 * wave + (i >> 2)) * t.ldw + 64 * (i & 3) + lane);
}
__device__ __forceinline__ void tr_store(const float (&tv)[32], const TrItem& t, LAS float* scr, int wave, int lane) {
#pragma unroll
    for (int i = 0; i < 32; ++i) scr[(8 * wave + (i >> 2)) * 257 + 64 * (i & 3) + lane] = tv[i];
    __syncthreads();
    const int c = lane & 7;
#pragma unroll
    for (int j = 0; j < 4; ++j) { const int n = 32 * wave + 8 * j + (lane >> 3); const LAS float* s = scr + (8 * c) * 257 + n;
        v4u o; o.x = pk2(s[0 * 257], s[1 * 257]); o.y = pk2(s[2 * 257], s[3 * 257]); o.z = pk2(s[4 * 257], s[5 * 257]); o.w = pk2(s[6 * 257], s[7 * 257]);
        const int drow = t.mode ? 256 * (n >> 7) + (n & 127) : n;
        if (t.f8) { v2u o8; o8.x = pg8::pk4_fp8(s[0 * 257] * 32.f, s[1 * 257] * 32.f, s[2 * 257] * 32.f, s[3 * 257] * 32.f); o8.y = pg8::pk4_fp8(s[4 * 257] * 32.f, s[5 * 257] * 32.f, s[6 * 257] * 32.f, s[7 * 257] * 32.f);
            __builtin_nontemporal_store(o8, (v2u*)((unsigned char*)t.WT + (size_t)drow * t.K + 8 * c)); }
        else *(v4u*)(t.WT + (size_t)drow * t.K + 8 * c) = o; }
    __syncthreads();
}

__device__ __forceinline__ void phase_prologue(Frame& F) {
    PHASE_IDS(F);
    LAS float* WL = (LAS float*)F.lds;
    LAS float* scr = (LAS float*)(F.lds + 65536);
    const float* w_in0 = F.in[4];
    for (int s0 = F.tid; s0 < 16 * 1024; s0 += 512 * 16) { float t[16];
#pragma unroll
        for (int i = 0; i < 16; ++i) { const int s = s0 + 512 * i; t[i] = w_in0[(size_t)(s >> 4) * EV_LD + 3072 + (s & 15)]; }
#pragma unroll
        for (int i = 0; i < 16; ++i) { const int s = s0 + 512 * i; WL[(s & 15) * 1024 + (s >> 4)] = t[i]; } }
    const int gw = F.vcu * NWAVES + F.wave, NGW = F.G * NWAVES;
    bf16* WIN0 = (bf16*)(F.ws + WS_WIN0); bf16* WOUT0 = (bf16*)(F.ws + WS_WOUT0); bf16* WIN1 = (bf16*)(F.ws + WS_WIN1); bf16* WOUT1 = (bf16*)(F.ws + WS_WOUT1);
    bf16* W13 = (bf16*)(F.ws + WS_W13); bf16* W2 = (bf16*)(F.ws + WS_W2);
    constexpr int I_A = 16 * 12, I_B = 16 * 2, I_C = 16 * 4, I_D = 16 * 10, I_E = 16 * 4, I_F = 2 * 32 * 2 * 32, I_G = 2 * 32 * 32;
    constexpr int NITEMS = I_A + I_B + I_C + I_D + I_E + I_F + I_G;
    auto decode = [&](int it) {
        TrItem t; int r = it; t.mode = 0; t.f8 = 0;
        if (r < I_A) { const int kb = r / 12, nb = r % 12; t.ldw = EV_LD; t.K = 1024; t.W = w_in0 + (size_t)(64 * kb) * EV_LD + 256 * nb; t.WT = WIN0 + (size_t)(256 * nb) * 1024 + 64 * kb; return t; } r -= I_A;
        if (r < I_B) { const int kb = r / 2, nb = r % 2; t.ldw = EV_LD; t.K = 1024; t.W = w_in0 + (size_t)(64 * kb) * EV_LD + 3088 + 256 * nb; t.WT = WIN0 + (size_t)(3072 + 256 * nb) * 1024 + 64 * kb; return t; } r -= I_B;
        if (r < I_C) { const int kb = r / 4, nb = r % 4; t.ldw = 1024; t.K = 1024; t.W = F.in[10] + (size_t)(64 * kb) * 1024 + 256 * nb; t.WT = WOUT0 + (size_t)(256 * nb) * 1024 + 64 * kb; return t; } r -= I_C;
        if (r < I_D) { const int kb = r / 10, nb = r % 10; t.ldw = OD_N; t.K = 1024; t.W = F.in[11] + (size_t)(64 * kb) * OD_N + 256 * nb; t.WT = WIN1 + (size_t)(256 * nb) * 1024 + 64 * kb; return t; } r -= I_D;
        if (r < I_E) { const int kb = r / 4, nb = r % 4; t.ldw = 1024; t.K = 1024; t.W = F.in[20] + (size_t)(64 * kb) * 1024 + 256 * nb; t.WT = WOUT1 + (size_t)(256 * nb) * 1024 + 64 * kb; return t; } r -= I_E;
        if (r < I_F) { const int le = r / 64, q = r % 64, which = q / 32, kb = (q % 32) / 2, nb = q % 2;
            t.ldw = 512; t.K = 1024; t.mode = 1; t.f8 = 1; t.W = (which ? F.in[26] : F.in[25]) + (size_t)le * 1024 * 512 + (size_t)(64 * kb) * 512 + 256 * nb;
            t.WT = (bf16*)((unsigned char*)(W13 + (size_t)(le >> 5) * 32 * 1024 * 1024) + (size_t)(le & 31) * 1024 * 1024 + (size_t)(512 * nb + which * 128) * 1024 + 64 * kb); return t; } r -= I_F;
        { const int le = r / 32, q = r % 32, kb = q / 4, nb = q % 4;
            t.ldw = 1024; t.K = 512; t.f8 = 1; t.W = F.in[27] + (size_t)le * 512 * 1024 + (size_t)(64 * kb) * 1024 + 256 * nb;
            t.WT = (bf16*)((unsigned char*)(W2 + (size_t)(le >> 5) * 32 * 1024 * 512) + (size_t)(le & 31) * 1024 * 512 + (size_t)(256 * nb) * 512 + 64 * kb); return t; }
    };
    __syncthreads();
    {
        float ta[32], tb[32]; TrItem da, db; int it = F.vcu;
        if (it < NITEMS) { da = decode(it); tr_load(ta, da, F.wave, F.lane); }
        while (it < NITEMS) {
            const int i1 = it + F.G, i2 = it + 2 * F.G;
            if (i1 < NITEMS) { db = decode(i1); tr_load(tb, db, F.wave, F.lane); }
            tr_store(ta, da, scr, F.wave, F.lane);
            if (i1 >= NITEMS) break;
            if (i2 < NITEMS) { da = decode(i2); tr_load(ta, da, F.wave, F.lane); }
            tr_store(tb, db, scr, F.wave, F.lane);
            it = i2;
        }
    }
    __syncthreads();
    const float* x = F.in[0]; const float* g = F.in[1];
    bf16* XN = (bf16*)(F.ws + WS_ACT); float* BL = (float*)(F.ws + WS_BLOW);
    f32x4 gv[4];
#pragma unroll
    for (int j = 0; j < 4; ++j) gv[j] = *((const f32x4*)g + 64 * j + F.lane);
    for (int m = gw; m < NT; m += NGW) {
        asm volatile("" ::: "memory");
        const f32x4* xr = (const f32x4*)(x + (size_t)m * D) + F.lane;
        f32x4 v[4]; float s = 0.f;
#pragma unroll
        for (int j = 0; j < 4; ++j) { v[j] = xr[64 * j]; s += (v[j].x * v[j].x + v[j].y * v[j].y) + (v[j].z * v[j].z + v[j].w * v[j].w); }
        const float rstd = rsqrtf(wave_sum(s) * (1.f / D) + EPS);
        v2u* o8 = (v2u*)(XN + (size_t)m * D) + F.lane;
#pragma unroll
        for (int j = 0; j < 4; ++j) { v[j] = v[j] * rstd * gv[j]; v2u w; w.x = pk2(v[j].x, v[j].y); w.y = pk2(v[j].z, v[j].w); o8[64 * j] = w; }
        float p[16];
#pragma unroll
        for (int o = 0; o < 16; ++o) {
            const LAS f32x4* wl = (const LAS f32x4*)(WL + o * 1024) + F.lane; float a = 0.f;
#pragma unroll
            for (int j = 0; j < 4; ++j) { const f32x4 w = wl[64 * j]; a += (v[j].x * w.x + v[j].y * w.y) + (v[j].z * w.z + v[j].w * w.w); }
            p[o] = a;
        }
#pragma unroll
        for (int o = 0; o < 8; ++o) { const bool hi = (F.lane & 32) != 0; const float snd = hi ? p[o] : p[o + 8], kp = hi ? p[o + 8] : p[o]; p[o] = kp + __shfl_xor(snd, 32); }
#pragma unroll
        for (int o = 0; o < 4; ++o) { const bool hi = (F.lane & 16) != 0; const float snd = hi ? p[o] : p[o + 4], kp = hi ? p[o + 4] : p[o]; p[o] = kp + __shfl_xor(snd, 16); }
#pragma unroll
        for (int o = 0; o < 2; ++o) { const bool hi = (F.lane & 8) != 0; const float snd = hi ? p[o] : p[o + 2], kp = hi ? p[o + 2] : p[o]; p[o] = kp + __shfl_xor(snd, 8); }
        { const bool hi = (F.lane & 4) != 0; const float snd = hi ? p[0] : p[1], kp = hi ? p[1] : p[0]; p[0] = kp + __shfl_xor(snd, 4); }
        p[0] += __shfl_xor(p[0], 2); p[0] += __shfl_xor(p[0], 1);
        if ((F.lane & 3) == 0) BL[(size_t)m * 16 + ((F.lane >> 5) & 1) * 8 + ((F.lane >> 4) & 1) * 4 + ((F.lane >> 3) & 1) * 2 + ((F.lane >> 2) & 1)] = p[0];
    }
}

__device__ __forceinline__ float row16_max(float v) { v = fmaxf(v, __shfl_xor(v, 1)); v = fmaxf(v, __shfl_xor(v, 2)); v = fmaxf(v, __shfl_xor(v, 4)); return fmaxf(v, __shfl_xor(v, 8)); }
__device__ __forceinline__ float row16_sum(float v) { v += __shfl_xor(v, 1); v += __shfl_xor(v, 2); v += __shfl_xor(v, 4); return v + __shfl_xor(v, 8); }
__device__ __forceinline__ int row16_min(int v) { v = min(v, __shfl_xor(v, 1)); v = min(v, __shfl_xor(v, 2)); v = min(v, __shfl_xor(v, 4)); return min(v, __shfl_xor(v, 8)); }
__device__ __forceinline__ void phase_router(Frame& F, int layer, const bf16* XR) {
    PHASE_IDS(F);
    constexpr int PW = 2064;
    LAS unsigned char* WH = F.lds; LAS unsigned char* WLO = F.lds + 36 * PW;
    LAS float* GL = (LAS float*)(F.lds + LDS_MISC + 1024);
    LAS int* hist = (LAS int*)(F.lds + LDS_MISC + 1024 + 4096); LAS int* base = hist + 32;
    LAS int* s_e0 = base + 32; LAS int* s_e1 = s_e0 + 128; LAS int* s_r0 = s_e1 + 128; LAS int* s_r1 = s_r0 + 128;
    LAS float* s_w0 = (LAS float*)(s_r1 + 128); LAS float* s_w1 = s_w0 + 128;
    const float* wg = F.in[21] + (size_t)layer * 1024 * 4; const float* we = F.in[23] + (size_t)layer * 1024 * 32;
    const float* g = F.in[2] + layer * 1024;
    for (int s = F.tid; s < 1024; s += 512) GL[s] = g[s];
    __syncthreads();
    for (int s0 = F.tid; s0 < 4096 + 32768; s0 += 512 * 18) {
        float t[18];
#pragma unroll
        for (int i = 0; i < 18; ++i) { const int s = s0 + 512 * i; t[i] = s < 4096 ? wg[s] : we[s - 4096]; }
#pragma unroll
        for (int i = 0; i < 18; ++i) { const int s = s0 + 512 * i; const int k = s < 4096 ? (s >> 2) : ((s - 4096) >> 5), o = s < 4096 ? (s & 3) : 4 + ((s - 4096) & 31);
            const float w = t[i] * GL[k]; const unsigned hb = f2bf(w);
            *(LAS bf16*)(WH + o * PW + k * 2) = (bf16)hb; *(LAS bf16*)(WLO + o * PW + k * 2) = (bf16)f2bf(w - bf2f((bf16)hb)); } }
    const int c = F.lane & 15, q = F.lane >> 4;
    float bias[3];
#pragma unroll
    for (int jt = 0; jt < 3; ++jt) { const int col = 16 * jt + c; bias[jt] = col < 4 ? F.in[22][layer * 4 + col] : (col < 36 ? F.in[24][layer * 32 + col - 4] : 0.f); }
    unsigned* cnt = F.ctl + CW_CNT + 64 * layer;
    bf16* XN = (bf16*)(F.ws + WS_ACT); const float* SSQ = (const float*)(F.ws + WS_SSQ);
    int* ME0 = (int*)(F.ws + WS_META); int* ME1 = ME0 + NT; int* MR0 = ME1 + NT; int* MR1 = MR0 + NT; float* MW0 = (float*)(MR1 + NT); float* MW1 = MW0 + NT;
    int* LIST = (int*)(F.ws + WS_LIST);
    int wrow[3];
#pragma unroll
    for (int jt = 0; jt < 3; ++jt) wrow[jt] = min(16 * jt + c, 35) * PW + 16 * q;
    __syncthreads();
    for (int row0 = 128 * F.vcu; row0 < NT; row0 += 128 * F.G) {
        if (F.tid < 32) hist[F.tid] = 0;
        __syncthreads();
        const int rl = F.wave * 16, row = row0 + rl + c;
        float rstd; { const f32x4 sp = *(const f32x4*)(SSQ + (size_t)row * 16 + 4 * q); float s = (sp[0] + sp[1]) + (sp[2] + sp[3]); s += __shfl_xor(s, 16); s += __shfl_xor(s, 32); rstd = rsqrtf(s * (1.f / D) + EPS); }
        const bf16* xr = XR + (size_t)row * D + 8 * q; unsigned char* xo = (unsigned char*)XN + (size_t)row * D + 8 * q;
        f32x4 acc[3];
#pragma unroll
        for (int jt = 0; jt < 3; ++jt) acc[jt] = (f32x4){0.f, 0.f, 0.f, 0.f};
        for (int k4 = 0; k4 < 32; k4 += 8) {
            v4u xw[8];
#pragma unroll
            for (int u = 0; u < 8; ++u) xw[u] = *(const v4u*)(xr + 32 * (k4 + u));
#pragma unroll
            for (int u = 0; u < 8; ++u) {
                const int kk = k4 + u;
                const f32x4 ga = *(const LAS f32x4*)(GL + 32 * kk + 8 * q), gb = *(const LAS f32x4*)(GL + 32 * kk + 8 * q + 4);
                const v4u w = xw[u];
#define BLO(x) __builtin_bit_cast(float, (x) << 16)
#define BHI(x) __builtin_bit_cast(float, (x) & 0xffff0000u)
                v2u xn; xn.x = pg8::pk4_fp8(BLO(w.x) * rstd * ga[0], BHI(w.x) * rstd * ga[1], BLO(w.y) * rstd * ga[2], BHI(w.y) * rstd * ga[3]);
                xn.y = pg8::pk4_fp8(BLO(w.z) * rstd * gb[0], BHI(w.z) * rstd * gb[1], BLO(w.w) * rstd * gb[2], BHI(w.w) * rstd * gb[3]);
#undef BLO
#undef BHI
                *(v2u*)(xo + 32 * kk) = xn;
                const bf16x8 ah = __builtin_bit_cast(bf16x8, w);
#pragma unroll
                for (int jt = 0; jt < 3; ++jt) { const bf16x8 bh = *(const LAS bf16x8*)(WH + wrow[jt] + 64 * kk), bl = *(const LAS bf16x8*)(WLO + wrow[jt] + 64 * kk);
                    acc[jt] = __builtin_amdgcn_mfma_f32_16x16x32_bf16(ah, bh, acc[jt], 0, 0, 0); acc[jt] = __builtin_amdgcn_mfma_f32_16x16x32_bf16(ah, bl, acc[jt], 0, 0, 0); }
            }
        }
#pragma unroll
        for (int i = 0; i < 4; ++i) {
            const float rs = __shfl(rstd, 4 * q + i);
            const float l0 = acc[0][i] * rs + bias[0], l1 = acc[1][i] * rs + bias[1], l2 = acc[2][i] * rs + bias[2];
            const float gvl = c < 4 ? l0 : -3.0e38f;
            const float gmax = row16_max(gvl); const int gi = row16_min(gvl == gmax ? c : 99);
            const float gwt = 1.f / row16_sum(c < 4 ? __expf(gvl - gmax) : 0.f);
            const int jt = c < 4 ? (gi == 1 ? 1 : 2) : (c < 12 ? (gi == 0 ? 0 : 1) : (gi == 1 ? 0 : 1));
            const bool valid = c < 4 ? (gi == 1 || gi == 3) : (c < 12 ? (gi == 0 || gi == 2) : (gi == 1 || gi == 3));
            const int eidx = 16 * jt + c - 4 - 8 * gi;
            float cv = jt == 0 ? l0 : (jt == 1 ? l1 : l2); cv = (valid && eidx >= 0 && eidx < 8) ? cv : -3.0e38f;
            const float v0 = row16_max(cv); const int i0 = row16_min(cv == v0 ? eidx : 99);
            const float cv2 = eidx == i0 ? -3.0e38f : cv;
            const float v1 = row16_max(cv2); const int i1 = row16_min(cv2 == v1 ? eidx : 99);
            const float ex = __expf(v1 - v0), tw0 = 1.f / (1.f + ex), tw1 = ex / (1.f + ex);
            if (c == 0) { const int r = rl + 4 * q + i, e0 = gi * 8 + i0, e1 = gi * 8 + i1;
                s_e0[r] = e0; s_e1[r] = e1; s_w0[r] = gwt * tw0; s_w1[r] = gwt * tw1;
                s_r0[r] = atomicAdd((int*)&hist[e0], 1); s_r1[r] = atomicAdd((int*)&hist[e1], 1); }
        }
        __syncthreads();
        if (F.tid < 32) base[F.tid] = (int)atomicAdd(cnt + F.tid, (unsigned)hist[F.tid]);
        __syncthreads();
        if (F.tid < 128) {
            const int m = row0 + F.tid, e0 = s_e0[F.tid], e1 = s_e1[F.tid], r0 = base[e0] + s_r0[F.tid], r1 = base[e1] + s_r1[F.tid];
            ME0[m] = e0; ME1[m] = e1; MR0[m] = r0; MR1[m] = r1; MW0[m] = s_w0[F.tid]; MW1[m] = s_w1[F.tid];
            LIST[(size_t)e0 * NT + r0] = m; LIST[(size_t)e1 * NT + r1] = m;
        }
        __syncthreads();
    }
}

__device__ __forceinline__ void phase_combine(Frame& F, int layer, const bf16* XRin, bf16* XRout) {
    PHASE_IDS(F);
    LAS int* poff = (LAS int*)(F.lds + LDS_MISC + 1024);
    const unsigned* cnt = F.ctl + CW_CNT + 64 * layer;
    if (F.tid < 32) poff[33 + F.tid] = (int)cnt[F.tid];
    __syncthreads();
    if (F.tid == 0) { int acc = 0; for (int e = 0; e < 32; ++e) { poff[e] = acc; acc += (poff[33 + e] + 255) & ~255; } poff[32] = acc; }
    __syncthreads();
    const int gw = F.vcu * NWAVES + F.wave, NGW = F.G * NWAVES;
    const float* g = layer == 0 ? F.in[1] + 1024 : F.in[3];
    const bf16* Y = (const bf16*)(F.ws + WS_Y); bf16* XN = (bf16*)(F.ws + WS_ACT);
    const int* ME0 = (const int*)(F.ws + WS_META); const int* ME1 = ME0 + NT; const int* MR0 = ME1 + NT; const int* MR1 = MR0 + NT; const float* MW0 = (const float*)(MR1 + NT); const float* MW1 = MW0 + NT;
    f32x4 gv[4];
#pragma unroll
    for (int j = 0; j < 4; ++j) gv[j] = *((const f32x4*)g + 64 * j + F.lane);
    for (int m0 = gw; m0 < NT; m0 += 2 * NGW) {
        int mr[2]; mr[0] = m0; mr[1] = (m0 + NGW < NT) ? m0 + NGW : m0;
        f32x4 v[2][4]; unsigned ya[2][4], yb[2][4]; float w0[2], w1[2];
#pragma unroll
        for (int r = 0; r < 2; ++r) {
            const int m = mr[r]; const int s0 = poff[ME0[m]] + MR0[m], s1 = poff[ME1[m]] + MR1[m]; w0[r] = MW0[m] * (1.f / 16.f); w1[r] = MW1[m] * (1.f / 16.f);
            const v2u* xr = (const v2u*)(XRin + (size_t)m * D) + F.lane;
            const unsigned* y0 = (const unsigned*)((const unsigned char*)Y + (size_t)s0 * D) + F.lane; const unsigned* y1 = (const unsigned*)((const unsigned char*)Y + (size_t)s1 * D) + F.lane;
#pragma unroll
            for (int j = 0; j < 4; ++j) { const v2u xw = xr[64 * j]; v[r][j] = (f32x4){bf2f((bf16)(xw.x & 0xffff)), bf2f((bf16)(xw.x >> 16)), bf2f((bf16)(xw.y & 0xffff)), bf2f((bf16)(xw.y >> 16))}; ya[r][j] = y0[64 * j]; yb[r][j] = y1[64 * j]; }
        }
#pragma unroll
        for (int r = 0; r < 2; ++r) {
            const int m = mr[r]; float s = 0.f;
            f32x4* xr = (f32x4*)(F.out + (size_t)m * D) + F.lane; v2u* xo2 = (v2u*)(XRout + (size_t)m * D) + F.lane;
#pragma unroll
            for (int j = 0; j < 4; ++j) { const f32x2 a0 = __builtin_amdgcn_cvt_pk_f32_fp8((int)ya[r][j], false), a1 = __builtin_amdgcn_cvt_pk_f32_fp8((int)ya[r][j], true), b0 = __builtin_amdgcn_cvt_pk_f32_fp8((int)yb[r][j], false), b1 = __builtin_amdgcn_cvt_pk_f32_fp8((int)yb[r][j], true);
                v[r][j].x += w0[r] * a0.x + w1[r] * b0.x; v[r][j].y += w0[r] * a0.y + w1[r] * b0.y;
                v[r][j].z += w0[r] * a1.x + w1[r] * b1.x; v[r][j].w += w0[r] * a1.y + w1[r] * b1.y;
                s += (v[r][j].x * v[r][j].x + v[r][j].y * v[r][j].y) + (v[r][j].z * v[r][j].z + v[r][j].w * v[r][j].w); }
            const float rstd = rsqrtf(wave_sum(s) * (1.f / D) + EPS);
            if (r == 1 && mr[1] == mr[0]) continue;
            if (layer == 0) {
                v2u* o8 = (v2u*)(XN + (size_t)m * D) + F.lane;
#pragma unroll
                for (int j = 0; j < 4; ++j) { v2u xw; xw.x = pk2(v[r][j].x, v[r][j].y); xw.y = pk2(v[r][j].z, v[r][j].w); xo2[64 * j] = xw; const f32x4 n = v[r][j] * rstd * gv[j]; v2u w; w.x = pk2(n.x, n.y); w.y = pk2(n.z, n.w); o8[64 * j] = w; }
            } else {
#pragma unroll
                for (int j = 0; j < 4; ++j) xr[64 * j] = v[r][j] * rstd * gv[j];
            }
        }
    }
}


namespace mx {
typedef short s4 __attribute__((ext_vector_type(4)));
constexpr int PV = 272, PP = 144;
template <int DK> struct Lay { static constexpr int PK = DK * 2 + 16, QS = 0, KS = 64 * PK, VV = 2 * 64 * PK, ST = VV + 64 * PV, PM = ST + 128 * PK, VEC = PM + 64 * PP, PART = VEC + 3 * DK * 4, RED = PART + 8 * DK * 4, BLS = RED + 4096, END = BLS + 4096; };
static_assert(Lay<128>::END <= LDS_MISC, "mixer LDS map");
__device__ __forceinline__ bf16x8 row_frag(const LAS unsigned char* base, int pitch, int row0, int kk, int lane) {
    return *(const LAS bf16x8*)(base + (row0 + (lane & 15)) * pitch + (32 * kk + 8 * (lane >> 4)) * 2);
}
__device__ __forceinline__ bf16x8 tr_frag(const LAS unsigned char* base, int pitch, int k0, int c0, int lane) {
    const int g = lane >> 4, q = (lane & 15) >> 2, p = lane & 3;
    const LAS unsigned char* a = base + (k0 + 8 * g + q) * pitch + (c0 + 4 * p) * 2;
    const s4 lo = __builtin_amdgcn_ds_read_tr16_b64_v4i16((LAS s4*)a);
    const s4 hi = __builtin_amdgcn_ds_read_tr16_b64_v4i16((LAS s4*)(a + 4 * pitch));
    return __builtin_shufflevector(lo, hi, 0, 1, 2, 3, 4, 5, 6, 7);
}
#define MFMA16(a, b, c) __builtin_amdgcn_mfma_f32_16x16x32_bf16(a, b, c, 0, 0, 0)

struct UnitP { const bf16* PROJ; bf16* YM; const float* nw; const float* BL; const float* p0; const float* p1; const float* p2; int b, h, c0, nch, seg; };

template <int KIND> struct KC {
    static constexpr int DK = KIND == 0 ? 128 : 64, LDP = KIND == 2 ? OD_N : EV_N;
    __device__ static __forceinline__ int qcol(int h) { return KIND == 0 ? h * 128 : (KIND == 1 ? 2048 + h * 64 : h * 64); }
    __device__ static __forceinline__ int kcol(int h) { return KIND == 0 ? 512 + h * 128 : (KIND == 1 ? 2304 + h * 64 : 256 + h * 64); }
    __device__ static __forceinline__ int vcol(int h) { return KIND == 0 ? 1024 + h * 128 : (KIND == 1 ? 2560 + h * 128 : 512 + h * 128); }
    __device__ static __forceinline__ int gcol(int h) { return KIND == 0 ? 1536 + h * 128 : (KIND == 1 ? 3072 + h * 128 : 1024 + h * 128); }
    __device__ static __forceinline__ int ocol(int h) { return KIND == 1 ? 512 + h * 128 : h * 128; }
};

template <int KIND, bool FULL>
__device__ __forceinline__ void mix_unit(LAS unsigned char* lds, float* Sg, float* Bg, const UnitP& U) {
    using K = KC<KIND>; constexpr int DK = K::DK, LDP = K::LDP, NJT = DK == 128 ? 8 : 4; using L = Lay<DK>; constexpr int PK = L::PK;
    int tid = threadIdx.x; asm volatile("" : "+v"(tid));
    const int lane = tid & 63, wave = __builtin_amdgcn_readfirstlane(tid >> 6), g = lane >> 4, c = lane & 15;
    const int h = U.h, dt = DK == 128 ? wave : (wave & 3), jt0 = DK == 128 ? 0 : 4 * (wave >> 2);
    LAS float* EM = (LAS float*)(lds + L::VEC); LAS float* EL = EM + DK; LAS float* BT = EL + DK; LAS float* PART = (LAS float*)(lds + L::PART);
    float lb0 = 0.f, lb1 = 0.f, wu[16], bu = 0.f, ci = 0.f, lgg = 0.f;
    if (KIND == 0) {
        const float* lbl = U.p0; const int col = h * 128 + 2 * lane;
#pragma unroll
        for (int x = 0; x < 2; ++x) { const float l0 = lbl[col + x], l1 = lbl[512 + col + x], l2 = lbl[1024 + col + x]; const float mx_ = fmaxf(l0, fmaxf(l1, l2));
            const float e0 = __expf(l0 - mx_), e1 = __expf(l1 - mx_), e2 = __expf(l2 - mx_); const float v = e0 / (e0 + e1 + e2); if (x == 0) lb0 = v; else lb1 = v; }
    }
    if (KIND == 1) {
#pragma unroll
        for (int r = 0; r < 16; ++r) wu[r] = U.p0[r * 256 + h * 64 + lane];
        bu = U.p1[h * 64 + lane];
    }
    if (KIND == 2) { ci = exp2f(-(float)(lane & 31) * (13.287712379549449f / 32.f)) * 0.15915494309189535f; lgg = log1pf(-exp2f(-5.f - (float)h)); }
    f32x4 S[NJT];
#pragma unroll
    for (int jt = 0; jt < NJT; ++jt) {
        S[jt] = (f32x4){0.f, 0.f, 0.f, 0.f};
    }
    if (FULL) {
        f32x4 L[NJT], D4 = (f32x4){0.f, 0.f, 0.f, 0.f};
        auto ldseg = [&](int s) { const float* Sp = Sg + (ptrdiff_t)s * 16384; D4 = *(const f32x4*)(Bg + s * 128 + 16 * dt + 4 * g);
#pragma unroll
            for (int jt = 0; jt < NJT; ++jt)
#pragma unroll
                for (int i = 0; i < 4; ++i) L[jt][i] = Sp[(16 * dt + 4 * g + i) * 128 + 16 * (jt0 + jt) + c]; };
        if (U.seg > 0) ldseg(-U.seg);
        for (int s = -U.seg; s < 0; ++s) {
            f32x4 Lc[NJT]; const f32x4 Dc = D4;
#pragma unroll
            for (int jt = 0; jt < NJT; ++jt) Lc[jt] = L[jt];
            if (s + 1 < 0) ldseg(s + 1);
#pragma unroll
            for (int jt = 0; jt < NJT; ++jt) S[jt] = Dc * S[jt] + Lc[jt];
        }
    }
    f32x4 nw4[4];
    if (FULL) {
#pragma unroll
        for (int x = 0; x < 4; ++x) nw4[x] = *(const f32x4*)(U.nw + h * 128 + 16 * (4 * (wave >> 2) + x) + 4 * g);
    }
    if (tid < DK) BT[tid] = KIND == 0 ? 1.f : 0.f;
    v4u rv0, rv1; unsigned ra[8], rb[8]; f32x4 rbl = (f32x4){0.f, 0.f, 0.f, 0.f};
    auto load_raw = [&](int ch) {
        const size_t row0 = (size_t)U.b * SEQ + (U.c0 + ch) * 64;
        const bf16* Vp = U.PROJ + (row0 + (tid >> 3)) * LDP + K::vcol(h) + (tid & 7) * 16;
        rv0 = *(const v4u*)Vp; rv1 = *(const v4u*)(Vp + 8);
        if (KIND == 1 && tid < 256) rbl = *(const f32x4*)(U.BL + (row0 + (tid >> 2)) * 16 + (tid & 3) * 4);
        if (KIND == 0) {
            const bf16* P = U.PROJ + (row0 + 8 * wave) * LDP + 2 * lane;
#pragma unroll
            for (int tt = 0; tt < 8; ++tt) { ra[tt] = *(const unsigned*)(P + (size_t)tt * LDP + K::kcol(h)); if (FULL) rb[tt] = *(const unsigned*)(P + (size_t)tt * LDP + K::qcol(h)); }
        } else {
            const bf16* P = U.PROJ + (row0 + 8 * wave) * LDP + lane;
#pragma unroll
            for (int tt = 0; tt < 8; ++tt) { ra[tt] = P[(size_t)tt * LDP + K::kcol(h)]; if (FULL) rb[tt] = P[(size_t)tt * LDP + K::qcol(h)]; }
        }
    };
    load_raw(0);
    for (int ch = 0; ch < U.nch; ++ch) {
        const int pos0 = (U.c0 + ch) * 64; const size_t row0 = (size_t)U.b * SEQ + pos0;
        *(LAS v4u*)(lds + L::VV + (tid >> 3) * PV + (tid & 7) * 32) = rv0; *(LAS v4u*)(lds + L::VV + (tid >> 3) * PV + (tid & 7) * 32 + 16) = rv1;
        if (KIND == 0) {
            float cp0[8], cp1[8], k0[8], k1[8]; float c0 = 1.f, c1 = 1.f;
#pragma unroll
            for (int tt = 0; tt < 8; ++tt) {
                const float f0 = lb0 + (1.f - lb0) * sigmoidf_(bf2f((bf16)(ra[tt] & 0xffff))), f1 = lb1 + (1.f - lb1) * sigmoidf_(bf2f((bf16)(ra[tt] >> 16)));
                c0 *= f0; c1 *= f1; cp0[tt] = c0; cp1[tt] = c1; k0[tt] = 1.f - f0; k1[tt] = 1.f - f1;
            }
            *(LAS f32x2*)(PART + wave * 128 + 2 * lane) = (f32x2){c0, c1};
            __syncthreads();
            float pre0 = 1.f, pre1 = 1.f, mid0 = 1.f, mid1 = 1.f, hi0 = 1.f, hi1 = 1.f;
#pragma unroll
            for (int w2 = 0; w2 < 8; ++w2) { const f32x2 p = *(const LAS f32x2*)(PART + w2 * 128 + 2 * lane);
                if (w2 < 4) { mid0 *= p.x; mid1 *= p.y; } else { hi0 *= p.x; hi1 *= p.y; }
                if (wave < 4 ? (w2 > wave && w2 < 4) : (w2 >= 4 && w2 < wave)) { pre0 *= p.x; pre1 *= p.y; } }
#pragma unroll
            for (int tt = 0; tt < 8; ++tt) {
                float qs0, qs1, ks0, ks1;
                if (wave >= 4) { qs0 = pre0 * cp0[tt]; qs1 = pre1 * cp1[tt]; ks0 = __builtin_amdgcn_rcpf(fmaxf(qs0, 1e-26f)); ks1 = __builtin_amdgcn_rcpf(fmaxf(qs1, 1e-26f)); }
                else { ks0 = pre0 * c0 * __builtin_amdgcn_rcpf(fmaxf(cp0[tt], 1e-26f)); ks1 = pre1 * c1 * __builtin_amdgcn_rcpf(fmaxf(cp1[tt], 1e-26f));
                       qs0 = __builtin_amdgcn_rcpf(fmaxf(ks0, 1e-26f)); qs1 = __builtin_amdgcn_rcpf(fmaxf(ks1, 1e-26f)); }
                *(LAS unsigned*)(lds + L::KS + (8 * wave + tt) * PK + 4 * lane) = pg8::cvt_pk_bf16(k0[tt] * ks0, k1[tt] * ks1);
                if (FULL) *(LAS unsigned*)(lds + L::QS + (8 * wave + tt) * PK + 4 * lane) = pg8::cvt_pk_bf16(bf2f((bf16)(rb[tt] & 0xffff)) * qs0, bf2f((bf16)(rb[tt] >> 16)) * qs1);
            }
            if (wave == 0) { *(LAS f32x2*)(EM + 2 * lane) = (f32x2){mid0, mid1}; *(LAS f32x2*)(EL + 2 * lane) = (f32x2){hi0, hi1};
                const f32x2 o = *(const LAS f32x2*)(BT + 2 * lane); *(LAS f32x2*)(BT + 2 * lane) = (f32x2){o.x * mid0 * hi0, o.y * mid1 * hi1}; }
        } else if (KIND == 1) {
            LAS float* BLS = (LAS float*)(lds + L::BLS);
            if (tid < 256) *(LAS f32x4*)(BLS + (tid >> 2) * 16 + (tid & 3) * 4) = rbl;
            __syncthreads();
            float cs[8]; float cc = 0.f;
#pragma unroll
            for (int tt = 0; tt < 8; ++tt) {
                const LAS f32x4* bl = (const LAS f32x4*)(BLS + (8 * wave + tt) * 16); float z = bu;
#pragma unroll
                for (int r = 0; r < 4; ++r) { const f32x4 bq = bl[r]; z += (bq[0] * wu[4 * r] + bq[1] * wu[4 * r + 1]) + (bq[2] * wu[4 * r + 2] + bq[3] * wu[4 * r + 3]); }
                const float ls = fminf(z, 0.f) - __logf(1.f + __expf(-fabsf(z)));
                cc += ls * (1.f / 16.f); cs[tt] = cc;
            }
            PART[wave * 64 + lane] = cc;
            __syncthreads();
            float off = 0.f, mid = 0.f, tot = 0.f;
#pragma unroll
            for (int w2 = 0; w2 < 8; ++w2) { const float p = PART[w2 * 64 + lane]; if (w2 < wave) off += p; if (w2 < 4) mid += p; tot += p; }
#pragma unroll
            for (int tt = 0; tt < 8; ++tt) {
                const float b = off + cs[tt];
                *(LAS bf16*)(lds + L::KS + (8 * wave + tt) * PK + 2 * lane) = (bf16)f2bf(bf2f((bf16)ra[tt]) * __expf(fminf(mid - b, 60.f)));
                if (FULL) *(LAS bf16*)(lds + L::QS + (8 * wave + tt) * PK + 2 * lane) = (bf16)f2bf(bf2f((bf16)rb[tt]) * 0.125f * __expf(fminf(b - mid, 60.f)));
            }
            if (wave == 0) { EM[lane] = __expf(mid); EL[lane] = __expf(tot - mid); BT[lane] += tot; }
        } else {
#pragma unroll
            for (int tt = 0; tt < 8; ++tt) {
                const int tl = 8 * wave + tt; float rev = (float)(pos0 + tl) * ci; rev -= floorf(rev);
                const float sn = __builtin_amdgcn_sinf(rev), cs = __builtin_amdgcn_cosf(rev);
                const float e = (float)(tl - 31) * lgg;
                const float kv = bf2f((bf16)ra[tt]), kp = __shfl_xor(kv, 32);
                const float kr = (lane < 32 ? kv * cs - kp * sn : kp * sn + kv * cs) * 0.125f;
                *(LAS bf16*)(lds + L::KS + tl * PK + 2 * lane) = (bf16)f2bf(kr * __expf(-e));
                if (FULL) { const float qv = bf2f((bf16)rb[tt]), qp = __shfl_xor(qv, 32); const float qr = lane < 32 ? qv * cs - qp * sn : qp * sn + qv * cs;
                    *(LAS bf16*)(lds + L::QS + tl * PK + 2 * lane) = (bf16)f2bf(qr * __expf(e)); }
            }
            if (wave == 0) { const float e32 = __expf(32.f * lgg); EM[lane] = e32; EL[lane] = e32; BT[lane] += 64.f * lgg; }
        }
        if (ch + 1 < U.nch) load_raw(ch + 1);
        v2u gq[4];
        if (FULL) { const bf16* gp = U.PROJ + (row0 + 16 * (wave & 3) + c) * LDP + K::gcol(h) + 16 * (4 * (wave >> 2)) + 4 * g;
#pragma unroll
            for (int x = 0; x < 4; ++x) gq[x] = *(const v2u*)(gp + 16 * x); }
        __syncthreads();
        { const f32x4 em4 = *(const LAS f32x4*)(EM + 16 * dt + 4 * g);
#pragma unroll
          for (int jt = 0; jt < NJT; ++jt) { S[jt] = S[jt] * em4;
              if (FULL) { v2u w; w.x = pg8::cvt_pk_bf16(S[jt][0], S[jt][1]); w.y = pg8::cvt_pk_bf16(S[jt][2], S[jt][3]);
                  *(LAS v2u*)(lds + L::ST + (16 * (jt0 + jt) + c) * PK + (16 * dt + 4 * g) * 2) = w; } } }
        if (FULL) {
            const int st = wave & 3, tt0 = 2 * (wave >> 2);
            f32x4 p0 = (f32x4){0.f, 0.f, 0.f, 0.f}, p1 = p0;
#pragma unroll
            for (int kk = 0; kk < DK / 32; ++kk) { const bf16x8 a = row_frag(lds + L::KS, PK, 16 * st, kk, lane);
                p0 = MFMA16(a, row_frag(lds + L::QS, PK, 16 * tt0, kk, lane), p0); p1 = MFMA16(a, row_frag(lds + L::QS, PK, 16 * (tt0 + 1), kk, lane), p1); }
#pragma unroll
            for (int x = 0; x < 2; ++x) { const f32x4 p = x ? p1 : p0; const int t = 16 * (tt0 + x) + c, s = 16 * st + 4 * g;
                v2u w; w.x = pg8::cvt_pk_bf16(s <= t ? p[0] : 0.f, s + 1 <= t ? p[1] : 0.f); w.y = pg8::cvt_pk_bf16(s + 2 <= t ? p[2] : 0.f, s + 3 <= t ? p[3] : 0.f);
                *(LAS v2u*)(lds + L::PM + t * PP + s * 2) = w; }
        }
        {
#pragma unroll
          for (int kk = 0; kk < 2; ++kk) { const bf16x8 a = tr_frag(lds + L::KS, PK, 32 * kk, 16 * dt, lane);
#pragma unroll
              for (int jt = 0; jt < NJT; ++jt) S[jt] = MFMA16(a, tr_frag(lds + L::VV, PV, 32 * kk, 16 * (jt0 + jt), lane), S[jt]); }
          const f32x4 el4 = *(const LAS f32x4*)(EL + 16 * dt + 4 * g);
#pragma unroll
          for (int jt = 0; jt < NJT; ++jt) S[jt] = S[jt] * el4;
        }
        __syncthreads();
        if (FULL) {
            const int tt = wave & 3, jh = wave >> 2, t = 16 * tt + c;
            f32x4 o[4];
#pragma unroll
            for (int x = 0; x < 4; ++x) o[x] = (f32x4){0.f, 0.f, 0.f, 0.f};
#pragma unroll
            for (int kk = 0; kk < 2; ++kk) { const bf16x8 bb = row_frag(lds + L::PM, PP, 16 * tt, kk, lane);
#pragma unroll
                for (int x = 0; x < 4; ++x) o[x] = MFMA16(tr_frag(lds + L::VV, PV, 32 * kk, 16 * (4 * jh + x), lane), bb, o[x]); }
#pragma unroll
            for (int kk = 0; kk < DK / 32; ++kk) { const bf16x8 bb = row_frag(lds + L::QS, PK, 16 * tt, kk, lane);
#pragma unroll
                for (int x = 0; x < 4; ++x) o[x] = MFMA16(row_frag(lds + L::ST, PK, 16 * (4 * jh + x), kk, lane), bb, o[x]); }
            float sm = 0.f, sq = 0.f;
#pragma unroll
            for (int x = 0; x < 4; ++x)
#pragma unroll
                for (int i = 0; i < 4; ++i) { sm += o[x][i]; sq += o[x][i] * o[x][i]; }
            sm += __shfl_xor(sm, 16); sq += __shfl_xor(sq, 16); sm += __shfl_xor(sm, 32); sq += __shfl_xor(sq, 32);
            LAS f32x2* RED = (LAS f32x2*)(lds + L::RED) + (ch & 1) * 128;
            if (g == 0) RED[jh * 64 + t] = (f32x2){sm, sq};
            __syncthreads();
            const f32x2 r0 = RED[t], r1 = RED[64 + t];
            const float mean = KIND == 2 ? (r0.x + r1.x) * (1.f / 128.f) : 0.f;
            const float rstd = rsqrtf(fmaxf((r0.y + r1.y) * (1.f / 128.f) - mean * mean, 0.f) + EPS);
            bf16* yp = U.YM + (row0 + t) * 1024 + K::ocol(h) + 16 * (4 * jh) + 4 * g;
#pragma unroll
            for (int x = 0; x < 4; ++x) {
                const float g0 = bf2f((bf16)(gq[x].x & 0xffff)), g1 = bf2f((bf16)(gq[x].x >> 16)), g2 = bf2f((bf16)(gq[x].y & 0xffff)), g3 = bf2f((bf16)(gq[x].y >> 16));
                v2u w; w.x = pg8::cvt_pk_bf16((o[x][0] - mean) * rstd * nw4[x][0] * siluf_(g0), (o[x][1] - mean) * rstd * nw4[x][1] * siluf_(g1));
                w.y = pg8::cvt_pk_bf16((o[x][2] - mean) * rstd * nw4[x][2] * siluf_(g2), (o[x][3] - mean) * rstd * nw4[x][3] * siluf_(g3));
                *(v2u*)(yp + 16 * x) = w; }
        }
    }
    if (!FULL) {
#pragma unroll
        for (int jt = 0; jt < NJT; ++jt)
#pragma unroll
            for (int i = 0; i < 4; ++i) Sg[(16 * dt + 4 * g + i) * 128 + 16 * (jt0 + jt) + c] = S[jt][i];
        __syncthreads();
        if (tid < DK) Bg[tid] = KIND == 0 ? BT[tid] : __expf(BT[tid]);
    }
    __syncthreads();
}
}


namespace rg {
constexpr int SEGMAX = 16;
constexpr int PX = 272, PW = 144, XCB = 0, XCF = 64 * PX, WT = XCF + 64 * 132 * 4, END = WT + 4 * 64 * PW;
static_assert(END <= LDS_MISC, "rglru LDS map");
template <bool FULL>
__device__ __forceinline__ void unit(LAS unsigned char* lds, const bf16* PROJ, bf16* YM, const float* const* in, int b, int c0, int nch, int sgi, int cg, float* RA, float* RH) {
    int tid = threadIdx.x; asm volatile("" : "+v"(tid));
    const int lane = tid & 63, wave = __builtin_amdgcn_readfirstlane(tid >> 6), g = lane >> 4, c = lane & 15;
    const int n0 = 2 * cg, chbase = cg * 128;
    const float* w_r = in[15]; const float* w_i = in[17];
    for (int i0 = tid; i0 < 4 * 4096; i0 += 512 * 16) { float t[16];
#pragma unroll
        for (int x = 0; x < 16; ++x) { const int i = i0 + 512 * x, m = i >> 12, gate = m >> 1, nb = m & 1, d = (i >> 6) & 63, e = i & 63; t[x] = (gate ? w_i : w_r)[((n0 + nb) * 64 + d) * 64 + e]; }
#pragma unroll
        for (int x = 0; x < 16; ++x) { const int i = i0 + 512 * x, m = i >> 12, d = (i >> 6) & 63, e = i & 63; *(LAS bf16*)(lds + WT + m * 64 * PW + e * PW + d * 2) = (bf16)f2bf(t[x]); } }
    float cw0[4], cw1[4]; const int cc = chbase + 2 * lane;
#pragma unroll
    for (int j = 0; j < 4; ++j) { cw0[j] = in[13][j * 512 + cc]; cw1[j] = in[13][j * 512 + cc + 1]; }
    const float cb0 = in[14][cc], cb1 = in[14][cc + 1];
    const int nb = wave >> 2, e0 = 16 * (wave & 3), chl = nb * 64 + e0 + c, chn = chbase + chl;
    const float brr = in[16][chn], bii = in[18][chn], sp = __logf(1.f + __expf(-in[19][chn]));
    float hcar = 0.f, atot = 1.f;
    if (FULL) {
        float fa[SEGMAX], fh[SEGMAX];
#pragma unroll
        for (int s = 0; s < SEGMAX; ++s) { const bool ok = s < sgi; fa[s] = ok ? RA[(s - sgi) * 512 + chn] : 1.f; fh[s] = ok ? RH[(s - sgi) * 512 + chn] : 0.f; }
#pragma unroll
        for (int s = 0; s < SEGMAX; ++s) hcar = s < sgi ? fa[s] * hcar + fh[s] : hcar;
    }
    unsigned xw[11];
    auto load_x = [&](int ch) {
#pragma unroll
        for (int r = 0; r < 11; ++r) { const int pos = (c0 + ch) * 64 + 8 * wave - 3 + r; xw[r] = 0u;
            if (pos >= 0) xw[r] = *(const unsigned*)(PROJ + ((size_t)b * SEQ + pos) * OD_N + 1536 + cc); }
    };
    load_x(0);
    __syncthreads();
    for (int ch = 0; ch < nch; ++ch) {
        const int pos0 = (c0 + ch) * 64; const size_t row0 = (size_t)b * SEQ + pos0;
        {
            float x0[11], x1[11];
#pragma unroll
            for (int r = 0; r < 11; ++r) { x0[r] = bf2f((bf16)(xw[r] & 0xffff)); x1[r] = bf2f((bf16)(xw[r] >> 16)); }
#pragma unroll
            for (int tt = 0; tt < 8; ++tt) {
                const float a0 = cb0 + cw0[0] * x0[tt] + cw0[1] * x0[tt + 1] + cw0[2] * x0[tt + 2] + cw0[3] * x0[tt + 3];
                const float a1 = cb1 + cw1[0] * x1[tt] + cw1[1] * x1[tt + 1] + cw1[2] * x1[tt + 2] + cw1[3] * x1[tt + 3];
                *(LAS unsigned*)(lds + XCB + (8 * wave + tt) * PX + 4 * lane) = pg8::cvt_pk_bf16(a0, a1);
                *(LAS f32x2*)(lds + XCF + ((8 * wave + tt) * 132 + 2 * lane) * 4) = (f32x2){a0, a1};
            }
        }
        if (ch + 1 < nch) load_x(ch + 1);
        bf16 gt[16];
        if (FULL) {
#pragma unroll
            for (int tt = 0; tt < 4; ++tt)
#pragma unroll
                for (int i = 0; i < 4; ++i) gt[4 * tt + i] = PROJ[(row0 + 16 * tt + 4 * g + i) * OD_N + 2048 + chn];
        }
        __syncthreads();
        f32x4 R[4], I[4];
#pragma unroll
        for (int tt = 0; tt < 4; ++tt) { R[tt] = (f32x4){0.f, 0.f, 0.f, 0.f}; I[tt] = R[tt]; }
#pragma unroll
        for (int kk = 0; kk < 2; ++kk) {
            const bf16x8 fr = mx::row_frag(lds + WT + nb * 64 * PW, PW, e0, kk, lane), fi = mx::row_frag(lds + WT + (2 + nb) * 64 * PW, PW, e0, kk, lane);
#pragma unroll
            for (int tt = 0; tt < 4; ++tt) { const bf16x8 a = mx::row_frag(lds + XCB + nb * 128, PX, 16 * tt, kk, lane); R[tt] = MFMA16(a, fr, R[tt]); I[tt] = MFMA16(a, fi, I[tt]); }
        }
#pragma unroll
        for (int tt = 0; tt < 4; ++tt) {
            float av[4], uv[4];
#pragma unroll
            for (int i = 0; i < 4; ++i) { const int t = 16 * tt + 4 * g + i;
                const float r = sigmoidf_(R[tt][i] + brr), ig = sigmoidf_(I[tt][i] + bii), la = -8.f * r * sp, a = __expf(la);
                av[i] = a; uv[i] = __builtin_amdgcn_sqrtf(fmaxf(1.f - a * a, 0.f)) * ig * *(const LAS float*)(lds + XCF + (t * 132 + chl) * 4); }
            float As = av[0] * av[1] * av[2] * av[3], Hs = ((uv[0] * av[1] + uv[1]) * av[2] + uv[2]) * av[3] + uv[3];
            float Ai = As, Hi = Hs;
            { const float Ap = __shfl(Ai, (lane - 16) & 63), Hp = __shfl(Hi, (lane - 16) & 63); if (g >= 1) { Hi = Hp * Ai + Hi; Ai = Ap * Ai; } }
            { const float Ap = __shfl(Ai, (lane - 32) & 63), Hp = __shfl(Hi, (lane - 32) & 63); if (g >= 2) { Hi = Hp * Ai + Hi; Ai = Ap * Ai; } }
            const float Ae = __shfl(Ai, (lane - 16) & 63), He = __shfl(Hi, (lane - 16) & 63), At = __shfl(Ai, 48 + c), Ht = __shfl(Hi, 48 + c);
            float h = g == 0 ? hcar : Ae * hcar + He;
            if (FULL) {
#pragma unroll
                for (int i = 0; i < 4; ++i) { const size_t row = row0 + 16 * tt + 4 * g + i; h = av[i] * h + uv[i];
                    YM[row * 1024 + 512 + chn] = (bf16)f2bf(h * gelu_tanh_(bf2f(gt[4 * tt + i]))); }
            }
            hcar = At * hcar + Ht; atot *= At;
        }
        __syncthreads();
    }
    if (!FULL && g == 0) { RA[chn] = atot; RH[chn] = hcar; }
}
}

constexpr int SEG_RET = 16, SEG_LRU = 16;
static_assert(SEG_LRU <= rg::SEGMAX, "RG-LRU segment count");
template <int SUB> __device__ __forceinline__ void phase_mix(Frame& F, int layer) {
    float* SG = (float*)(F.ws + WS_ST); float* BG = (float*)(F.ws + WS_ST + 16 * MiB);
    const bf16* PROJ = (const bf16*)(F.ws + WS_PROJ); bf16* YM = (bf16*)(F.ws + WS_ACT);
    float* RA = (float*)(F.ws + WS_ST + 16 * MiB + 256 * 1024); float* RH = RA + 2 * 32 * 512;
    const int S = layer == 0 ? 16 : SEG_RET;
    if (SUB == 1) {
        int tid = threadIdx.x; asm volatile("" : "+v"(tid));
        const int nel = (layer == 0 ? 16 : 8) * 16384;
        for (int idx = F.vcu * 512 + tid; idx < nel; idx += F.G * 512) {
            const int cidx = idx >> 14, e = idx & 16383, DK = (layer == 0 && cidx < 8) ? 128 : 64;
            if (e >= DK * 128) continue;
            const int d = e >> 7; float carry = 0.f;
            for (int seg = 0; seg < S; ++seg) { float* p = SG + (size_t)(cidx * S + seg) * 16384 + e; const float tmp = *p; *p = carry; carry = BG[(cidx * S + seg) * 128 + d] * carry + tmp; }
        }
        if (layer == 1) for (int idx = F.vcu * 512 + tid; idx < 1024; idx += F.G * 512) { const int bb = idx >> 9, cch = idx & 511; float carry = 0.f;
            for (int seg = 0; seg < SEG_LRU; ++seg) { const int o = (bb * SEG_LRU + seg) * 512 + cch; const float ta = RA[o], th = RH[o]; RH[o] = carry; carry = ta * carry + th; } }
        return;
    }
    for (int u = F.vcu; u < 256; u += F.G) {
        if (layer == 1 && u >= 8 * SEG_RET) {
            const int x = u - 8 * SEG_RET, bb = x / (4 * SEG_LRU), sg = (x >> 2) % SEG_LRU, cg = x & 3, c0 = (256 * sg) / SEG_LRU, nch = (256 * (sg + 1)) / SEG_LRU - c0;
            rg::unit<SUB == 2>(F.lds, PROJ, YM, F.in, bb, c0, nch, sg, cg, RA + (bb * SEG_LRU + sg) * 512, RH + (bb * SEG_LRU + sg) * 512);
            continue;
        }
        const int cidx = u / S, seg = u % S, chain = cidx & 7;
        mx::UnitP U; U.PROJ = PROJ; U.YM = YM; U.BL = (const float*)(F.ws + WS_BLOW); U.b = chain >> 2; U.h = chain & 3; U.p2 = nullptr;
        U.c0 = (256 * seg) / S; U.nch = (256 * (seg + 1)) / S - U.c0; U.seg = seg;
        float* Sg = SG + (size_t)(cidx * S + seg) * 16384; float* Bg = BG + (cidx * S + seg) * 128;
        if (layer == 0) {
            if (cidx < 8) { U.nw = F.in[6]; U.p0 = F.in[5]; U.p1 = nullptr; mx::mix_unit<0, SUB == 2>(F.lds, Sg, Bg, U); }
            else { U.nw = F.in[9]; U.p0 = F.in[7]; U.p1 = F.in[8]; mx::mix_unit<1, SUB == 2>(F.lds, Sg, Bg, U); }
        } else { U.nw = F.in[12]; U.p0 = nullptr; U.p1 = nullptr; mx::mix_unit<2, SUB == 2>(F.lds, Sg, Bg, U); }
    }
}

__device__ __forceinline__ void moe_poff(Frame& F, int layer) {
    PHASE_IDS(F);
    LAS int* poff = (LAS int*)(F.lds + LDS_MISC + 1024);
    const unsigned* cnt = F.ctl + CW_CNT + 64 * layer;
    __syncthreads();
    if (F.tid < 32) poff[33 + F.tid] = (int)cnt[F.tid];
    __syncthreads();
    if (F.tid == 0) { int acc = 0; for (int e = 0; e < 32; ++e) { poff[e] = acc; acc += (poff[33 + e] + 255) & ~255; } poff[32] = acc; }
    __syncthreads();
}
struct Args { const float* in[28]; float* out; unsigned char* ws; int ph_lo, ph_hi, li, pad; };
__global__ void __launch_bounds__(NWAVES * 64, 2) mega(Args args) {
    extern __shared__ __attribute__((aligned(16))) unsigned char lds[];
    Frame F;
    F.lds = (LAS unsigned char*)lds; F.tid = threadIdx.x; F.lane = F.tid & 63; F.wave = __builtin_amdgcn_readfirstlane(F.tid >> 6);
    F.G = gridDim.x; { const int bx = blockIdx.x; F.vcu = (F.G % 8 == 0) ? (bx % 8) * (F.G / 8) + bx / 8 : bx; }
    F.in = args.in; F.out = args.out; F.ws = args.ws; F.ctl = (unsigned*)(args.ws + WS_CTL);
    const int lo = args.ph_lo, hi = args.ph_hi;
    for (int u = F.tid; u < (LDS_BYTES - LDS_MISC) / 4; u += NWAVES * 64) ((LAS unsigned*)(F.lds + LDS_MISC))[u] = 0u;
    __syncthreads();
    XcdBarrier bar; bar.bar = F.ctl + CW_BAR + args.li * XCD_BAR_WORDS; bar.x = 0; bar.st = nullptr;
    if (hi - lo > 1) bar = xcd_barrier_post(F.ctl + CW_BAR + args.li * XCD_BAR_WORDS, (volatile LAS unsigned*)(F.lds + LDS_MISC + 32));
#ifndef ONLY_MASK
#define ONLY_MASK 0x7ffff
#endif
#define IN(k) (((ONLY_MASK >> (k)) & 1) && lo <= (k) && (k) < hi)
#define SEAM(k) do { if (IN(k) && IN((k) + 1)) xcd_barrier(bar); } while (0)
    bf16* ACT = (bf16*)(F.ws + WS_ACT); bf16* PROJ = (bf16*)(F.ws + WS_PROJ); bf16* H = (bf16*)(F.ws + WS_H); bf16* Y = (bf16*)(F.ws + WS_Y);
    const LAS int* poff = (const LAS int*)(F.lds + LDS_MISC + 1024);
    bf16* XR1 = (bf16*)F.out; bf16* XR2 = XR1 + (size_t)NT * D; bf16* XR3 = (bf16*)(F.ws + WS_W13);
    if (IN(0)) phase_prologue(F);
    SEAM(0);
#pragma unroll
    for (int l = 0; l < 2; ++l) {
        const int pb = 9 * l;
        if (IN(pb + 1)) {
            const int N = l == 0 ? EV_N : OD_N;
            pg8::DenseOrder S; S.init(ACT, F.ws + (l == 0 ? WS_WIN0 : WS_WIN1), NT, N, 1024, F.G, (int)blockIdx.x);
            pg8::EpiBf E{PROJ, N, 1.f};
            pg8::gemm_phase<pg8::EpiBf, pg8::DenseOrder, true>(F.lds, 1024, S, E);
        }
        SEAM(pb + 1);
        {
            if (IN(pb + 2)) phase_mix<0>(F, l);
            SEAM(pb + 2);
            if (IN(pb + 4)) phase_mix<2>(F, l);
            SEAM(pb + 4);
        }
        if (IN(pb + 5)) {
            pg8::DenseOrder S; S.init(ACT, F.ws + (l == 0 ? WS_WOUT0 : WS_WOUT1), NT, 1024, 1024, F.G, (int)blockIdx.x);
            if (l == 0) { pg8::EpiRes<false> E{F.in[0], XR1, (float*)(F.ws + WS_SSQ)}; pg8::gemm_phase<pg8::EpiRes<false>, pg8::DenseOrder, true>(F.lds, 1024, S, E); }
            else { pg8::EpiRes<true> E{XR2, XR3, (float*)(F.ws + WS_SSQ)}; pg8::gemm_phase<pg8::EpiRes<true>, pg8::DenseOrder, true>(F.lds, 1024, S, E); }
        }
        SEAM(pb + 5);
        if (IN(pb + 6)) phase_router(F, l, l == 0 ? XR1 : XR3);
        SEAM(pb + 6);
        if (IN(pb + 7)) {
            moe_poff(F, l);
            pg8::MoeOrder S{poff, F.ctl + CW_CNT + 64 * l, (const int*)(F.ws + WS_LIST), (const char*)ACT, (const char*)(F.ws + WS_W13) + (size_t)l * 32 * 1024 * 1024 * 2, (size_t)1024 * 1024, 512, F.G, F.vcu, true};
            pg8::EpiUp E{(unsigned char*)H};
            pg8::gemm_phase<pg8::EpiUp, pg8::MoeOrder, true, true>(F.lds, 512, S, E);
        }
        SEAM(pb + 7);
        if (IN(pb + 8)) {
            moe_poff(F, l);
            pg8::MoeOrder S{poff, F.ctl + CW_CNT + 64 * l, (const int*)(F.ws + WS_LIST), (const char*)H, (const char*)(F.ws + WS_W2) + (size_t)l * 32 * 1024 * 512 * 2, (size_t)1024 * 512, 256, F.G, F.vcu, false};
            pg8::EpiF8 E{(unsigned char*)Y, 1024, 0.5f};
            pg8::gemm_phase<pg8::EpiF8, pg8::MoeOrder, true, true>(F.lds, 256, S, E);
        }
        SEAM(pb + 8);
        if (IN(pb + 9)) phase_combine(F, l, l == 0 ? XR1 : XR3, XR2);
        SEAM(pb + 9);
    }
#undef IN
#undef SEAM
}

extern "C" void kernel_launch(void* const* d_in, const int* in_sizes, int n_in, void* d_out, int out_size, void* d_ws, size_t ws_size, hipStream_t stream) {
    static int grid = 0;
    if (grid == 0) {
        if (n_in != 28 || out_size != NT * D || ws_size < WS_END) { fprintf(stderr, "kernel_launch: unexpected problem (n_in %d, out %d, ws %zu)\n", n_in, out_size, ws_size); grid = -1; return; }
        int dev = 0, cus = 0;
        if (hipGetDevice(&dev) != hipSuccess || hipDeviceGetAttribute(&cus, hipDeviceAttributeMultiprocessorCount, dev) != hipSuccess) { grid = -1; return; }
        if (hipFuncSetAttribute((const void*)mega, hipFuncAttributeMaxDynamicSharedMemorySize, LDS_BYTES) != hipSuccess) { fprintf(stderr, "kernel_launch: hipFuncSetAttribute failed\n"); grid = -1; return; }
        (void)hipGetLastError();
        grid = cus;
    }
    if (grid < 0) return;
    (void)hipMemsetAsync((char*)d_ws + WS_CTL, 0, CTL_BYTES, stream);
    Args a{};
    for (int i = 0; i < 28; ++i) a.in[i] = (const float*)d_in[i];
    a.out = (float*)d_out; a.ws = (unsigned char*)d_ws;
    int nli = 0;
    auto run = [&](int lo, int hi) { a.ph_lo = lo; a.ph_hi = hi; a.li = (hi - lo > 1) ? nli++ : 0; hipLaunchKernelGGL(mega, dim3(grid), dim3(NWAVES * 64), LDS_BYTES, stream, a); };
    run(0, 19);
}
```

```cpp
#include <hip/hip_runtime.h>
#include <cstdio>
#include <cstdint>

#define GAS __attribute__((address_space(1)))
#define LAS __attribute__((address_space(3)))
typedef unsigned short bf16;
typedef unsigned v4u __attribute__((ext_vector_type(4)));
typedef unsigned v2u __attribute__((ext_vector_type(2)));
typedef float f32x4 __attribute__((ext_vector_type(4)));
typedef float f32x2 __attribute__((ext_vector_type(2)));
typedef short bf16x8 __attribute__((ext_vector_type(8)));

constexpr int NT = 32768, D = 1024, SEQ = 16384;
constexpr int EV_N = 3584, OD_N = 2560, EV_LD = 3600;
constexpr float EPS = 1e-6f;
constexpr int NEXP = 32, SLOT_ROWS = 2 * NT + NEXP * 256;

constexpr size_t MiB = 1u << 20;
constexpr size_t WS_CTL = 0, CTL_BYTES = 1 * MiB;
constexpr size_t WS_WIN0 = 2 * MiB, WS_WOUT0 = 9 * MiB, WS_WIN1 = 11 * MiB, WS_WOUT1 = 16 * MiB, WS_W13 = 18 * MiB, WS_W2 = 146 * MiB;
constexpr size_t WS_ACT = 210 * MiB, WS_PROJ = 274 * MiB, WS_H = WS_PROJ, WS_Y = WS_PROJ + 72 * MiB;
constexpr size_t WS_BLOW = 498 * MiB, WS_META = 500 * MiB, WS_LIST = 501 * MiB, WS_ST = 505 * MiB, WS_SSQ = 522 * MiB, WS_END = 524 * MiB;
constexpr int CW_TMO = 0, CW_BAR = 4096, CW_CNT = 16384;

constexpr int NWAVES = 8;
constexpr int LDS_BYTES = 163840;
constexpr int LDS_MISC = 149504;

__device__ __forceinline__ float bf2f(bf16 b) { return __builtin_bit_cast(float, (unsigned)b << 16); }
__device__ __forceinline__ unsigned pk2(float lo, float hi) { unsigned r; asm("v_cvt_pk_bf16_f32 %0, %1, %2" : "=v"(r) : "v"(lo), "v"(hi)); return r; }
__device__ __forceinline__ unsigned f2bf(float f) { return pk2(f, f) & 0xffffu; }
__device__ __forceinline__ float sigmoidf_(float x) { return __builtin_amdgcn_rcpf(1.f + __expf(-x)); }
__device__ __forceinline__ float siluf_(float x) { return x * sigmoidf_(x); }
__device__ __forceinline__ float gelu_tanh_(float x) { const float u = 0.7978845608f * (x + 0.044715f * x * x * x); return x * sigmoidf_(2.f * u); }
__device__ __forceinline__ float wave_sum(float v) {
#pragma unroll
    for (int o = 1; o < 64; o <<= 1) v += __shfl_xor(v, o);
    return v;
}
#define LDS_WAIT() asm volatile("s_waitcnt lgkmcnt(0)" ::: "memory")

struct Frame {
    LAS unsigned char* lds;
    int tid, lane, wave, vcu, G;
    const float* const* in;
    float* out; unsigned char* ws;
    unsigned* ctl;
};


#define XB_TMO      128
#define XB_XCNT(j)  (256  + 64 * (j))
#define XB_XSUB(j)  (1280 + 64 * (j))
#define XB_XGEN(j)  (2304 + 64 * (j))
#define XB_TOP      3328
#define XB_TOPGEN   3392
#define XCD_BAR_WORDS 3456
#define XB_SPIN_CAP (1u << 18)
__device__ __forceinline__ unsigned xb_ld(unsigned* p)              { return __hip_atomic_load(p, __ATOMIC_RELAXED, __HIP_MEMORY_SCOPE_AGENT); }
__device__ __forceinline__ unsigned xb_add(unsigned* p, unsigned v) { return __hip_atomic_fetch_add(p, v, __ATOMIC_RELAXED, __HIP_MEMORY_SCOPE_AGENT); }
__device__ __forceinline__ unsigned xb_xcc_id() { return (unsigned)__builtin_amdgcn_s_getreg((3 << 11) | 20) & 0xFu; }
#define XB_SPIN(cond, bar) do { unsigned _sp = 0; while (cond) { __builtin_amdgcn_s_sleep(1); \
    if ((++_sp & 255u) == 0u) { if (xb_ld(&(bar)[XB_TMO])) break; if (_sp > XB_SPIN_CAP) { atomicAdd(&(bar)[XB_TMO], 1u); break; } } } } while (0)
struct XcdBarrier { unsigned* bar; unsigned x; volatile LAS unsigned* st; };
__device__ __forceinline__ XcdBarrier xcd_barrier_post(unsigned* bar, volatile LAS unsigned* st) {
    XcdBarrier b; b.bar = bar; b.x = xb_xcc_id(); b.st = st;
    if (threadIdx.x == 0) (void)xb_add(&bar[XB_XCNT(b.x)], 1u);
    return b;
}
__device__ __forceinline__ void xcd_barrier_complete(unsigned* bar, unsigned x, unsigned& nloc, unsigned& nx) {
    const unsigned G = gridDim.x * gridDim.y * gridDim.z;
    unsigned sum, cnt, mine, sp = 0u;
    for (;;) {
        sum = 0u; cnt = 0u; mine = 0u;
#pragma unroll
        for (unsigned j = 0; j < 16; ++j) { const unsigned c = xb_ld(&bar[XB_XCNT(j)]); sum += c; cnt += (c > 0u) ? 1u : 0u; mine = (j == x) ? c : mine; }
        if (sum == G) break;
        __builtin_amdgcn_s_sleep(1);
        if ((++sp & 255u) == 0u) { if (xb_ld(&bar[XB_TMO])) break; if (sp > XB_SPIN_CAP) { atomicAdd(&bar[XB_TMO], 1u); break; } }
    }
    nloc = mine > 0u ? mine : 1u; nx = cnt > 0u ? cnt : 1u;
}
__device__ __forceinline__ void xcd_barrier(const XcdBarrier& b) {
    asm volatile("s_waitcnt vmcnt(0)" ::: "memory");
    __syncthreads();
    if (threadIdx.x == 0) {
        unsigned* bar = b.bar;
        __builtin_amdgcn_s_waitcnt(0);
        unsigned nloc = b.st[0], nx = b.st[1];
        if (nloc == 0u) { xcd_barrier_complete(bar, b.x, nloc, nx); b.st[0] = nloc; b.st[1] = nx; }
        const unsigned old = xb_add(&bar[XB_XSUB(b.x)], 1u);
        const unsigned gen = old / nloc;
        if (old + 1u == (gen + 1u) * nloc) {
            __builtin_amdgcn_fence(__ATOMIC_RELEASE, "agent");
            asm volatile("s_waitcnt vmcnt(0)" ::: "memory");
            const unsigned og = xb_add(&bar[XB_TOP], 1u);
            const unsigned tg = og / nx;
            if (og + 1u == (tg + 1u) * nx) xb_add(&bar[XB_TOPGEN], 1u);
            else XB_SPIN(xb_ld(&bar[XB_TOPGEN]) == tg, bar);
            __builtin_amdgcn_fence(__ATOMIC_ACQUIRE, "agent");
            xb_add(&bar[XB_XGEN(b.x)], 1u);
            asm volatile("s_waitcnt vmcnt(0)" ::: "memory");
        } else {
            XB_SPIN(xb_ld(&bar[XB_XGEN(b.x)]) == gen, bar);
            __builtin_amdgcn_fence(__ATOMIC_ACQUIRE, "agent");
            asm volatile("s_waitcnt vmcnt(0)" ::: "memory");
        }
    }
    __syncthreads();
}

namespace pg8 {
typedef unsigned u32x4 __attribute__((ext_vector_type(4)));
typedef int i32x4 __attribute__((ext_vector_type(4)));
typedef int i32x8 __attribute__((ext_vector_type(8)));
constexpr int BM = 256, BK = 64, HALF = 128, HTB = HALF * BK * 2, STAGE_BYTES = 8 * HTB, NXCD = 8, WGM = 8;
__host__ __device__ __forceinline__ int lds_byte(int r, int c) { const int st = (r >> 4) * 2 + (c >> 5), rr = r & 15, cc = c & 31, ob = rr * 64 + cc * 2; return st * 1024 + (ob ^ (((ob >> 9) & 1) << 5)); }
__host__ __device__ __forceinline__ void stage_rc(int b, int& R, int& C) { const int st = b / 1024, sb = b % 1024, swz = sb ^ (((sb >> 9) & 1) << 5); R = (st >> 1) * 16 + swz / 64; C = (st & 1) * 32 + (swz % 64) / 2; }
__host__ __device__ __forceinline__ int perm32(int rho) { const int n = rho >> 4, i = rho & 15; return 8 * (i >> 2) + 4 * n + (i & 3); }
struct Unit { int pm, pn, e; };
__device__ __forceinline__ unsigned cvt_pk_bf16(float lo, float hi) { return pk2(lo, hi); }

struct DenseOrder {
    int nM, nN, nwg, G, c, K; const char* A; const char* Bt;
    __device__ __forceinline__ void init(const void* A_, const void* Bt_, int M, int N, int K_, int G_, int c_) { A = (const char*)A_; Bt = (const char*)Bt_; nM = M / BM; nN = N / BM; nwg = nM * nN; G = G_; c = c_; K = K_; }
    __device__ __forceinline__ bool next(int i, Unit& u) const {
        const long L = (long)i * G + c; if (L >= nwg) return false;
        int wgid = (int)L; { const int q = nwg / NXCD, r = nwg % NXCD, xcd = wgid % NXCD, off = wgid / NXCD; wgid = (xcd < r ? xcd * (q + 1) : r * (q + 1) + (xcd - r) * q) + off; }
        const int nig = WGM * nN, gid = wgid / nig, fm = gid * WGM, gsz = (nM - fm) < WGM ? (nM - fm) : WGM;
        u.pm = fm + ((wgid % nig) % gsz); u.pn = (wgid % nig) / gsz; u.e = 0; return true;
    }
    __device__ __forceinline__ unsigned a_off(const Unit& u, int r) const { return (unsigned)((u.pm * BM + r) * K) * 2u; }
    __device__ __forceinline__ const char* b_ptr(const Unit& u) const { return Bt + (size_t)u.pn * BM * K * 2; }
};
struct MoeOrder {
    const LAS int* poff; const unsigned* cnt; const int* list; const char* A; const char* Bt; size_t estride; int K, G, c; bool gather;
    __device__ __forceinline__ bool next(int i, Unit& u) const {
        const int L = i * G + c, np = __builtin_amdgcn_readfirstlane(poff[32]) >> 8; if (L >= np * 4) return false;
        u.pm = L >> 2; u.pn = L & 3; const int row = u.pm << 8; int e = 0;
        while (row >= __builtin_amdgcn_readfirstlane(poff[e + 1])) ++e;
        u.e = e; return true;
    }
    __device__ __forceinline__ unsigned a_off(const Unit& u, int r) const {
        if (!gather) return (unsigned)((u.pm * BM + r) * K) * 2u;
        const int idx = min(u.pm * BM + r - poff[u.e], poff[33 + u.e] - 1);
        return (unsigned)list[(size_t)u.e * NT + idx] * (unsigned)(K * 2);
    }
    __device__ __forceinline__ const char* b_ptr(const Unit& u) const { return Bt + (size_t)u.e * estride + (size_t)u.pn * BM * K * 2; }
};

struct EpiBf {
    static constexpr bool PERM = true;
    bf16* O; int ldc; float scale;
    __device__ __forceinline__ void operator()(const f32x4 (&acc)[2][2][4][2], const Unit& u, int wr, int wc, int fr, int fq) const {
        const int row0 = u.pm * BM + wr * 64 + fr, col0 = u.pn * BM + wc * 32 + 8 * fq;
#pragma unroll
        for (int ai = 0; ai < 2; ++ai)
#pragma unroll
            for (int m = 0; m < 4; ++m) { bf16* rowp = O + (size_t)(row0 + ai * HALF + m * 16) * ldc + col0;
#pragma unroll
                for (int bj = 0; bj < 2; ++bj) { const f32x4 v0 = acc[ai][bj][m][0] * scale, v1 = acc[ai][bj][m][1] * scale;
                    u32x4 w; w.x = cvt_pk_bf16(v0[0], v0[1]); w.y = cvt_pk_bf16(v0[2], v0[3]); w.z = cvt_pk_bf16(v1[0], v1[1]); w.w = cvt_pk_bf16(v1[2], v1[3]);
                    *(u32x4*)(rowp + bj * HALF) = w; } }
    }
};
template <bool RES_BF16>
struct EpiRes {
    static constexpr bool PERM = true;
    const void* res; bf16* xout; float* ssq;
    __device__ __forceinline__ void operator()(const f32x4 (&acc)[2][2][4][2], const Unit& u, int wr, int wc, int fr, int fq) const {
        const int row0 = u.pm * BM + wr * 64 + fr, col0 = u.pn * BM + wc * 32 + 8 * fq;
#pragma unroll
        for (int ai = 0; ai < 2; ++ai) {
            f32x4 r0[4][2], r1[4][2];
#pragma unroll
            for (int m = 0; m < 4; ++m) { const size_t off = (size_t)(row0 + ai * HALF + m * 16) * 1024 + col0;
#pragma unroll
                for (int bj = 0; bj < 2; ++bj) {
                    if (RES_BF16) { const u32x4 rw = *(const u32x4*)((const bf16*)res + off + bj * HALF);
                        r0[m][bj] = (f32x4){__builtin_bit_cast(float, rw.x << 16), __builtin_bit_cast(float, rw.x & 0xffff0000u), __builtin_bit_cast(float, rw.y << 16), __builtin_bit_cast(float, rw.y & 0xffff0000u)};
                        r1[m][bj] = (f32x4){__builtin_bit_cast(float, rw.z << 16), __builtin_bit_cast(float, rw.z & 0xffff0000u), __builtin_bit_cast(float, rw.w << 16), __builtin_bit_cast(float, rw.w & 0xffff0000u)}; }
                    else { r0[m][bj] = *(const f32x4*)((const float*)res + off + bj * HALF); r1[m][bj] = *(const f32x4*)((const float*)res + off + bj * HALF + 4); } } }
#pragma unroll
            for (int m = 0; m < 4; ++m) { const int row = row0 + ai * HALF + m * 16; const size_t off = (size_t)row * 1024 + col0; float ss = 0.f;
#pragma unroll
                for (int bj = 0; bj < 2; ++bj) {
                    const f32x4 v0 = r0[m][bj] + acc[ai][bj][m][0], v1 = r1[m][bj] + acc[ai][bj][m][1];
                    ss += ((v0[0] * v0[0] + v0[1] * v0[1]) + (v0[2] * v0[2] + v0[3] * v0[3])) + ((v1[0] * v1[0] + v1[1] * v1[1]) + (v1[2] * v1[2] + v1[3] * v1[3]));
                    u32x4 w; w.x = cvt_pk_bf16(v0[0], v0[1]); w.y = cvt_pk_bf16(v0[2], v0[3]); w.z = cvt_pk_bf16(v1[0], v1[1]); w.w = cvt_pk_bf16(v1[2], v1[3]);
                    *(u32x4*)(xout + off + bj * HALF) = w; }
                ss += __shfl_xor(ss, 16); ss += __shfl_xor(ss, 32);
                if (fq == 0) ssq[(size_t)row * 16 + u.pn * 4 + wc] = ss; }
            asm volatile("" ::: "memory");
        }
    }
};
__device__ __forceinline__ unsigned pk4_fp8(float a, float b, float c, float d) { int p = __builtin_amdgcn_cvt_pk_fp8_f32(a, b, 0, false); return (unsigned)__builtin_amdgcn_cvt_pk_fp8_f32(c, d, p, true); }
struct EpiF8 {
    static constexpr bool PERM = true;
    unsigned char* O; int ldc; float scale;
    __device__ __forceinline__ void operator()(const f32x4 (&acc)[2][2][4][2], const Unit& u, int wr, int wc, int fr, int fq) const {
        const int row0 = u.pm * BM + wr * 64 + fr, col0 = u.pn * BM + wc * 32 + 8 * fq;
#pragma unroll
        for (int ai = 0; ai < 2; ++ai)
#pragma unroll
            for (int m = 0; m < 4; ++m) { unsigned char* rowp = O + (size_t)(row0 + ai * HALF + m * 16) * ldc + col0;
#pragma unroll
                for (int bj = 0; bj < 2; ++bj) { const f32x4 v0 = acc[ai][bj][m][0] * scale, v1 = acc[ai][bj][m][1] * scale;
                    v2u w; w.x = pk4_fp8(v0[0], v0[1], v0[2], v0[3]); w.y = pk4_fp8(v1[0], v1[1], v1[2], v1[3]);
                    *(v2u*)(rowp + bj * HALF) = w; } }
    }
};
struct EpiUp {
    static constexpr bool PERM = true;
    unsigned char* H;
    __device__ __forceinline__ void operator()(const f32x4 (&acc)[2][2][4][2], const Unit& u, int wr, int wc, int fr, int fq) const {
        const int row0 = u.pm * BM + wr * 64 + fr, col0 = u.pn * HALF + wc * 32 + 8 * fq;
#pragma unroll
        for (int ai = 0; ai < 2; ++ai)
#pragma unroll
            for (int m = 0; m < 4; ++m) { unsigned char* rowp = H + (size_t)(row0 + ai * HALF + m * 16) * 512 + col0;
                float h[8];
#pragma unroll
                for (int n = 0; n < 2; ++n)
#pragma unroll
                    for (int i = 0; i < 4; ++i) { const float a = acc[ai][0][m][n][i] * (1.f / 32.f), b = acc[ai][1][m][n][i] * (1.f / 32.f); h[n * 4 + i] = a * __builtin_amdgcn_rcpf(1.f + __expf(-a)) * b; }
                v2u w; w.x = pk4_fp8(h[0], h[1], h[2], h[3]); w.y = pk4_fp8(h[4], h[5], h[6], h[7]);
                *(v2u*)rowp = w; }
    }
};

template <class Epi, class Sched, bool ALIGN_EPI, bool FP8 = false>
__device__ __forceinline__ void gemm_phase(LAS unsigned char* lds, const int K_, const Sched& S, const Epi& E) {
    int K = K_; asm volatile("" : "+s"(K));
    int tid = threadIdx.x; asm volatile("" : "+v"(tid));
    const int wid = __builtin_amdgcn_readfirstlane(tid >> 6), lane = tid & 63, wr = wid >> 2, wc = wid & 3, fr = lane & 15, fq = lane >> 4;
    const int nt = K / BK;
    unsigned voffB[2];
#pragma unroll
    for (int i = 0; i < 2; ++i) { int R, C; stage_rc(tid * 16 + i * 8192, R, C); const int Rb = Epi::PERM ? ((R & ~31) + perm32(R & 31)) : R; voffB[i] = (unsigned)(Rb * K + C) * 2u; }
#define PG8_AOFF(u, o0, o1, o2, o3) do { int R0_, C0_, R1_, C1_; stage_rc(tid * 16, R0_, C0_); stage_rc(tid * 16 + 8192, R1_, C1_); \
        o0 = S.a_off(u, R0_) + (unsigned)C0_ * 2u; o1 = S.a_off(u, R1_) + (unsigned)C1_ * 2u; o2 = S.a_off(u, HALF + R0_) + (unsigned)C0_ * 2u; o3 = S.a_off(u, HALF + R1_) + (unsigned)C1_ * 2u; } while (0)
    const size_t kstep = (size_t)(BK * 2);
    const size_t hstep = (size_t)HALF * K * 2;
    const unsigned ldsw = (unsigned)wid * 1024u;
    const int aoff = lds_byte(wr * 64 + fr, fq * 8), boff = lds_byte(wc * 32 + fr, fq * 8);
    const char* const A0 = S.A;
#define PG8_SA(b, h) (((b) * 2 + (h)) * HTB)
#define PG8_SB(b, h) ((4 + (b) * 2 + (h)) * HTB)
#define PG8_STAGE(bufoff, gbase, voff) do { _Pragma("unroll") for (int _i = 0; _i < 2; ++_i) \
        __builtin_amdgcn_global_load_lds((const unsigned*)((const char*)(gbase) + (voff)[_i]), (LAS unsigned*)(lds + (bufoff) + ldsw + _i * 8192), 16, 0, 0); } while (0)
#define PG8_STAGEA(bufoff, kbyte, o0, o1) do { \
        __builtin_amdgcn_global_load_lds((const unsigned*)(A0 + (kbyte) + (o0)), (LAS unsigned*)(lds + (bufoff) + ldsw), 16, 0, 0); \
        __builtin_amdgcn_global_load_lds((const unsigned*)(A0 + (kbyte) + (o1)), (LAS unsigned*)(lds + (bufoff) + ldsw + 8192), 16, 0, 0); } while (0)
#define PG8_LD8(p) __builtin_shufflevector(*(const LAS i32x4*)(p), *(const LAS i32x4*)((p) + 1024), 0, 1, 2, 3, 4, 5, 6, 7)
#define PG8_LDA(dst, b, h) do { _Pragma("unroll") for (int m = 0; m < 4; ++m) dst[m] = PG8_LD8(lds + PG8_SA(b, h) + aoff + m * 2048); } while (0)
#define PG8_LDB(dst, b, h) do { _Pragma("unroll") for (int n = 0; n < 2; ++n) dst[n] = PG8_LD8(lds + PG8_SB(b, h) + boff + n * 2048); } while (0)
#define PG8_H(x, k) __builtin_bit_cast(bf16x8, __builtin_shufflevector(x, x, 4 * (k), 4 * (k) + 1, 4 * (k) + 2, 4 * (k) + 3))
#define PG8_MMA(ai, bj, At, Bt) do { __builtin_amdgcn_s_setprio(1); _Pragma("unroll") for (int m = 0; m < 4; ++m) _Pragma("unroll") for (int n = 0; n < 2; ++n) { \
        if constexpr (FP8) acc[ai][bj][m][n] = __builtin_amdgcn_mfma_scale_f32_16x16x128_f8f6f4(Bt[n], At[m], acc[ai][bj][m][n], 0, 0, 0, 0x7f7f7f7f, 0, 0x7f7f7f7f); \
        else { acc[ai][bj][m][n] = __builtin_amdgcn_mfma_f32_16x16x32_bf16(PG8_H(Bt[n], 0), PG8_H(At[m], 0), acc[ai][bj][m][n], 0, 0, 0); \
               acc[ai][bj][m][n] = __builtin_amdgcn_mfma_f32_16x16x32_bf16(PG8_H(Bt[n], 1), PG8_H(At[m], 1), acc[ai][bj][m][n], 0, 0, 0); } } \
        __builtin_amdgcn_s_setprio(0); } while (0)
#define PG8_WAIT_V(n) asm volatile("s_waitcnt vmcnt(" #n ")" ::: "memory")
#define PG8_WAIT_L(n) asm volatile("s_waitcnt lgkmcnt(" #n ")" ::: "memory")
#define PG8_BAR __builtin_amdgcn_s_barrier()
#define PG8_SCHED __builtin_amdgcn_sched_barrier(0)
    Unit cur, nxt; int ui = 0;
    if (!S.next(0, cur)) return;
    f32x4 acc[2][2][4][2];
#pragma unroll
    for (int a = 0; a < 2; ++a)
#pragma unroll
        for (int b = 0; b < 2; ++b)
#pragma unroll
            for (int m = 0; m < 4; ++m)
#pragma unroll
                for (int n = 0; n < 2; ++n) acc[a][b][m][n] = (f32x4){0.f, 0.f, 0.f, 0.f};
    i32x8 At[4], B0[2], B1[2];
    unsigned oc00, oc01, oc10, oc11, on00, on01, on10, on11;
    PG8_AOFF(cur, oc00, oc01, oc10, oc11);
    const char* cB = S.b_ptr(cur);
    PG8_STAGE(PG8_SB(0, 0), cB, voffB); PG8_STAGE(PG8_SB(0, 1), cB + hstep, voffB); PG8_STAGEA(PG8_SA(0, 0), 0, oc00, oc01); PG8_STAGEA(PG8_SA(0, 1), 0, oc10, oc11);
    if (wr == 1) PG8_BAR;
    PG8_WAIT_V(2); PG8_BAR;
    PG8_STAGE(PG8_SB(1, 0), cB + kstep, voffB); PG8_STAGEA(PG8_SA(1, 0), kstep, oc00, oc01); PG8_STAGE(PG8_SB(1, 1), cB + hstep + kstep, voffB);
    PG8_WAIT_V(6); PG8_BAR;
    for (;;) {
        const bool has_next = S.next(ui + 1, nxt);
        const char* nB = cB;
        on00 = oc00; on01 = oc01; on10 = oc10; on11 = oc11;
        if (has_next) { nB = S.b_ptr(nxt); PG8_AOFF(nxt, on00, on01, on10, on11); }
#pragma unroll 1
        for (int t = 0; t < nt; t += 2) {
            const bool last = (t == nt - 2);
            const size_t k1 = (size_t)(t + 1) * kstep, k2 = last ? 0 : (size_t)(t + 2) * kstep, k3 = k2 + kstep;
            const char* b2 = last ? nB : cB + (size_t)(t + 2) * kstep; const char* b3 = b2 + kstep;
            PG8_LDB(B0, 0, 0); PG8_LDB(B1, 0, 1); PG8_SCHED; PG8_LDA(At, 0, 0); PG8_STAGEA(PG8_SA(1, 1), k1, oc10, oc11);
            if (last) { oc00 = on00; oc01 = on01; oc10 = on10; oc11 = on11; }
            PG8_WAIT_V(8); PG8_WAIT_L(0); PG8_BAR; PG8_MMA(0, 0, At, B0); PG8_MMA(0, 1, At, B1); PG8_BAR; PG8_SCHED;
            PG8_LDA(At, 0, 1); PG8_STAGE(PG8_SB(0, 0), b2, voffB); PG8_STAGE(PG8_SB(0, 1), b2 + hstep, voffB); PG8_STAGEA(PG8_SA(0, 0), k2, oc00, oc01);
            PG8_WAIT_V(8); PG8_WAIT_L(0); PG8_BAR; PG8_MMA(1, 0, At, B0); PG8_MMA(1, 1, At, B1); PG8_BAR; PG8_SCHED;
            PG8_LDB(B0, 1, 0); PG8_LDB(B1, 1, 1); PG8_SCHED; PG8_LDA(At, 1, 0); PG8_STAGEA(PG8_SA(0, 1), k2, oc10, oc11);
            PG8_WAIT_V(8); PG8_WAIT_L(0); PG8_BAR; PG8_MMA(0, 0, At, B0); PG8_MMA(0, 1, At, B1); PG8_BAR; PG8_SCHED;
            PG8_LDA(At, 1, 1); PG8_STAGE(PG8_SB(1, 0), b3, voffB); PG8_STAGE(PG8_SB(1, 1), b3 + hstep, voffB); PG8_STAGEA(PG8_SA(1, 0), k3, oc00, oc01);
            PG8_WAIT_V(8); PG8_WAIT_L(0); PG8_BAR; PG8_MMA(1, 0, At, B0); PG8_MMA(1, 1, At, B1); PG8_BAR; PG8_SCHED;
        }
        if constexpr (ALIGN_EPI) { if (wr == 0) PG8_BAR; }
        E(acc, cur, wr, wc, fr, fq);
        if (!has_next) break;
#pragma unroll
        for (int a = 0; a < 2; ++a)
#pragma unroll
            for (int b = 0; b < 2; ++b)
#pragma unroll
                for (int m = 0; m < 4; ++m)
#pragma unroll
                    for (int n = 0; n < 2; ++n) acc[a][b][m][n] = (f32x4){0.f, 0.f, 0.f, 0.f};
        cur = nxt; cB = nB; ++ui;
        if constexpr (ALIGN_EPI) { if (wr == 1) PG8_BAR; }
    }
    PG8_WAIT_V(0);
    if constexpr (!ALIGN_EPI) { if (wr == 0) PG8_BAR; }
    PG8_BAR;
#undef PG8_SA
#undef PG8_SB
#undef PG8_STAGE
#undef PG8_STAGEA
#undef PG8_AOFF
#undef PG8_LDA
#undef PG8_LDB
#undef PG8_MMA
#undef PG8_LD8
#undef PG8_H
#undef PG8_WAIT_V
#undef PG8_WAIT_L
#undef PG8_BAR
#undef PG8_SCHED
}
}

#define PHASE_IDS(F) do { int _t = threadIdx.x; asm volatile("" : "+v"(_t)); (F).tid = _t; (F).lane = _t & 63; (F).wave = __builtin_amdgcn_readfirstlane(_t >> 6); } while (0)
struct TrItem { const float* W; bf16* WT; int ldw, K, mode, f8; };
__device__ __forceinline__ void tr_load(float (&tv)[32], const TrItem& t, int wave, int lane) {
#pragma unroll
    for (int i = 0; i < 32; ++i) tv[i] = __builtin_nontemporal_load(t.W + (size_t)(8 * wave + (i >> 2)) * t.ldw + 64 * (i & 3) + lane);
}
__device__ __forceinline__ void tr_store(const float (&tv)[32], const TrItem& t, LAS float* scr, int wave, int lane) {
#pragma unroll
    for (int i = 0; i < 32; ++i) scr[(8 * wave + (i >> 2)) * 257 + 64 * (i & 3) + lane] = tv[i];
    __syncthreads();
    const int c = lane & 7;
#pragma unroll
    for (int j = 0; j < 4; ++j) { const int n = 32 * wave + 8 * j + (lane >> 3); const LAS float* s = scr + (8 * c) * 257 + n;
        v4u o; o.x = pk2(s[0 * 257], s[1 * 257]); o.y = pk2(s[2 * 257], s[3 * 257]); o.z = pk2(s[4 * 257], s[5 * 257]); o.w = pk2(s[6 * 257], s[7 * 257]);
        const int drow = t.mode ? 256 * (n >> 7) + (n & 127) : n;
        if (t.f8) { v2u o8; o8.x = pg8::pk4_fp8(s[0 * 257] * 32.f, s[1 * 257] * 32.f, s[2 * 257] * 32.f, s[3 * 257] * 32.f); o8.y = pg8::pk4_fp8(s[4 * 257] * 32.f, s[5 * 257] * 32.f, s[6 * 257] * 32.f, s[7 * 257] * 32.f);
            __builtin_nontemporal_store(o8, (v2u*)((unsigned char*)t.WT + (size_t)drow * t.K + 8 * c)); }
        else *(v4u*)(t.WT + (size_t)drow * t.K + 8 * c) = o; }
    __syncthreads();
}

__device__ __forceinline__ void phase_prologue(Frame& F) {
    PHASE_IDS(F);
    LAS float* WL = (LAS float*)F.lds;
    LAS float* scr = (LAS float*)(F.lds + 65536);
    const float* w_in0 = F.in[4];
    for (int s0 = F.tid; s0 < 16 * 1024; s0 += 512 * 16) { float t[16];
#pragma unroll
        for (int i = 0; i < 16; ++i) { const int s = s0 + 512 * i; t[i] = w_in0[(size_t)(s >> 4) * EV_LD + 3072 + (s & 15)]; }
#pragma unroll
        for (int i = 0; i < 16; ++i) { const int s = s0 + 512 * i; WL[(s & 15) * 1024 + (s >> 4)] = t[i]; } }
    const int gw = F.vcu * NWAVES + F.wave, NGW = F.G * NWAVES;
    bf16* WIN0 = (bf16*)(F.ws + WS_WIN0); bf16* WOUT0 = (bf16*)(F.ws + WS_WOUT0); bf16* WIN1 = (bf16*)(F.ws + WS_WIN1); bf16* WOUT1 = (bf16*)(F.ws + WS_WOUT1);
    bf16* W13 = (bf16*)(F.ws + WS_W13); bf16* W2 = (bf16*)(F.ws + WS_W2);
    constexpr int I_A = 16 * 12, I_B = 16 * 2, I_C = 16 * 4, I_D = 16 * 10, I_E = 16 * 4, I_F = 2 * 32 * 2 * 32, I_G = 2 * 32 * 32;
    constexpr int NITEMS = I_A + I_B + I_C + I_D + I_E;
    auto decode = [&](int it) {
        TrItem t; int r = it; t.mode = 0; t.f8 = 0;
        if (r < I_A) { const int kb = r / 12, nb = r % 12; t.ldw = EV_LD; t.K = 1024; t.W = w_in0 + (size_t)(64 * kb) * EV_LD + 256 * nb; t.WT = WIN0 + (size_t)(256 * nb) * 1024 + 64 * kb; return t; } r -= I_A;
        if (r < I_B) { const int kb = r / 2, nb = r % 2; t.ldw = EV_LD; t.K = 1024; t.W = w_in0 + (size_t)(64 * kb) * EV_LD + 3088 + 256 * nb; t.WT = WIN0 + (size_t)(3072 + 256 * nb) * 1024 + 64 * kb; return t; } r -= I_B;
        if (r < I_C) { const int kb = r / 4, nb = r % 4; t.ldw = 1024; t.K = 1024; t.W = F.in[10] + (size_t)(64 * kb) * 1024 + 256 * nb; t.WT = WOUT0 + (size_t)(256 * nb) * 1024 + 64 * kb; return t; } r -= I_C;
        if (r < I_D) { const int kb = r / 10, nb = r % 10; t.ldw = OD_N; t.K = 1024; t.W = F.in[11] + (size_t)(64 * kb) * OD_N + 256 * nb; t.WT = WIN1 + (size_t)(256 * nb) * 1024 + 64 * kb; return t; } r -= I_D;
        if (r < I_E) { const int kb = r / 4, nb = r % 4; t.ldw = 1024; t.K = 1024; t.W = F.in[20] + (size_t)(64 * kb) * 1024 + 256 * nb; t.WT = WOUT1 + (size_t)(256 * nb) * 1024 + 64 * kb; return t; } r -= I_E;
        if (r < I_F) { const int le = r / 64, q = r % 64, which = q / 32, kb = (q % 32) / 2, nb = q % 2;
            t.ldw = 512; t.K = 1024; t.mode = 1; t.f8 = 1; t.W = (which ? F.in[26] : F.in[25]) + (size_t)le * 1024 * 512 + (size_t)(64 * kb) * 512 + 256 * nb;
            t.WT = (bf16*)((unsigned char*)(W13 + (size_t)(le >> 5) * 32 * 1024 * 1024) + (size_t)(le & 31) * 1024 * 1024 + (size_t)(512 * nb + which * 128) * 1024 + 64 * kb); return t; } r -= I_F;
        { const int le = r / 32, q = r % 32, kb = q / 4, nb = q % 4;
            t.ldw = 1024; t.K = 512; t.f8 = 1; t.W = F.in[27] + (size_t)le * 512 * 1024 + (size_t)(64 * kb) * 1024 + 256 * nb;
            t.WT = (bf16*)((unsigned char*)(W2 + (size_t)(le >> 5) * 32 * 1024 * 512) + (size_t)(le & 31) * 1024 * 512 + (size_t)(256 * nb) * 512 + 64 * kb); return t; }
    };
    __syncthreads();
    {
        float ta[32], tb[32]; TrItem da, db; int it = F.vcu;
        if (it < NITEMS) { da = decode(it); tr_load(ta, da, F.wave, F.lane); }
        while (it < NITEMS) {
            const int i1 = it + F.G, i2 = it + 2 * F.G;
            if (i1 < NITEMS) { db = decode(i1); tr_load(tb, db, F.wave, F.lane); }
            tr_store(ta, da, scr, F.wave, F.lane);
            if (i1 >= NITEMS) break;
            if (i2 < NITEMS) { da = decode(i2); tr_load(ta, da, F.wave, F.lane); }
            tr_store(tb, db, scr, F.wave, F.lane);
            it = i2;
        }
    }
    __syncthreads();
    const float* x = F.in[0]; const float* g = F.in[1];
    bf16* XN = (bf16*)(F.ws + WS_ACT); float* BL = (float*)(F.ws + WS_BLOW);
    f32x4 gv[4];
#pragma unroll
    for (int j = 0; j < 4; ++j) gv[j] = *((const f32x4*)g + 64 * j + F.lane);
    for (int m = gw; m < NT; m += NGW) {
        asm volatile("" ::: "memory");
        const f32x4* xr = (const f32x4*)(x + (size_t)m * D) + F.lane;
        f32x4 v[4]; float s = 0.f;
#pragma unroll
        for (int j = 0; j < 4; ++j) { v[j] = xr[64 * j]; s += (v[j].x * v[j].x + v[j].y * v[j].y) + (v[j].z * v[j].z + v[j].w * v[j].w); }
        const float rstd = rsqrtf(wave_sum(s) * (1.f / D) + EPS);
        v2u* o8 = (v2u*)(XN + (size_t)m * D) + F.lane;
#pragma unroll
        for (int j = 0; j < 4; ++j) { v[j] = v[j] * rstd * gv[j]; v2u w; w.x = pk2(v[j].x, v[j].y); w.y = pk2(v[j].z, v[j].w); o8[64 * j] = w; }
        float p[16];
#pragma unroll
        for (int o = 0; o < 16; ++o) {
            const LAS f32x4* wl = (const LAS f32x4*)(WL + o * 1024) + F.lane; float a = 0.f;
#pragma unroll
            for (int j = 0; j < 4; ++j) { const f32x4 w = wl[64 * j]; a += (v[j].x * w.x + v[j].y * w.y) + (v[j].z * w.z + v[j].w * w.w); }
            p[o] = a;
        }
#pragma unroll
        for (int o = 0; o < 8; ++o) { const bool hi = (F.lane & 32) != 0; const float snd = hi ? p[o] : p[o + 8], kp = hi ? p[o + 8] : p[o]; p[o] = kp + __shfl_xor(snd, 32); }
#pragma unroll
        for (int o = 0; o < 4; ++o) { const bool hi = (F.lane & 16) != 0; const float snd = hi ? p[o] : p[o + 4], kp = hi ? p[o + 4] : p[o]; p[o] = kp + __shfl_xor(snd, 16); }
#pragma unroll
        for (int o = 0; o < 2; ++o) { const bool hi = (F.lane & 8) != 0; const float snd = hi ? p[o] : p[o + 2], kp = hi ? p[o + 2] : p[o]; p[o] = kp + __shfl_xor(snd, 8); }
        { const bool hi = (F.lane & 4) != 0; const float snd = hi ? p[0] : p[1], kp = hi ? p[1] : p[0]; p[0] = kp + __shfl_xor(snd, 4); }
        p[0] += __shfl_xor(p[0], 2); p[0] += __shfl_xor(p[0], 1);
        if ((F.lane & 3) == 0) BL[(size_t)m * 16 + ((F.lane >> 5) & 1) * 8 + ((F.lane >> 4) & 1) * 4 + ((F.lane >> 3) & 1) * 2 + ((F.lane >> 2) & 1)] = p[0];
    }
}

__device__ __forceinline__ void convert_moe(Frame& F, int layer) {
    PHASE_IDS(F);
    LAS float* scr = (LAS float*)F.lds;
    unsigned char* W13 = F.ws + WS_W13 + (size_t)layer * 32 * 1024 * 1024 * 2; unsigned char* W2 = F.ws + WS_W2 + (size_t)layer * 32 * 1024 * 512 * 2;
    const float* w1 = F.in[25] + (size_t)layer * 32 * 1024 * 512; const float* w3 = F.in[26] + (size_t)layer * 32 * 1024 * 512; const float* w2 = F.in[27] + (size_t)layer * 32 * 512 * 1024;
    auto decode = [&](int r) {
        TrItem t; t.f8 = 1;
        if (r < 2048) { const int e = r / 64, q = r % 64, which = q / 32, kb = (q % 32) / 2, nb = q % 2;
            t.ldw = 512; t.K = 1024; t.mode = 1; t.W = (which ? w3 : w1) + (size_t)e * 1024 * 512 + (size_t)(64 * kb) * 512 + 256 * nb;
            t.WT = (bf16*)(W13 + (size_t)e * 1024 * 1024 + (size_t)(512 * nb + which * 128) * 1024 + 64 * kb); return t; }
        r -= 2048;
        { const int e = r / 32, q = r % 32, kb = q / 4, nb = q % 4;
            t.ldw = 1024; t.K = 512; t.mode = 0; t.W = w2 + (size_t)e * 512 * 1024 + (size_t)(64 * kb) * 1024 + 256 * nb;
            t.WT = (bf16*)(W2 + (size_t)e * 1024 * 512 + (size_t)(256 * nb) * 512 + 64 * kb); return t; }
    };
    constexpr int NIT = 3072;
    __syncthreads();
    float ta[32], tb[32]; TrItem da, db; int it = F.vcu;
    if (it < NIT) { da = decode(it); tr_load(ta, da, F.wave, F.lane); }
    while (it < NIT) {
        const int i1 = it + F.G, i2 = it + 2 * F.G;
        if (i1 < NIT) { db = decode(i1); tr_load(tb, db, F.wave, F.lane); }
        tr_store(ta, da, scr, F.wave, F.lane);
        if (i1 >= NIT) break;
        if (i2 < NIT) { da = decode(i2); tr_load(ta, da, F.wave, F.lane); }
        tr_store(tb, db, scr, F.wave, F.lane);
        it = i2;
    }
    __syncthreads();
}

__device__ __forceinline__ float row16_max(float v) { v = fmaxf(v, __shfl_xor(v, 1)); v = fmaxf(v, __shfl_xor(v, 2)); v = fmaxf(v, __shfl_xor(v, 4)); return fmaxf(v, __shfl_xor(v, 8)); }
__device__ __forceinline__ float row16_sum(float v) { v += __shfl_xor(v, 1); v += __shfl_xor(v, 2); v += __shfl_xor(v, 4); return v + __shfl_xor(v, 8); }
__device__ __forceinline__ int row16_min(int v) { v = min(v, __shfl_xor(v, 1)); v = min(v, __shfl_xor(v, 2)); v = min(v, __shfl_xor(v, 4)); return min(v, __shfl_xor(v, 8)); }
__device__ __forceinline__ void phase_router(Frame& F, int layer, const bf16* XR) {
    PHASE_IDS(F);
    constexpr int PW = 2064;
    LAS unsigned char* WH = F.lds; LAS unsigned char* WLO = F.lds + 36 * PW;
    LAS float* GL = (LAS float*)(F.lds + LDS_MISC + 1024);
    LAS int* hist = (LAS int*)(F.lds + LDS_MISC + 1024 + 4096); LAS int* base = hist + 32;
    LAS int* s_e0 = base + 32; LAS int* s_e1 = s_e0 + 128; LAS int* s_r0 = s_e1 + 128; LAS int* s_r1 = s_r0 + 128;
    LAS float* s_w0 = (LAS float*)(s_r1 + 128); LAS float* s_w1 = s_w0 + 128;
    const float* wg = F.in[21] + (size_t)layer * 1024 * 4; const float* we = F.in[23] + (size_t)layer * 1024 * 32;
    const float* g = F.in[2] + layer * 1024;
    for (int s = F.tid; s < 1024; s += 512) GL[s] = g[s];
    __syncthreads();
    for (int s0 = F.tid; s0 < 4096 + 32768; s0 += 512 * 18) {
        float t[18];
#pragma unroll
        for (int i = 0; i < 18; ++i) { const int s = s0 + 512 * i; t[i] = s < 4096 ? wg[s] : we[s - 4096]; }
#pragma unroll
        for (int i = 0; i < 18; ++i) { const int s = s0 + 512 * i; const int k = s < 4096 ? (s >> 2) : ((s - 4096) >> 5), o = s < 4096 ? (s & 3) : 4 + ((s - 4096) & 31);
            const float w = t[i] * GL[k]; const unsigned hb = f2bf(w);
            *(LAS bf16*)(WH + o * PW + k * 2) = (bf16)hb; *(LAS bf16*)(WLO + o * PW + k * 2) = (bf16)f2bf(w - bf2f((bf16)hb)); } }
    const int c = F.lane & 15, q = F.lane >> 4;
    float bias[3];
#pragma unroll
    for (int jt = 0; jt < 3; ++jt) { const int col = 16 * jt + c; bias[jt] = col < 4 ? F.in[22][layer * 4 + col] : (col < 36 ? F.in[24][layer * 32 + col - 4] : 0.f); }
    unsigned* cnt = F.ctl + CW_CNT + 64 * layer;
    bf16* XN = (bf16*)(F.ws + WS_ACT); const float* SSQ = (const float*)(F.ws + WS_SSQ);
    int* ME0 = (int*)(F.ws + WS_META); int* ME1 = ME0 + NT; int* MR0 = ME1 + NT; int* MR1 = MR0 + NT; float* MW0 = (float*)(MR1 + NT); float* MW1 = MW0 + NT;
    int* LIST = (int*)(F.ws + WS_LIST);
    int wrow[3];
#pragma unroll
    for (int jt = 0; jt < 3; ++jt) wrow[jt] = min(16 * jt + c, 35) * PW + 16 * q;
    __syncthreads();
    for (int row0 = 128 * F.vcu; row0 < NT; row0 += 128 * F.G) {
        if (F.tid < 32) hist[F.tid] = 0;
        __syncthreads();
        const int rl = F.wave * 16, row = row0 + rl + c;
        float rstd; { const f32x4 sp = *(const f32x4*)(SSQ + (size_t)row * 16 + 4 * q); float s = (sp[0] + sp[1]) + (sp[2] + sp[3]); s += __shfl_xor(s, 16); s += __shfl_xor(s, 32); rstd = rsqrtf(s * (1.f / D) + EPS); }
        const bf16* xr = XR + (size_t)row * D + 8 * q; unsigned char* xo = (unsigned char*)XN + (size_t)row * D + 8 * q;
        f32x4 acc[3];
#pragma unroll
        for (int jt = 0; jt < 3; ++jt) acc[jt] = (f32x4){0.f, 0.f, 0.f, 0.f};
        for (int k4 = 0; k4 < 32; k4 += 8) {
            v4u xw[8];
#pragma unroll
            for (int u = 0; u < 8; ++u) xw[u] = *(const v4u*)(xr + 32 * (k4 + u));
#pragma unroll
            for (int u = 0; u < 8; ++u) {
                const int kk = k4 + u;
                const f32x4 ga = *(const LAS f32x4*)(GL + 32 * kk + 8 * q), gb = *(const LAS f32x4*)(GL + 32 * kk + 8 * q + 4);
                const v4u w = xw[u];
#define BLO(x) __builtin_bit_cast(float, (x) << 16)
#define BHI(x) __builtin_bit_cast(float, (x) & 0xffff0000u)
                v2u xn; xn.x = pg8::pk4_fp8(BLO(w.x) * rstd * ga[0], BHI(w.x) * rstd * ga[1], BLO(w.y) * rstd * ga[2], BHI(w.y) * rstd * ga[3]);
                xn.y = pg8::pk4_fp8(BLO(w.z) * rstd * gb[0], BHI(w.z) * rstd * gb[1], BLO(w.w) * rstd * gb[2], BHI(w.w) * rstd * gb[3]);
#undef BLO
#undef BHI
                *(v2u*)(xo + 32 * kk) = xn;
                const bf16x8 ah = __builtin_bit_cast(bf16x8, w);
#pragma unroll
                for (int jt = 0; jt < 3; ++jt) { const bf16x8 bh = *(const LAS bf16x8*)(WH + wrow[jt] + 64 * kk), bl = *(const LAS bf16x8*)(WLO + wrow[jt] + 64 * kk);
                    acc[jt] = __builtin_amdgcn_mfma_f32_16x16x32_bf16(ah, bh, acc[jt], 0, 0, 0); acc[jt] = __builtin_amdgcn_mfma_f32_16x16x32_bf16(ah, bl, acc[jt], 0, 0, 0); }
            }
        }
#pragma unroll
        for (int i = 0; i < 4; ++i) {
            const float rs = __shfl(rstd, 4 * q + i);
            const float l0 = acc[0][i] * rs + bias[0], l1 = acc[1][i] * rs + bias[1], l2 = acc[2][i] * rs + bias[2];
            const float gvl = c < 4 ? l0 : -3.0e38f;
            const float gmax = row16_max(gvl); const int gi = row16_min(gvl == gmax ? c : 99);
            const float gwt = 1.f / row16_sum(c < 4 ? __expf(gvl - gmax) : 0.f);
            const int jt = c < 4 ? (gi == 1 ? 1 : 2) : (c < 12 ? (gi == 0 ? 0 : 1) : (gi == 1 ? 0 : 1));
            const bool valid = c < 4 ? (gi == 1 || gi == 3) : (c < 12 ? (gi == 0 || gi == 2) : (gi == 1 || gi == 3));
            const int eidx = 16 * jt + c - 4 - 8 * gi;
            float cv = jt == 0 ? l0 : (jt == 1 ? l1 : l2); cv = (valid && eidx >= 0 && eidx < 8) ? cv : -3.0e38f;
            const float v0 = row16_max(cv); const int i0 = row16_min(cv == v0 ? eidx : 99);
            const float cv2 = eidx == i0 ? -3.0e38f : cv;
            const float v1 = row16_max(cv2); const int i1 = row16_min(cv2 == v1 ? eidx : 99);
            const float ex = __expf(v1 - v0), tw0 = 1.f / (1.f + ex), tw1 = ex / (1.f + ex);
            if (c == 0) { const int r = rl + 4 * q + i, e0 = gi * 8 + i0, e1 = gi * 8 + i1;
                s_e0[r] = e0; s_e1[r] = e1; s_w0[r] = gwt * tw0; s_w1[r] = gwt * tw1;
                s_r0[r] = atomicAdd((int*)&hist[e0], 1); s_r1[r] = atomicAdd((int*)&hist[e1], 1); }
        }
        __syncthreads();
        if (F.tid < 32) base[F.tid] = (int)atomicAdd(cnt + F.tid, (unsigned)hist[F.tid]);
        __syncthreads();
        if (F.tid < 128) {
            const int m = row0 + F.tid, e0 = s_e0[F.tid], e1 = s_e1[F.tid], r0 = base[e0] + s_r0[F.tid], r1 = base[e1] + s_r1[F.tid];
            ME0[m] = e0; ME1[m] = e1; MR0[m] = r0; MR1[m] = r1; MW0[m] = s_w0[F.tid]; MW1[m] = s_w1[F.tid];
            LIST[(size_t)e0 * NT + r0] = m; LIST[(size_t)e1 * NT + r1] = m;
        }
        __syncthreads();
    }
}

__device__ __forceinline__ void phase_combine(Frame& F, int layer, const bf16* XRin, bf16* XRout) {
    PHASE_IDS(F);
    LAS int* poff = (LAS int*)(F.lds + LDS_MISC + 1024);
    const unsigned* cnt = F.ctl + CW_CNT + 64 * layer;
    if (F.tid < 32) poff[33 + F.tid] = (int)cnt[F.tid];
    __syncthreads();
    if (F.tid == 0) { int acc = 0; for (int e = 0; e < 32; ++e) { poff[e] = acc; acc += (poff[33 + e] + 255) & ~255; } poff[32] = acc; }
    __syncthreads();
    const int gw = F.vcu * NWAVES + F.wave, NGW = F.G * NWAVES;
    const float* g = layer == 0 ? F.in[1] + 1024 : F.in[3];
    const bf16* Y = (const bf16*)(F.ws + WS_Y); bf16* XN = (bf16*)(F.ws + WS_ACT);
    const int* ME0 = (const int*)(F.ws + WS_META); const int* ME1 = ME0 + NT; const int* MR0 = ME1 + NT; const int* MR1 = MR0 + NT; const float* MW0 = (const float*)(MR1 + NT); const float* MW1 = MW0 + NT;
    f32x4 gv[4];
#pragma unroll
    for (int j = 0; j < 4; ++j) gv[j] = *((const f32x4*)g + 64 * j + F.lane);
    for (int m0 = gw; m0 < NT; m0 += 2 * NGW) {
        int mr[2]; mr[0] = m0; mr[1] = (m0 + NGW < NT) ? m0 + NGW : m0;
        f32x4 v[2][4]; unsigned ya[2][4], yb[2][4]; float w0[2], w1[2];
#pragma unroll
        for (int r = 0; r < 2; ++r) {
            const int m = mr[r]; const int s0 = poff[ME0[m]] + MR0[m], s1 = poff[ME1[m]] + MR1[m]; w0[r] = MW0[m] * (1.f / 16.f); w1[r] = MW1[m] * (1.f / 16.f);
            const v2u* xr = (const v2u*)(XRin + (size_t)m * D) + F.lane;
            const unsigned* y0 = (const unsigned*)((const unsigned char*)Y + (size_t)s0 * D) + F.lane; const unsigned* y1 = (const unsigned*)((const unsigned char*)Y + (size_t)s1 * D) + F.lane;
#pragma unroll
            for (int j = 0; j < 4; ++j) { const v2u xw = xr[64 * j]; v[r][j] = (f32x4){bf2f((bf16)(xw.x & 0xffff)), bf2f((bf16)(xw.x >> 16)), bf2f((bf16)(xw.y & 0xffff)), bf2f((bf16)(xw.y >> 16))}; ya[r][j] = y0[64 * j]; yb[r][j] = y1[64 * j]; }
        }
#pragma unroll
        for (int r = 0; r < 2; ++r) {
            const int m = mr[r]; float s = 0.f;
            f32x4* xr = (f32x4*)(F.out + (size_t)m * D) + F.lane; v2u* xo2 = (v2u*)(XRout + (size_t)m * D) + F.lane;
#pragma unroll
            for (int j = 0; j < 4; ++j) { const f32x2 a0 = __builtin_amdgcn_cvt_pk_f32_fp8((int)ya[r][j], false), a1 = __builtin_amdgcn_cvt_pk_f32_fp8((int)ya[r][j], true), b0 = __builtin_amdgcn_cvt_pk_f32_fp8((int)yb[r][j], false), b1 = __builtin_amdgcn_cvt_pk_f32_fp8((int)yb[r][j], true);
                v[r][j].x += w0[r] * a0.x + w1[r] * b0.x; v[r][j].y += w0[r] * a0.y + w1[r] * b0.y;
                v[r][j].z += w0[r] * a1.x + w1[r] * b1.x; v[r][j].w += w0[r] * a1.y + w1[r] * b1.y;
                s += (v[r][j].x * v[r][j].x + v[r][j].y * v[r][j].y) + (v[r][j].z * v[r][j].z + v[r][j].w * v[r][j].w); }
            const float rstd = rsqrtf(wave_sum(s) * (1.f / D) + EPS);
            if (r == 1 && mr[1] == mr[0]) continue;
            if (layer == 0) {
                v2u* o8 = (v2u*)(XN + (size_t)m * D) + F.lane;
#pragma unroll
                for (int j = 0; j < 4; ++j) { v2u xw; xw.x = pk2(v[r][j].x, v[r][j].y); xw.y = pk2(v[r][j].z, v[r][j].w); xo2[64 * j] = xw; const f32x4 n = v[r][j] * rstd * gv[j]; v2u w; w.x = pk2(n.x, n.y); w.y = pk2(n.z, n.w); o8[64 * j] = w; }
            } else {
#pragma unroll
                for (int j = 0; j < 4; ++j) xr[64 * j] = v[r][j] * rstd * gv[j];
            }
        }
    }
}


namespace mx {
typedef short s4 __attribute__((ext_vector_type(4)));
constexpr int PV = 272, PP = 144;
template <int DK> struct Lay { static constexpr int PK = DK * 2 + 16, QS = 0, KS = 64 * PK, VV = 2 * 64 * PK, ST = VV + 64 * PV, PM = ST + 128 * PK, VEC = PM + 64 * PP, PART = VEC + 3 * DK * 4, RED = PART + 8 * DK * 4, BLS = RED + 4096, END = BLS + 4096; };
static_assert(Lay<128>::END <= LDS_MISC, "mixer LDS map");
__device__ __forceinline__ bf16x8 row_frag(const LAS unsigned char* base, int pitch, int row0, int kk, int lane) {
    return *(const LAS bf16x8*)(base + (row0 + (lane & 15)) * pitch + (32 * kk + 8 * (lane >> 4)) * 2);
}
__device__ __forceinline__ bf16x8 tr_frag(const LAS unsigned char* base, int pitch, int k0, int c0, int lane) {
    const int g = lane >> 4, q = (lane & 15) >> 2, p = lane & 3;
    const LAS unsigned char* a = base + (k0 + 8 * g + q) * pitch + (c0 + 4 * p) * 2;
    const s4 lo = __builtin_amdgcn_ds_read_tr16_b64_v4i16((LAS s4*)a);
    const s4 hi = __builtin_amdgcn_ds_read_tr16_b64_v4i16((LAS s4*)(a + 4 * pitch));
    return __builtin_shufflevector(lo, hi, 0, 1, 2, 3, 4, 5, 6, 7);
}
#define MFMA16(a, b, c) __builtin_amdgcn_mfma_f32_16x16x32_bf16(a, b, c, 0, 0, 0)

struct UnitP { const bf16* PROJ; bf16* YM; const float* nw; const float* BL; const float* p0; const float* p1; const float* p2; int b, h, c0, nch, seg; };

template <int KIND> struct KC {
    static constexpr int DK = KIND == 0 ? 128 : 64, LDP = KIND == 2 ? OD_N : EV_N;
    __device__ static __forceinline__ int qcol(int h) { return KIND == 0 ? h * 128 : (KIND == 1 ? 2048 + h * 64 : h * 64); }
    __device__ static __forceinline__ int kcol(int h) { return KIND == 0 ? 512 + h * 128 : (KIND == 1 ? 2304 + h * 64 : 256 + h * 64); }
    __device__ static __forceinline__ int vcol(int h) { return KIND == 0 ? 1024 + h * 128 : (KIND == 1 ? 2560 + h * 128 : 512 + h * 128); }
    __device__ static __forceinline__ int gcol(int h) { return KIND == 0 ? 1536 + h * 128 : (KIND == 1 ? 3072 + h * 128 : 1024 + h * 128); }
    __device__ static __forceinline__ int ocol(int h) { return KIND == 1 ? 512 + h * 128 : h * 128; }
};

template <int KIND, bool FULL>
__device__ __forceinline__ void mix_unit(LAS unsigned char* lds, float* Sg, float* Bg, const UnitP& U) {
    using K = KC<KIND>; constexpr int DK = K::DK, LDP = K::LDP, NJT = DK == 128 ? 8 : 4; using L = Lay<DK>; constexpr int PK = L::PK;
    int tid = threadIdx.x; asm volatile("" : "+v"(tid));
    const int lane = tid & 63, wave = __builtin_amdgcn_readfirstlane(tid >> 6), g = lane >> 4, c = lane & 15;
    const int h = U.h, dt = DK == 128 ? wave : (wave & 3), jt0 = DK == 128 ? 0 : 4 * (wave >> 2);
    LAS float* EM = (LAS float*)(lds + L::VEC); LAS float* EL = EM + DK; LAS float* BT = EL + DK; LAS float* PART = (LAS float*)(lds + L::PART);
    float lb0 = 0.f, lb1 = 0.f, wu[16], bu = 0.f, ci = 0.f, lgg = 0.f;
    if (KIND == 0) {
        const float* lbl = U.p0; const int col = h * 128 + 2 * lane;
#pragma unroll
        for (int x = 0; x < 2; ++x) { const float l0 = lbl[col + x], l1 = lbl[512 + col + x], l2 = lbl[1024 + col + x]; const float mx_ = fmaxf(l0, fmaxf(l1, l2));
            const float e0 = __expf(l0 - mx_), e1 = __expf(l1 - mx_), e2 = __expf(l2 - mx_); const float v = e0 / (e0 + e1 + e2); if (x == 0) lb0 = v; else lb1 = v; }
    }
    if (KIND == 1) {
#pragma unroll
        for (int r = 0; r < 16; ++r) wu[r] = U.p0[r * 256 + h * 64 + lane];
        bu = U.p1[h * 64 + lane];
    }
    if (KIND == 2) { ci = exp2f(-(float)(lane & 31) * (13.287712379549449f / 32.f)) * 0.15915494309189535f; lgg = log1pf(-exp2f(-5.f - (float)h)); }
    f32x4 S[NJT];
#pragma unroll
    for (int jt = 0; jt < NJT; ++jt) {
        S[jt] = (f32x4){0.f, 0.f, 0.f, 0.f};
    }
    if (FULL) {
        f32x4 L[NJT], D4 = (f32x4){0.f, 0.f, 0.f, 0.f};
        auto ldseg = [&](int s) { const float* Sp = Sg + (ptrdiff_t)s * 16384; D4 = *(const f32x4*)(Bg + s * 128 + 16 * dt + 4 * g);
#pragma unroll
            for (int jt = 0; jt < NJT; ++jt)
#pragma unroll
                for (int i = 0; i < 4; ++i) L[jt][i] = Sp[(16 * dt + 4 * g + i) * 128 + 16 * (jt0 + jt) + c]; };
        if (U.seg > 0) ldseg(-U.seg);
        for (int s = -U.seg; s < 0; ++s) {
            f32x4 Lc[NJT]; const f32x4 Dc = D4;
#pragma unroll
            for (int jt = 0; jt < NJT; ++jt) Lc[jt] = L[jt];
            if (s + 1 < 0) ldseg(s + 1);
#pragma unroll
            for (int jt = 0; jt < NJT; ++jt) S[jt] = Dc * S[jt] + Lc[jt];
        }
    }
    f32x4 nw4[4];
    if (FULL) {
#pragma unroll
        for (int x = 0; x < 4; ++x) nw4[x] = *(const f32x4*)(U.nw + h * 128 + 16 * (4 * (wave >> 2) + x) + 4 * g);
    }
    if (tid < DK) BT[tid] = KIND == 0 ? 1.f : 0.f;
    v4u rv0, rv1; unsigned ra[8], rb[8]; f32x4 rbl = (f32x4){0.f, 0.f, 0.f, 0.f};
    auto load_raw = [&](int ch) {
        const size_t row0 = (size_t)U.b * SEQ + (U.c0 + ch) * 64;
        const bf16* Vp = U.PROJ + (row0 + (tid >> 3)) * LDP + K::vcol(h) + (tid & 7) * 16;
        rv0 = *(const v4u*)Vp; rv1 = *(const v4u*)(Vp + 8);
        if (KIND == 1 && tid < 256) rbl = *(const f32x4*)(U.BL + (row0 + (tid >> 2)) * 16 + (tid & 3) * 4);
        if (KIND == 0) {
            const bf16* P = U.PROJ + (row0 + 8 * wave) * LDP + 2 * lane;
#pragma unroll
            for (int tt = 0; tt < 8; ++tt) { ra[tt] = *(const unsigned*)(P + (size_t)tt * LDP + K::kcol(h)); if (FULL) rb[tt] = *(const unsigned*)(P + (size_t)tt * LDP + K::qcol(h)); }
        } else {
            const bf16* P = U.PROJ + (row0 + 8 * wave) * LDP + lane;
#pragma unroll
            for (int tt = 0; tt < 8; ++tt) { ra[tt] = P[(size_t)tt * LDP + K::kcol(h)]; if (FULL) rb[tt] = P[(size_t)tt * LDP + K::qcol(h)]; }
        }
    };
    load_raw(0);
    for (int ch = 0; ch < U.nch; ++ch) {
        const int pos0 = (U.c0 + ch) * 64; const size_t row0 = (size_t)U.b * SEQ + pos0;
        *(LAS v4u*)(lds + L::VV + (tid >> 3) * PV + (tid & 7) * 32) = rv0; *(LAS v4u*)(lds + L::VV + (tid >> 3) * PV + (tid & 7) * 32 + 16) = rv1;
        if (KIND == 0) {
            float cp0[8], cp1[8], k0[8], k1[8]; float c0 = 1.f, c1 = 1.f;
#pragma unroll
            for (int tt = 0; tt < 8; ++tt) {
                const float f0 = lb0 + (1.f - lb0) * sigmoidf_(bf2f((bf16)(ra[tt] & 0xffff))), f1 = lb1 + (1.f - lb1) * sigmoidf_(bf2f((bf16)(ra[tt] >> 16)));
                c0 *= f0; c1 *= f1; cp0[tt] = c0; cp1[tt] = c1; k0[tt] = 1.f - f0; k1[tt] = 1.f - f1;
            }
            *(LAS f32x2*)(PART + wave * 128 + 2 * lane) = (f32x2){c0, c1};
            __syncthreads();
            float pre0 = 1.f, pre1 = 1.f, mid0 = 1.f, mid1 = 1.f, hi0 = 1.f, hi1 = 1.f;
#pragma unroll
            for (int w2 = 0; w2 < 8; ++w2) { const f32x2 p = *(const LAS f32x2*)(PART + w2 * 128 + 2 * lane);
                if (w2 < 4) { mid0 *= p.x; mid1 *= p.y; } else { hi0 *= p.x; hi1 *= p.y; }
                if (wave < 4 ? (w2 > wave && w2 < 4) : (w2 >= 4 && w2 < wave)) { pre0 *= p.x; pre1 *= p.y; } }
#pragma unroll
            for (int tt = 0; tt < 8; ++tt) {
                float qs0, qs1, ks0, ks1;
                if (wave >= 4) { qs0 = pre0 * cp0[tt]; qs1 = pre1 * cp1[tt]; ks0 = __builtin_amdgcn_rcpf(fmaxf(qs0, 1e-26f)); ks1 = __builtin_amdgcn_rcpf(fmaxf(qs1, 1e-26f)); }
                else { ks0 = pre0 * c0 * __builtin_amdgcn_rcpf(fmaxf(cp0[tt], 1e-26f)); ks1 = pre1 * c1 * __builtin_amdgcn_rcpf(fmaxf(cp1[tt], 1e-26f));
                       qs0 = __builtin_amdgcn_rcpf(fmaxf(ks0, 1e-26f)); qs1 = __builtin_amdgcn_rcpf(fmaxf(ks1, 1e-26f)); }
                *(LAS unsigned*)(lds + L::KS + (8 * wave + tt) * PK + 4 * lane) = pg8::cvt_pk_bf16(k0[tt] * ks0, k1[tt] * ks1);
                if (FULL) *(LAS unsigned*)(lds + L::QS + (8 * wave + tt) * PK + 4 * lane) = pg8::cvt_pk_bf16(bf2f((bf16)(rb[tt] & 0xffff)) * qs0, bf2f((bf16)(rb[tt] >> 16)) * qs1);
            }
            if (wave == 0) { *(LAS f32x2*)(EM + 2 * lane) = (f32x2){mid0, mid1}; *(LAS f32x2*)(EL + 2 * lane) = (f32x2){hi0, hi1};
                const f32x2 o = *(const LAS f32x2*)(BT + 2 * lane); *(LAS f32x2*)(BT + 2 * lane) = (f32x2){o.x * mid0 * hi0, o.y * mid1 * hi1}; }
        } else if (KIND == 1) {
            LAS float* BLS = (LAS float*)(lds + L::BLS);
            if (tid < 256) *(LAS f32x4*)(BLS + (tid >> 2) * 16 + (tid & 3) * 4) = rbl;
            __syncthreads();
            float cs[8]; float cc = 0.f;
#pragma unroll
            for (int tt = 0; tt < 8; ++tt) {
                const LAS f32x4* bl = (const LAS f32x4*)(BLS + (8 * wave + tt) * 16); float z = bu;
#pragma unroll
                for (int r = 0; r < 4; ++r) { const f32x4 bq = bl[r]; z += (bq[0] * wu[4 * r] + bq[1] * wu[4 * r + 1]) + (bq[2] * wu[4 * r + 2] + bq[3] * wu[4 * r + 3]); }
                const float ls = fminf(z, 0.f) - __logf(1.f + __expf(-fabsf(z)));
                cc += ls * (1.f / 16.f); cs[tt] = cc;
            }
            PART[wave * 64 + lane] = cc;
            __syncthreads();
            float off = 0.f, mid = 0.f, tot = 0.f;
#pragma unroll
            for (int w2 = 0; w2 < 8; ++w2) { const float p = PART[w2 * 64 + lane]; if (w2 < wave) off += p; if (w2 < 4) mid += p; tot += p; }
#pragma unroll
            for (int tt = 0; tt < 8; ++tt) {
                const float b = off + cs[tt];
                *(LAS bf16*)(lds + L::KS + (8 * wave + tt) * PK + 2 * lane) = (bf16)f2bf(bf2f((bf16)ra[tt]) * __expf(fminf(mid - b, 60.f)));
                if (FULL) *(LAS bf16*)(lds + L::QS + (8 * wave + tt) * PK + 2 * lane) = (bf16)f2bf(bf2f((bf16)rb[tt]) * 0.125f * __expf(fminf(b - mid, 60.f)));
            }
            if (wave == 0) { EM[lane] = __expf(mid); EL[lane] = __expf(tot - mid); BT[lane] += tot; }
        } else {
#pragma unroll
            for (int tt = 0; tt < 8; ++tt) {
                const int tl = 8 * wave + tt; float rev = (float)(pos0 + tl) * ci; rev -= floorf(rev);
                const float sn = __builtin_amdgcn_sinf(rev), cs = __builtin_amdgcn_cosf(rev);
                const float e = (float)(tl - 31) * lgg;
                const float kv = bf2f((bf16)ra[tt]), kp = __shfl_xor(kv, 32);
                const float kr = (lane < 32 ? kv * cs - kp * sn : kp * sn + kv * cs) * 0.125f;
                *(LAS bf16*)(lds + L::KS + tl * PK + 2 * lane) = (bf16)f2bf(kr * __expf(-e));
                if (FULL) { const float qv = bf2f((bf16)rb[tt]), qp = __shfl_xor(qv, 32); const float qr = lane < 32 ? qv * cs - qp * sn : qp * sn + qv * cs;
                    *(LAS bf16*)(lds + L::QS + tl * PK + 2 * lane) = (bf16)f2bf(qr * __expf(e)); }
            }
            if (wave == 0) { const float e32 = __expf(32.f * lgg); EM[lane] = e32; EL[lane] = e32; BT[lane] += 64.f * lgg; }
        }
        if (ch + 1 < U.nch) load_raw(ch + 1);
        v2u gq[4];
        if (FULL) { const bf16* gp = U.PROJ + (row0 + 16 * (wave & 3) + c) * LDP + K::gcol(h) + 16 * (4 * (wave >> 2)) + 4 * g;
#pragma unroll
            for (int x = 0; x < 4; ++x) gq[x] = *(const v2u*)(gp + 16 * x); }
        __syncthreads();
        { const f32x4 em4 = *(const LAS f32x4*)(EM + 16 * dt + 4 * g);
#pragma unroll
          for (int jt = 0; jt < NJT; ++jt) { S[jt] = S[jt] * em4;
              if (FULL) { v2u w; w.x = pg8::cvt_pk_bf16(S[jt][0], S[jt][1]); w.y = pg8::cvt_pk_bf16(S[jt][2], S[jt][3]);
                  *(LAS v2u*)(lds + L::ST + (16 * (jt0 + jt) + c) * PK + (16 * dt + 4 * g) * 2) = w; } } }
        if (FULL) {
            const int st = wave & 3, tt0 = 2 * (wave >> 2);
            f32x4 p0 = (f32x4){0.f, 0.f, 0.f, 0.f}, p1 = p0;
#pragma unroll
            for (int kk = 0; kk < DK / 32; ++kk) { const bf16x8 a = row_frag(lds + L::KS, PK, 16 * st, kk, lane);
                p0 = MFMA16(a, row_frag(lds + L::QS, PK, 16 * tt0, kk, lane), p0); p1 = MFMA16(a, row_frag(lds + L::QS, PK, 16 * (tt0 + 1), kk, lane), p1); }
#pragma unroll
            for (int x = 0; x < 2; ++x) { const f32x4 p = x ? p1 : p0; const int t = 16 * (tt0 + x) + c, s = 16 * st + 4 * g;
                v2u w; w.x = pg8::cvt_pk_bf16(s <= t ? p[0] : 0.f, s + 1 <= t ? p[1] : 0.f); w.y = pg8::cvt_pk_bf16(s + 2 <= t ? p[2] : 0.f, s + 3 <= t ? p[3] : 0.f);
                *(LAS v2u*)(lds + L::PM + t * PP + s * 2) = w; }
        }
        {
#pragma unroll
          for (int kk = 0; kk < 2; ++kk) { const bf16x8 a = tr_frag(lds + L::KS, PK, 32 * kk, 16 * dt, lane);
#pragma unroll
              for (int jt = 0; jt < NJT; ++jt) S[jt] = MFMA16(a, tr_frag(lds + L::VV, PV, 32 * kk, 16 * (jt0 + jt), lane), S[jt]); }
          const f32x4 el4 = *(const LAS f32x4*)(EL + 16 * dt + 4 * g);
#pragma unroll
          for (int jt = 0; jt < NJT; ++jt) S[jt] = S[jt] * el4;
        }
        __syncthreads();
        if (FULL) {
            const int tt = wave & 3, jh = wave >> 2, t = 16 * tt + c;
            f32x4 o[4];
#pragma unroll
            for (int x = 0; x < 4; ++x) o[x] = (f32x4){0.f, 0.f, 0.f, 0.f};
#pragma unroll
            for (int kk = 0; kk < 2; ++kk) { const bf16x8 bb = row_frag(lds + L::PM, PP, 16 * tt, kk, lane);
#pragma unroll
                for (int x = 0; x < 4; ++x) o[x] = MFMA16(tr_frag(lds + L::VV, PV, 32 * kk, 16 * (4 * jh + x), lane), bb, o[x]); }
#pragma unroll
            for (int kk = 0; kk < DK / 32; ++kk) { const bf16x8 bb = row_frag(lds + L::QS, PK, 16 * tt, kk, lane);
#pragma unroll
                for (int x = 0; x < 4; ++x) o[x] = MFMA16(row_frag(lds + L::ST, PK, 16 * (4 * jh + x), kk, lane), bb, o[x]); }
            float sm = 0.f, sq = 0.f;
#pragma unroll
            for (int x = 0; x < 4; ++x)
#pragma unroll
                for (int i = 0; i < 4; ++i) { sm += o[x][i]; sq += o[x][i] * o[x][i]; }
            sm += __shfl_xor(sm, 16); sq += __shfl_xor(sq, 16); sm += __shfl_xor(sm, 32); sq += __shfl_xor(sq, 32);
            LAS f32x2* RED = (LAS f32x2*)(lds + L::RED) + (ch & 1) * 128;
            if (g == 0) RED[jh * 64 + t] = (f32x2){sm, sq};
            __syncthreads();
            const f32x2 r0 = RED[t], r1 = RED[64 + t];
            const float mean = KIND == 2 ? (r0.x + r1.x) * (1.f / 128.f) : 0.f;
            const float rstd = rsqrtf(fmaxf((r0.y + r1.y) * (1.f / 128.f) - mean * mean, 0.f) + EPS);
            bf16* yp = U.YM + (row0 + t) * 1024 + K::ocol(h) + 16 * (4 * jh) + 4 * g;
#pragma unroll
            for (int x = 0; x < 4; ++x) {
                const float g0 = bf2f((bf16)(gq[x].x & 0xffff)), g1 = bf2f((bf16)(gq[x].x >> 16)), g2 = bf2f((bf16)(gq[x].y & 0xffff)), g3 = bf2f((bf16)(gq[x].y >> 16));
                v2u w; w.x = pg8::cvt_pk_bf16((o[x][0] - mean) * rstd * nw4[x][0] * siluf_(g0), (o[x][1] - mean) * rstd * nw4[x][1] * siluf_(g1));
                w.y = pg8::cvt_pk_bf16((o[x][2] - mean) * rstd * nw4[x][2] * siluf_(g2), (o[x][3] - mean) * rstd * nw4[x][3] * siluf_(g3));
                *(v2u*)(yp + 16 * x) = w; }
        }
    }
    if (!FULL) {
#pragma unroll
        for (int jt = 0; jt < NJT; ++jt)
#pragma unroll
            for (int i = 0; i < 4; ++i) Sg[(16 * dt + 4 * g + i) * 128 + 16 * (jt0 + jt) + c] = S[jt][i];
        __syncthreads();
        if (tid < DK) Bg[tid] = KIND == 0 ? BT[tid] : __expf(BT[tid]);
    }
    __syncthreads();
}
}


namespace rg {
constexpr int SEGMAX = 16;
constexpr int PX = 272, PW = 144, XCB = 0, XCF = 64 * PX, WT = XCF + 64 * 132 * 4, END = WT + 4 * 64 * PW;
static_assert(END <= LDS_MISC, "rglru LDS map");
template <bool FULL>
__device__ __forceinline__ void unit(LAS unsigned char* lds, const bf16* PROJ, bf16* YM, const float* const* in, int b, int c0, int nch, int sgi, int cg, float* RA, float* RH) {
    int tid = threadIdx.x; asm volatile("" : "+v"(tid));
    const int lane = tid & 63, wave = __builtin_amdgcn_readfirstlane(tid >> 6), g = lane >> 4, c = lane & 15;
    const int n0 = 2 * cg, chbase = cg * 128;
    const float* w_r = in[15]; const float* w_i = in[17];
    for (int i0 = tid; i0 < 4 * 4096; i0 += 512 * 16) { float t[16];
#pragma unroll
        for (int x = 0; x < 16; ++x) { const int i = i0 + 512 * x, m = i >> 12, gate = m >> 1, nb = m & 1, d = (i >> 6) & 63, e = i & 63; t[x] = (gate ? w_i : w_r)[((n0 + nb) * 64 + d) * 64 + e]; }
#pragma unroll
        for (int x = 0; x < 16; ++x) { const int i = i0 + 512 * x, m = i >> 12, d = (i >> 6) & 63, e = i & 63; *(LAS bf16*)(lds + WT + m * 64 * PW + e * PW + d * 2) = (bf16)f2bf(t[x]); } }
    float cw0[4], cw1[4]; const int cc = chbase + 2 * lane;
#pragma unroll
    for (int j = 0; j < 4; ++j) { cw0[j] = in[13][j * 512 + cc]; cw1[j] = in[13][j * 512 + cc + 1]; }
    const float cb0 = in[14][cc], cb1 = in[14][cc + 1];
    const int nb = wave >> 2, e0 = 16 * (wave & 3), chl = nb * 64 + e0 + c, chn = chbase + chl;
    const float brr = in[16][chn], bii = in[18][chn], sp = __logf(1.f + __expf(-in[19][chn]));
    float hcar = 0.f, atot = 1.f;
    if (FULL) {
        float fa[SEGMAX], fh[SEGMAX];
#pragma unroll
        for (int s = 0; s < SEGMAX; ++s) { const bool ok = s < sgi; fa[s] = ok ? RA[(s - sgi) * 512 + chn] : 1.f; fh[s] = ok ? RH[(s - sgi) * 512 + chn] : 0.f; }
#pragma unroll
        for (int s = 0; s < SEGMAX; ++s) hcar = s < sgi ? fa[s] * hcar + fh[s] : hcar;
    }
    unsigned xw[11];
    auto load_x = [&](int ch) {
#pragma unroll
        for (int r = 0; r < 11; ++r) { const int pos = (c0 + ch) * 64 + 8 * wave - 3 + r; xw[r] = 0u;
            if (pos >= 0) xw[r] = *(const unsigned*)(PROJ + ((size_t)b * SEQ + pos) * OD_N + 1536 + cc); }
    };
    load_x(0);
    __syncthreads();
    for (int ch = 0; ch < nch; ++ch) {
        const int pos0 = (c0 + ch) * 64; const size_t row0 = (size_t)b * SEQ + pos0;
        {
            float x0[11], x1[11];
#pragma unroll
            for (int r = 0; r < 11; ++r) { x0[r] = bf2f((bf16)(xw[r] & 0xffff)); x1[r] = bf2f((bf16)(xw[r] >> 16)); }
#pragma unroll
            for (int tt = 0; tt < 8; ++tt) {
                const float a0 = cb0 + cw0[0] * x0[tt] + cw0[1] * x0[tt + 1] + cw0[2] * x0[tt + 2] + cw0[3] * x0[tt + 3];
                const float a1 = cb1 + cw1[0] * x1[tt] + cw1[1] * x1[tt + 1] + cw1[2] * x1[tt + 2] + cw1[3] * x1[tt + 3];
                *(LAS unsigned*)(lds + XCB + (8 * wave + tt) * PX + 4 * lane) = pg8::cvt_pk_bf16(a0, a1);
                *(LAS f32x2*)(lds + XCF + ((8 * wave + tt) * 132 + 2 * lane) * 4) = (f32x2){a0, a1};
            }
        }
        if (ch + 1 < nch) load_x(ch + 1);
        bf16 gt[16];
        if (FULL) {
#pragma unroll
            for (int tt = 0; tt < 4; ++tt)
#pragma unroll
                for (int i = 0; i < 4; ++i) gt[4 * tt + i] = PROJ[(row0 + 16 * tt + 4 * g + i) * OD_N + 2048 + chn];
        }
        __syncthreads();
        f32x4 R[4], I[4];
#pragma unroll
        for (int tt = 0; tt < 4; ++tt) { R[tt] = (f32x4){0.f, 0.f, 0.f, 0.f}; I[tt] = R[tt]; }
#pragma unroll
        for (int kk = 0; kk < 2; ++kk) {
            const bf16x8 fr = mx::row_frag(lds + WT + nb * 64 * PW, PW, e0, kk, lane), fi = mx::row_frag(lds + WT + (2 + nb) * 64 * PW, PW, e0, kk, lane);
#pragma unroll
            for (int tt = 0; tt < 4; ++tt) { const bf16x8 a = mx::row_frag(lds + XCB + nb * 128, PX, 16 * tt, kk, lane); R[tt] = MFMA16(a, fr, R[tt]); I[tt] = MFMA16(a, fi, I[tt]); }
        }
#pragma unroll
        for (int tt = 0; tt < 4; ++tt) {
            float av[4], uv[4];
#pragma unroll
            for (int i = 0; i < 4; ++i) { const int t = 16 * tt + 4 * g + i;
                const float r = sigmoidf_(R[tt][i] + brr), ig = sigmoidf_(I[tt][i] + bii), la = -8.f * r * sp, a = __expf(la);
                av[i] = a; uv[i] = __builtin_amdgcn_sqrtf(fmaxf(1.f - a * a, 0.f)) * ig * *(const LAS float*)(lds + XCF + (t * 132 + chl) * 4); }
            float As = av[0] * av[1] * av[2] * av[3], Hs = ((uv[0] * av[1] + uv[1]) * av[2] + uv[2]) * av[3] + uv[3];
            float Ai = As, Hi = Hs;
            { const float Ap = __shfl(Ai, (lane - 16) & 63), Hp = __shfl(Hi, (lane - 16) & 63); if (g >= 1) { Hi = Hp * Ai + Hi; Ai = Ap * Ai; } }
            { const float Ap = __shfl(Ai, (lane - 32) & 63), Hp = __shfl(Hi, (lane - 32) & 63); if (g >= 2) { Hi = Hp * Ai + Hi; Ai = Ap * Ai; } }
            const float Ae = __shfl(Ai, (lane - 16) & 63), He = __shfl(Hi, (lane - 16) & 63), At = __shfl(Ai, 48 + c), Ht = __shfl(Hi, 48 + c);
            float h = g == 0 ? hcar : Ae * hcar + He;
            if (FULL) {
#pragma unroll
                for (int i = 0; i < 4; ++i) { const size_t row = row0 + 16 * tt + 4 * g + i; h = av[i] * h + uv[i];
                    YM[row * 1024 + 512 + chn] = (bf16)f2bf(h * gelu_tanh_(bf2f(gt[4 * tt + i]))); }
            }
            hcar = At * hcar + Ht; atot *= At;
        }
        __syncthreads();
    }
    if (!FULL && g == 0) { RA[chn] = atot; RH[chn] = hcar; }
}
}

constexpr int SEG_RET = 16, SEG_LRU = 16;
static_assert(SEG_LRU <= rg::SEGMAX, "RG-LRU segment count");
template <int SUB> __device__ __forceinline__ void phase_mix(Frame& F, int layer) {
    float* SG = (float*)(F.ws + WS_ST); float* BG = (float*)(F.ws + WS_ST + 16 * MiB);
    const bf16* PROJ = (const bf16*)(F.ws + WS_PROJ); bf16* YM = (bf16*)(F.ws + WS_ACT);
    float* RA = (float*)(F.ws + WS_ST + 16 * MiB + 256 * 1024); float* RH = RA + 2 * 32 * 512;
    const int S = layer == 0 ? 16 : SEG_RET;
    if (SUB == 1) {
        int tid = threadIdx.x; asm volatile("" : "+v"(tid));
        const int nel = (layer == 0 ? 16 : 8) * 16384;
        for (int idx = F.vcu * 512 + tid; idx < nel; idx += F.G * 512) {
            const int cidx = idx >> 14, e = idx & 16383, DK = (layer == 0 && cidx < 8) ? 128 : 64;
            if (e >= DK * 128) continue;
            const int d = e >> 7; float carry = 0.f;
            for (int seg = 0; seg < S; ++seg) { float* p = SG + (size_t)(cidx * S + seg) * 16384 + e; const float tmp = *p; *p = carry; carry = BG[(cidx * S + seg) * 128 + d] * carry + tmp; }
        }
        if (layer == 1) for (int idx = F.vcu * 512 + tid; idx < 1024; idx += F.G * 512) { const int bb = idx >> 9, cch = idx & 511; float carry = 0.f;
            for (int seg = 0; seg < SEG_LRU; ++seg) { const int o = (bb * SEG_LRU + seg) * 512 + cch; const float ta = RA[o], th = RH[o]; RH[o] = carry; carry = ta * carry + th; } }
        return;
    }
    for (int u = F.vcu; u < 256; u += F.G) {
        if (layer == 1 && u >= 8 * SEG_RET) {
            const int x = u - 8 * SEG_RET, bb = x / (4 * SEG_LRU), sg = (x >> 2) % SEG_LRU, cg = x & 3, c0 = (256 * sg) / SEG_LRU, nch = (256 * (sg + 1)) / SEG_LRU - c0;
            rg::unit<SUB == 2>(F.lds, PROJ, YM, F.in, bb, c0, nch, sg, cg, RA + (bb * SEG_LRU + sg) * 512, RH + (bb * SEG_LRU + sg) * 512);
            continue;
        }
        const int cidx = u / S, seg = u % S, chain = cidx & 7;
        mx::UnitP U; U.PROJ = PROJ; U.YM = YM; U.BL = (const float*)(F.ws + WS_BLOW); U.b = chain >> 2; U.h = chain & 3; U.p2 = nullptr;
        U.c0 = (256 * seg) / S; U.nch = (256 * (seg + 1)) / S - U.c0; U.seg = seg;
        float* Sg = SG + (size_t)(cidx * S + seg) * 16384; float* Bg = BG + (cidx * S + seg) * 128;
        if (layer == 0) {
            if (cidx < 8) { U.nw = F.in[6]; U.p0 = F.in[5]; U.p1 = nullptr; mx::mix_unit<0, SUB == 2>(F.lds, Sg, Bg, U); }
            else { U.nw = F.in[9]; U.p0 = F.in[7]; U.p1 = F.in[8]; mx::mix_unit<1, SUB == 2>(F.lds, Sg, Bg, U); }
        } else { U.nw = F.in[12]; U.p0 = nullptr; U.p1 = nullptr; mx::mix_unit<2, SUB == 2>(F.lds, Sg, Bg, U); }
    }
}

__device__ __forceinline__ void moe_poff(Frame& F, int layer) {
    PHASE_IDS(F);
    LAS int* poff = (LAS int*)(F.lds + LDS_MISC + 1024);
    const unsigned* cnt = F.ctl + CW_CNT + 64 * layer;
    __syncthreads();
    if (F.tid < 32) poff[33 + F.tid] = (int)cnt[F.tid];
    __syncthreads();
    if (F.tid == 0) { int acc = 0; for (int e = 0; e < 32; ++e) { poff[e] = acc; acc += (poff[33 + e] + 255) & ~255; } poff[32] = acc; }
    __syncthreads();
}
struct Args { const float* in[28]; float* out; unsigned char* ws; int ph_lo, ph_hi, li, pad; };
__global__ void __launch_bounds__(NWAVES * 64, 2) mega(Args args) {
    extern __shared__ __attribute__((aligned(16))) unsigned char lds[];
    Frame F;
    F.lds = (LAS unsigned char*)lds; F.tid = threadIdx.x; F.lane = F.tid & 63; F.wave = __builtin_amdgcn_readfirstlane(F.tid >> 6);
    F.G = gridDim.x; { const int bx = blockIdx.x; F.vcu = (F.G % 8 == 0) ? (bx % 8) * (F.G / 8) + bx / 8 : bx; }
    F.in = args.in; F.out = args.out; F.ws = args.ws; F.ctl = (unsigned*)(args.ws + WS_CTL);
    const int lo = args.ph_lo, hi = args.ph_hi;
    for (int u = F.tid; u < (LDS_BYTES - LDS_MISC) / 4; u += NWAVES * 64) ((LAS unsigned*)(F.lds + LDS_MISC))[u] = 0u;
    __syncthreads();
    XcdBarrier bar; bar.bar = F.ctl + CW_BAR + args.li * XCD_BAR_WORDS; bar.x = 0; bar.st = nullptr;
    if (hi - lo > 1) bar = xcd_barrier_post(F.ctl + CW_BAR + args.li * XCD_BAR_WORDS, (volatile LAS unsigned*)(F.lds + LDS_MISC + 32));
#ifndef ONLY_MASK
#define ONLY_MASK 0x7ffff
#endif
#define IN(k) (((ONLY_MASK >> (k)) & 1) && lo <= (k) && (k) < hi)
#define SEAM(k) do { if (IN(k) && IN((k) + 1)) xcd_barrier(bar); } while (0)
    bf16* ACT = (bf16*)(F.ws + WS_ACT); bf16* PROJ = (bf16*)(F.ws + WS_PROJ); bf16* H = (bf16*)(F.ws + WS_H); bf16* Y = (bf16*)(F.ws + WS_Y);
    const LAS int* poff = (const LAS int*)(F.lds + LDS_MISC + 1024);
    bf16* XR1 = (bf16*)F.out; bf16* XR2 = XR1 + (size_t)NT * D; bf16* XR3 = (bf16*)(F.ws + WS_W13);
    if (IN(0)) phase_prologue(F);
    SEAM(0);
#pragma unroll
    for (int l = 0; l < 2; ++l) {
        const int pb = 9 * l;
        if (IN(pb + 1)) {
            const int N = l == 0 ? EV_N : OD_N;
            for (int step = 0; step < 3; ++step) {
                if (step == 1) {
                    pg8::DenseOrder S; S.init(ACT, F.ws + (l == 0 ? WS_WIN0 : WS_WIN1), NT, N, 1024, F.G, (int)blockIdx.x);
                    pg8::EpiBf E{PROJ, N, 1.f};
                    pg8::gemm_phase<pg8::EpiBf, pg8::DenseOrder, true>(F.lds, 1024, S, E);
                } else if ((step == 0) == ((F.vcu & 1) == 0)) convert_moe(F, l);
            }
        }
        SEAM(pb + 1);
        {
            if (IN(pb + 2)) phase_mix<0>(F, l);
            SEAM(pb + 2);
            if (IN(pb + 4)) phase_mix<2>(F, l);
            SEAM(pb + 4);
        }
        if (IN(pb + 5)) {
            pg8::DenseOrder S; S.init(ACT, F.ws + (l == 0 ? WS_WOUT0 : WS_WOUT1), NT, 1024, 1024, F.G, (int)blockIdx.x);
            if (l == 0) { pg8::EpiRes<false> E{F.in[0], XR1, (float*)(F.ws + WS_SSQ)}; pg8::gemm_phase<pg8::EpiRes<false>, pg8::DenseOrder, true>(F.lds, 1024, S, E); }
            else { pg8::EpiRes<true> E{XR2, XR3, (float*)(F.ws + WS_SSQ)}; pg8::gemm_phase<pg8::EpiRes<true>, pg8::DenseOrder, true>(F.lds, 1024, S, E); }
        }
        SEAM(pb + 5);
        if (IN(pb + 6)) phase_router(F, l, l == 0 ? XR1 : XR3);
        SEAM(pb + 6);
        if (IN(pb + 7)) {
            moe_poff(F, l);
            pg8::MoeOrder S{poff, F.ctl + CW_CNT + 64 * l, (const int*)(F.ws + WS_LIST), (const char*)ACT, (const char*)(F.ws + WS_W13) + (size_t)l * 32 * 1024 * 1024 * 2, (size_t)1024 * 1024, 512, F.G, F.vcu, true};
            pg8::EpiUp E{(unsigned char*)H};
            pg8::gemm_phase<pg8::EpiUp, pg8::MoeOrder, true, true>(F.lds, 512, S, E);
        }
        SEAM(pb + 7);
        if (IN(pb + 8)) {
            moe_poff(F, l);
            pg8::MoeOrder S{poff, F.ctl + CW_CNT + 64 * l, (const int*)(F.ws + WS_LIST), (const char*)H, (const char*)(F.ws + WS_W2) + (size_t)l * 32 * 1024 * 512 * 2, (size_t)1024 * 512, 256, F.G, F.vcu, false};
            pg8::EpiF8 E{(unsigned char*)Y, 1024, 0.5f};
            pg8::gemm_phase<pg8::EpiF8, pg8::MoeOrder, true, true>(F.lds, 256, S, E);
        }
        SEAM(pb + 8);
        if (IN(pb + 9)) phase_combine(F, l, l == 0 ? XR1 : XR3, XR2);
        SEAM(pb + 9);
    }
#undef IN
#undef SEAM
}

extern "C" void kernel_launch(void* const* d_in, const int* in_sizes, int n_in, void* d_out, int out_size, void* d_ws, size_t ws_size, hipStream_t stream) {
    static int grid = 0;
    if (grid == 0) {
        if (n_in != 28 || out_size != NT * D || ws_size < WS_END) { fprintf(stderr, "kernel_launch: unexpected problem (n_in %d, out %d, ws %zu)\n", n_in, out_size, ws_size); grid = -1; return; }
        int dev = 0, cus = 0;
        if (hipGetDevice(&dev) != hipSuccess || hipDeviceGetAttribute(&cus, hipDeviceAttributeMultiprocessorCount, dev) != hipSuccess) { grid = -1; return; }
        if (hipFuncSetAttribute((const void*)mega, hipFuncAttributeMaxDynamicSharedMemorySize, LDS_BYTES) != hipSuccess) { fprintf(stderr, "kernel_launch: hipFuncSetAttribute failed\n"); grid = -1; return; }
        (void)hipGetLastError();
        grid = cus;
    }
    if (grid < 0) return;
    (void)hipMemsetAsync((char*)d_ws + WS_CTL, 0, CTL_BYTES, stream);
    Args a{};
    for (int i = 0; i < 28; ++i) a.in[i] = (const float*)d_in[i];
    a.out = (float*)d_out; a.ws = (unsigned char*)d_ws;
    int nli = 0;
    auto run = [&](int lo, int hi) { a.ph_lo = lo; a.ph_hi = hi; a.li = (hi - lo > 1) ? nli++ : 0; hipLaunchKernelGGL(mega, dim3(grid), dim3(NWAVES * 64), LDS_BYTES, stream, a); };
    run(0, 19);
}
```
